# Optimizing an MI355X kernel written in HIP

```python
import jax, jax.numpy as jnp
from jax import lax
import numpy as np

D_MODEL = 2048
BATCH = 2
SEQ = 4096
DEPTH = 1

HEAD_DIM = 64
N_Q_HEADS = 16
N_KV_HEADS = 4
GQA_GROUP = N_Q_HEADS // N_KV_HEADS
ATTN_WIDTH = N_Q_HEADS * HEAD_DIM
KV_WIDTH = N_KV_HEADS * HEAD_DIM
WINDOW = 128
ATTN_BLOCK = 128
ROPE_THETA = 500000.0
ROT_DIM = HEAD_DIM // 4
POOL_WINDOWS = (2, 4, 8, 16)
N_POOL_GROUPS = len(POOL_WINDOWS)
POOL_WIDTH = D_MODEL // 2
POOL_GROUP_WIDTH = POOL_WIDTH // N_POOL_GROUPS
MIX_WIDTH = ATTN_WIDTH + POOL_WIDTH
IN_WIDTH = ATTN_WIDTH + 2 * KV_WIDTH + POOL_WIDTH
PEER_HEADS = 8
PEER_KEY_DIM = 256
PEER_HALF = PEER_KEY_DIM // 2
PEER_N_KEYS = 128
PEER_N_EXPERTS = PEER_N_KEYS * PEER_N_KEYS
PEER_TOPK = 16
PEER_CHUNK = 128
PLE_DIM = 256
RMS_EPS = 1e-6

kernel_name = "hymba_swa_pool_peer_block"


def rmsnorm(x, g):
    xf = x.astype(jnp.float32)
    y = xf * lax.rsqrt(jnp.mean(xf * xf, axis=-1, keepdims=True) + RMS_EPS)
    return (y * g.astype(jnp.float32)).astype(x.dtype)


def rope_tables(positions):
    inv_freq = 1.0 / (ROPE_THETA ** (jnp.arange(0, ROT_DIM, 2, dtype=jnp.float32) / ROT_DIM))
    ang = positions.astype(jnp.float32)[..., None] * inv_freq
    return jnp.cos(ang)[:, :, None, :], jnp.sin(ang)[:, :, None, :]


def apply_partial_rope(x, cos, sin):
    half = ROT_DIM // 2
    xr = x[..., :ROT_DIM].astype(jnp.float32)
    x1, x2 = xr[..., :half], xr[..., half:]
    rot = jnp.concatenate([x1 * cos - x2 * sin, x2 * cos + x1 * sin], axis=-1).astype(x.dtype)
    return jnp.concatenate([rot, x[..., ROT_DIM:]], axis=-1)


def sliding_window_attention(q, k, v, sinks):
    B, S = q.shape[0], q.shape[1]
    nb = S // ATTN_BLOCK
    qb = q.reshape(B, nb, ATTN_BLOCK, N_KV_HEADS, GQA_GROUP, HEAD_DIM)
    kb = k.reshape(B, nb, ATTN_BLOCK, N_KV_HEADS, HEAD_DIM)
    vb = v.reshape(B, nb, ATTN_BLOCK, N_KV_HEADS, HEAD_DIM)
    pad = ((0, 0), (1, 0), (0, 0), (0, 0), (0, 0))
    k_band = jnp.concatenate([jnp.pad(kb, pad)[:, :-1], kb], axis=2)
    v_band = jnp.concatenate([jnp.pad(vb, pad)[:, :-1], vb], axis=2)
    scale = HEAD_DIM ** -0.5
    s = jnp.einsum('bnqhgd,bnshd->bnhgqs', qb, k_band).astype(jnp.float32) * scale
    qi = jnp.arange(ATTN_BLOCK)[:, None] + ATTN_BLOCK
    kj = jnp.arange(2 * ATTN_BLOCK)[None, :]
    rel = qi - kj
    band = (rel >= 0) & (rel < WINDOW)
    has_prev = (jnp.arange(nb) > 0)[:, None, None] | (kj >= ATTN_BLOCK)[None]
    mask = band[None] & has_prev
    s = jnp.where(mask[None, :, None, None], s, jnp.finfo(jnp.float32).min)
    sink = sinks.astype(jnp.float32).reshape(N_KV_HEADS, GQA_GROUP)[None, None, :, :, None, None]
    sink = jnp.broadcast_to(sink, s.shape[:-1] + (1,))
    probs = jax.nn.softmax(jnp.concatenate([s, sink], axis=-1), axis=-1)[..., :-1]
    o = jnp.einsum('bnhgqs,bnshd->bnqhgd', probs.astype(v.dtype), v_band)
    return o.reshape(B, S, N_Q_HEADS * HEAD_DIM)


def multiscale_pool(u, w_pool, pool_scale):
    B, S = u.shape[0], u.shape[1]
    ug = u.reshape(B, S, N_POOL_GROUPS, POOL_GROUP_WIDTH)
    t = jnp.arange(S)
    outs = []
    for gi, w in enumerate(POOL_WINDOWS):
        xg = ug[:, :, gi, :].astype(jnp.float32)
        cs = jnp.cumsum(xg, axis=1)
        shifted = jnp.pad(cs, ((0, 0), (w, 0), (0, 0)))[:, :S]
        count = jnp.minimum(t + 1, w).astype(jnp.float32)[None, :, None]
        outs.append((cs - shifted) / count - xg)
    pooled = jnp.stack(outs, axis=2).astype(u.dtype)
    mixed = jnp.einsum('bsgc,gce->bsge', pooled, w_pool)
    return mixed.reshape(B, S, POOL_WIDTH) * pool_scale


def peer_ffn(xn, w_query, sub_keys, expert_u, expert_v):
    B, S, D = xn.shape
    q = (xn @ w_query).reshape(B, S, PEER_HEADS, PEER_KEY_DIM).astype(jnp.float32)
    sk = sub_keys.astype(jnp.float32)
    s1 = jnp.einsum('bshd,nd->bshn', q[..., :PEER_HALF], sk[0])
    s2 = jnp.einsum('bshd,nd->bshn', q[..., PEER_HALF:], sk[1])
    v1, i1 = lax.top_k(s1, PEER_TOPK)
    v2, i2 = lax.top_k(s2, PEER_TOPK)
    cand = (v1[..., :, None] + v2[..., None, :]).reshape(B, S, PEER_HEADS, PEER_TOPK * PEER_TOPK)
    cidx = (i1[..., :, None] * PEER_N_KEYS + i2[..., None, :]).reshape(B, S, PEER_HEADS, PEER_TOPK * PEER_TOPK)
    top, pos = lax.top_k(cand, PEER_TOPK)
    eidx = jnp.take_along_axis(cidx, pos, axis=-1)
    gates = jax.nn.softmax(top, axis=-1).astype(xn.dtype)
    T = B * S
    nc = T // PEER_CHUNK
    K = PEER_HEADS * PEER_TOPK
    xt = xn.reshape(nc, PEER_CHUNK, D)
    it = eidx.reshape(nc, PEER_CHUNK, K)
    gt = gates.reshape(nc, PEER_CHUNK, K)

    def expert_block(args):
        xc, ic, gc = args
        u = jnp.take(expert_u, ic, axis=0)
        h = jnp.einsum('cd,ckd->ck', xc, u)
        a = gc * jax.nn.gelu(h, approximate=False)
        v = jnp.take(expert_v, ic, axis=0)
        return jnp.einsum('ck,ckd->cd', a, v)

    out = lax.map(expert_block, (xt, it, gt))
    return out.reshape(B, S, D)


def setup_inputs(seed: int = 0) -> dict:
    key = jax.random.key(seed)
    ks = jax.random.split(key, 20)
    f32 = jnp.float32
    n = lambda k, shape, s: jax.random.normal(k, shape, f32) * s
    x = jax.random.normal(ks[0], (BATCH, SEQ, D_MODEL), f32)
    p = jax.random.normal(ks[1], (DEPTH, BATCH, SEQ, PLE_DIM), f32)
    offsets = jax.random.randint(ks[2], (BATCH, 1), 0, 1024, dtype=jnp.int32)
    positions = (offsets + jnp.arange(SEQ, dtype=jnp.int32)[None, :]).astype(jnp.int32)
    return {
        "x": x,
        "p": p,
        "positions": positions,
        "g_mix": 1.0 + n(ks[3], (DEPTH, D_MODEL), 0.05),
        "w_in": n(ks[4], (DEPTH, D_MODEL, IN_WIDTH), D_MODEL ** -0.5),
        "sinks": n(ks[5], (DEPTH, N_Q_HEADS), 0.5),
        "w_pool": n(ks[6], (DEPTH, N_POOL_GROUPS, POOL_GROUP_WIDTH, POOL_GROUP_WIDTH), POOL_GROUP_WIDTH ** -0.5),
        "pool_scale": 1.0 + n(ks[7], (DEPTH, POOL_WIDTH), 0.1),
        "w_out": n(ks[8], (DEPTH, MIX_WIDTH, D_MODEL), MIX_WIDTH ** -0.5),
        "g_ffn": 1.0 + n(ks[9], (DEPTH, D_MODEL), 0.05),
        "w_query": n(ks[10], (DEPTH, D_MODEL, PEER_HEADS * PEER_KEY_DIM), D_MODEL ** -0.5),
        "sub_keys": n(ks[11], (DEPTH, 2, PEER_N_KEYS, PEER_HALF), PEER_HALF ** -0.5),
        "expert_u": n(ks[12], (DEPTH, PEER_N_EXPERTS, D_MODEL), D_MODEL ** -0.5),
        "expert_v": n(ks[13], (DEPTH, PEER_N_EXPERTS, D_MODEL), 0.5),
        "g_ple": 1.0 + n(ks[14], (DEPTH, D_MODEL), 0.05),
        "w_ple_gate": n(ks[15], (DEPTH, D_MODEL, D_MODEL), D_MODEL ** -0.5),
        "w_ple_proj": n(ks[16], (DEPTH, PLE_DIM, D_MODEL), PLE_DIM ** -0.5),
        "g_final": 1.0 + n(ks[17], (D_MODEL,), 0.05),
    }


def reference(x, p, positions, g_mix, w_in, sinks, w_pool, pool_scale, w_out, g_ffn,
              w_query, sub_keys, expert_u, expert_v, g_ple, w_ple_gate, w_ple_proj, g_final):
    B, S = x.shape[0], x.shape[1]
    cos, sin = rope_tables(positions)
    h = x
    for i in range(DEPTH):
        hn = rmsnorm(h, g_mix[i])
        proj = hn @ w_in[i]
        q = proj[..., :ATTN_WIDTH].reshape(B, S, N_Q_HEADS, HEAD_DIM)
        k = proj[..., ATTN_WIDTH:ATTN_WIDTH + KV_WIDTH].reshape(B, S, N_KV_HEADS, HEAD_DIM)
        v = proj[..., ATTN_WIDTH + KV_WIDTH:ATTN_WIDTH + 2 * KV_WIDTH].reshape(B, S, N_KV_HEADS, HEAD_DIM)
        u = proj[..., ATTN_WIDTH + 2 * KV_WIDTH:]
        q = apply_partial_rope(q, cos, sin)
        k = apply_partial_rope(k, cos, sin)
        attn = sliding_window_attention(q, k, v, sinks[i])
        pool = multiscale_pool(u, w_pool[i], pool_scale[i])
        h = h + jnp.concatenate([attn, pool], axis=-1) @ w_out[i]
        h = h + peer_ffn(rmsnorm(h, g_ffn[i]), w_query[i], sub_keys[i], expert_u[i], expert_v[i])
        gate = jax.nn.sigmoid(rmsnorm(h, g_ple[i]) @ w_ple_gate[i])
        h = h + gate * (p[i] @ w_ple_proj[i])
    return rmsnorm(h, g_final)
```

```cpp
#include <hip/hip_runtime.h>
#include <cstdio>
#include <cstdint>
namespace pg8 {
#define PG8_LAS __attribute__((address_space(3)))
typedef unsigned short bf16_t;
typedef short bf16x8 __attribute__((ext_vector_type(8)));
typedef float f32x4 __attribute__((ext_vector_type(4)));
typedef unsigned u32x4 __attribute__((ext_vector_type(4)));
constexpr int BM = 256, BK = 64, HALF = 128, HTB = HALF * BK * 2  , STAGE_BYTES = 8 * HTB, NXCD = 8, WGM = 8;

__host__ __device__ __forceinline__ int lds_byte(int r, int c) { const int st = (r >> 4) * 2 + (c >> 5), rr = r & 15, cc = c & 31, ob = rr * 64 + cc * 2; return st * 1024 + (ob ^ (((ob >> 9) & 1) << 5)); }
__host__ __device__ __forceinline__ void stage_rc(int b, int& R, int& C) { const int st = b / 1024, sb = b % 1024, swz = sb ^ (((sb >> 9) & 1) << 5); R = (st >> 1) * 16 + swz / 64; C = (st & 1) * 32 + (swz % 64) / 2; }
__host__ __device__ __forceinline__ int perm32(int rho) { const int n = rho >> 4, i = rho & 15; return 8 * (i >> 2) + 4 * n + (i & 3); }

struct Unit { int pm, pn; };
struct Gemm { const bf16_t* A; const bf16_t* Bt; int M, N, K, lda, ldb; };

struct StaticOrder {
    int nM, nN, nwg, G, c;
    __host__ __device__ void init(int M, int N, int G_, int c_) { nM = M / BM; nN = N / BM; nwg = nM * nN; G = G_; c = c_; }
    __host__ __device__ bool next(int i, Unit& u) const {
        const long L = (long)i * G + c; if (L >= nwg) return false;
        int wgid = (int)L; { const int q = nwg / NXCD, r = nwg % NXCD, xcd = wgid % NXCD, off = wgid / NXCD; wgid = (xcd < r ? xcd * (q + 1) : r * (q + 1) + (xcd - r) * q) + off; }
        const int nig = WGM * nN, gid = wgid / nig, fm = gid * WGM, gsz = (nM - fm) < WGM ? (nM - fm) : WGM;
        u.pm = fm + ((wgid % nig) % gsz); u.pn = (wgid % nig) / gsz; return true;
    }
    __device__ __forceinline__ void a_ready(const Unit&) const {}
    __device__ __forceinline__ void done(const Unit&) const {}
};

__device__ __forceinline__ unsigned cvt_pk_bf16(float lo, float hi) { unsigned r; asm volatile("v_cvt_pk_bf16_f32 %0, %1, %2" : "=v"(r) : "v"(lo), "v"(hi)); return r; }
typedef float f32x2 __attribute__((ext_vector_type(2)));

template <class Epi, class Sched, bool ALIGN_EPI = false, bool SP2 = false>
__device__ __forceinline__ void gemm_phase(PG8_LAS unsigned char* lds, const Gemm g, const Sched& S, const Epi& E) {
    const int tid = threadIdx.x, wid = __builtin_amdgcn_readfirstlane(tid >> 6), lane = tid & 63, wr = wid >> 2, wc = wid & 3, fr = lane & 15, fq = lane >> 4;
    const int K = g.K, nt = K / BK;
    unsigned voffA[2], voffB[2];
#pragma unroll
    for (int i = 0; i < 2; ++i) { int R, C; stage_rc(tid * 16 + i * 8192, R, C); const int Rb = Epi::PERM ? ((R & ~31) + perm32(R & 31)) : R;
        voffA[i] = (unsigned)(R * g.lda + C) * 2u; voffB[i] = (unsigned)(Rb * g.ldb + C) * 2u; }
    const size_t kstep = (size_t)(BK * 2);
    const size_t hstepA = (size_t)HALF * g.lda * 2, hstepB = (size_t)HALF * g.ldb * 2;
    const size_t tstepA = 2 * hstepA, tstepB = 2 * hstepB;
    const unsigned ldsw = (unsigned)wid * 1024u;
    const int aoff = lds_byte(wr * 64 + fr, fq * 8), boff = lds_byte(wc * 32 + fr, fq * 8);
#define PG8_SA(b, h) (((b) * 2 + (h)) * HTB)
#define PG8_SB(b, h) ((4 + (b) * 2 + (h)) * HTB)
#define PG8_STAGE(bufoff, gbase, voff) do { _Pragma("unroll") for (int _i = 0; _i < 2; ++_i) \
        __builtin_amdgcn_global_load_lds((const unsigned*)((const char*)(gbase) + (voff)[_i]), (PG8_LAS unsigned*)(lds + (bufoff) + ldsw + _i * 8192), 16, 0, 0); } while (0)
#define PG8_LDA(dst, b, h) do { _Pragma("unroll") for (int m = 0; m < 4; ++m) _Pragma("unroll") for (int k = 0; k < 2; ++k) dst[m][k] = *(const PG8_LAS bf16x8*)(lds + PG8_SA(b, h) + aoff + m * 2048 + k * 1024); } while (0)
#define PG8_LDB(dst, b, h) do { _Pragma("unroll") for (int n = 0; n < 2; ++n) _Pragma("unroll") for (int k = 0; k < 2; ++k) dst[n][k] = *(const PG8_LAS bf16x8*)(lds + PG8_SB(b, h) + boff + n * 2048 + k * 1024); } while (0)
#define PG8_MMA(ai, bj, At, Bt) do { __builtin_amdgcn_s_setprio(1); _Pragma("unroll") for (int m = 0; m < 4; ++m) _Pragma("unroll") for (int n = 0; n < 2; ++n) _Pragma("unroll") for (int k = 0; k < 2; ++k) \
        acc[ai][bj][m][n] = __builtin_amdgcn_mfma_f32_16x16x32_bf16(Bt[n][k], At[m][k], acc[ai][bj][m][n], 0, 0, 0); __builtin_amdgcn_s_setprio(0); } while (0)
#define PG8_WAIT_V(n) asm volatile("s_waitcnt vmcnt(" #n ")" ::: "memory")
#define PG8_WAIT_L(n) asm volatile("s_waitcnt lgkmcnt(" #n ")" ::: "memory")
#define PG8_BAR __builtin_amdgcn_s_barrier()
#define PG8_SCHED __builtin_amdgcn_sched_barrier(0)
    Unit cur, nxt; int ui = 0;
    if (!S.next(0, cur)) return;
    f32x4 acc[2][2][4][2];
#pragma unroll
    for (int a = 0; a < 2; ++a)
#pragma unroll
        for (int b = 0; b < 2; ++b)
#pragma unroll
            for (int m = 0; m < 4; ++m)
#pragma unroll
                for (int n = 0; n < 2; ++n) acc[a][b][m][n] = (f32x4){0.f, 0.f, 0.f, 0.f};
    bf16x8 At[4][2], B0[2][2], B1[2][2];
    const char* cA = (const char*)g.A + (size_t)cur.pm * tstepA; const char* cB = (const char*)g.Bt + (size_t)cur.pn * tstepB;
    S.a_ready(cur);
    if constexpr (SP2) {
        PG8_STAGE(PG8_SB(0, 0), cB, voffB); PG8_STAGE(PG8_SB(0, 1), cB + hstepB, voffB); PG8_STAGE(PG8_SA(0, 0), cA, voffA); PG8_STAGE(PG8_SA(0, 1), cA + hstepA, voffA);
        if (wr == 1) PG8_BAR;
        PG8_WAIT_V(2); PG8_BAR;
        PG8_STAGE(PG8_SB(1, 0), cB + kstep, voffB); PG8_STAGE(PG8_SA(1, 0), cA + kstep, voffA); PG8_STAGE(PG8_SB(1, 1), cB + hstepB + kstep, voffB);
        PG8_WAIT_V(6); PG8_BAR;
    } else {
        PG8_STAGE(PG8_SB(0, 0), cB, voffB); PG8_STAGE(PG8_SA(0, 0), cA, voffA); PG8_STAGE(PG8_SB(0, 1), cB + hstepB, voffB); PG8_STAGE(PG8_SA(0, 1), cA + hstepA, voffA);
        if (wr == 1) PG8_BAR;
        PG8_WAIT_V(4); PG8_BAR;
        PG8_STAGE(PG8_SB(1, 0), cB + kstep, voffB); PG8_STAGE(PG8_SA(1, 0), cA + kstep, voffA); PG8_STAGE(PG8_SB(1, 1), cB + hstepB + kstep, voffB);
        PG8_WAIT_V(6); PG8_BAR;
    }
    for (;;) {
        const bool has_next = S.next(ui + 1, nxt);
        const char* nA = has_next ? (const char*)g.A + (size_t)nxt.pm * tstepA : cA; const char* nB = has_next ? (const char*)g.Bt + (size_t)nxt.pn * tstepB : cB;
        for (int t = 0; t < nt; t += 2) {
            const bool last = (t == nt - 2);
            const char* a1 = cA + (size_t)(t + 1) * kstep;
            const char* a2 = last ? nA : cA + (size_t)(t + 2) * kstep; const char* b2 = last ? nB : cB + (size_t)(t + 2) * kstep;
            const char* a3 = a2 + kstep; const char* b3 = b2 + kstep;
            if (last && has_next) S.a_ready(nxt);
            if constexpr (SP2) {
            PG8_LDB(B0, 0, 0); PG8_LDB(B1, 0, 1); PG8_SCHED; PG8_LDA(At, 0, 0); PG8_STAGE(PG8_SA(1, 1), a1 + hstepA, voffA);
            PG8_WAIT_V(8); PG8_WAIT_L(0); PG8_BAR; PG8_MMA(0, 0, At, B0); PG8_MMA(0, 1, At, B1); PG8_BAR; PG8_SCHED;
            PG8_LDA(At, 0, 1); PG8_STAGE(PG8_SB(0, 0), b2, voffB); PG8_STAGE(PG8_SB(0, 1), b2 + hstepB, voffB); PG8_STAGE(PG8_SA(0, 0), a2, voffA);
            PG8_WAIT_V(8); PG8_WAIT_L(0); PG8_BAR; PG8_MMA(1, 0, At, B0); PG8_MMA(1, 1, At, B1); PG8_BAR; PG8_SCHED;
            PG8_LDB(B0, 1, 0); PG8_LDB(B1, 1, 1); PG8_SCHED; PG8_LDA(At, 1, 0); PG8_STAGE(PG8_SA(0, 1), a2 + hstepA, voffA);
            PG8_WAIT_V(8); PG8_WAIT_L(0); PG8_BAR; PG8_MMA(0, 0, At, B0); PG8_MMA(0, 1, At, B1); PG8_BAR; PG8_SCHED;
            PG8_LDA(At, 1, 1); PG8_STAGE(PG8_SB(1, 0), b3, voffB); PG8_STAGE(PG8_SB(1, 1), b3 + hstepB, voffB); PG8_STAGE(PG8_SA(1, 0), a3, voffA);
            PG8_WAIT_V(8); PG8_WAIT_L(0); PG8_BAR; PG8_MMA(1, 0, At, B0); PG8_MMA(1, 1, At, B1); PG8_BAR; PG8_SCHED;
            } else {
            PG8_LDB(B0, 0, 0); PG8_SCHED; PG8_LDA(At, 0, 0); PG8_STAGE(PG8_SA(1, 1), a1 + hstepA, voffA);
            PG8_WAIT_L(8); PG8_BAR; PG8_WAIT_L(0); PG8_MMA(0, 0, At, B0); PG8_BAR; PG8_SCHED;
            PG8_LDB(B1, 0, 1); PG8_STAGE(PG8_SB(0, 0), b2, voffB);
            PG8_BAR; PG8_WAIT_L(0); PG8_MMA(0, 1, At, B1); PG8_BAR;
            PG8_LDA(At, 0, 1); PG8_STAGE(PG8_SA(0, 0), a2, voffA);
            PG8_BAR; PG8_WAIT_L(0); PG8_MMA(1, 0, At, B0); PG8_BAR; PG8_SCHED;
            PG8_STAGE(PG8_SB(0, 1), b2 + hstepB, voffB);
            PG8_WAIT_V(6); PG8_BAR; PG8_MMA(1, 1, At, B1); PG8_BAR;
            PG8_LDB(B0, 1, 0); PG8_SCHED; PG8_LDA(At, 1, 0); PG8_STAGE(PG8_SA(0, 1), a2 + hstepA, voffA);
            PG8_WAIT_L(8); PG8_BAR; PG8_WAIT_L(0); PG8_MMA(0, 0, At, B0); PG8_BAR; PG8_SCHED;
            PG8_LDB(B1, 1, 1); PG8_STAGE(PG8_SB(1, 0), b3, voffB);
            PG8_BAR; PG8_WAIT_L(0); PG8_MMA(0, 1, At, B1); PG8_BAR;
            PG8_LDA(At, 1, 1); PG8_STAGE(PG8_SA(1, 0), a3, voffA);
            PG8_BAR; PG8_WAIT_L(0); PG8_MMA(1, 0, At, B0); PG8_BAR; PG8_SCHED;
            PG8_STAGE(PG8_SB(1, 1), b3 + hstepB, voffB);
            PG8_WAIT_V(6); PG8_BAR; PG8_MMA(1, 1, At, B1); PG8_BAR;
            }
        }
        if constexpr (ALIGN_EPI) { if (wr == 0) PG8_BAR; }
        if constexpr (!Epi::AFTER_DRAIN) { E(acc, cur, wr, wc, fr, fq); S.done(cur); }
        if (!has_next) break;
#pragma unroll
        for (int a = 0; a < 2; ++a)
#pragma unroll
            for (int b = 0; b < 2; ++b)
#pragma unroll
                for (int m = 0; m < 4; ++m)
#pragma unroll
                    for (int n = 0; n < 2; ++n) acc[a][b][m][n] = (f32x4){0.f, 0.f, 0.f, 0.f};
        cur = nxt; cA = nA; cB = nB; ++ui;
        if constexpr (ALIGN_EPI) { if (wr == 1) PG8_BAR; }
    }
    PG8_WAIT_V(0);
    if constexpr (!ALIGN_EPI) { if (wr == 0) PG8_BAR; }
    PG8_BAR;
    if constexpr (Epi::AFTER_DRAIN) { E.fused(acc, cur, wr, wc, fr, fq, lds, wid, lane); S.done(cur); }
#undef PG8_SA
#undef PG8_SB
#undef PG8_STAGE
#undef PG8_LDA
#undef PG8_LDB
#undef PG8_MMA
#undef PG8_WAIT_V
#undef PG8_WAIT_L
#undef PG8_BAR
#undef PG8_SCHED
}
}


constexpr int NWAVES = 8;
constexpr int DM = 2048, BATCH = 2, SEQ = 4096, M = BATCH * SEQ;
constexpr int HD = 64, NQH = 16, NKVH = 4, ATTW = 1024, KVW = 256, POOLW = 1024, INW = 2560;
constexpr int PKH = 8, NEXP = 16384, PLE = 256;
constexpr float EPS = 1e-6f;
#ifndef MK_N_LAUNCHES
#define MK_N_LAUNCHES 1
#endif
constexpr int N_PHASES = 9;
#ifndef DBG_NO_PEER
#define DBG_NO_PEER 0
#endif
#ifndef DBG_NO_PLE
#define DBG_NO_PLE 0
#endif
#ifndef DBG_NO_MIX
#define DBG_NO_MIX 0
#endif

constexpr size_t MiB = 1u << 20;
constexpr size_t WS_CTL = 0, CTL_ZERO_BYTES = 256 * 1024;
constexpr size_t WS_WIN = 1 * MiB, WS_WOUT = 11 * MiB, WS_WQ = 19 * MiB, WS_WG = 27 * MiB, WS_WP = 35 * MiB, WS_WPOOL = 36 * MiB;
constexpr size_t WS_SKH = 36 * MiB + 512 * 1024, WS_SKL = WS_SKH + 64 * 1024;
constexpr size_t WS_ROPE = 37 * MiB;
constexpr size_t WS_RSTD1 = 37 * MiB + 512 * 1024, WS_RSTD3 = WS_RSTD1 + 32 * 1024;
constexpr size_t WS_EU = 38 * MiB, WS_EV = 102 * MiB;
constexpr size_t WS_XB = 166 * MiB, WS_PB = 198 * MiB;
constexpr size_t WS_Q = 202 * MiB, WS_K = 218 * MiB, WS_V = 222 * MiB, WS_U = 226 * MiB, WS_POOLED = 242 * MiB, WS_MIX = 258 * MiB;
constexpr size_t WS_QP = 202 * MiB;
constexpr size_t WS_EIDX = 266 * MiB, WS_GATE = 270 * MiB;
constexpr size_t WS_H1 = 290 * MiB, WS_H1B = 354 * MiB, WS_PP = 386 * MiB, WS_H2B = 418 * MiB, WS_END = 450 * MiB;
constexpr int CW_BAR = 4096;
constexpr int CW_SSQ2 = 16384, CW_SSQ4 = 16384 + 8192;
static_assert((CW_SSQ4 + 8192) * 4 <= (int)CTL_ZERO_BYTES, "ctl");

constexpr int RING_OFF = 0, RING_BYTES = 131072;
constexpr int LDSCTL_OFF = RING_BYTES, MISC_OFF = LDSCTL_OFF + 320;
constexpr int LDS_BYTES = 147456;

#define GAS __attribute__((address_space(1)))
#define LAS __attribute__((address_space(3)))
typedef unsigned short bf16;
typedef unsigned v4u __attribute__((ext_vector_type(4)));
typedef unsigned v2u __attribute__((ext_vector_type(2)));
typedef float f32x4 __attribute__((ext_vector_type(4)));
typedef float f32x16 __attribute__((ext_vector_type(16)));
typedef short bf16x8 __attribute__((ext_vector_type(8)));
typedef GAS unsigned gu32;
#define RLX_AGENT __ATOMIC_RELAXED, __HIP_MEMORY_SCOPE_AGENT
#define LDS_WAIT() asm volatile("s_waitcnt lgkmcnt(0)" ::: "memory")
#define VM_WAIT() asm volatile("s_waitcnt vmcnt(0)" ::: "memory")
typedef float f32x2_t __attribute__((ext_vector_type(2))); typedef __bf16 bf16x2_t __attribute__((ext_vector_type(2)));
__device__ __forceinline__ unsigned pk2(float lo, float hi) { f32x2_t v = {lo, hi}; bf16x2_t b = __builtin_convertvector(v, bf16x2_t); return __builtin_bit_cast(unsigned, b); }
__device__ __forceinline__ float bf_lo(unsigned w) { return __uint_as_float(w << 16); }
__device__ __forceinline__ float bf_hi(unsigned w) { return __uint_as_float(w & 0xffff0000u); }
__device__ __forceinline__ float dot2bf(unsigned a, unsigned b, float c) { return __builtin_amdgcn_fdot2_f32_bf16(__builtin_bit_cast(bf16x2_t, a), __builtin_bit_cast(bf16x2_t, b), c, false); }
__device__ __forceinline__ float max2f(float a, float b) { float r; asm("v_max_f32_e32 %0, %1, %2" : "=v"(r) : "v"(a), "v"(b)); return r; }
__device__ __forceinline__ float min2f(float a, float b) { float r; asm("v_min_f32_e32 %0, %1, %2" : "=v"(r) : "v"(a), "v"(b)); return r; }
__device__ __forceinline__ float wave_sum(float v) {
#pragma unroll
    for (int o = 1; o < 64; o <<= 1) v += __shfl_xor(v, o);
    return v;
}

#define XB_TMO      128
#define XB_XCNT(j)  (256  + 64 * (j))
#define XB_XSUB(j)  (1280 + 64 * (j))
#define XB_XGEN(j)  (2304 + 64 * (j))
#define XB_TOP      3328
#define XB_TOPGEN   3392
#define XCD_BAR_WORDS 3456
#define XB_SPIN_CAP (1u << 18)
__device__ __forceinline__ unsigned xb_ld(unsigned* p)              { return __hip_atomic_load(p, __ATOMIC_RELAXED, __HIP_MEMORY_SCOPE_AGENT); }
__device__ __forceinline__ unsigned xb_add(unsigned* p, unsigned v) { return __hip_atomic_fetch_add(p, v, __ATOMIC_RELAXED, __HIP_MEMORY_SCOPE_AGENT); }
__device__ __forceinline__ unsigned xb_xcc_id() { return (unsigned)__builtin_amdgcn_s_getreg((3 << 11) | 20) & 0xFu; }
#define XB_SPIN(cond, bar) do { unsigned _sp = 0; while (cond) { __builtin_amdgcn_s_sleep(1); \
    if ((++_sp & 255u) == 0u) { if (xb_ld(&(bar)[XB_TMO])) break; if (_sp > XB_SPIN_CAP) { atomicAdd(&(bar)[XB_TMO], 1u); break; } } } } while (0)
struct XcdBarrier { unsigned* bar; unsigned x; volatile LAS unsigned* st; };
__device__ __forceinline__ XcdBarrier xcd_barrier_post(unsigned* bar, volatile LAS unsigned* st) {
    XcdBarrier b; b.bar = bar; b.x = xb_xcc_id(); b.st = st;
    if (threadIdx.x == 0) (void)xb_add(&bar[XB_XCNT(b.x)], 1u);
    return b;
}
__device__ __forceinline__ void xcd_barrier_complete(unsigned* bar, unsigned x, unsigned& nloc, unsigned& nx) {
    const unsigned G = gridDim.x * gridDim.y * gridDim.z;
    unsigned sum, cnt, mine, sp = 0u;
    for (;;) {
        sum = 0u; cnt = 0u; mine = 0u;
#pragma unroll
        for (unsigned j = 0; j < 16; ++j) { const unsigned c = xb_ld(&bar[XB_XCNT(j)]); sum += c; cnt += (c > 0u) ? 1u : 0u; mine = (j == x) ? c : mine; }
        if (sum == G) break;
        __builtin_amdgcn_s_sleep(1);
        if ((++sp & 255u) == 0u) { if (xb_ld(&bar[XB_TMO])) break; if (sp > XB_SPIN_CAP) { atomicAdd(&bar[XB_TMO], 1u); break; } }
    }
    nloc = mine > 0u ? mine : 1u; nx = cnt > 0u ? cnt : 1u;
}
__device__ __forceinline__ void xcd_barrier(const XcdBarrier& b) {
    asm volatile("s_waitcnt vmcnt(0)" ::: "memory");
    __syncthreads();
    if (threadIdx.x == 0) {
        unsigned* bar = b.bar;
        __builtin_amdgcn_s_waitcnt(0);
        unsigned nloc = b.st[0], nx = b.st[1];
        if (nloc == 0u) { xcd_barrier_complete(bar, b.x, nloc, nx); b.st[0] = nloc; b.st[1] = nx; }
        const unsigned old = xb_add(&bar[XB_XSUB(b.x)], 1u);
        const unsigned gen = old / nloc;
        if (old + 1u == (gen + 1u) * nloc) {
            __builtin_amdgcn_fence(__ATOMIC_RELEASE, "agent");
            asm volatile("s_waitcnt vmcnt(0)" ::: "memory");
            const unsigned og = xb_add(&bar[XB_TOP], 1u);
            const unsigned tg = og / nx;
            if (og + 1u == (tg + 1u) * nx) xb_add(&bar[XB_TOPGEN], 1u);
            else XB_SPIN(xb_ld(&bar[XB_TOPGEN]) == tg, bar);
            __builtin_amdgcn_fence(__ATOMIC_ACQUIRE, "agent");
            xb_add(&bar[XB_XGEN(b.x)], 1u);
            asm volatile("s_waitcnt vmcnt(0)" ::: "memory");
        } else {
            XB_SPIN(xb_ld(&bar[XB_XGEN(b.x)]) == gen, bar);
            __builtin_amdgcn_fence(__ATOMIC_ACQUIRE, "agent");
            asm volatile("s_waitcnt vmcnt(0)" ::: "memory");
        }
    }
    __syncthreads();
}

struct Frame {
    LAS unsigned char* lds;
    volatile LAS unsigned* MISC;
    gu32* ctl;
    int tid, lane, wave;
    int vcu, G;
    const float *x, *p, *g_mix, *w_in, *sinks, *w_pool, *pool_scale, *w_out, *g_ffn, *w_query, *sub_keys, *expert_u, *expert_v, *g_ple, *w_ple_gate, *w_ple_proj, *g_final;
    const int* positions;
    float* out;
    unsigned char* ws;
};
#define F_Win_t  ((bf16*)(F.ws + WS_WIN))
#define F_Wout_t ((bf16*)(F.ws + WS_WOUT))
#define F_Wq_t   ((bf16*)(F.ws + WS_WQ))
#define F_Wg_t   ((bf16*)(F.ws + WS_WG))
#define F_Wp_t   ((bf16*)(F.ws + WS_WP))
#define F_Wpool_t ((bf16*)(F.ws + WS_WPOOL))
#define F_SKH    ((bf16*)(F.ws + WS_SKH))
#define F_SKL    ((bf16*)(F.ws + WS_SKL))
#define F_EU     ((bf16*)(F.ws + WS_EU))
#define F_EV     ((bf16*)(F.ws + WS_EV))
#define F_XB     ((bf16*)(F.ws + WS_XB))
#define F_PB     ((bf16*)(F.ws + WS_PB))
#define F_QB     ((bf16*)(F.ws + WS_Q))
#define F_KB     ((bf16*)(F.ws + WS_K))
#define F_VB     ((bf16*)(F.ws + WS_V))
#define F_UB     ((bf16*)(F.ws + WS_U))
#define F_POOLED ((bf16*)(F.ws + WS_POOLED))
#define F_MIX    ((bf16*)(F.ws + WS_MIX))
#define F_H1B    ((bf16*)(F.ws + WS_H1B))
#define F_PP     ((bf16*)(F.ws + WS_PP))
#define F_H2B    ((bf16*)(F.ws + WS_H2B))
#define F_ROPE   ((float*)(F.ws + WS_ROPE))
#define F_RSTD1  ((float*)(F.ws + WS_RSTD1))
#define F_RSTD3  ((float*)(F.ws + WS_RSTD3))
#define F_QP     ((float*)(F.ws + WS_QP))
#define F_GATE   ((float*)(F.ws + WS_GATE))
#define F_H1     ((float*)(F.ws + WS_H1))
#define F_SSQ2   ((float*)(F.ws + WS_CTL) + CW_SSQ2)
#define F_SSQ4   ((float*)(F.ws + WS_CTL) + CW_SSQ4)
#define F_EIDX   ((int*)(F.ws + WS_EIDX))

__device__ __forceinline__ void p0_transpose_item(const float* W, int ldw, int N, const float* gain, bf16* WT, int ldt, LAS float* scr, int item, int lane) {
    const int nblk = N / 32, kb = item / nblk, nb = item % nblk, k0 = 64 * kb, n0 = 32 * nb;
#pragma unroll 8
    for (int i = 0; i < 32; ++i) { const int kk = 2 * i + (lane >> 5); float w = W[(size_t)(k0 + kk) * ldw + n0 + (lane & 31)]; if (gain) w *= gain[k0 + kk]; scr[kk * 33 + (lane & 31)] = w; }
    LDS_WAIT(); asm volatile("" ::: "memory");
    const int c = lane & 7;
#pragma unroll
    for (int j = 0; j < 4; ++j) { const int n = (lane >> 3) + 8 * j; const LAS float* s = scr + (8 * c) * 33 + n;
        v4u o; o.x = pk2(s[0 * 33], s[1 * 33]); o.y = pk2(s[2 * 33], s[3 * 33]); o.z = pk2(s[4 * 33], s[5 * 33]); o.w = pk2(s[6 * 33], s[7 * 33]);
        *(GAS v4u*)(WT + (size_t)(n0 + n) * ldt + k0 + 8 * c) = o; }
    LDS_WAIT(); asm volatile("" ::: "memory");
}
__device__ __forceinline__ void p0_prologue(Frame& F) {
    LAS float* scr = (LAS float*)(F.lds + RING_OFF + F.wave * 16384);
    const int gw = F.vcu * NWAVES + F.wave, NGW = F.G * NWAVES;
    const int gt = gw * 64 + F.lane, NGT = NGW * 64;
    constexpr int I_IN = (DM / 64) * (INW / 32), I_SQ = (DM / 64) * (DM / 32), I_P = (PLE / 64) * (DM / 32), I_POOL = 4 * (256 / 64) * (256 / 32);
    constexpr int NITEMS = I_IN + 3 * I_SQ + I_P + I_POOL;
    for (int it = gw; it < NITEMS; it += NGW) {
        int r = it;
        if (r < I_IN) { p0_transpose_item(F.w_in, INW, INW, F.g_mix, F_Win_t, DM, scr, r, F.lane); continue; } r -= I_IN;
        if (r < I_SQ) { p0_transpose_item(F.w_out, DM, DM, nullptr, F_Wout_t, DM, scr, r, F.lane); continue; } r -= I_SQ;
        if (r < I_SQ) { p0_transpose_item(F.w_query, DM, DM, F.g_ffn, F_Wq_t, DM, scr, r, F.lane); continue; } r -= I_SQ;
        if (r < I_SQ) { p0_transpose_item(F.w_ple_gate, DM, DM, F.g_ple, F_Wg_t, DM, scr, r, F.lane); continue; } r -= I_SQ;
        if (r < I_P) { p0_transpose_item(F.w_ple_proj, DM, DM, nullptr, F_Wp_t, PLE, scr, r, F.lane); continue; } r -= I_P;
        { const int g = r / 32, rr = r % 32; p0_transpose_item(F.w_pool + (size_t)g * 65536, 256, 256, nullptr, F_Wpool_t + (size_t)g * 65536, 256, scr, rr, F.lane); }
    }
    for (int m = gw; m < M; m += NGW) {
        const GAS f32x4* xr = (const GAS f32x4*)(F.x + (size_t)m * DM) + F.lane;
        f32x4 v[8]; float s = 0.f;
#pragma unroll
        for (int j = 0; j < 8; ++j) { v[j] = xr[64 * j]; s += (v[j].x * v[j].x + v[j].y * v[j].y) + (v[j].z * v[j].z + v[j].w * v[j].w); }
        s = wave_sum(s);
        if (F.lane == 0) F_RSTD1[m] = 1.0f / sqrtf(s * (1.0f / DM) + EPS);
        GAS v2u* o8 = (GAS v2u*)(F_XB + (size_t)m * DM) + F.lane;
#pragma unroll
        for (int j = 0; j < 8; ++j) { v2u o; o.x = pk2(v[j].x, v[j].y); o.y = pk2(v[j].z, v[j].w); o8[64 * j] = o; }
    }
    for (int c = gt; c < M * PLE / 8; c += NGT) {
        const GAS f32x4* s = (const GAS f32x4*)F.p + 2 * (size_t)c; const f32x4 a = s[0], b = s[1];
        v4u o; o.x = pk2(a.x, a.y); o.y = pk2(a.z, a.w); o.z = pk2(b.x, b.y); o.w = pk2(b.z, b.w);
        *((GAS v4u*)F_PB + c) = o;
    }
    for (int c = gt; c < NEXP * DM / 8; c += NGT) {
        const GAS f32x4* s = (const GAS f32x4*)F.expert_u + 2 * (size_t)c; f32x4 a = s[0], b = s[1];
        const int d0 = (c * 8) & (DM - 1); const f32x4 ga = *(const GAS f32x4*)(F.g_ffn + d0), gb = *(const GAS f32x4*)(F.g_ffn + d0 + 4);
        a = a * ga; b = b * gb;
        v4u o; o.x = pk2(a.x, a.y); o.y = pk2(a.z, a.w); o.z = pk2(b.x, b.y); o.w = pk2(b.z, b.w);
        *((GAS v4u*)F_EU + c) = o;
    }
    for (int c = gt; c < NEXP * DM / 8; c += NGT) {
        const GAS f32x4* s = (const GAS f32x4*)F.expert_v + 2 * (size_t)c; const f32x4 a = s[0], b = s[1];
        v4u o; o.x = pk2(a.x, a.y); o.y = pk2(a.z, a.w); o.z = pk2(b.x, b.y); o.w = pk2(b.z, b.w);
        *((GAS v4u*)F_EV + c) = o;
    }
    for (int c = gt; c < M * 8; c += NGT) {
        const int t = c >> 3, i = c & 7;
        const float inv = 1.0f / (float)pow(500000.0, (double)(2 * i) / 16.0);
        const float ang = (float)F.positions[t] * inv;
        F_ROPE[t * 16 + i] = (float)cos((double)ang); F_ROPE[t * 16 + 8 + i] = (float)sin((double)ang);
    }
    for (int c = gt; c < 2 * 128 * 128; c += NGT) {
        const float v = F.sub_keys[c]; const unsigned h = pk2(v, 0.f) & 0xffffu; const float hf = __uint_as_float(h << 16);
        F_SKH[c] = (bf16)h; F_SKL[c] = (bf16)(pk2(v - hf, 0.f) & 0xffffu);
    }
}

struct EpiG1 {
    static constexpr bool PERM = true, AFTER_DRAIN = false;
    bf16 *Q, *Kb, *Vb, *U; const float* rstd; const float* rope;
    __device__ __forceinline__ void operator()(const f32x4 (&acc)[2][2][4][2], const pg8::Unit& u, int wr, int wc, int fr, int fq) const {
        const int pn = u.pn; bf16* base; int ldc, colt;
        if (pn < 4) { base = Q; ldc = ATTW; colt = pn * 256; } else if (pn == 4) { base = Kb; ldc = KVW; colt = 0; } else if (pn == 5) { base = Vb; ldc = KVW; colt = 0; } else { base = U; ldc = POOLW; colt = (pn - 6) * 256; }
        const bool rot = (pn <= 4) && ((wc & 1) == 0);
        const float qs = (pn < 4) ? 0.125f : 1.0f;
#pragma unroll
        for (int ai = 0; ai < 2; ++ai)
#pragma unroll
            for (int m = 0; m < 4; ++m) {
                const int row = u.pm * 256 + ai * 128 + wr * 64 + m * 16 + fr;
                const float rs = rstd[row] * qs;
                const GAS f32x4* rp = (const GAS f32x4*)(rope + (size_t)row * 16);
#pragma unroll
                for (int bj = 0; bj < 2; ++bj) {
                    f32x4 v0 = acc[ai][bj][m][0] * rs, v1 = acc[ai][bj][m][1] * rs;
                    if (rot) {
                        { const f32x4 c = rp[0], s = rp[2]; f32x4 p;
#pragma unroll
                          for (int i = 0; i < 4; ++i) p[i] = __shfl_xor(v0[i], 16);
                          if (fq == 0) v0 = v0 * c - p * s; else if (fq == 1) v0 = v0 * c + p * s; }
                        { const f32x4 c = rp[1], s = rp[3]; f32x4 p;
#pragma unroll
                          for (int i = 0; i < 4; ++i) p[i] = __shfl_xor(v1[i], 16);
                          if (fq == 0) v1 = v1 * c - p * s; else if (fq == 1) v1 = v1 * c + p * s; }
                    }
                    v4u w; w.x = pk2(v0[0], v0[1]); w.y = pk2(v0[2], v0[3]); w.z = pk2(v1[0], v1[1]); w.w = pk2(v1[2], v1[3]);
                    *(GAS v4u*)(base + (size_t)row * ldc + colt + bj * 128 + wc * 32 + 8 * fq) = w;
                }
            }
    }
};
struct EpiBf16Scale {
    static constexpr bool PERM = true, AFTER_DRAIN = false;
    bf16* O; int ldc, col_off; const float* cscale;
    __device__ __forceinline__ void operator()(const f32x4 (&acc)[2][2][4][2], const pg8::Unit& u, int wr, int wc, int fr, int fq) const {
        const int c0 = u.pn * 256 + wc * 32 + 8 * fq;
#pragma unroll
        for (int ai = 0; ai < 2; ++ai)
#pragma unroll
            for (int m = 0; m < 4; ++m) {
                const int row = u.pm * 256 + ai * 128 + wr * 64 + m * 16 + fr;
#pragma unroll
                for (int bj = 0; bj < 2; ++bj) {
                    f32x4 v0 = acc[ai][bj][m][0], v1 = acc[ai][bj][m][1];
                    if (cscale) { v0 = v0 * *(const GAS f32x4*)(cscale + c0 + bj * 128); v1 = v1 * *(const GAS f32x4*)(cscale + c0 + bj * 128 + 4); }
                    v4u w; w.x = pk2(v0[0], v0[1]); w.y = pk2(v0[2], v0[3]); w.z = pk2(v1[0], v1[1]); w.w = pk2(v1[2], v1[3]);
                    *(GAS v4u*)(O + (size_t)row * ldc + col_off + c0 + bj * 128) = w;
                }
            }
    }
};
struct EpiG3 {
    static constexpr bool PERM = false, AFTER_DRAIN = false;
    const float* x; float* h1; bf16* h1b; float* ssq;
    __device__ __forceinline__ void operator()(const f32x4 (&acc)[2][2][4][2], const pg8::Unit& u, int wr, int wc, int fr, int fq) const {
        const int col0 = u.pn * 256 + wc * 32 + 4 * fq;
#pragma unroll
        for (int ai = 0; ai < 2; ++ai)
#pragma unroll
            for (int m = 0; m < 4; ++m) {
                const int row = u.pm * 256 + ai * 128 + wr * 64 + m * 16 + fr; float ss = 0.f;
#pragma unroll
                for (int bj = 0; bj < 2; ++bj)
#pragma unroll
                    for (int n = 0; n < 2; ++n) {
                        const size_t off = (size_t)row * DM + col0 + bj * 128 + n * 16;
                        const f32x4 h = DBG_NO_MIX ? *(const GAS f32x4*)(x + off) : *(const GAS f32x4*)(x + off) + acc[ai][bj][m][n];
                        *(GAS f32x4*)(h1 + off) = h;
                        v2u w; w.x = pk2(h[0], h[1]); w.y = pk2(h[2], h[3]); *(GAS v2u*)(h1b + off) = w;
                        ss += (h[0] * h[0] + h[1] * h[1]) + (h[2] * h[2] + h[3] * h[3]);
                    }
                ss += __shfl_xor(ss, 16); ss += __shfl_xor(ss, 32);
                if (fq == 0) atomicAdd(ssq + row, ss);
            }
    }
};
struct EpiG4 {
    static constexpr bool PERM = false, AFTER_DRAIN = false;
    float* qp; const float* ssq;
    __device__ __forceinline__ void operator()(const f32x4 (&acc)[2][2][4][2], const pg8::Unit& u, int wr, int wc, int fr, int fq) const {
        const int col0 = u.pn * 256 + wc * 32 + 4 * fq;
#pragma unroll
        for (int ai = 0; ai < 2; ++ai)
#pragma unroll
            for (int m = 0; m < 4; ++m) {
                const int row = u.pm * 256 + ai * 128 + wr * 64 + m * 16 + fr;
                const float rs = 1.0f / sqrtf(__hip_atomic_load(ssq + row, RLX_AGENT) * (1.0f / DM) + EPS);
#pragma unroll
                for (int bj = 0; bj < 2; ++bj)
#pragma unroll
                    for (int n = 0; n < 2; ++n) *(GAS f32x4*)(qp + (size_t)row * DM + col0 + bj * 128 + n * 16) = acc[ai][bj][m][n] * rs;
            }
    }
};
struct EpiG5 {
    static constexpr bool PERM = false, AFTER_DRAIN = false;
    const float* h2; const bf16* pp; const float* rstd3; float* out; float* ssq;
    __device__ __forceinline__ void operator()(const f32x4 (&acc)[2][2][4][2], const pg8::Unit& u, int wr, int wc, int fr, int fq) const {
        const int col0 = u.pn * 256 + wc * 32 + 4 * fq;
#pragma unroll
        for (int ai = 0; ai < 2; ++ai)
#pragma unroll
            for (int m = 0; m < 4; ++m) {
                const int row = u.pm * 256 + ai * 128 + wr * 64 + m * 16 + fr; float ss = 0.f;
                const float rs = rstd3[row];
#pragma unroll
                for (int bj = 0; bj < 2; ++bj)
#pragma unroll
                    for (int n = 0; n < 2; ++n) {
                        const size_t off = (size_t)row * DM + col0 + bj * 128 + n * 16;
                        const f32x4 z = DBG_NO_PLE ? (f32x4){-1e30f, -1e30f, -1e30f, -1e30f} : acc[ai][bj][m][n] * rs; const v2u pw = *(const GAS v2u*)(pp + off); const f32x4 hv = *(const GAS f32x4*)(h2 + off);
                        f32x4 o;
                        o[0] = hv[0] + bf_lo(pw.x) / (1.0f + __expf(-z[0])); o[1] = hv[1] + bf_hi(pw.x) / (1.0f + __expf(-z[1]));
                        o[2] = hv[2] + bf_lo(pw.y) / (1.0f + __expf(-z[2])); o[3] = hv[3] + bf_hi(pw.y) / (1.0f + __expf(-z[3]));
                        *(GAS f32x4*)(out + off) = o;
                        ss += (o[0] * o[0] + o[1] * o[1]) + (o[2] * o[2] + o[3] * o[3]);
                    }
                ss += __shfl_xor(ss, 16); ss += __shfl_xor(ss, 32);
                if (fq == 0) atomicAdd(ssq + row, ss);
            }
    }
};
struct SingleUnit {
    int pm, pn;
    __device__ __forceinline__ bool next(int i, pg8::Unit& u) const { if (i != 0) return false; u.pm = pm; u.pn = pn; return true; }
    __device__ __forceinline__ void a_ready(const pg8::Unit&) const {}
    __device__ __forceinline__ void done(const pg8::Unit&) const {}
};

__device__ __forceinline__ int crow(int r, int hi) { return (r & 3) + 8 * (r >> 2) + 4 * hi; }
constexpr int KS_STRIDE = 144, VT_STRIDE = 520, VT_OFF = 256 * KS_STRIDE;
__device__ __forceinline__ void attn_unit(Frame& F, int unit) {
    const int g = unit & 3, nblk = (unit >> 2) & 31, b = unit >> 7;
    const int t0 = b * SEQ + nblk * 128;
    LAS unsigned char* Ks = F.lds + RING_OFF;
    LAS unsigned char* Vt = F.lds + RING_OFF + VT_OFF;
    for (int c = F.tid; c < 2048; c += NWAVES * 64) {
        const int j = c >> 3, ch = c & 7;
        v4u kv = {0u, 0u, 0u, 0u}, vv = {0u, 0u, 0u, 0u};
        if (nblk > 0 || j >= 128) { const size_t row = (size_t)(t0 - 128 + j); kv = *(const GAS v4u*)(F_KB + row * KVW + g * 64 + ch * 8); vv = *(const GAS v4u*)(F_VB + row * KVW + g * 64 + ch * 8); }
        *(LAS v4u*)(Ks + j * KS_STRIDE + ch * 16) = kv;
#pragma unroll
        for (int e = 0; e < 8; ++e) *(LAS unsigned short*)(Vt + (ch * 8 + e) * VT_STRIDE + j * 2) = (unsigned short)((vv[e >> 1] >> (16 * (e & 1))) & 0xffffu);
    }
    __syncthreads();
    const int hq = 4 * g + (F.wave >> 1);
    const float sink = F.sinks[hq];
    const int q = F.lane & 31, h = F.lane >> 5;
#pragma unroll 1
    for (int sub = 0; sub < 2; ++sub) {
        const int i0 = (F.wave & 1) * 64 + sub * 32;
        bf16x8 qf[4];
#pragma unroll
        for (int ks = 0; ks < 4; ++ks) qf[ks] = *(const GAS bf16x8*)(F_QB + (size_t)(t0 + i0 + q) * ATTW + hq * 64 + 16 * ks + 8 * h);
        f32x16 s[5];
#pragma unroll
        for (int kt = 0; kt < 5; ++kt) {
#pragma unroll
            for (int r = 0; r < 16; ++r) s[kt][r] = 0.f;
#pragma unroll
            for (int ks = 0; ks < 4; ++ks) {
                const bf16x8 a = *(const LAS bf16x8*)(Ks + (i0 + 32 * kt + q) * KS_STRIDE + (16 * ks + 8 * h) * 2);
                s[kt] = __builtin_amdgcn_mfma_f32_32x32x16_bf16(a, qf[ks], s[kt], 0, 0, 0);
            }
        }
        float mx = sink;
#pragma unroll
        for (int kt = 0; kt < 5; ++kt)
#pragma unroll
            for (int r = 0; r < 16; ++r) {
                const bool tv = (nblk > 0) || (i0 + 32 * kt >= 128);
                const bool ok = (kt == 0) ? (crow(r, h) > q) : (kt == 4) ? (crow(r, h) <= q) : true;
                const float v = (ok && tv) ? s[kt][r] : -INFINITY;
                s[kt][r] = v; mx = fmaxf(mx, v);
            }
        mx = fmaxf(mx, __shfl_xor(mx, 32));
        float sum = 0.f;
#pragma unroll
        for (int kt = 0; kt < 5; ++kt)
#pragma unroll
            for (int r = 0; r < 16; ++r) { const float pv = __expf(s[kt][r] - mx); s[kt][r] = pv; sum += pv; }
        sum += __shfl_xor(sum, 32);
        sum += __expf(sink - mx);
        const float inv = 1.0f / sum;
        f32x16 o[2];
#pragma unroll
        for (int dt = 0; dt < 2; ++dt)
#pragma unroll
            for (int r = 0; r < 16; ++r) o[dt][r] = 0.f;
#pragma unroll
        for (int kt = 0; kt < 5; ++kt)
#pragma unroll
            for (int st = 0; st < 2; ++st) {
                v4u pw; pw.x = pk2(s[kt][8 * st + 0], s[kt][8 * st + 1]); pw.y = pk2(s[kt][8 * st + 2], s[kt][8 * st + 3]); pw.z = pk2(s[kt][8 * st + 4], s[kt][8 * st + 5]); pw.w = pk2(s[kt][8 * st + 6], s[kt][8 * st + 7]);
                const bf16x8 pb = __builtin_bit_cast(bf16x8, pw);
#pragma unroll
                for (int dt = 0; dt < 2; ++dt) {
                    const LAS unsigned char* vb = Vt + (32 * dt + q) * VT_STRIDE + (i0 + 32 * kt + 16 * st + 4 * h) * 2;
                    const v2u lo = *(const LAS v2u*)vb, hi2 = *(const LAS v2u*)(vb + 16);
                    v4u aw; aw.x = lo.x; aw.y = lo.y; aw.z = hi2.x; aw.w = hi2.y;
                    o[dt] = __builtin_amdgcn_mfma_f32_32x32x16_bf16(__builtin_bit_cast(bf16x8, aw), pb, o[dt], 0, 0, 0);
                }
            }
        bf16* orow = F_MIX + (size_t)(t0 + i0 + q) * DM + hq * 64;
#pragma unroll
        for (int dt = 0; dt < 2; ++dt)
#pragma unroll
            for (int g4 = 0; g4 < 4; ++g4) {
                v2u w; w.x = pk2(o[dt][4 * g4] * inv, o[dt][4 * g4 + 1] * inv); w.y = pk2(o[dt][4 * g4 + 2] * inv, o[dt][4 * g4 + 3] * inv);
                *(GAS v2u*)(orow + 32 * dt + 8 * g4 + 4 * h) = w;
            }
    }
    __syncthreads();
}
__device__ __forceinline__ void pool_tile(Frame& F, int pm, int g) {
    const int w = 2 << g;
    const int cg = F.tid & 31, rg = F.tid >> 5;
    const int r0 = pm * 256 + rg * 16;
    const int col = g * 256 + cg * 8;
    float sum[8];
#pragma unroll
    for (int e = 0; e < 8; ++e) sum[e] = 0.f;
    const int tseq0 = r0 & (SEQ - 1);
    for (int j = 1; j < w; ++j) { if (tseq0 - j >= 0) { const v4u v = *(const GAS v4u*)(F_UB + (size_t)(r0 - j) * POOLW + col);
#pragma unroll
            for (int e = 0; e < 4; ++e) { sum[2 * e] += bf_lo(v[e]); sum[2 * e + 1] += bf_hi(v[e]); } } }
    for (int i = 0; i < 16; ++i) {
        const int r = r0 + i, ts = tseq0 + i;
        const v4u v = *(const GAS v4u*)(F_UB + (size_t)r * POOLW + col);
        float cur[8];
#pragma unroll
        for (int e = 0; e < 4; ++e) { cur[2 * e] = bf_lo(v[e]); cur[2 * e + 1] = bf_hi(v[e]); }
#pragma unroll
        for (int e = 0; e < 8; ++e) sum[e] += cur[e];
        const int cnt = (ts + 1 < w) ? ts + 1 : w; const float ic = 1.0f / (float)cnt;
        v4u o;
        o.x = pk2(sum[0] * ic - cur[0], sum[1] * ic - cur[1]); o.y = pk2(sum[2] * ic - cur[2], sum[3] * ic - cur[3]);
        o.z = pk2(sum[4] * ic - cur[4], sum[5] * ic - cur[5]); o.w = pk2(sum[6] * ic - cur[6], sum[7] * ic - cur[7]);
        *(GAS v4u*)(F_POOLED + (size_t)r * POOLW + col) = o;
        if (ts - (w - 1) >= 0) { const v4u ov = *(const GAS v4u*)(F_UB + (size_t)(r - (w - 1)) * POOLW + col);
#pragma unroll
            for (int e = 0; e < 4; ++e) { sum[2 * e] -= bf_lo(ov[e]); sum[2 * e + 1] -= bf_hi(ov[e]); } }
    }
}

template <int N> __device__ __forceinline__ void insert_desc(float (&val)[N], float x) {
#pragma unroll
    for (int k = 0; k < N; ++k) { const float hi = max2f(x, val[k]); x = min2f(x, val[k]); val[k] = hi; }
}
__device__ __forceinline__ void bitonic_merge16(float (&m)[16]) {
#pragma unroll
    for (int st = 8; st >= 1; st >>= 1)
#pragma unroll
        for (int i = 0; i < 16; ++i) if ((i & st) == 0) { const float hi = max2f(m[i], m[i + st]), lo = min2f(m[i], m[i + st]); m[i] = hi; m[i + st] = lo; }
}
__device__ __forceinline__ void merge_partner16(float (&val)[16]) {
    float pr[16];
#pragma unroll
    for (int k = 0; k < 16; ++k) pr[k] = __shfl_xor(val[k], 32);
#pragma unroll
    for (int k = 0; k < 16; ++k) val[k] = max2f(val[k], pr[15 - k]);
    bitonic_merge16(val);
}
__device__ __forceinline__ void pin16(float (&v)[16]) {
#pragma unroll
    for (int k = 0; k < 16; ++k) asm volatile("" : "+v"(v[k]));
}
struct CandTab { int a[50], b[50]; };
__host__ __device__ constexpr CandTab make_cands() { CandTab t{}; int n = 0; for (int a = 0; a < 16; ++a) for (int b = 0; b < 16; ++b) if ((a + 1) * (b + 1) <= 16) { t.a[n] = a; t.b[n] = b; ++n; } return t; }
__device__ __forceinline__ float vsel(unsigned long long m, float a, float b) { float r; asm("v_cndmask_b32_e64 %0, %1, %2, %3" : "=v"(r) : "v"(b), "v"(a), "s"(m)); return r; }
__device__ __forceinline__ float sel16(const float (&L)[16], int a) { float r = L[0];
#pragma unroll
    for (int k = 1; k < 16; ++k) r = vsel(__ballot(a == k), L[k], r);
    return r; }
template <int HALF_>
__device__ __forceinline__ void route_half(Frame& F, const float* qrow, int r, int h, float (&Lout)[16]) {
    f32x16 acc[4];
#pragma unroll
    for (int kt = 0; kt < 4; ++kt)
#pragma unroll
        for (int i = 0; i < 16; ++i) acc[kt][i] = 0.f;
    const bf16* skh = F_SKH + HALF_ * 16384; const bf16* skl = F_SKL + HALF_ * 16384;
#pragma unroll 2
    for (int ks = 0; ks < 8; ++ks) {
        const f32x4 qa = *(const GAS f32x4*)(qrow + HALF_ * 128 + 16 * ks + 8 * h), qb = *(const GAS f32x4*)(qrow + HALF_ * 128 + 16 * ks + 8 * h + 4);
        v4u hw, lw;
        hw.x = pk2(qa.x, qa.y); hw.y = pk2(qa.z, qa.w); hw.z = pk2(qb.x, qb.y); hw.w = pk2(qb.z, qb.w);
        lw.x = pk2(qa.x - bf_lo(hw.x), qa.y - bf_hi(hw.x)); lw.y = pk2(qa.z - bf_lo(hw.y), qa.w - bf_hi(hw.y));
        lw.z = pk2(qb.x - bf_lo(hw.z), qb.y - bf_hi(hw.z)); lw.w = pk2(qb.z - bf_lo(hw.w), qb.w - bf_hi(hw.w));
        const bf16x8 bh = __builtin_bit_cast(bf16x8, hw), bl = __builtin_bit_cast(bf16x8, lw);
#pragma unroll
        for (int kt = 0; kt < 4; ++kt) {
            const bf16x8 ah = *(const GAS bf16x8*)(skh + (32 * kt + r) * 128 + 16 * ks + 8 * h), al = *(const GAS bf16x8*)(skl + (32 * kt + r) * 128 + 16 * ks + 8 * h);
            acc[kt] = __builtin_amdgcn_mfma_f32_32x32x16_bf16(ah, bh, acc[kt], 0, 0, 0);
            acc[kt] = __builtin_amdgcn_mfma_f32_32x32x16_bf16(al, bh, acc[kt], 0, 0, 0);
            acc[kt] = __builtin_amdgcn_mfma_f32_32x32x16_bf16(ah, bl, acc[kt], 0, 0, 0);
        }
    }
#pragma unroll
    for (int k = 0; k < 16; ++k) Lout[k] = -INFINITY;
#pragma unroll
    for (int kt = 0; kt < 4; ++kt)
#pragma unroll
        for (int i = 0; i < 16; ++i) {
            const unsigned n = (unsigned)(32 * kt + (i & 3) + 8 * (i >> 2) + 4 * h);
            insert_desc<16>(Lout, __uint_as_float((__float_as_uint(acc[kt][i]) & ~127u) | n));
        }
    merge_partner16(Lout);
}
__device__ __forceinline__ void route_task(Frame& F, int task) {
    const int r = F.lane & 31, h = F.lane >> 5;
    const int item = task * 32 + r, tok = item >> 3, head = item & 7;
    const float* qrow = F_QP + (size_t)tok * DM + head * 256;
    float L0[16], L1[16];
    route_half<0>(F, qrow, r, h, L0);
    route_half<1>(F, qrow, r, h, L1);
    pin16(L0); pin16(L1);
    constexpr CandTab CT = make_cands();
    const unsigned long long hm = __ballot(h != 0);
    float cand[16];
#pragma unroll
    for (int k = 0; k < 16; ++k) cand[k] = -INFINITY;
#pragma unroll
    for (int i = 0; i < 25; ++i) {
        const float v1 = vsel(hm, L0[CT.a[2 * i + 1]], L0[CT.a[2 * i]]);
        const float v2 = vsel(hm, L1[CT.b[2 * i + 1]], L1[CT.b[2 * i]]);
        const unsigned id = h ? (unsigned)(CT.a[2 * i + 1] * 16 + CT.b[2 * i + 1]) : (unsigned)(CT.a[2 * i] * 16 + CT.b[2 * i]);
        const float sm = __uint_as_float(__float_as_uint(v1) & ~127u) + __uint_as_float(__float_as_uint(v2) & ~127u);
        insert_desc<16>(cand, __uint_as_float((__float_as_uint(sm) & ~255u) | id));
    }
    merge_partner16(cand);
    pin16(cand);
    float se = 0.f;
#pragma unroll
    for (int k = 0; k < 16; ++k) se += __expf(cand[k] - cand[0]);
    const float ise = 1.0f / se;
    int eo[8]; float go[8];
#pragma unroll
    for (int kk = 0; kk < 8; ++kk) {
        const float cv = vsel(hm, cand[8 + kk], cand[kk]);
        const unsigned id = __float_as_uint(cv) & 255u; const int a = (int)(id >> 4), bb = (int)(id & 15u);
        const unsigned i1 = __float_as_uint(sel16(L0, a)) & 127u, i2 = __float_as_uint(sel16(L1, bb)) & 127u;
        eo[kk] = (int)(i1 * 128u + i2); go[kk] = __expf(cv - cand[0]) * ise;
    }
    int* ep = F_EIDX + (size_t)tok * 128 + head * 16 + 8 * h; float* gp = F_GATE + (size_t)tok * 128 + head * 16 + 8 * h;
    *(GAS v4u*)ep = (v4u){(unsigned)eo[0], (unsigned)eo[1], (unsigned)eo[2], (unsigned)eo[3]}; *(GAS v4u*)(ep + 4) = (v4u){(unsigned)eo[4], (unsigned)eo[5], (unsigned)eo[6], (unsigned)eo[7]};
    *(GAS f32x4*)gp = (f32x4){go[0], go[1], go[2], go[3]}; *(GAS f32x4*)(gp + 4) = (f32x4){go[4], go[5], go[6], go[7]};
}


#ifndef DBG_ROUTE_BF
#define DBG_ROUTE_BF 0
#endif
__device__ __forceinline__ void lds_insert(LAS float* V, LAS int* I, int tid, float x, int id) {
    if (x > V[15 * 256 + tid]) {
        int pos = 15;
        while (pos > 0 && V[(pos - 1) * 256 + tid] < x) { V[pos * 256 + tid] = V[(pos - 1) * 256 + tid]; I[pos * 256 + tid] = I[(pos - 1) * 256 + tid]; --pos; }
        V[pos * 256 + tid] = x; I[pos * 256 + tid] = id;
    }
}
__device__ __forceinline__ void route_bruteforce(Frame& F) {
    if (F.tid >= 256) return;
    const int tid = F.tid;
    LAS float* V0 = (LAS float*)(F.lds); LAS int* I0 = (LAS int*)(F.lds + 16384);
    LAS float* V1 = (LAS float*)(F.lds + 32768); LAS int* I1 = (LAS int*)(F.lds + 49152);
    LAS float* VC = (LAS float*)(F.lds + 65536); LAS int* IC = (LAS int*)(F.lds + 81920);
    for (int item = (int)blockIdx.x * 256 + tid; item < M * PKH; item += F.G * 256) {
        const int tok = item >> 3, head = item & 7;
        const float* qrow = F_QP + (size_t)tok * DM + head * 256;
        for (int k = 0; k < 16; ++k) { V0[k * 256 + tid] = -INFINITY; I0[k * 256 + tid] = 0; V1[k * 256 + tid] = -INFINITY; I1[k * 256 + tid] = 0; VC[k * 256 + tid] = -INFINITY; IC[k * 256 + tid] = 0; }
        for (int half = 0; half < 2; ++half) {
            float q[128];
#pragma unroll
            for (int d = 0; d < 128; d += 4) { const f32x4 t = *(const GAS f32x4*)(qrow + half * 128 + d); q[d] = t.x; q[d + 1] = t.y; q[d + 2] = t.z; q[d + 3] = t.w; }
            for (int n = 0; n < 128; ++n) {
                const float* sk = F.sub_keys + (size_t)half * 16384 + n * 128;
                float s = 0.f;
#pragma unroll
                for (int d = 0; d < 128; ++d) s += q[d] * sk[d];
                if (half == 0) lds_insert(V0, I0, tid, s, n); else lds_insert(V1, I1, tid, s, n);
            }
        }
        for (int a = 0; a < 16; ++a) for (int b = 0; b < 16; ++b) lds_insert(VC, IC, tid, V0[a * 256 + tid] + V1[b * 256 + tid], I0[a * 256 + tid] * 128 + I1[b * 256 + tid]);
        const float mx = VC[tid]; float se = 0.f;
        for (int k = 0; k < 16; ++k) se += __expf(VC[k * 256 + tid] - mx);
        for (int k = 0; k < 16; ++k) { F_EIDX[(size_t)tok * 128 + head * 16 + k] = IC[k * 256 + tid]; F_GATE[(size_t)tok * 128 + head * 16 + k] = __expf(VC[k * 256 + tid] - mx) / se; }
    }
}

__device__ __forceinline__ void peer_token(Frame& F, int t) {
    LAS int* sidx = (LAS int*)(F.lds + RING_OFF + F.wave * 2048);
    LAS float* sg = (LAS float*)(F.lds + RING_OFF + F.wave * 2048 + 512);
    LAS float* sa = (LAS float*)(F.lds + RING_OFF + F.wave * 2048 + 1024);
    const int lane = F.lane;
    sidx[lane] = F_EIDX[(size_t)t * 128 + lane]; sidx[lane + 64] = F_EIDX[(size_t)t * 128 + 64 + lane];
    sg[lane] = F_GATE[(size_t)t * 128 + lane]; sg[lane + 64] = F_GATE[(size_t)t * 128 + 64 + lane];
    v4u xv[4];
#pragma unroll
    for (int j = 0; j < 4; ++j) xv[j] = *(const GAS v4u*)(F_H1B + (size_t)t * DM + 8 * lane + 512 * j);
    const float rs2 = 1.0f / sqrtf(__hip_atomic_load(F_SSQ2 + t, RLX_AGENT) * (1.0f / DM) + EPS);
    LDS_WAIT(); asm volatile("" ::: "memory");
#pragma unroll 1
    for (int kb = 0; kb < 16; ++kb) {
        float part[8];
#pragma unroll
        for (int i = 0; i < 8; ++i) {
            const int e = __builtin_amdgcn_readfirstlane(sidx[kb * 8 + i]);
            const bf16* ur = F_EU + (size_t)e * DM + 8 * lane;
            v4u w[4];
#pragma unroll
            for (int j = 0; j < 4; ++j) w[j] = *(const GAS v4u*)(ur + 512 * j);
            float a = 0.f;
#pragma unroll
            for (int j = 0; j < 4; ++j)
#pragma unroll
                for (int c = 0; c < 4; ++c) { const unsigned xa = xv[j][c], wb = w[j][c]; a = dot2bf(xa, wb, a); }
            part[i] = a;
        }
        float r4[4], r2[2], r1;
        { const bool up = (lane & 32) != 0;
#pragma unroll
          for (int i = 0; i < 4; ++i) { const float send = up ? part[i] : part[i + 4], keep = up ? part[i + 4] : part[i]; r4[i] = keep + __shfl_xor(send, 32); } }
        { const bool up = (lane & 16) != 0;
#pragma unroll
          for (int i = 0; i < 2; ++i) { const float send = up ? r4[i] : r4[i + 2], keep = up ? r4[i + 2] : r4[i]; r2[i] = keep + __shfl_xor(send, 16); } }
        { const bool up = (lane & 8) != 0; const float send = up ? r2[0] : r2[1], keep = up ? r2[1] : r2[0]; r1 = keep + __shfl_xor(send, 8); }
        r1 += __shfl_xor(r1, 4); r1 += __shfl_xor(r1, 2); r1 += __shfl_xor(r1, 1);
        const int ei = 4 * (lane >> 5) + 2 * ((lane >> 4) & 1) + ((lane >> 3) & 1);
        const float hv = r1 * rs2;
        const float ge = 0.5f * hv * (1.0f + erff(hv * 0.70710678118654752f));
        if ((lane & 7) == 0) sa[kb * 8 + ei] = sg[kb * 8 + ei] * ge;
    }
    LDS_WAIT(); asm volatile("" ::: "memory");
    float o[32];
#pragma unroll
    for (int i = 0; i < 32; ++i) o[i] = 0.f;
#pragma unroll 1
    for (int kb = 0; kb < 16; ++kb) {
#pragma unroll
        for (int i = 0; i < 8; ++i) {
            const int e = __builtin_amdgcn_readfirstlane(sidx[kb * 8 + i]);
            const float a = sa[kb * 8 + i];
            const bf16* vr = F_EV + (size_t)e * DM + 8 * lane;
            v4u w[4];
#pragma unroll
            for (int j = 0; j < 4; ++j) w[j] = *(const GAS v4u*)(vr + 512 * j);
#pragma unroll
            for (int j = 0; j < 4; ++j)
#pragma unroll
                for (int c = 0; c < 4; ++c) { o[j * 8 + 2 * c] += a * bf_lo(w[j][c]); o[j * 8 + 2 * c + 1] += a * bf_hi(w[j][c]); }
        }
    }
    float ss = 0.f;
#pragma unroll
    for (int j = 0; j < 4; ++j) {
        GAS f32x4* hp = (GAS f32x4*)(F_H1 + (size_t)t * DM + 8 * lane + 512 * j);
        f32x4 ha = hp[0], hb = hp[1];
        if (!DBG_NO_PEER) {
        ha[0] += o[j * 8 + 0]; ha[1] += o[j * 8 + 1]; ha[2] += o[j * 8 + 2]; ha[3] += o[j * 8 + 3];
        hb[0] += o[j * 8 + 4]; hb[1] += o[j * 8 + 5]; hb[2] += o[j * 8 + 6]; hb[3] += o[j * 8 + 7]; }
        hp[0] = ha; hp[1] = hb;
        v4u wv; wv.x = pk2(ha[0], ha[1]); wv.y = pk2(ha[2], ha[3]); wv.z = pk2(hb[0], hb[1]); wv.w = pk2(hb[2], hb[3]);
        *(GAS v4u*)(F_H2B + (size_t)t * DM + 8 * lane + 512 * j) = wv;
        ss += (ha[0] * ha[0] + ha[1] * ha[1]) + (ha[2] * ha[2] + ha[3] * ha[3]) + (hb[0] * hb[0] + hb[1] * hb[1]) + (hb[2] * hb[2] + hb[3] * hb[3]);
    }
    ss = wave_sum(ss);
    if (lane == 0) F_RSTD3[t] = 1.0f / sqrtf(ss * (1.0f / DM) + EPS);
    LDS_WAIT(); asm volatile("" ::: "memory");
}

struct Args { const void* in[18]; float* out; unsigned char* ws; int ph_lo, ph_hi, li, pad; };
__global__ void __launch_bounds__(NWAVES * 64, 2) hymba_fwd(Args args) {
    extern __shared__ __attribute__((aligned(16))) unsigned char lds[];
    Frame F;
    F.lds = (LAS unsigned char*)lds;
    F.MISC = (volatile LAS unsigned*)(F.lds + MISC_OFF);
    F.tid = threadIdx.x; F.lane = F.tid & 63; F.wave = __builtin_amdgcn_readfirstlane(F.tid >> 6);
    F.G = gridDim.x; { const int bx = blockIdx.x; F.vcu = (F.G % 8 == 0) ? (bx % 8) * (F.G / 8) + bx / 8 : bx; }
    F.ws = args.ws;
    F.ctl = (gu32*)(F.ws + WS_CTL);
    F.x = (const float*)args.in[0]; F.p = (const float*)args.in[1]; F.positions = (const int*)args.in[2]; F.g_mix = (const float*)args.in[3]; F.w_in = (const float*)args.in[4];
    F.sinks = (const float*)args.in[5]; F.w_pool = (const float*)args.in[6]; F.pool_scale = (const float*)args.in[7]; F.w_out = (const float*)args.in[8]; F.g_ffn = (const float*)args.in[9];
    F.w_query = (const float*)args.in[10]; F.sub_keys = (const float*)args.in[11]; F.expert_u = (const float*)args.in[12]; F.expert_v = (const float*)args.in[13]; F.g_ple = (const float*)args.in[14];
    F.w_ple_gate = (const float*)args.in[15]; F.w_ple_proj = (const float*)args.in[16]; F.g_final = (const float*)args.in[17]; F.out = args.out;
    for (int u = F.tid; u < (LDS_BYTES - LDSCTL_OFF) / 4; u += NWAVES * 64) ((LAS unsigned*)(F.lds + LDSCTL_OFF))[u] = 0u;
    __syncthreads();
    const bool one_phase = (args.ph_hi - args.ph_lo) == 1;
    XcdBarrier bar; bar.bar = (unsigned*)(F.ctl + CW_BAR); bar.x = 0; bar.st = nullptr;
    if (!one_phase) bar = xcd_barrier_post((unsigned*)(F.ctl + CW_BAR), F.MISC + 8);
    const int lo = args.ph_lo, hi = args.ph_hi;
#define IN(k) (lo <= (k) && (k) < hi)
#define BOTH(k) (IN(k) && IN((k) + 1))
#define GRID_BAR() xcd_barrier(bar)

    if (IN(0)) { p0_prologue(F); if (BOTH(0)) GRID_BAR(); }

    if (IN(1)) {
        { pg8::Gemm g{F_XB, F_Win_t, M, INW, DM, DM, DM}; pg8::StaticOrder S; S.init(M, INW, F.G, (int)blockIdx.x);
          EpiG1 E{F_QB, F_KB, F_VB, F_UB, F_RSTD1, F_ROPE};
          pg8::gemm_phase<EpiG1, pg8::StaticOrder, true, true>(F.lds + RING_OFF, g, S, E); }
        { pg8::Gemm g{F_PB, F_Wp_t, M, DM, PLE, PLE, PLE}; pg8::StaticOrder S; S.init(M, DM, F.G, (int)blockIdx.x);
          EpiBf16Scale E{F_PP, DM, 0, nullptr};
          pg8::gemm_phase<EpiBf16Scale, pg8::StaticOrder, true, true>(F.lds + RING_OFF, g, S, E); }
        if (BOTH(1)) GRID_BAR();
    }

    if (IN(2)) {
        for (int u = (int)blockIdx.x; u < BATCH * 32 * NKVH; u += F.G) attn_unit(F, u);
        if ((int)blockIdx.x < 128) {
            const int pu = (int)blockIdx.x, pm = pu >> 2, g = pu & 3;
            pool_tile(F, pm, g);
            VM_WAIT(); __syncthreads();
            pg8::Gemm gm{F_POOLED + g * 256, F_Wpool_t + (size_t)g * 65536, M, 256, 256, POOLW, 256}; SingleUnit S{pm, 0};
            EpiBf16Scale E{F_MIX, DM, ATTW + g * 256, F.pool_scale + g * 256};
            pg8::gemm_phase<EpiBf16Scale, SingleUnit, false, true>(F.lds + RING_OFF, gm, S, E);
            __syncthreads();
        }
        if (BOTH(2)) GRID_BAR();
    }

    if (IN(3)) {
        pg8::Gemm g{F_MIX, F_Wout_t, M, DM, DM, DM, DM}; pg8::StaticOrder S; S.init(M, DM, F.G, (int)blockIdx.x);
        EpiG3 E{F.x, F_H1, F_H1B, F_SSQ2};
        pg8::gemm_phase<EpiG3, pg8::StaticOrder, true, true>(F.lds + RING_OFF, g, S, E);
        if (BOTH(3)) GRID_BAR();
    }

    if (IN(4)) {
        pg8::Gemm g{F_H1B, F_Wq_t, M, DM, DM, DM, DM}; pg8::StaticOrder S; S.init(M, DM, F.G, (int)blockIdx.x);
        EpiG4 E{F_QP, F_SSQ2};
        pg8::gemm_phase<EpiG4, pg8::StaticOrder, true, true>(F.lds + RING_OFF, g, S, E);
        if (BOTH(4)) GRID_BAR();
    }

    if (IN(5)) {
        const int gw = F.vcu * NWAVES + F.wave, NGW = F.G * NWAVES;
        for (int task = gw; task < M * PKH / 32; task += NGW) route_task(F, task);
        if (BOTH(5)) GRID_BAR();
    }

    if (IN(6)) {
        const int gw = F.vcu * NWAVES + F.wave, NGW = F.G * NWAVES;
        for (int t = gw; t < M; t += NGW) peer_token(F, t);
        __syncthreads();
        if (BOTH(6)) GRID_BAR();
    }

    if (IN(7)) {
        pg8::Gemm g{F_H2B, F_Wg_t, M, DM, DM, DM, DM}; pg8::StaticOrder S; S.init(M, DM, F.G, (int)blockIdx.x);
        EpiG5 E{F_H1, F_PP, F_RSTD3, F.out, F_SSQ4};
        pg8::gemm_phase<EpiG5, pg8::StaticOrder, true, true>(F.lds + RING_OFF, g, S, E);
        if (BOTH(7)) GRID_BAR();
    }

    if (IN(8)) {
        const int gw = F.vcu * NWAVES + F.wave, NGW = F.G * NWAVES;
        for (int m = gw; m < M; m += NGW) {
            const float rs = 1.0f / sqrtf(__hip_atomic_load(F_SSQ4 + m, RLX_AGENT) * (1.0f / DM) + EPS);
            GAS f32x4* orow = (GAS f32x4*)(F.out + (size_t)m * DM) + F.lane; const GAS f32x4* gr = (const GAS f32x4*)F.g_final + F.lane;
#pragma unroll
            for (int j = 0; j < 8; ++j) { const f32x4 v = orow[64 * j]; orow[64 * j] = v * rs * gr[64 * j]; }
        }
    }
#undef IN
#undef BOTH
#undef GRID_BAR
}


#if DBG_ROUTE_BF
__global__ void __launch_bounds__(NWAVES * 64, 2) dbg_route_kernel(Args args) {
    extern __shared__ __attribute__((aligned(16))) unsigned char lds[];
    Frame F; F.lds = (LAS unsigned char*)lds; F.tid = threadIdx.x; F.lane = F.tid & 63; F.wave = F.tid >> 6; F.G = gridDim.x; F.vcu = blockIdx.x; F.ws = args.ws; F.sub_keys = (const float*)args.in[11];
    route_bruteforce(F);
}
#endif
extern "C" void kernel_launch(void* const* d_in, const int* in_sizes, int n_in, void* d_out, int out_size, void* d_ws, size_t ws_size, hipStream_t stream) {
    static int grid = 0;
    if (grid == 0) {
        if (n_in != 18 || out_size != M * DM || ws_size < WS_END) { fprintf(stderr, "kernel_launch: unexpected shapes (n_in %d, out %d, ws %zu)\n", n_in, out_size, ws_size); grid = -1; return; }
        int dev = 0, cus = 0, per_cu = 0;
        if (hipGetDevice(&dev) != hipSuccess || hipDeviceGetAttribute(&cus, hipDeviceAttributeMultiprocessorCount, dev) != hipSuccess) { grid = -1; return; }
#if DBG_ROUTE_BF
        (void)hipFuncSetAttribute((const void*)dbg_route_kernel, hipFuncAttributeMaxDynamicSharedMemorySize, 98304);
#endif
        if (hipFuncSetAttribute((const void*)hymba_fwd, hipFuncAttributeMaxDynamicSharedMemorySize, LDS_BYTES) != hipSuccess) { fprintf(stderr, "kernel_launch: hipFuncSetAttribute failed\n"); grid = -1; return; }
        if (hipOccupancyMaxActiveBlocksPerMultiprocessor(&per_cu, (const void*)hymba_fwd, NWAVES * 64, LDS_BYTES) != hipSuccess || per_cu < 1)
            fprintf(stderr, "kernel_launch: note: occupancy query reports %d workgroups per CU\n", per_cu);
        (void)hipGetLastError();
        if (cus < 128) { fprintf(stderr, "kernel_launch: needs >= 128 CUs\n"); grid = -1; return; }
        grid = cus;
    }
    if (grid < 0) return;
    if (hipMemsetAsync((char*)d_ws + WS_CTL, 0, CTL_ZERO_BYTES, stream) != hipSuccess) return;
    Args a{};
    for (int i = 0; i < 18; ++i) a.in[i] = d_in[i];
    a.out = (float*)d_out; a.ws = (unsigned char*)d_ws;
    constexpr int NL = MK_N_LAUNCHES;
    for (int li = 0; li < NL; ++li) {
        a.ph_lo = (NL == 1) ? 0 : li; a.ph_hi = (NL == 1) ? N_PHASES : li + 1; a.li = li;
#if DBG_ROUTE_BF
        if (NL == 9 && li == 5) { hipLaunchKernelGGL(dbg_route_kernel, dim3(grid), dim3(NWAVES * 64), 98304, stream, a); continue; }
#endif
        hipLaunchKernelGGL(hymba_fwd, dim3(grid), dim3(NWAVES * 64), LDS_BYTES, stream, a);
    }
}
```

```cpp
#include <hip/hip_runtime.h>
#include <cstdio>
#include <cstdint>
namespace pg8 {
#define PG8_LAS __attribute__((address_space(3)))
typedef unsigned short bf16_t;
typedef short bf16x8 __attribute__((ext_vector_type(8)));
typedef float f32x4 __attribute__((ext_vector_type(4)));
typedef unsigned u32x4 __attribute__((ext_vector_type(4)));
constexpr int BM = 256, BK = 64, HALF = 128, HTB = HALF * BK * 2  , STAGE_BYTES = 8 * HTB, NXCD = 8, WGM = 8;

__host__ __device__ __forceinline__ int lds_byte(int r, int c) { const int st = (r >> 4) * 2 + (c >> 5), rr = r & 15, cc = c & 31, ob = rr * 64 + cc * 2; return st * 1024 + (ob ^ (((ob >> 9) & 1) << 5)); }
__host__ __device__ __forceinline__ void stage_rc(int b, int& R, int& C) { const int st = b / 1024, sb = b % 1024, swz = sb ^ (((sb >> 9) & 1) << 5); R = (st >> 1) * 16 + swz / 64; C = (st & 1) * 32 + (swz % 64) / 2; }
__host__ __device__ __forceinline__ int perm32(int rho) { const int n = rho >> 4, i = rho & 15; return 8 * (i >> 2) + 4 * n + (i & 3); }

struct Unit { int pm, pn; };
struct Gemm { const bf16_t* A; const bf16_t* Bt; int M, N, K, lda, ldb; };

struct StaticOrder {
    int nM, nN, nwg, G, c;
    __host__ __device__ void init(int M, int N, int G_, int c_) { nM = M / BM; nN = N / BM; nwg = nM * nN; G = G_; c = c_; }
    __host__ __device__ bool next(int i, Unit& u) const {
        const long L = (long)i * G + c; if (L >= nwg) return false;
        int wgid = (int)L; { const int q = nwg / NXCD, r = nwg % NXCD, xcd = wgid % NXCD, off = wgid / NXCD; wgid = (xcd < r ? xcd * (q + 1) : r * (q + 1) + (xcd - r) * q) + off; }
        const int nig = WGM * nN, gid = wgid / nig, fm = gid * WGM, gsz = (nM - fm) < WGM ? (nM - fm) : WGM;
        u.pm = fm + ((wgid % nig) % gsz); u.pn = (wgid % nig) / gsz; return true;
    }
    __device__ __forceinline__ void a_ready(const Unit&) const {}
    __device__ __forceinline__ void done(const Unit&) const {}
};

__device__ __forceinline__ unsigned cvt_pk_bf16(float lo, float hi) { unsigned r; asm volatile("v_cvt_pk_bf16_f32 %0, %1, %2" : "=v"(r) : "v"(lo), "v"(hi)); return r; }
typedef float f32x2 __attribute__((ext_vector_type(2)));

template <class Epi, class Sched, bool ALIGN_EPI = false, bool SP2 = false>
__device__ __forceinline__ void gemm_phase(PG8_LAS unsigned char* lds, const Gemm g, const Sched& S, const Epi& E) {
    const int tid = threadIdx.x, wid = __builtin_amdgcn_readfirstlane(tid >> 6), lane = tid & 63, wr = wid >> 2, wc = wid & 3, fr = lane & 15, fq = lane >> 4;
    const int K = g.K, nt = K / BK;
    unsigned voffA[2], voffB[2];
#pragma unroll
    for (int i = 0; i < 2; ++i) { int R, C; stage_rc(tid * 16 + i * 8192, R, C); const int Rb = Epi::PERM ? ((R & ~31) + perm32(R & 31)) : R;
        voffA[i] = (unsigned)(R * g.lda + C) * 2u; voffB[i] = (unsigned)(Rb * g.ldb + C) * 2u; }
    const size_t kstep = (size_t)(BK * 2);
    const size_t hstepA = (size_t)HALF * g.lda * 2, hstepB = (size_t)HALF * g.ldb * 2;
    const size_t tstepA = 2 * hstepA, tstepB = 2 * hstepB;
    const unsigned ldsw = (unsigned)wid * 1024u;
    const int aoff = lds_byte(wr * 64 + fr, fq * 8), boff = lds_byte(wc * 32 + fr, fq * 8);
#define PG8_SA(b, h) (((b) * 2 + (h)) * HTB)
#define PG8_SB(b, h) ((4 + (b) * 2 + (h)) * HTB)
#define PG8_STAGE(bufoff, gbase, voff) do { _Pragma("unroll") for (int _i = 0; _i < 2; ++_i) \
        __builtin_amdgcn_global_load_lds((const unsigned*)((const char*)(gbase) + (voff)[_i]), (PG8_LAS unsigned*)(lds + (bufoff) + ldsw + _i * 8192), 16, 0, 0); } while (0)
#define PG8_LDA(dst, b, h) do { _Pragma("unroll") for (int m = 0; m < 4; ++m) _Pragma("unroll") for (int k = 0; k < 2; ++k) dst[m][k] = *(const PG8_LAS bf16x8*)(lds + PG8_SA(b, h) + aoff + m * 2048 + k * 1024); } while (0)
#define PG8_LDB(dst, b, h) do { _Pragma("unroll") for (int n = 0; n < 2; ++n) _Pragma("unroll") for (int k = 0; k < 2; ++k) dst[n][k] = *(const PG8_LAS bf16x8*)(lds + PG8_SB(b, h) + boff + n * 2048 + k * 1024); } while (0)
#define PG8_MMA(ai, bj, At, Bt) do { __builtin_amdgcn_s_setprio(1); _Pragma("unroll") for (int m = 0; m < 4; ++m) _Pragma("unroll") for (int n = 0; n < 2; ++n) _Pragma("unroll") for (int k = 0; k < 2; ++k) \
        acc[ai][bj][m][n] = __builtin_amdgcn_mfma_f32_16x16x32_bf16(Bt[n][k], At[m][k], acc[ai][bj][m][n], 0, 0, 0); __builtin_amdgcn_s_setprio(0); } while (0)
#define PG8_WAIT_V(n) asm volatile("s_waitcnt vmcnt(" #n ")" ::: "memory")
#define PG8_WAIT_L(n) asm volatile("s_waitcnt lgkmcnt(" #n ")" ::: "memory")
#define PG8_BAR __builtin_amdgcn_s_barrier()
#define PG8_SCHED __builtin_amdgcn_sched_barrier(0)
    Unit cur, nxt; int ui = 0;
    if (!S.next(0, cur)) return;
    f32x4 acc[2][2][4][2];
#pragma unroll
    for (int a = 0; a < 2; ++a)
#pragma unroll
        for (int b = 0; b < 2; ++b)
#pragma unroll
            for (int m = 0; m < 4; ++m)
#pragma unroll
                for (int n = 0; n < 2; ++n) acc[a][b][m][n] = (f32x4){0.f, 0.f, 0.f, 0.f};
    bf16x8 At[4][2], B0[2][2], B1[2][2];
    const char* cA = (const char*)g.A + (size_t)cur.pm * tstepA; const char* cB = (const char*)g.Bt + (size_t)cur.pn * tstepB;
    S.a_ready(cur);
    if constexpr (SP2) {
        PG8_STAGE(PG8_SB(0, 0), cB, voffB); PG8_STAGE(PG8_SB(0, 1), cB + hstepB, voffB); PG8_STAGE(PG8_SA(0, 0), cA, voffA); PG8_STAGE(PG8_SA(0, 1), cA + hstepA, voffA);
        if (wr == 1) PG8_BAR;
        PG8_WAIT_V(2); PG8_BAR;
        PG8_STAGE(PG8_SB(1, 0), cB + kstep, voffB); PG8_STAGE(PG8_SA(1, 0), cA + kstep, voffA); PG8_STAGE(PG8_SB(1, 1), cB + hstepB + kstep, voffB);
        PG8_WAIT_V(6); PG8_BAR;
    } else {
        PG8_STAGE(PG8_SB(0, 0), cB, voffB); PG8_STAGE(PG8_SA(0, 0), cA, voffA); PG8_STAGE(PG8_SB(0, 1), cB + hstepB, voffB); PG8_STAGE(PG8_SA(0, 1), cA + hstepA, voffA);
        if (wr == 1) PG8_BAR;
        PG8_WAIT_V(4); PG8_BAR;
        PG8_STAGE(PG8_SB(1, 0), cB + kstep, voffB); PG8_STAGE(PG8_SA(1, 0), cA + kstep, voffA); PG8_STAGE(PG8_SB(1, 1), cB + hstepB + kstep, voffB);
        PG8_WAIT_V(6); PG8_BAR;
    }
    for (;;) {
        const bool has_next = S.next(ui + 1, nxt);
        const char* nA = has_next ? (const char*)g.A + (size_t)nxt.pm * tstepA : cA; const char* nB = has_next ? (const char*)g.Bt + (size_t)nxt.pn * tstepB : cB;
        for (int t = 0; t < nt; t += 2) {
            const bool last = (t == nt - 2);
            const char* a1 = cA + (size_t)(t + 1) * kstep;
            const char* a2 = last ? nA : cA + (size_t)(t + 2) * kstep; const char* b2 = last ? nB : cB + (size_t)(t + 2) * kstep;
            const char* a3 = a2 + kstep; const char* b3 = b2 + kstep;
            if (last && has_next) S.a_ready(nxt);
            if constexpr (SP2) {
            PG8_LDB(B0, 0, 0); PG8_LDB(B1, 0, 1); PG8_SCHED; PG8_LDA(At, 0, 0); PG8_STAGE(PG8_SA(1, 1), a1 + hstepA, voffA);
            PG8_WAIT_V(8); PG8_WAIT_L(0); PG8_BAR; PG8_MMA(0, 0, At, B0); PG8_MMA(0, 1, At, B1); PG8_BAR; PG8_SCHED;
            PG8_LDA(At, 0, 1); PG8_STAGE(PG8_SB(0, 0), b2, voffB); PG8_STAGE(PG8_SB(0, 1), b2 + hstepB, voffB); PG8_STAGE(PG8_SA(0, 0), a2, voffA);
            PG8_WAIT_V(8); PG8_WAIT_L(0); PG8_BAR; PG8_MMA(1, 0, At, B0); PG8_MMA(1, 1, At, B1); PG8_BAR; PG8_SCHED;
            PG8_LDB(B0, 1, 0); PG8_LDB(B1, 1, 1); PG8_SCHED; PG8_LDA(At, 1, 0); PG8_STAGE(PG8_SA(0, 1), a2 + hstepA, voffA);
            PG8_WAIT_V(8); PG8_WAIT_L(0); PG8_BAR; PG8_MMA(0, 0, At, B0); PG8_MMA(0, 1, At, B1); PG8_BAR; PG8_SCHED;
            PG8_LDA(At, 1, 1); PG8_STAGE(PG8_SB(1, 0), b3, voffB); PG8_STAGE(PG8_SB(1, 1), b3 + hstepB, voffB); PG8_STAGE(PG8_SA(1, 0), a3, voffA);
            PG8_WAIT_V(8); PG8_WAIT_L(0); PG8_BAR; PG8_MMA(1, 0, At, B0); PG8_MMA(1, 1, At, B1); PG8_BAR; PG8_SCHED;
            } else {
            PG8_LDB(B0, 0, 0); PG8_SCHED; PG8_LDA(At, 0, 0); PG8_STAGE(PG8_SA(1, 1), a1 + hstepA, voffA);
            PG8_WAIT_L(8); PG8_BAR; PG8_WAIT_L(0); PG8_MMA(0, 0, At, B0); PG8_BAR; PG8_SCHED;
            PG8_LDB(B1, 0, 1); PG8_STAGE(PG8_SB(0, 0), b2, voffB);
            PG8_BAR; PG8_WAIT_L(0); PG8_MMA(0, 1, At, B1); PG8_BAR;
            PG8_LDA(At, 0, 1); PG8_STAGE(PG8_SA(0, 0), a2, voffA);
            PG8_BAR; PG8_WAIT_L(0); PG8_MMA(1, 0, At, B0); PG8_BAR; PG8_SCHED;
            PG8_STAGE(PG8_SB(0, 1), b2 + hstepB, voffB);
            PG8_WAIT_V(6); PG8_BAR; PG8_MMA(1, 1, At, B1); PG8_BAR;
            PG8_LDB(B0, 1, 0); PG8_SCHED; PG8_LDA(At, 1, 0); PG8_STAGE(PG8_SA(0, 1), a2 + hstepA, voffA);
            PG8_WAIT_L(8); PG8_BAR; PG8_WAIT_L(0); PG8_MMA(0, 0, At, B0); PG8_BAR; PG8_SCHED;
            PG8_LDB(B1, 1, 1); PG8_STAGE(PG8_SB(1, 0), b3, voffB);
            PG8_BAR; PG8_WAIT_L(0); PG8_MMA(0, 1, At, B1); PG8_BAR;
            PG8_LDA(At, 1, 1); PG8_STAGE(PG8_SA(1, 0), a3, voffA);
            PG8_BAR; PG8_WAIT_L(0); PG8_MMA(1, 0, At, B0); PG8_BAR; PG8_SCHED;
            PG8_STAGE(PG8_SB(1, 1), b3 + hstepB, voffB);
            PG8_WAIT_V(6); PG8_BAR; PG8_MMA(1, 1, At, B1); PG8_BAR;
            }
        }
        if constexpr (ALIGN_EPI) { if (wr == 0) PG8_BAR; }
        if constexpr (!Epi::AFTER_DRAIN) { E(acc, cur, wr, wc, fr, fq); S.done(cur); }
        if (!has_next) break;
#pragma unroll
        for (int a = 0; a < 2; ++a)
#pragma unroll
            for (int b = 0; b < 2; ++b)
#pragma unroll
                for (int m = 0; m < 4; ++m)
#pragma unroll
                    for (int n = 0; n < 2; ++n) acc[a][b][m][n] = (f32x4){0.f, 0.f, 0.f, 0.f};
        cur = nxt; cA = nA; cB = nB; ++ui;
        if constexpr (ALIGN_EPI) { if (wr == 1) PG8_BAR; }
    }
    PG8_WAIT_V(0);
    if constexpr (!ALIGN_EPI) { if (wr == 0) PG8_BAR; }
    PG8_BAR;
    if constexpr (Epi::AFTER_DRAIN) { E.fused(acc, cur, wr, wc, fr, fq, lds, wid, lane); S.done(cur); }
#undef PG8_SA
#undef PG8_SB
#undef PG8_STAGE
#undef PG8_LDA
#undef PG8_LDB
#undef PG8_MMA
#undef PG8_WAIT_V
#undef PG8_WAIT_L
#undef PG8_BAR
#undef PG8_SCHED
}
}


constexpr int NWAVES = 8;
constexpr int DM = 2048, BATCH = 2, SEQ = 4096, M = BATCH * SEQ;
constexpr int HD = 64, NQH = 16, NKVH = 4, ATTW = 1024, KVW = 256, POOLW = 1024, INW = 2560;
constexpr int PKH = 8, NEXP = 16384, PLE = 256;
constexpr float EPS = 1e-6f;
#ifndef MK_N_LAUNCHES
#define MK_N_LAUNCHES 1
#endif
constexpr int N_PHASES = 9;
#ifndef DBG_NO_PEER
#define DBG_NO_PEER 0
#endif
#ifndef DBG_NO_PLE
#define DBG_NO_PLE 0
#endif
#ifndef DBG_NO_MIX
#define DBG_NO_MIX 0
#endif

constexpr size_t MiB = 1u << 20;
constexpr size_t WS_CTL = 0, CTL_ZERO_BYTES = 256 * 1024;
constexpr size_t WS_WIN = 1 * MiB, WS_WOUT = 11 * MiB, WS_WQ = 19 * MiB, WS_WG = 27 * MiB, WS_WP = 35 * MiB, WS_WPOOL = 36 * MiB;
constexpr size_t WS_SKH = 36 * MiB + 512 * 1024, WS_SKL = WS_SKH + 64 * 1024;
constexpr size_t WS_ROPE = 37 * MiB;
constexpr size_t WS_RSTD1 = 37 * MiB + 512 * 1024, WS_RSTD3 = WS_RSTD1 + 32 * 1024;
constexpr size_t WS_EU = 38 * MiB, WS_EV = 102 * MiB;
constexpr size_t WS_XB = 166 * MiB, WS_PB = 198 * MiB;
constexpr size_t WS_Q = 202 * MiB, WS_K = 218 * MiB, WS_V = 222 * MiB, WS_U = 226 * MiB, WS_POOLED = 242 * MiB, WS_MIX = 258 * MiB;
constexpr size_t WS_QP = 202 * MiB;
constexpr size_t WS_EIDX = 266 * MiB, WS_GATE = 270 * MiB;
constexpr size_t WS_H1 = 290 * MiB, WS_H1B = 354 * MiB, WS_PP = 386 * MiB, WS_H2B = 418 * MiB, WS_END = 450 * MiB;
constexpr int CW_BAR = 4096;
constexpr int CW_SSQ2 = 16384, CW_SSQ4 = 16384 + 8192;
static_assert((CW_SSQ4 + 8192) * 4 <= (int)CTL_ZERO_BYTES, "ctl");

constexpr int RING_OFF = 0, RING_BYTES = 131072;
constexpr int LDSCTL_OFF = RING_BYTES, MISC_OFF = LDSCTL_OFF + 320;
constexpr int LDS_BYTES = 147456;

#define GAS __attribute__((address_space(1)))
#define LAS __attribute__((address_space(3)))
typedef unsigned short bf16;
typedef unsigned v4u __attribute__((ext_vector_type(4)));
typedef unsigned v2u __attribute__((ext_vector_type(2)));
typedef float f32x4 __attribute__((ext_vector_type(4)));
typedef float f32x16 __attribute__((ext_vector_type(16)));
typedef short bf16x8 __attribute__((ext_vector_type(8)));
typedef GAS unsigned gu32;
#define RLX_AGENT __ATOMIC_RELAXED, __HIP_MEMORY_SCOPE_AGENT
#define LDS_WAIT() asm volatile("s_waitcnt lgkmcnt(0)" ::: "memory")
#define VM_WAIT() asm volatile("s_waitcnt vmcnt(0)" ::: "memory")
typedef float f32x2_t __attribute__((ext_vector_type(2))); typedef __bf16 bf16x2_t __attribute__((ext_vector_type(2)));
__device__ __forceinline__ unsigned pk2(float lo, float hi) { f32x2_t v = {lo, hi}; bf16x2_t b = __builtin_convertvector(v, bf16x2_t); return __builtin_bit_cast(unsigned, b); }
__device__ __forceinline__ float bf_lo(unsigned w) { return __uint_as_float(w << 16); }
__device__ __forceinline__ float bf_hi(unsigned w) { return __uint_as_float(w & 0xffff0000u); }
__device__ __forceinline__ float dot2bf(unsigned a, unsigned b, float c) { return __builtin_amdgcn_fdot2_f32_bf16(__builtin_bit_cast(bf16x2_t, a), __builtin_bit_cast(bf16x2_t, b), c, false); }
__device__ __forceinline__ float max2f(float a, float b) { float r; asm("v_max_f32_e32 %0, %1, %2" : "=v"(r) : "v"(a), "v"(b)); return r; }
__device__ __forceinline__ float min2f(float a, float b) { float r; asm("v_min_f32_e32 %0, %1, %2" : "=v"(r) : "v"(a), "v"(b)); return r; }
__device__ __forceinline__ float wave_sum(float v) {
#pragma unroll
    for (int o = 1; o < 64; o <<= 1) v += __shfl_xor(v, o);
    return v;
}

#define XB_TMO      128
#define XB_XCNT(j)  (256  + 64 * (j))
#define XB_XSUB(j)  (1280 + 64 * (j))
#define XB_XGEN(j)  (2304 + 64 * (j))
#define XB_TOP      3328
#define XB_TOPGEN   3392
#define XCD_BAR_WORDS 3456
#define XB_SPIN_CAP (1u << 18)
__device__ __forceinline__ unsigned xb_ld(unsigned* p)              { return __hip_atomic_load(p, __ATOMIC_RELAXED, __HIP_MEMORY_SCOPE_AGENT); }
__device__ __forceinline__ unsigned xb_add(unsigned* p, unsigned v) { return __hip_atomic_fetch_add(p, v, __ATOMIC_RELAXED, __HIP_MEMORY_SCOPE_AGENT); }
__device__ __forceinline__ unsigned xb_xcc_id() { return (unsigned)__builtin_amdgcn_s_getreg((3 << 11) | 20) & 0xFu; }
#define XB_SPIN(cond, bar) do { unsigned _sp = 0; while (cond) { __builtin_amdgcn_s_sleep(1); \
    if ((++_sp & 255u) == 0u) { if (xb_ld(&(bar)[XB_TMO])) break; if (_sp > XB_SPIN_CAP) { atomicAdd(&(bar)[XB_TMO], 1u); break; } } } } while (0)
struct XcdBarrier { unsigned* bar; unsigned x; volatile LAS unsigned* st; };
__device__ __forceinline__ XcdBarrier xcd_barrier_post(unsigned* bar, volatile LAS unsigned* st) {
    XcdBarrier b; b.bar = bar; b.x = xb_xcc_id(); b.st = st;
    if (threadIdx.x == 0) (void)xb_add(&bar[XB_XCNT(b.x)], 1u);
    return b;
}
__device__ __forceinline__ void xcd_barrier_complete(unsigned* bar, unsigned x, unsigned& nloc, unsigned& nx) {
    const unsigned G = gridDim.x * gridDim.y * gridDim.z;
    unsigned sum, cnt, mine, sp = 0u;
    for (;;) {
        sum = 0u; cnt = 0u; mine = 0u;
#pragma unroll
        for (unsigned j = 0; j < 16; ++j) { const unsigned c = xb_ld(&bar[XB_XCNT(j)]); sum += c; cnt += (c > 0u) ? 1u : 0u; mine = (j == x) ? c : mine; }
        if (sum == G) break;
        __builtin_amdgcn_s_sleep(1);
        if ((++sp & 255u) == 0u) { if (xb_ld(&bar[XB_TMO])) break; if (sp > XB_SPIN_CAP) { atomicAdd(&bar[XB_TMO], 1u); break; } }
    }
    nloc = mine > 0u ? mine : 1u; nx = cnt > 0u ? cnt : 1u;
}
__device__ __forceinline__ void xcd_barrier(const XcdBarrier& b) {
    asm volatile("s_waitcnt vmcnt(0)" ::: "memory");
    __syncthreads();
    if (threadIdx.x == 0) {
        unsigned* bar = b.bar;
        __builtin_amdgcn_s_waitcnt(0);
        unsigned nloc = b.st[0], nx = b.st[1];
        if (nloc == 0u) { xcd_barrier_complete(bar, b.x, nloc, nx); b.st[0] = nloc; b.st[1] = nx; }
        const unsigned old = xb_add(&bar[XB_XSUB(b.x)], 1u);
        const unsigned gen = old / nloc;
        if (old + 1u == (gen + 1u) * nloc) {
            __builtin_amdgcn_fence(__ATOMIC_RELEASE, "agent");
            asm volatile("s_waitcnt vmcnt(0)" ::: "memory");
            const unsigned og = xb_add(&bar[XB_TOP], 1u);
            const unsigned tg = og / nx;
            if (og + 1u == (tg + 1u) * nx) xb_add(&bar[XB_TOPGEN], 1u);
            else XB_SPIN(xb_ld(&bar[XB_TOPGEN]) == tg, bar);
            __builtin_amdgcn_fence(__ATOMIC_ACQUIRE, "agent");
            xb_add(&bar[XB_XGEN(b.x)], 1u);
            asm volatile("s_waitcnt vmcnt(0)" ::: "memory");
        } else {
            XB_SPIN(xb_ld(&bar[XB_XGEN(b.x)]) == gen, bar);
            __builtin_amdgcn_fence(__ATOMIC_ACQUIRE, "agent");
            asm volatile("s_waitcnt vmcnt(0)" ::: "memory");
        }
    }
    __syncthreads();
}

struct Frame {
    LAS unsigned char* lds;
    volatile LAS unsigned* MISC;
    gu32* ctl;
    int tid, lane, wave;
    int vcu, G;
    const float *x, *p, *g_mix, *w_in, *sinks, *w_pool, *pool_scale, *w_out, *g_ffn, *w_query, *sub_keys, *expert_u, *expert_v, *g_ple, *w_ple_gate, *w_ple_proj, *g_final;
    const int* positions;
    float* out;
    unsigned char* ws;
};
#define F_Win_t  ((bf16*)(F.ws + WS_WIN))
#define F_Wout_t ((bf16*)(F.ws + WS_WOUT))
#define F_Wq_t   ((bf16*)(F.ws + WS_WQ))
#define F_Wg_t   ((bf16*)(F.ws + WS_WG))
#define F_Wp_t   ((bf16*)(F.ws + WS_WP))
#define F_Wpool_t ((bf16*)(F.ws + WS_WPOOL))
#define F_SKH    ((bf16*)(F.ws + WS_SKH))
#define F_SKL    ((bf16*)(F.ws + WS_SKL))
#define F_EU     ((bf16*)(F.ws + WS_EU))
#define F_EV     ((bf16*)(F.ws + WS_EV))
#define F_XB     ((bf16*)(F.ws + WS_XB))
#define F_PB     ((bf16*)(F.ws + WS_PB))
#define F_QB     ((bf16*)(F.ws + WS_Q))
#define F_KB     ((bf16*)(F.ws + WS_K))
#define F_VB     ((bf16*)(F.ws + WS_V))
#define F_UB     ((bf16*)(F.ws + WS_U))
#define F_POOLED ((bf16*)(F.ws + WS_POOLED))
#define F_MIX    ((bf16*)(F.ws + WS_MIX))
#define F_H1B    ((bf16*)(F.ws + WS_H1B))
#define F_PP     ((bf16*)(F.ws + WS_PP))
#define F_H2B    ((bf16*)(F.ws + WS_H2B))
#define F_ROPE   ((float*)(F.ws + WS_ROPE))
#define F_RSTD1  ((float*)(F.ws + WS_RSTD1))
#define F_RSTD3  ((float*)(F.ws + WS_RSTD3))
#define F_QP     ((float*)(F.ws + WS_QP))
#define F_GATE   ((float*)(F.ws + WS_GATE))
#define F_H1     ((float*)(F.ws + WS_H1))
#define F_SSQ2   ((float*)(F.ws + WS_CTL) + CW_SSQ2)
#define F_SSQ4   ((float*)(F.ws + WS_CTL) + CW_SSQ4)
#define F_EIDX   ((int*)(F.ws + WS_EIDX))

__device__ __forceinline__ void p0_transpose_item(const float* W, int ldw, int N, const float* gain, bf16* WT, int ldt, LAS float* scr, int item, int lane) {
    const int nblk = N / 32, kb = item / nblk, nb = item % nblk, k0 = 64 * kb, n0 = 32 * nb;
#pragma unroll 8
    for (int i = 0; i < 32; ++i) { const int kk = 2 * i + (lane >> 5); float w = W[(size_t)(k0 + kk) * ldw + n0 + (lane & 31)]; if (gain) w *= gain[k0 + kk]; scr[kk * 33 + (lane & 31)] = w; }
    LDS_WAIT(); asm volatile("" ::: "memory");
    const int c = lane & 7;
#pragma unroll
    for (int j = 0; j < 4; ++j) { const int n = (lane >> 3) + 8 * j; const LAS float* s = scr + (8 * c) * 33 + n;
        v4u o; o.x = pk2(s[0 * 33], s[1 * 33]); o.y = pk2(s[2 * 33], s[3 * 33]); o.z = pk2(s[4 * 33], s[5 * 33]); o.w = pk2(s[6 * 33], s[7 * 33]);
        *(GAS v4u*)(WT + (size_t)(n0 + n) * ldt + k0 + 8 * c) = o; }
    LDS_WAIT(); asm volatile("" ::: "memory");
}
__device__ __forceinline__ void p0_prologue(Frame& F) {
    LAS float* scr = (LAS float*)(F.lds + RING_OFF + F.wave * 16384);
    const int gw = F.vcu * NWAVES + F.wave, NGW = F.G * NWAVES;
    const int gt = gw * 64 + F.lane, NGT = NGW * 64;
    constexpr int I_IN = (DM / 64) * (INW / 32), I_SQ = (DM / 64) * (DM / 32), I_P = (PLE / 64) * (DM / 32), I_POOL = 4 * (256 / 64) * (256 / 32);
    constexpr int NITEMS = I_IN + 3 * I_SQ + I_P + I_POOL;
    for (int it = gw; it < NITEMS; it += NGW) {
        int r = it;
        if (r < I_IN) { p0_transpose_item(F.w_in, INW, INW, F.g_mix, F_Win_t, DM, scr, r, F.lane); continue; } r -= I_IN;
        if (r < I_SQ) { p0_transpose_item(F.w_out, DM, DM, nullptr, F_Wout_t, DM, scr, r, F.lane); continue; } r -= I_SQ;
        if (r < I_SQ) { p0_transpose_item(F.w_query, DM, DM, F.g_ffn, F_Wq_t, DM, scr, r, F.lane); continue; } r -= I_SQ;
        if (r < I_SQ) { p0_transpose_item(F.w_ple_gate, DM, DM, F.g_ple, F_Wg_t, DM, scr, r, F.lane); continue; } r -= I_SQ;
        if (r < I_P) { p0_transpose_item(F.w_ple_proj, DM, DM, nullptr, F_Wp_t, PLE, scr, r, F.lane); continue; } r -= I_P;
        { const int g = r / 32, rr = r % 32; p0_transpose_item(F.w_pool + (size_t)g * 65536, 256, 256, nullptr, F_Wpool_t + (size_t)g * 65536, 256, scr, rr, F.lane); }
    }
    for (int m = gw; m < M; m += NGW) {
        const GAS f32x4* xr = (const GAS f32x4*)(F.x + (size_t)m * DM) + F.lane;
        f32x4 v[8]; float s = 0.f;
#pragma unroll
        for (int j = 0; j < 8; ++j) { v[j] = xr[64 * j]; s += (v[j].x * v[j].x + v[j].y * v[j].y) + (v[j].z * v[j].z + v[j].w * v[j].w); }
        s = wave_sum(s);
        if (F.lane == 0) F_RSTD1[m] = 1.0f / sqrtf(s * (1.0f / DM) + EPS);
        GAS v2u* o8 = (GAS v2u*)(F_XB + (size_t)m * DM) + F.lane;
#pragma unroll
        for (int j = 0; j < 8; ++j) { v2u o; o.x = pk2(v[j].x, v[j].y); o.y = pk2(v[j].z, v[j].w); o8[64 * j] = o; }
    }
    for (int c = gt; c < M * PLE / 8; c += NGT) {
        const GAS f32x4* s = (const GAS f32x4*)F.p + 2 * (size_t)c; const f32x4 a = s[0], b = s[1];
        v4u o; o.x = pk2(a.x, a.y); o.y = pk2(a.z, a.w); o.z = pk2(b.x, b.y); o.w = pk2(b.z, b.w);
        *((GAS v4u*)F_PB + c) = o;
    }
    for (int c = gt; c < NEXP * DM / 8; c += NGT) {
        const int e = c >> 8, d0 = (c & 255) * 8; const size_t dst = ((size_t)(d0 >> 6) * NEXP + e) * 64 + (d0 & 63);
        const GAS f32x4* s = (const GAS f32x4*)F.expert_u + 2 * (size_t)c; f32x4 a = s[0], b = s[1];
        const f32x4 ga = *(const GAS f32x4*)(F.g_ffn + d0), gb = *(const GAS f32x4*)(F.g_ffn + d0 + 4);
        a = a * ga; b = b * gb;
        v4u o; o.x = pk2(a.x, a.y); o.y = pk2(a.z, a.w); o.z = pk2(b.x, b.y); o.w = pk2(b.z, b.w);
        *(GAS v4u*)(F_EU + dst) = o;
    }
    for (int c = gt; c < NEXP * DM / 8; c += NGT) {
        const int e = c >> 8, d0 = (c & 255) * 8; const size_t dst = ((size_t)(d0 >> 6) * NEXP + e) * 64 + (d0 & 63);
        const GAS f32x4* s = (const GAS f32x4*)F.expert_v + 2 * (size_t)c; const f32x4 a = s[0], b = s[1];
        v4u o; o.x = pk2(a.x, a.y); o.y = pk2(a.z, a.w); o.z = pk2(b.x, b.y); o.w = pk2(b.z, b.w);
        *(GAS v4u*)(F_EV + dst) = o;
    }
    for (int c = gt; c < M * 8; c += NGT) {
        const int t = c >> 3, i = c & 7;
        const float inv = 1.0f / (float)pow(500000.0, (double)(2 * i) / 16.0);
        const float ang = (float)F.positions[t] * inv;
        F_ROPE[t * 16 + i] = (float)cos((double)ang); F_ROPE[t * 16 + 8 + i] = (float)sin((double)ang);
    }
    for (int c = gt; c < 2 * 128 * 128; c += NGT) {
        const float v = F.sub_keys[c]; const unsigned h = pk2(v, 0.f) & 0xffffu; const float hf = __uint_as_float(h << 16);
        F_SKH[c] = (bf16)h; F_SKL[c] = (bf16)(pk2(v - hf, 0.f) & 0xffffu);
    }
}

struct EpiG1 {
    static constexpr bool PERM = true, AFTER_DRAIN = false;
    bf16 *Q, *Kb, *Vb, *U; const float* rstd; const float* rope;
    __device__ __forceinline__ void operator()(const f32x4 (&acc)[2][2][4][2], const pg8::Unit& u, int wr, int wc, int fr, int fq) const {
        const int pn = u.pn; bf16* base; int ldc, colt;
        if (pn < 4) { base = Q; ldc = ATTW; colt = pn * 256; } else if (pn == 4) { base = Kb; ldc = KVW; colt = 0; } else if (pn == 5) { base = Vb; ldc = KVW; colt = 0; } else { base = U; ldc = POOLW; colt = (pn - 6) * 256; }
        const bool rot = (pn <= 4) && ((wc & 1) == 0);
        const float qs = (pn < 4) ? 0.125f : 1.0f;
#pragma unroll
        for (int ai = 0; ai < 2; ++ai)
#pragma unroll
            for (int m = 0; m < 4; ++m) {
                const int row = u.pm * 256 + ai * 128 + wr * 64 + m * 16 + fr;
                const float rs = rstd[row] * qs;
                const GAS f32x4* rp = (const GAS f32x4*)(rope + (size_t)row * 16);
#pragma unroll
                for (int bj = 0; bj < 2; ++bj) {
                    f32x4 v0 = acc[ai][bj][m][0] * rs, v1 = acc[ai][bj][m][1] * rs;
                    if (rot) {
                        { const f32x4 c = rp[0], s = rp[2]; f32x4 p;
#pragma unroll
                          for (int i = 0; i < 4; ++i) p[i] = __shfl_xor(v0[i], 16);
                          if (fq == 0) v0 = v0 * c - p * s; else if (fq == 1) v0 = v0 * c + p * s; }
                        { const f32x4 c = rp[1], s = rp[3]; f32x4 p;
#pragma unroll
                          for (int i = 0; i < 4; ++i) p[i] = __shfl_xor(v1[i], 16);
                          if (fq == 0) v1 = v1 * c - p * s; else if (fq == 1) v1 = v1 * c + p * s; }
                    }
                    v4u w; w.x = pk2(v0[0], v0[1]); w.y = pk2(v0[2], v0[3]); w.z = pk2(v1[0], v1[1]); w.w = pk2(v1[2], v1[3]);
                    *(GAS v4u*)(base + (size_t)row * ldc + colt + bj * 128 + wc * 32 + 8 * fq) = w;
                }
            }
    }
};
template <bool HAS_SCALE> struct EpiBf16Scale {
    static constexpr bool PERM = true, AFTER_DRAIN = false;
    bf16* O; int ldc, col_off; const float* cscale;
    __device__ __forceinline__ void operator()(const f32x4 (&acc)[2][2][4][2], const pg8::Unit& u, int wr, int wc, int fr, int fq) const {
        const int c0 = u.pn * 256 + wc * 32 + 8 * fq;
#pragma unroll
        for (int ai = 0; ai < 2; ++ai)
#pragma unroll
            for (int m = 0; m < 4; ++m) {
                const int row = u.pm * 256 + ai * 128 + wr * 64 + m * 16 + fr;
#pragma unroll
                for (int bj = 0; bj < 2; ++bj) {
                    f32x4 v0 = acc[ai][bj][m][0], v1 = acc[ai][bj][m][1];
                    if constexpr (HAS_SCALE) { v0 = v0 * *(const GAS f32x4*)(cscale + c0 + bj * 128); v1 = v1 * *(const GAS f32x4*)(cscale + c0 + bj * 128 + 4); }
                    v4u w; w.x = pk2(v0[0], v0[1]); w.y = pk2(v0[2], v0[3]); w.z = pk2(v1[0], v1[1]); w.w = pk2(v1[2], v1[3]);
                    *(GAS v4u*)(O + (size_t)row * ldc + col_off + c0 + bj * 128) = w;
                }
            }
    }
};
struct EpiG3 {
    static constexpr bool PERM = false, AFTER_DRAIN = false;
    const float* x; float* h1; bf16* h1b; float* ssq;
    __device__ __forceinline__ void operator()(const f32x4 (&acc)[2][2][4][2], const pg8::Unit& u, int wr, int wc, int fr, int fq) const {
        const int col0 = u.pn * 256 + wc * 32 + 4 * fq;
#pragma unroll
        for (int ai = 0; ai < 2; ++ai)
#pragma unroll
            for (int m = 0; m < 4; ++m) {
                const int row = u.pm * 256 + ai * 128 + wr * 64 + m * 16 + fr; float ss = 0.f;
#pragma unroll
                for (int bj = 0; bj < 2; ++bj)
#pragma unroll
                    for (int n = 0; n < 2; ++n) {
                        const size_t off = (size_t)row * DM + col0 + bj * 128 + n * 16;
                        const f32x4 h = DBG_NO_MIX ? *(const GAS f32x4*)(x + off) : *(const GAS f32x4*)(x + off) + acc[ai][bj][m][n];
                        *(GAS f32x4*)(h1 + off) = h;
                        v2u w; w.x = pk2(h[0], h[1]); w.y = pk2(h[2], h[3]); *(GAS v2u*)(h1b + off) = w;
                        ss += (h[0] * h[0] + h[1] * h[1]) + (h[2] * h[2] + h[3] * h[3]);
                    }
                ss += __shfl_xor(ss, 16); ss += __shfl_xor(ss, 32);
                if (fq == 0) atomicAdd(ssq + row, ss);
            }
    }
};
struct EpiG4 {
    static constexpr bool PERM = false, AFTER_DRAIN = false;
    float* qp; const float* ssq;
    __device__ __forceinline__ void operator()(const f32x4 (&acc)[2][2][4][2], const pg8::Unit& u, int wr, int wc, int fr, int fq) const {
        const int col0 = u.pn * 256 + wc * 32 + 4 * fq;
#pragma unroll
        for (int ai = 0; ai < 2; ++ai)
#pragma unroll
            for (int m = 0; m < 4; ++m) {
                const int row = u.pm * 256 + ai * 128 + wr * 64 + m * 16 + fr;
                const float rs = 1.0f / sqrtf(__hip_atomic_load(ssq + row, RLX_AGENT) * (1.0f / DM) + EPS);
#pragma unroll
                for (int bj = 0; bj < 2; ++bj)
#pragma unroll
                    for (int n = 0; n < 2; ++n) *(GAS f32x4*)(qp + (size_t)row * DM + col0 + bj * 128 + n * 16) = acc[ai][bj][m][n] * rs;
            }
    }
};
struct EpiG5 {
    static constexpr bool PERM = false, AFTER_DRAIN = false;
    const float* h2; const bf16* pp; const float* rstd3; float* out; float* ssq;
    __device__ __forceinline__ void operator()(const f32x4 (&acc)[2][2][4][2], const pg8::Unit& u, int wr, int wc, int fr, int fq) const {
        const int col0 = u.pn * 256 + wc * 32 + 4 * fq;
#pragma unroll
        for (int ai = 0; ai < 2; ++ai)
#pragma unroll
            for (int m = 0; m < 4; ++m) {
                const int row = u.pm * 256 + ai * 128 + wr * 64 + m * 16 + fr; float ss = 0.f;
                const float rs = rstd3[row];
#pragma unroll
                for (int bj = 0; bj < 2; ++bj)
#pragma unroll
                    for (int n = 0; n < 2; ++n) {
                        const size_t off = (size_t)row * DM + col0 + bj * 128 + n * 16;
                        const f32x4 z = DBG_NO_PLE ? (f32x4){-1e30f, -1e30f, -1e30f, -1e30f} : acc[ai][bj][m][n] * rs; const v2u pw = *(const GAS v2u*)(pp + off); const f32x4 hv = *(const GAS f32x4*)(h2 + off);
                        f32x4 o;
                        o[0] = hv[0] + bf_lo(pw.x) / (1.0f + __expf(-z[0])); o[1] = hv[1] + bf_hi(pw.x) / (1.0f + __expf(-z[1]));
                        o[2] = hv[2] + bf_lo(pw.y) / (1.0f + __expf(-z[2])); o[3] = hv[3] + bf_hi(pw.y) / (1.0f + __expf(-z[3]));
                        *(GAS f32x4*)(out + off) = o;
                        ss += (o[0] * o[0] + o[1] * o[1]) + (o[2] * o[2] + o[3] * o[3]);
                    }
                ss += __shfl_xor(ss, 16); ss += __shfl_xor(ss, 32);
                if (fq == 0) atomicAdd(ssq + row, ss);
            }
    }
};
struct SingleUnit {
    int pm, pn;
    __device__ __forceinline__ bool next(int i, pg8::Unit& u) const { if (i != 0) return false; u.pm = pm; u.pn = pn; return true; }
    __device__ __forceinline__ void a_ready(const pg8::Unit&) const {}
    __device__ __forceinline__ void done(const pg8::Unit&) const {}
};

__device__ __forceinline__ int crow(int r, int hi) { return (r & 3) + 8 * (r >> 2) + 4 * hi; }
constexpr int KS_STRIDE = 144, VT_STRIDE = 520, VT_OFF = 256 * KS_STRIDE;
__device__ __forceinline__ void attn_unit(Frame& F, int unit) {
    const int g = unit & 3, nblk = (unit >> 2) & 31, b = unit >> 7;
    const int t0 = b * SEQ + nblk * 128;
    LAS unsigned char* Ks = F.lds + RING_OFF;
    LAS unsigned char* Vt = F.lds + RING_OFF + VT_OFF;
    for (int c = F.tid; c < 2048; c += NWAVES * 64) {
        const int j = c >> 3, ch = c & 7;
        v4u kv = {0u, 0u, 0u, 0u}, vv = {0u, 0u, 0u, 0u};
        if (nblk > 0 || j >= 128) { const size_t row = (size_t)(t0 - 128 + j); kv = *(const GAS v4u*)(F_KB + row * KVW + g * 64 + ch * 8); vv = *(const GAS v4u*)(F_VB + row * KVW + g * 64 + ch * 8); }
        *(LAS v4u*)(Ks + j * KS_STRIDE + ch * 16) = kv;
#pragma unroll
        for (int e = 0; e < 8; ++e) *(LAS unsigned short*)(Vt + (ch * 8 + e) * VT_STRIDE + j * 2) = (unsigned short)((vv[e >> 1] >> (16 * (e & 1))) & 0xffffu);
    }
    __syncthreads();
    const int hq = 4 * g + (F.wave >> 1);
    const float sink = F.sinks[hq];
    const int q = F.lane & 31, h = F.lane >> 5;
#pragma unroll 1
    for (int sub = 0; sub < 2; ++sub) {
        const int i0 = (F.wave & 1) * 64 + sub * 32;
        bf16x8 qf[4];
#pragma unroll
        for (int ks = 0; ks < 4; ++ks) qf[ks] = *(const GAS bf16x8*)(F_QB + (size_t)(t0 + i0 + q) * ATTW + hq * 64 + 16 * ks + 8 * h);
        f32x16 s[5];
#pragma unroll
        for (int kt = 0; kt < 5; ++kt) {
#pragma unroll
            for (int r = 0; r < 16; ++r) s[kt][r] = 0.f;
#pragma unroll
            for (int ks = 0; ks < 4; ++ks) {
                const bf16x8 a = *(const LAS bf16x8*)(Ks + (i0 + 32 * kt + q) * KS_STRIDE + (16 * ks + 8 * h) * 2);
                s[kt] = __builtin_amdgcn_mfma_f32_32x32x16_bf16(a, qf[ks], s[kt], 0, 0, 0);
            }
        }
        float mx = sink;
#pragma unroll
        for (int kt = 0; kt < 5; ++kt)
#pragma unroll
            for (int r = 0; r < 16; ++r) {
                const bool tv = (nblk > 0) || (i0 + 32 * kt >= 128);
                const bool ok = (kt == 0) ? (crow(r, h) > q) : (kt == 4) ? (crow(r, h) <= q) : true;
                const float v = (ok && tv) ? s[kt][r] : -INFINITY;
                s[kt][r] = v; mx = fmaxf(mx, v);
            }
        mx = fmaxf(mx, __shfl_xor(mx, 32));
        float sum = 0.f;
#pragma unroll
        for (int kt = 0; kt < 5; ++kt)
#pragma unroll
            for (int r = 0; r < 16; ++r) { const float pv = __expf(s[kt][r] - mx); s[kt][r] = pv; sum += pv; }
        sum += __shfl_xor(sum, 32);
        sum += __expf(sink - mx);
        const float inv = 1.0f / sum;
        f32x16 o[2];
#pragma unroll
        for (int dt = 0; dt < 2; ++dt)
#pragma unroll
            for (int r = 0; r < 16; ++r) o[dt][r] = 0.f;
#pragma unroll
        for (int kt = 0; kt < 5; ++kt)
#pragma unroll
            for (int st = 0; st < 2; ++st) {
                v4u pw; pw.x = pk2(s[kt][8 * st + 0], s[kt][8 * st + 1]); pw.y = pk2(s[kt][8 * st + 2], s[kt][8 * st + 3]); pw.z = pk2(s[kt][8 * st + 4], s[kt][8 * st + 5]); pw.w = pk2(s[kt][8 * st + 6], s[kt][8 * st + 7]);
                const bf16x8 pb = __builtin_bit_cast(bf16x8, pw);
#pragma unroll
                for (int dt = 0; dt < 2; ++dt) {
                    const LAS unsigned char* vb = Vt + (32 * dt + q) * VT_STRIDE + (i0 + 32 * kt + 16 * st + 4 * h) * 2;
                    const v2u lo = *(const LAS v2u*)vb, hi2 = *(const LAS v2u*)(vb + 16);
                    v4u aw; aw.x = lo.x; aw.y = lo.y; aw.z = hi2.x; aw.w = hi2.y;
                    o[dt] = __builtin_amdgcn_mfma_f32_32x32x16_bf16(__builtin_bit_cast(bf16x8, aw), pb, o[dt], 0, 0, 0);
                }
            }
        bf16* orow = F_MIX + (size_t)(t0 + i0 + q) * DM + hq * 64;
#pragma unroll
        for (int dt = 0; dt < 2; ++dt)
#pragma unroll
            for (int g4 = 0; g4 < 4; ++g4) {
                v2u w; w.x = pk2(o[dt][4 * g4] * inv, o[dt][4 * g4 + 1] * inv); w.y = pk2(o[dt][4 * g4 + 2] * inv, o[dt][4 * g4 + 3] * inv);
                *(GAS v2u*)(orow + 32 * dt + 8 * g4 + 4 * h) = w;
            }
    }
    __syncthreads();
}
__device__ __forceinline__ void pool_tile(Frame& F, int pm, int g) {
    const int w = 2 << g;
    const int cg = F.tid & 31, rg = F.tid >> 5;
    const int r0 = pm * 256 + rg * 16;
    const int col = g * 256 + cg * 8;
    float sum[8];
#pragma unroll
    for (int e = 0; e < 8; ++e) sum[e] = 0.f;
    const int tseq0 = r0 & (SEQ - 1);
    for (int j = 1; j < w; ++j) { if (tseq0 - j >= 0) { const v4u v = *(const GAS v4u*)(F_UB + (size_t)(r0 - j) * POOLW + col);
#pragma unroll
            for (int e = 0; e < 4; ++e) { sum[2 * e] += bf_lo(v[e]); sum[2 * e + 1] += bf_hi(v[e]); } } }
    for (int i = 0; i < 16; ++i) {
        const int r = r0 + i, ts = tseq0 + i;
        const v4u v = *(const GAS v4u*)(F_UB + (size_t)r * POOLW + col);
        float cur[8];
#pragma unroll
        for (int e = 0; e < 4; ++e) { cur[2 * e] = bf_lo(v[e]); cur[2 * e + 1] = bf_hi(v[e]); }
#pragma unroll
        for (int e = 0; e < 8; ++e) sum[e] += cur[e];
        const int cnt = (ts + 1 < w) ? ts + 1 : w; const float ic = 1.0f / (float)cnt;
        v4u o;
        o.x = pk2(sum[0] * ic - cur[0], sum[1] * ic - cur[1]); o.y = pk2(sum[2] * ic - cur[2], sum[3] * ic - cur[3]);
        o.z = pk2(sum[4] * ic - cur[4], sum[5] * ic - cur[5]); o.w = pk2(sum[6] * ic - cur[6], sum[7] * ic - cur[7]);
        *(GAS v4u*)(F_POOLED + (size_t)r * POOLW + col) = o;
        if (ts - (w - 1) >= 0) { const v4u ov = *(const GAS v4u*)(F_UB + (size_t)(r - (w - 1)) * POOLW + col);
#pragma unroll
            for (int e = 0; e < 4; ++e) { sum[2 * e] -= bf_lo(ov[e]); sum[2 * e + 1] -= bf_hi(ov[e]); } }
    }
}

template <int N> __device__ __forceinline__ void insert_desc(float (&val)[N], float x) {
#pragma unroll
    for (int k = 0; k < N; ++k) { const float hi = max2f(x, val[k]); x = min2f(x, val[k]); val[k] = hi; }
}
__device__ __forceinline__ void bitonic_merge16(float (&m)[16]) {
#pragma unroll
    for (int st = 8; st >= 1; st >>= 1)
#pragma unroll
        for (int i = 0; i < 16; ++i) if ((i & st) == 0) { const float hi = max2f(m[i], m[i + st]), lo = min2f(m[i], m[i + st]); m[i] = hi; m[i + st] = lo; }
}
__device__ __forceinline__ void merge_partner16(float (&val)[16]) {
    float pr[16];
#pragma unroll
    for (int k = 0; k < 16; ++k) pr[k] = __shfl_xor(val[k], 32);
#pragma unroll
    for (int k = 0; k < 16; ++k) val[k] = max2f(val[k], pr[15 - k]);
    bitonic_merge16(val);
}
__device__ __forceinline__ void pin16(float (&v)[16]) {
#pragma unroll
    for (int k = 0; k < 16; ++k) asm volatile("" : "+v"(v[k]));
}
struct CandTab { int a[50], b[50]; };
__host__ __device__ constexpr CandTab make_cands() { CandTab t{}; int n = 0; for (int a = 0; a < 16; ++a) for (int b = 0; b < 16; ++b) if ((a + 1) * (b + 1) <= 16) { t.a[n] = a; t.b[n] = b; ++n; } return t; }
__device__ __forceinline__ float vsel(unsigned long long m, float a, float b) { float r; asm("v_cndmask_b32_e64 %0, %1, %2, %3" : "=v"(r) : "v"(b), "v"(a), "s"(m)); return r; }
__device__ __forceinline__ float sel16(const float (&L)[16], int a) { float r = L[0];
#pragma unroll
    for (int k = 1; k < 16; ++k) r = vsel(__ballot(a == k), L[k], r);
    return r; }
template <int HALF_>
__device__ __forceinline__ void route_half(Frame& F, const float* qrow, int r, int h, float (&Lout)[16]) {
    f32x16 acc[4];
#pragma unroll
    for (int kt = 0; kt < 4; ++kt)
#pragma unroll
        for (int i = 0; i < 16; ++i) acc[kt][i] = 0.f;
    const bf16* skh = F_SKH + HALF_ * 16384; const bf16* skl = F_SKL + HALF_ * 16384;
#pragma unroll 2
    for (int ks = 0; ks < 8; ++ks) {
        const f32x4 qa = *(const GAS f32x4*)(qrow + HALF_ * 128 + 16 * ks + 8 * h), qb = *(const GAS f32x4*)(qrow + HALF_ * 128 + 16 * ks + 8 * h + 4);
        v4u hw, lw;
        hw.x = pk2(qa.x, qa.y); hw.y = pk2(qa.z, qa.w); hw.z = pk2(qb.x, qb.y); hw.w = pk2(qb.z, qb.w);
        lw.x = pk2(qa.x - bf_lo(hw.x), qa.y - bf_hi(hw.x)); lw.y = pk2(qa.z - bf_lo(hw.y), qa.w - bf_hi(hw.y));
        lw.z = pk2(qb.x - bf_lo(hw.z), qb.y - bf_hi(hw.z)); lw.w = pk2(qb.z - bf_lo(hw.w), qb.w - bf_hi(hw.w));
        const bf16x8 bh = __builtin_bit_cast(bf16x8, hw), bl = __builtin_bit_cast(bf16x8, lw);
#pragma unroll
        for (int kt = 0; kt < 4; ++kt) {
            const bf16x8 ah = *(const GAS bf16x8*)(skh + (32 * kt + r) * 128 + 16 * ks + 8 * h), al = *(const GAS bf16x8*)(skl + (32 * kt + r) * 128 + 16 * ks + 8 * h);
            acc[kt] = __builtin_amdgcn_mfma_f32_32x32x16_bf16(ah, bh, acc[kt], 0, 0, 0);
            acc[kt] = __builtin_amdgcn_mfma_f32_32x32x16_bf16(al, bh, acc[kt], 0, 0, 0);
            acc[kt] = __builtin_amdgcn_mfma_f32_32x32x16_bf16(ah, bl, acc[kt], 0, 0, 0);
        }
    }
#pragma unroll
    for (int k = 0; k < 16; ++k) Lout[k] = -INFINITY;
#pragma unroll
    for (int kt = 0; kt < 4; ++kt)
#pragma unroll
        for (int i = 0; i < 16; ++i) {
            const unsigned n = (unsigned)(32 * kt + (i & 3) + 8 * (i >> 2) + 4 * h);
            insert_desc<16>(Lout, __uint_as_float((__float_as_uint(acc[kt][i]) & ~127u) | n));
        }
    merge_partner16(Lout);
}
__device__ __forceinline__ void route_task(Frame& F, int task) {
    const int r = F.lane & 31, h = F.lane >> 5;
    const int item = task * 32 + r, tok = item >> 3, head = item & 7;
    const float* qrow = F_QP + (size_t)tok * DM + head * 256;
    float L0[16], L1[16];
    route_half<0>(F, qrow, r, h, L0);
    route_half<1>(F, qrow, r, h, L1);
    pin16(L0); pin16(L1);
    constexpr CandTab CT = make_cands();
    const unsigned long long hm = __ballot(h != 0);
    float cand[16];
#pragma unroll
    for (int k = 0; k < 16; ++k) cand[k] = -INFINITY;
#pragma unroll
    for (int i = 0; i < 25; ++i) {
        const float v1 = vsel(hm, L0[CT.a[2 * i + 1]], L0[CT.a[2 * i]]);
        const float v2 = vsel(hm, L1[CT.b[2 * i + 1]], L1[CT.b[2 * i]]);
        const unsigned id = h ? (unsigned)(CT.a[2 * i + 1] * 16 + CT.b[2 * i + 1]) : (unsigned)(CT.a[2 * i] * 16 + CT.b[2 * i]);
        const float sm = __uint_as_float(__float_as_uint(v1) & ~127u) + __uint_as_float(__float_as_uint(v2) & ~127u);
        insert_desc<16>(cand, __uint_as_float((__float_as_uint(sm) & ~255u) | id));
    }
    merge_partner16(cand);
    pin16(cand);
    float se = 0.f;
#pragma unroll
    for (int k = 0; k < 16; ++k) se += __expf(cand[k] - cand[0]);
    const float ise = 1.0f / se;
    int eo[8]; float go[8];
#pragma unroll
    for (int kk = 0; kk < 8; ++kk) {
        const float cv = vsel(hm, cand[8 + kk], cand[kk]);
        const unsigned id = __float_as_uint(cv) & 255u; const int a = (int)(id >> 4), bb = (int)(id & 15u);
        const unsigned i1 = __float_as_uint(sel16(L0, a)) & 127u, i2 = __float_as_uint(sel16(L1, bb)) & 127u;
        eo[kk] = (int)(i1 * 128u + i2); go[kk] = __expf(cv - cand[0]) * ise;
    }
    int* ep = F_EIDX + (size_t)tok * 128 + head * 16 + 8 * h; float* gp = F_GATE + (size_t)tok * 128 + head * 16 + 8 * h;
    *(GAS v4u*)ep = (v4u){(unsigned)eo[0], (unsigned)eo[1], (unsigned)eo[2], (unsigned)eo[3]}; *(GAS v4u*)(ep + 4) = (v4u){(unsigned)eo[4], (unsigned)eo[5], (unsigned)eo[6], (unsigned)eo[7]};
    *(GAS f32x4*)gp = (f32x4){go[0], go[1], go[2], go[3]}; *(GAS f32x4*)(gp + 4) = (f32x4){go[4], go[5], go[6], go[7]};
}


#ifndef DBG_ROUTE_BF
#define DBG_ROUTE_BF 0
#endif
__device__ __forceinline__ void lds_insert(LAS float* V, LAS int* I, int tid, float x, int id) {
    if (x > V[15 * 256 + tid]) {
        int pos = 15;
        while (pos > 0 && V[(pos - 1) * 256 + tid] < x) { V[pos * 256 + tid] = V[(pos - 1) * 256 + tid]; I[pos * 256 + tid] = I[(pos - 1) * 256 + tid]; --pos; }
        V[pos * 256 + tid] = x; I[pos * 256 + tid] = id;
    }
}
__device__ __forceinline__ void route_bruteforce(Frame& F) {
    if (F.tid >= 256) return;
    const int tid = F.tid;
    LAS float* V0 = (LAS float*)(F.lds); LAS int* I0 = (LAS int*)(F.lds + 16384);
    LAS float* V1 = (LAS float*)(F.lds + 32768); LAS int* I1 = (LAS int*)(F.lds + 49152);
    LAS float* VC = (LAS float*)(F.lds + 65536); LAS int* IC = (LAS int*)(F.lds + 81920);
    for (int item = (int)blockIdx.x * 256 + tid; item < M * PKH; item += F.G * 256) {
        const int tok = item >> 3, head = item & 7;
        const float* qrow = F_QP + (size_t)tok * DM + head * 256;
        for (int k = 0; k < 16; ++k) { V0[k * 256 + tid] = -INFINITY; I0[k * 256 + tid] = 0; V1[k * 256 + tid] = -INFINITY; I1[k * 256 + tid] = 0; VC[k * 256 + tid] = -INFINITY; IC[k * 256 + tid] = 0; }
        for (int half = 0; half < 2; ++half) {
            float q[128];
#pragma unroll
            for (int d = 0; d < 128; d += 4) { const f32x4 t = *(const GAS f32x4*)(qrow + half * 128 + d); q[d] = t.x; q[d + 1] = t.y; q[d + 2] = t.z; q[d + 3] = t.w; }
            for (int n = 0; n < 128; ++n) {
                const float* sk = F.sub_keys + (size_t)half * 16384 + n * 128;
                float s = 0.f;
#pragma unroll
                for (int d = 0; d < 128; ++d) s += q[d] * sk[d];
                if (half == 0) lds_insert(V0, I0, tid, s, n); else lds_insert(V1, I1, tid, s, n);
            }
        }
        for (int a = 0; a < 16; ++a) for (int b = 0; b < 16; ++b) lds_insert(VC, IC, tid, V0[a * 256 + tid] + V1[b * 256 + tid], I0[a * 256 + tid] * 128 + I1[b * 256 + tid]);
        const float mx = VC[tid]; float se = 0.f;
        for (int k = 0; k < 16; ++k) se += __expf(VC[k * 256 + tid] - mx);
        for (int k = 0; k < 16; ++k) { F_EIDX[(size_t)tok * 128 + head * 16 + k] = IC[k * 256 + tid]; F_GATE[(size_t)tok * 128 + head * 16 + k] = __expf(VC[k * 256 + tid] - mx) / se; }
    }
}

template <int N> __device__ __forceinline__ void treduce(float (&v)[N], int lane, int d) {
    const bool up = (lane & d) != 0;
#pragma unroll
    for (int i = 0; i < N / 2; ++i) { const float send = up ? v[i] : v[i + N / 2], keep = up ? v[i + N / 2] : v[i]; v[i] = keep + __shfl_xor(send, d); }
}
constexpr int SLICE_ELEMS = NEXP * 64;
__device__ __forceinline__ void peer_phase(Frame& F) {
    const int lane = F.lane, g = lane >> 3, p = lane & 7;
    const int tbase = (int)blockIdx.x * 32 + F.wave * 4;
    LAS float* alds = (LAS float*)(F.lds + RING_OFF + F.wave * 2048);
    const __amdgpu_buffer_rsrc_t rsu = __builtin_amdgcn_make_buffer_rsrc((void*)F_EU, 0, NEXP * DM * 2, 0x00020000);
    const __amdgpu_buffer_rsrc_t rsv = __builtin_amdgcn_make_buffer_rsrc((void*)F_EV, 0, NEXP * DM * 2, 0x00020000);
    for (int tb = tbase; tb < M; tb += F.G * 32) {
        unsigned voff[4][16];
        float hacc[4][2];
#pragma unroll
        for (int tk = 0; tk < 4; ++tk) {
#pragma unroll
            for (int i = 0; i < 16; ++i) voff[tk][i] = (unsigned)F_EIDX[(size_t)(tb + tk) * 128 + 8 * i + g] * 128u + (unsigned)p * 16u;
            hacc[tk][0] = 0.f; hacc[tk][1] = 0.f;
        }
#pragma unroll 1
        for (int s = 0; s < 32; ++s) {
#pragma unroll
            for (int tk = 0; tk < 4; ++tk) {
                const v4u xp = *(const GAS v4u*)(F_H1B + (size_t)(tb + tk) * DM + 64 * s + 8 * p);
                v4u w[16];
#pragma unroll
                for (int i = 0; i < 16; ++i) w[i] = __builtin_amdgcn_raw_buffer_load_b128(rsu, voff[tk][i], s * (SLICE_ELEMS * 2), 0);
                float part[16];
#pragma unroll
                for (int i = 0; i < 16; ++i) { float a = 0.f;
#pragma unroll
                    for (int c = 0; c < 4; ++c) { const unsigned xa = xp[c], wb = w[i][c]; a = dot2bf(xa, wb, a); }
                    part[i] = a; }
                treduce<16>(part, lane, 1); treduce<8>(reinterpret_cast<float (&)[8]>(part), lane, 2); treduce<4>(reinterpret_cast<float (&)[4]>(part), lane, 4);
                hacc[tk][0] += part[0]; hacc[tk][1] += part[1];
                __builtin_amdgcn_sched_barrier(0);
            }
            __syncthreads();
        }
#pragma unroll
        for (int tk = 0; tk < 4; ++tk) {
            const int t = tb + tk;
            const float rs2 = 1.0f / sqrtf(__hip_atomic_load(F_SSQ2 + t, RLX_AGENT) * (1.0f / DM) + EPS);
#pragma unroll
            for (int j = 0; j < 2; ++j) {
                const int i = 8 * (p & 1) + 4 * ((p >> 1) & 1) + 2 * ((p >> 2) & 1) + j;
                const float hv = hacc[tk][j] * rs2;
                const float ge = 0.5f * hv * (1.0f + erff(hv * 0.70710678118654752f));
                alds[tk * 128 + g * 16 + i] = F_GATE[(size_t)t * 128 + 8 * i + g] * ge;
            }
        }
        LDS_WAIT(); asm volatile("" ::: "memory");
        float ssq[4] = {0.f, 0.f, 0.f, 0.f};
#pragma unroll 1
        for (int s = 0; s < 32; ++s) {
#pragma unroll
            for (int tk = 0; tk < 4; ++tk) {
                v4u w[16];
#pragma unroll
                for (int i = 0; i < 16; ++i) w[i] = __builtin_amdgcn_raw_buffer_load_b128(rsv, voff[tk][i], s * (SLICE_ELEMS * 2), 0);
                f32x4 av[4];
#pragma unroll
                for (int q4 = 0; q4 < 4; ++q4) av[q4] = *(const LAS f32x4*)(alds + tk * 128 + g * 16 + 4 * q4);
                float oc[8];
#pragma unroll
                for (int c = 0; c < 8; ++c) oc[c] = 0.f;
#pragma unroll
                for (int i = 0; i < 16; ++i) { const float a = av[i >> 2][i & 3];
#pragma unroll
                    for (int c = 0; c < 4; ++c) { const unsigned wv = w[i][c]; oc[2 * c] += a * bf_lo(wv); oc[2 * c + 1] += a * bf_hi(wv); } }
                treduce<8>(oc, lane, 8); treduce<4>(reinterpret_cast<float (&)[4]>(oc), lane, 16); treduce<2>(reinterpret_cast<float (&)[2]>(oc), lane, 32);
                const int col = 64 * s + 8 * p + 4 * (g & 1) + 2 * ((g >> 1) & 1) + ((g >> 2) & 1);
                const size_t off = (size_t)(tb + tk) * DM + col;
                const float h2 = F_H1[off] + oc[0];
                F_H1[off] = h2;
                F_H2B[off] = (bf16)(pk2(h2, 0.f) & 0xffffu);
                ssq[tk] += h2 * h2;
                __builtin_amdgcn_sched_barrier(0);
            }
            __syncthreads();
        }
#pragma unroll
        for (int tk = 0; tk < 4; ++tk) { const float ss = wave_sum(ssq[tk]); if (lane == 0) F_RSTD3[tb + tk] = 1.0f / sqrtf(ss * (1.0f / DM) + EPS); }
        LDS_WAIT(); asm volatile("" ::: "memory");
    }
}

struct Args { const void* in[18]; float* out; unsigned char* ws; int ph_lo, ph_hi, li, pad; };
__global__ void __launch_bounds__(NWAVES * 64, 2) hymba_fwd(Args args) {
    extern __shared__ __attribute__((aligned(16))) unsigned char lds[];
    Frame F;
    F.lds = (LAS unsigned char*)lds;
    F.MISC = (volatile LAS unsigned*)(F.lds + MISC_OFF);
    F.tid = threadIdx.x; F.lane = F.tid & 63; F.wave = __builtin_amdgcn_readfirstlane(F.tid >> 6);
    F.G = gridDim.x; { const int bx = blockIdx.x; F.vcu = (F.G % 8 == 0) ? (bx % 8) * (F.G / 8) + bx / 8 : bx; }
    F.ws = args.ws;
    F.ctl = (gu32*)(F.ws + WS_CTL);
    F.x = (const float*)args.in[0]; F.p = (const float*)args.in[1]; F.positions = (const int*)args.in[2]; F.g_mix = (const float*)args.in[3]; F.w_in = (const float*)args.in[4];
    F.sinks = (const float*)args.in[5]; F.w_pool = (const float*)args.in[6]; F.pool_scale = (const float*)args.in[7]; F.w_out = (const float*)args.in[8]; F.g_ffn = (const float*)args.in[9];
    F.w_query = (const float*)args.in[10]; F.sub_keys = (const float*)args.in[11]; F.expert_u = (const float*)args.in[12]; F.expert_v = (const float*)args.in[13]; F.g_ple = (const float*)args.in[14];
    F.w_ple_gate = (const float*)args.in[15]; F.w_ple_proj = (const float*)args.in[16]; F.g_final = (const float*)args.in[17]; F.out = args.out;
    for (int u = F.tid; u < (LDS_BYTES - LDSCTL_OFF) / 4; u += NWAVES * 64) ((LAS unsigned*)(F.lds + LDSCTL_OFF))[u] = 0u;
    __syncthreads();
    const bool one_phase = (args.ph_hi - args.ph_lo) == 1;
    XcdBarrier bar; bar.bar = (unsigned*)(F.ctl + CW_BAR); bar.x = 0; bar.st = nullptr;
    if (!one_phase) bar = xcd_barrier_post((unsigned*)(F.ctl + CW_BAR), F.MISC + 8);
    const int lo = args.ph_lo, hi = args.ph_hi;
#define IN(k) (lo <= (k) && (k) < hi)
#define BOTH(k) (IN(k) && IN((k) + 1))
#define GRID_BAR() xcd_barrier(bar)

    if (IN(0)) { p0_prologue(F); if (BOTH(0)) GRID_BAR(); }

    if (IN(1)) {
        { pg8::Gemm g{F_XB, F_Win_t, M, INW, DM, DM, DM}; pg8::StaticOrder S; S.init(M, INW, F.G, (int)blockIdx.x);
          EpiG1 E{F_QB, F_KB, F_VB, F_UB, F_RSTD1, F_ROPE};
          pg8::gemm_phase<EpiG1, pg8::StaticOrder, true, true>(F.lds + RING_OFF, g, S, E); }
        { pg8::Gemm g{F_PB, F_Wp_t, M, DM, PLE, PLE, PLE}; pg8::StaticOrder S; S.init(M, DM, F.G, (int)blockIdx.x);
          EpiBf16Scale<false> E{F_PP, DM, 0, nullptr};
          pg8::gemm_phase<EpiBf16Scale<false>, pg8::StaticOrder, true, true>(F.lds + RING_OFF, g, S, E); }
        if (BOTH(1)) GRID_BAR();
    }

    if (IN(2)) {
        for (int u = (int)blockIdx.x; u < BATCH * 32 * NKVH; u += F.G) attn_unit(F, u);
        if ((int)blockIdx.x < 128) {
            const int pu = (int)blockIdx.x, pm = pu >> 2, g = pu & 3;
            pool_tile(F, pm, g);
            VM_WAIT(); __syncthreads();
            pg8::Gemm gm{F_POOLED + g * 256, F_Wpool_t + (size_t)g * 65536, M, 256, 256, POOLW, 256}; SingleUnit S{pm, 0};
            EpiBf16Scale<true> E{F_MIX, DM, ATTW + g * 256, F.pool_scale + g * 256};
            pg8::gemm_phase<EpiBf16Scale<true>, SingleUnit, false, true>(F.lds + RING_OFF, gm, S, E);
            __syncthreads();
        }
        if (BOTH(2)) GRID_BAR();
    }

    if (IN(3)) {
        pg8::Gemm g{F_MIX, F_Wout_t, M, DM, DM, DM, DM}; pg8::StaticOrder S; S.init(M, DM, F.G, (int)blockIdx.x);
        EpiG3 E{F.x, F_H1, F_H1B, F_SSQ2};
        pg8::gemm_phase<EpiG3, pg8::StaticOrder, true, true>(F.lds + RING_OFF, g, S, E);
        if (BOTH(3)) GRID_BAR();
    }

    if (IN(4)) {
        pg8::Gemm g{F_H1B, F_Wq_t, M, DM, DM, DM, DM}; pg8::StaticOrder S; S.init(M, DM, F.G, (int)blockIdx.x);
        EpiG4 E{F_QP, F_SSQ2};
        pg8::gemm_phase<EpiG4, pg8::StaticOrder, true, true>(F.lds + RING_OFF, g, S, E);
        if (BOTH(4)) GRID_BAR();
    }

    if (IN(5)) {
        const int gw = F.vcu * NWAVES + F.wave, NGW = F.G * NWAVES;
        for (int task = gw; task < M * PKH / 32; task += NGW) route_task(F, task);
        if (BOTH(5)) GRID_BAR();
    }

    if (IN(6)) {
        peer_phase(F);
        __syncthreads();
        if (BOTH(6)) GRID_BAR();
    }

    if (IN(7)) {
        pg8::Gemm g{F_H2B, F_Wg_t, M, DM, DM, DM, DM}; pg8::StaticOrder S; S.init(M, DM, F.G, (int)blockIdx.x);
        EpiG5 E{F_H1, F_PP, F_RSTD3, F.out, F_SSQ4};
        pg8::gemm_phase<EpiG5, pg8::StaticOrder, true, true>(F.lds + RING_OFF, g, S, E);
        if (BOTH(7)) GRID_BAR();
    }

    if (IN(8)) {
        const int gw = F.vcu * NWAVES + F.wave, NGW = F.G * NWAVES;
        for (int m = gw; m < M; m += NGW) {
            const float rs = 1.0f / sqrtf(__hip_atomic_load(F_SSQ4 + m, RLX_AGENT) * (1.0f / DM) + EPS);
            GAS f32x4* orow = (GAS f32x4*)(F.out + (size_t)m * DM) + F.lane; const GAS f32x4* gr = (const GAS f32x4*)F.g_final + F.lane;
#pragma unroll
            for (int j = 0; j < 8; ++j) { const f32x4 v = orow[64 * j]; orow[64 * j] = v * rs * gr[64 * j]; }
        }
    }
#undef IN
#undef BOTH
#undef GRID_BAR
}


#if DBG_ROUTE_BF
__global__ void __launch_bounds__(NWAVES * 64, 2) dbg_route_kernel(Args args) {
    extern __shared__ __attribute__((aligned(16))) unsigned char lds[];
    Frame F; F.lds = (LAS unsigned char*)lds; F.tid = threadIdx.x; F.lane = F.tid & 63; F.wave = F.tid >> 6; F.G = gridDim.x; F.vcu = blockIdx.x; F.ws = args.ws; F.sub_keys = (const float*)args.in[11];
    route_bruteforce(F);
}
#endif
extern "C" void kernel_launch(void* const* d_in, const int* in_sizes, int n_in, void* d_out, int out_size, void* d_ws, size_t ws_size, hipStream_t stream) {
    static int grid = 0;
    if (grid == 0) {
        if (n_in != 18 || out_size != M * DM || ws_size < WS_END) { fprintf(stderr, "kernel_launch: unexpected shapes (n_in %d, out %d, ws %zu)\n", n_in, out_size, ws_size); grid = -1; return; }
        int dev = 0, cus = 0, per_cu = 0;
        if (hipGetDevice(&dev) != hipSuccess || hipDeviceGetAttribute(&cus, hipDeviceAttributeMultiprocessorCount, dev) != hipSuccess) { grid = -1; return; }
#if DBG_ROUTE_BF
        (void)hipFuncSetAttribute((const void*)dbg_route_kernel, hipFuncAttributeMaxDynamicSharedMemorySize, 98304);
#endif
        if (hipFuncSetAttribute((const void*)hymba_fwd, hipFuncAttributeMaxDynamicSharedMemorySize, LDS_BYTES) != hipSuccess) { fprintf(stderr, "kernel_launch: hipFuncSetAttribute failed\n"); grid = -1; return; }
        if (hipOccupancyMaxActiveBlocksPerMultiprocessor(&per_cu, (const void*)hymba_fwd, NWAVES * 64, LDS_BYTES) != hipSuccess || per_cu < 1)
            fprintf(stderr, "kernel_launch: note: occupancy query reports %d workgroups per CU\n", per_cu);
        (void)hipGetLastError();
        if (cus < 128) { fprintf(stderr, "kernel_launch: needs >= 128 CUs\n"); grid = -1; return; }
        grid = cus;
    }
    if (grid < 0) return;
    if (hipMemsetAsync((char*)d_ws + WS_CTL, 0, CTL_ZERO_BYTES, stream) != hipSuccess) return;
    Args a{};
    for (int i = 0; i < 18; ++i) a.in[i] = d_in[i];
    a.out = (float*)d_out; a.ws = (unsigned char*)d_ws;
    constexpr int NL = MK_N_LAUNCHES;
    for (int li = 0; li < NL; ++li) {
        a.ph_lo = (NL == 1) ? 0 : li; a.ph_hi = (NL == 1) ? N_PHASES : li + 1; a.li = li;
#if DBG_ROUTE_BF
        if (NL == 9 && li == 5) { hipLaunchKernelGGL(dbg_route_kernel, dim3(grid), dim3(NWAVES * 64), 98304, stream, a); continue; }
#endif
        hipLaunchKernelGGL(hymba_fwd, dim3(grid), dim3(NWAVES * 64), LDS_BYTES, stream, a);
    }
}
```

```cpp
#include <hip/hip_runtime.h>
#include <cstdio>
#include <cstdint>
namespace pg8 {
#define PG8_LAS __attribute__((address_space(3)))
typedef unsigned short bf16_t;
typedef short bf16x8 __attribute__((ext_vector_type(8)));
typedef float f32x4 __attribute__((ext_vector_type(4)));
typedef unsigned u32x4 __attribute__((ext_vector_type(4)));
constexpr int BM = 256, BK = 64, HALF = 128, HTB = HALF * BK * 2  , STAGE_BYTES = 8 * HTB, NXCD = 8, WGM = 8;

__host__ __device__ __forceinline__ int lds_byte(int r, int c) { const int st = (r >> 4) * 2 + (c >> 5), rr = r & 15, cc = c & 31, ob = rr * 64 + cc * 2; return st * 1024 + (ob ^ (((ob >> 9) & 1) << 5)); }
__host__ __device__ __forceinline__ void stage_rc(int b, int& R, int& C) { const int st = b / 1024, sb = b % 1024, swz = sb ^ (((sb >> 9) & 1) << 5); R = (st >> 1) * 16 + swz / 64; C = (st & 1) * 32 + (swz % 64) / 2; }
__host__ __device__ __forceinline__ int perm32(int rho) { const int n = rho >> 4, i = rho & 15; return 8 * (i >> 2) + 4 * n + (i & 3); }

struct Unit { int pm, pn; };
struct Gemm { const bf16_t* A; const bf16_t* Bt; int M, N, K, lda, ldb; };

struct StaticOrder {
    int nM, nN, nwg, G, c;
    __host__ __device__ void init(int M, int N, int G_, int c_) { nM = M / BM; nN = N / BM; nwg = nM * nN; G = G_; c = c_; }
    __host__ __device__ bool next(int i, Unit& u) const {
        const long L = (long)i * G + c; if (L >= nwg) return false;
        int wgid = (int)L; { const int q = nwg / NXCD, r = nwg % NXCD, xcd = wgid % NXCD, off = wgid / NXCD; wgid = (xcd < r ? xcd * (q + 1) : r * (q + 1) + (xcd - r) * q) + off; }
        const int nig = WGM * nN, gid = wgid / nig, fm = gid * WGM, gsz = (nM - fm) < WGM ? (nM - fm) : WGM;
        u.pm = fm + ((wgid % nig) % gsz); u.pn = (wgid % nig) / gsz; return true;
    }
    __device__ __forceinline__ void a_ready(const Unit&) const {}
    __device__ __forceinline__ void done(const Unit&) const {}
};

__device__ __forceinline__ unsigned cvt_pk_bf16(float lo, float hi) { unsigned r; asm volatile("v_cvt_pk_bf16_f32 %0, %1, %2" : "=v"(r) : "v"(lo), "v"(hi)); return r; }
typedef float f32x2 __attribute__((ext_vector_type(2)));

template <class Epi, class Sched, bool ALIGN_EPI = false, bool SP2 = false>
__device__ __forceinline__ void gemm_phase(PG8_LAS unsigned char* lds, const Gemm g, const Sched& S, const Epi& E) {
    const int tid = threadIdx.x, wid = __builtin_amdgcn_readfirstlane(tid >> 6), lane = tid & 63, wr = wid >> 2, wc = wid & 3, fr = lane & 15, fq = lane >> 4;
    const int K = g.K, nt = K / BK;
    unsigned voffA[2], voffB[2];
#pragma unroll
    for (int i = 0; i < 2; ++i) { int R, C; stage_rc(tid * 16 + i * 8192, R, C); const int Rb = Epi::PERM ? ((R & ~31) + perm32(R & 31)) : R;
        voffA[i] = (unsigned)(R * g.lda + C) * 2u; voffB[i] = (unsigned)(Rb * g.ldb + C) * 2u; }
    const size_t kstep = (size_t)(BK * 2);
    const size_t hstepA = (size_t)HALF * g.lda * 2, hstepB = (size_t)HALF * g.ldb * 2;
    const size_t tstepA = 2 * hstepA, tstepB = 2 * hstepB;
    const unsigned ldsw = (unsigned)wid * 1024u;
    const int aoff = lds_byte(wr * 64 + fr, fq * 8), boff = lds_byte(wc * 32 + fr, fq * 8);
#define PG8_SA(b, h) (((b) * 2 + (h)) * HTB)
#define PG8_SB(b, h) ((4 + (b) * 2 + (h)) * HTB)
#define PG8_STAGE(bufoff, gbase, voff) do { _Pragma("unroll") for (int _i = 0; _i < 2; ++_i) \
        __builtin_amdgcn_global_load_lds((const unsigned*)((const char*)(gbase) + (voff)[_i]), (PG8_LAS unsigned*)(lds + (bufoff) + ldsw + _i * 8192), 16, 0, 0); } while (0)
#define PG8_LDA(dst, b, h) do { _Pragma("unroll") for (int m = 0; m < 4; ++m) _Pragma("unroll") for (int k = 0; k < 2; ++k) dst[m][k] = *(const PG8_LAS bf16x8*)(lds + PG8_SA(b, h) + aoff + m * 2048 + k * 1024); } while (0)
#define PG8_LDB(dst, b, h) do { _Pragma("unroll") for (int n = 0; n < 2; ++n) _Pragma("unroll") for (int k = 0; k < 2; ++k) dst[n][k] = *(const PG8_LAS bf16x8*)(lds + PG8_SB(b, h) + boff + n * 2048 + k * 1024); } while (0)
#define PG8_MMA(ai, bj, At, Bt) do { __builtin_amdgcn_s_setprio(1); _Pragma("unroll") for (int m = 0; m < 4; ++m) _Pragma("unroll") for (int n = 0; n < 2; ++n) _Pragma("unroll") for (int k = 0; k < 2; ++k) \
        acc[ai][bj][m][n] = __builtin_amdgcn_mfma_f32_16x16x32_bf16(Bt[n][k], At[m][k], acc[ai][bj][m][n], 0, 0, 0); __builtin_amdgcn_s_setprio(0); } while (0)
#define PG8_WAIT_V(n) asm volatile("s_waitcnt vmcnt(" #n ")" ::: "memory")
#define PG8_WAIT_L(n) asm volatile("s_waitcnt lgkmcnt(" #n ")" ::: "memory")
#define PG8_BAR __builtin_amdgcn_s_barrier()
#define PG8_SCHED __builtin_amdgcn_sched_barrier(0)
    Unit cur, nxt; int ui = 0;
    if (!S.next(0, cur)) return;
    f32x4 acc[2][2][4][2];
#pragma unroll
    for (int a = 0; a < 2; ++a)
#pragma unroll
        for (int b = 0; b < 2; ++b)
#pragma unroll
            for (int m = 0; m < 4; ++m)
#pragma unroll
                for (int n = 0; n < 2; ++n) acc[a][b][m][n] = (f32x4){0.f, 0.f, 0.f, 0.f};
    bf16x8 At[4][2], B0[2][2], B1[2][2];
    const char* cA = (const char*)g.A + (size_t)cur.pm * tstepA; const char* cB = (const char*)g.Bt + (size_t)cur.pn * tstepB;
    S.a_ready(cur);
    if constexpr (SP2) {
        PG8_STAGE(PG8_SB(0, 0), cB, voffB); PG8_STAGE(PG8_SB(0, 1), cB + hstepB, voffB); PG8_STAGE(PG8_SA(0, 0), cA, voffA); PG8_STAGE(PG8_SA(0, 1), cA + hstepA, voffA);
        if (wr == 1) PG8_BAR;
        PG8_WAIT_V(2); PG8_BAR;
        PG8_STAGE(PG8_SB(1, 0), cB + kstep, voffB); PG8_STAGE(PG8_SA(1, 0), cA + kstep, voffA); PG8_STAGE(PG8_SB(1, 1), cB + hstepB + kstep, voffB);
        PG8_WAIT_V(6); PG8_BAR;
    } else {
        PG8_STAGE(PG8_SB(0, 0), cB, voffB); PG8_STAGE(PG8_SA(0, 0), cA, voffA); PG8_STAGE(PG8_SB(0, 1), cB + hstepB, voffB); PG8_STAGE(PG8_SA(0, 1), cA + hstepA, voffA);
        if (wr == 1) PG8_BAR;
        PG8_WAIT_V(4); PG8_BAR;
        PG8_STAGE(PG8_SB(1, 0), cB + kstep, voffB); PG8_STAGE(PG8_SA(1, 0), cA + kstep, voffA); PG8_STAGE(PG8_SB(1, 1), cB + hstepB + kstep, voffB);
        PG8_WAIT_V(6); PG8_BAR;
    }
    for (;;) {
        const bool has_next = S.next(ui + 1, nxt);
        const char* nA = has_next ? (const char*)g.A + (size_t)nxt.pm * tstepA : cA; const char* nB = has_next ? (const char*)g.Bt + (size_t)nxt.pn * tstepB : cB;
        for (int t = 0; t < nt; t += 2) {
            const bool last = (t == nt - 2);
            const char* a1 = cA + (size_t)(t + 1) * kstep;
            const char* a2 = last ? nA : cA + (size_t)(t + 2) * kstep; const char* b2 = last ? nB : cB + (size_t)(t + 2) * kstep;
            const char* a3 = a2 + kstep; const char* b3 = b2 + kstep;
            if (last && has_next) S.a_ready(nxt);
            if constexpr (SP2) {
            PG8_LDB(B0, 0, 0); PG8_LDB(B1, 0, 1); PG8_SCHED; PG8_LDA(At, 0, 0); PG8_STAGE(PG8_SA(1, 1), a1 + hstepA, voffA);
            PG8_WAIT_V(8); PG8_WAIT_L(0); PG8_BAR; PG8_MMA(0, 0, At, B0); PG8_MMA(0, 1, At, B1); PG8_BAR; PG8_SCHED;
            PG8_LDA(At, 0, 1); PG8_STAGE(PG8_SB(0, 0), b2, voffB); PG8_STAGE(PG8_SB(0, 1), b2 + hstepB, voffB); PG8_STAGE(PG8_SA(0, 0), a2, voffA);
            PG8_WAIT_V(8); PG8_WAIT_L(0); PG8_BAR; PG8_MMA(1, 0, At, B0); PG8_MMA(1, 1, At, B1); PG8_BAR; PG8_SCHED;
            PG8_LDB(B0, 1, 0); PG8_LDB(B1, 1, 1); PG8_SCHED; PG8_LDA(At, 1, 0); PG8_STAGE(PG8_SA(0, 1), a2 + hstepA, voffA);
            PG8_WAIT_V(8); PG8_WAIT_L(0); PG8_BAR; PG8_MMA(0, 0, At, B0); PG8_MMA(0, 1, At, B1); PG8_BAR; PG8_SCHED;
            PG8_LDA(At, 1, 1); PG8_STAGE(PG8_SB(1, 0), b3, voffB); PG8_STAGE(PG8_SB(1, 1), b3 + hstepB, voffB); PG8_STAGE(PG8_SA(1, 0), a3, voffA);
            PG8_WAIT_V(8); PG8_WAIT_L(0); PG8_BAR; PG8_MMA(1, 0, At, B0); PG8_MMA(1, 1, At, B1); PG8_BAR; PG8_SCHED;
            } else {
            PG8_LDB(B0, 0, 0); PG8_SCHED; PG8_LDA(At, 0, 0); PG8_STAGE(PG8_SA(1, 1), a1 + hstepA, voffA);
            PG8_WAIT_L(8); PG8_BAR; PG8_WAIT_L(0); PG8_MMA(0, 0, At, B0); PG8_BAR; PG8_SCHED;
            PG8_LDB(B1, 0, 1); PG8_STAGE(PG8_SB(0, 0), b2, voffB);
            PG8_BAR; PG8_WAIT_L(0); PG8_MMA(0, 1, At, B1); PG8_BAR;
            PG8_LDA(At, 0, 1); PG8_STAGE(PG8_SA(0, 0), a2, voffA);
            PG8_BAR; PG8_WAIT_L(0); PG8_MMA(1, 0, At, B0); PG8_BAR; PG8_SCHED;
            PG8_STAGE(PG8_SB(0, 1), b2 + hstepB, voffB);
            PG8_WAIT_V(6); PG8_BAR; PG8_MMA(1, 1, At, B1); PG8_BAR;
            PG8_LDB(B0, 1, 0); PG8_SCHED; PG8_LDA(At, 1, 0); PG8_STAGE(PG8_SA(0, 1), a2 + hstepA, voffA);
            PG8_WAIT_L(8); PG8_BAR; PG8_WAIT_L(0); PG8_MMA(0, 0, At, B0); PG8_BAR; PG8_SCHED;
            PG8_LDB(B1, 1, 1); PG8_STAGE(PG8_SB(1, 0), b3, voffB);
            PG8_BAR; PG8_WAIT_L(0); PG8_MMA(0, 1, At, B1); PG8_BAR;
            PG8_LDA(At, 1, 1); PG8_STAGE(PG8_SA(1, 0), a3, voffA);
            PG8_BAR; PG8_WAIT_L(0); PG8_MMA(1, 0, At, B0); PG8_BAR; PG8_SCHED;
            PG8_STAGE(PG8_SB(1, 1), b3 + hstepB, voffB);
            PG8_WAIT_V(6); PG8_BAR; PG8_MMA(1, 1, At, B1); PG8_BAR;
            }
        }
        if constexpr (ALIGN_EPI) { if (wr == 0) PG8_BAR; }
        if constexpr (!Epi::AFTER_DRAIN) { E(acc, cur, wr, wc, fr, fq); S.done(cur); }
        if (!has_next) break;
#pragma unroll
        for (int a = 0; a < 2; ++a)
#pragma unroll
            for (int b = 0; b < 2; ++b)
#pragma unroll
                for (int m = 0; m < 4; ++m)
#pragma unroll
                    for (int n = 0; n < 2; ++n) acc[a][b][m][n] = (f32x4){0.f, 0.f, 0.f, 0.f};
        cur = nxt; cA = nA; cB = nB; ++ui;
        if constexpr (ALIGN_EPI) { if (wr == 1) PG8_BAR; }
    }
    PG8_WAIT_V(0);
    if constexpr (!ALIGN_EPI) { if (wr == 0) PG8_BAR; }
    PG8_BAR;
    if constexpr (Epi::AFTER_DRAIN) { E.fused(acc, cur, wr, wc, fr, fq, lds, wid, lane); S.done(cur); }
#undef PG8_SA
#undef PG8_SB
#undef PG8_STAGE
#undef PG8_LDA
#undef PG8_LDB
#undef PG8_MMA
#undef PG8_WAIT_V
#undef PG8_WAIT_L
#undef PG8_BAR
#undef PG8_SCHED
}
}


constexpr int NWAVES = 8;
constexpr int DM = 2048, BATCH = 2, SEQ = 4096, M = BATCH * SEQ;
constexpr int HD = 64, NQH = 16, NKVH = 4, ATTW = 1024, KVW = 256, POOLW = 1024, INW = 2560;
constexpr int PKH = 8, NEXP = 16384, PLE = 256;
constexpr float EPS = 1e-6f;
constexpr float EU_SCALE = 256.0f, EV_SCALE = 16.0f;
#ifndef MK_N_LAUNCHES
#define MK_N_LAUNCHES 1
#endif
constexpr int N_PHASES = 9;
#ifndef REP_MASK
#define REP_MASK 0
#endif
#define NREP(k) (((REP_MASK >> (k)) & 1) ? 2 : 1)
#ifndef DBG_NO_PEER
#define DBG_NO_PEER 0
#endif
#ifndef DBG_NO_PLE
#define DBG_NO_PLE 0
#endif
#ifndef DBG_NO_MIX
#define DBG_NO_MIX 0
#endif

constexpr size_t MiB = 1u << 20;
constexpr size_t WS_CTL = 0, CTL_ZERO_BYTES = 256 * 1024;
constexpr size_t WS_WIN = 1 * MiB, WS_WOUT = 11 * MiB, WS_WQ = 19 * MiB, WS_WG = 27 * MiB, WS_WP = 35 * MiB, WS_WPOOL = 36 * MiB;
constexpr size_t WS_SKH = 36 * MiB + 512 * 1024, WS_SKL = WS_SKH + 64 * 1024;
constexpr size_t WS_ROPE = 37 * MiB;
constexpr size_t WS_RSTD1 = 37 * MiB + 512 * 1024, WS_RSTD3 = WS_RSTD1 + 32 * 1024;
constexpr size_t WS_EU = 38 * MiB, WS_EV = 102 * MiB;
constexpr size_t WS_XB = 166 * MiB, WS_PB = 198 * MiB;
constexpr size_t WS_Q = 202 * MiB, WS_K = 218 * MiB, WS_V = 222 * MiB, WS_U = 226 * MiB, WS_POOLED = 242 * MiB, WS_MIX = 258 * MiB;
constexpr size_t WS_QP = 202 * MiB;
constexpr size_t WS_EIDX = 266 * MiB, WS_GATE = 270 * MiB;
constexpr size_t WS_H1 = 290 * MiB, WS_H1B = 354 * MiB, WS_PP = 386 * MiB, WS_H2B = 418 * MiB, WS_END = 450 * MiB;
constexpr int CW_BAR = 4096;
constexpr int CW_SSQ2 = 16384, CW_SSQ4 = 16384 + 8192;
static_assert((CW_SSQ4 + 8192) * 4 <= (int)CTL_ZERO_BYTES, "ctl");

constexpr int RING_OFF = 0, RING_BYTES = 131072;
constexpr int LDSCTL_OFF = RING_BYTES, MISC_OFF = LDSCTL_OFF + 320;
constexpr int LDS_BYTES = 147456;

#define GAS __attribute__((address_space(1)))
#define LAS __attribute__((address_space(3)))
typedef unsigned short bf16;
typedef unsigned v4u __attribute__((ext_vector_type(4)));
typedef unsigned v2u __attribute__((ext_vector_type(2)));
typedef float f32x4 __attribute__((ext_vector_type(4)));
typedef float f32x16 __attribute__((ext_vector_type(16)));
typedef short bf16x8 __attribute__((ext_vector_type(8)));
typedef GAS unsigned gu32;
#define RLX_AGENT __ATOMIC_RELAXED, __HIP_MEMORY_SCOPE_AGENT
#define LDS_WAIT() asm volatile("s_waitcnt lgkmcnt(0)" ::: "memory")
#define VM_WAIT() asm volatile("s_waitcnt vmcnt(0)" ::: "memory")
typedef float f32x2_t __attribute__((ext_vector_type(2))); typedef __bf16 bf16x2_t __attribute__((ext_vector_type(2)));
__device__ __forceinline__ unsigned pk2(float lo, float hi) { f32x2_t v = {lo, hi}; bf16x2_t b = __builtin_convertvector(v, bf16x2_t); return __builtin_bit_cast(unsigned, b); }
__device__ __forceinline__ float bf_lo(unsigned w) { return __uint_as_float(w << 16); }
__device__ __forceinline__ float bf_hi(unsigned w) { return __uint_as_float(w & 0xffff0000u); }
__device__ __forceinline__ float dot2bf(unsigned a, unsigned b, float c) { return __builtin_amdgcn_fdot2_f32_bf16(__builtin_bit_cast(bf16x2_t, a), __builtin_bit_cast(bf16x2_t, b), c, false); }
__device__ __forceinline__ float max2f(float a, float b) { float r; asm("v_max_f32_e32 %0, %1, %2" : "=v"(r) : "v"(a), "v"(b)); return r; }
__device__ __forceinline__ float min2f(float a, float b) { float r; asm("v_min_f32_e32 %0, %1, %2" : "=v"(r) : "v"(a), "v"(b)); return r; }
__device__ __forceinline__ float wave_sum(float v) {
#pragma unroll
    for (int o = 1; o < 64; o <<= 1) v += __shfl_xor(v, o);
    return v;
}

#define XB_TMO      128
#define XB_XCNT(j)  (256  + 64 * (j))
#define XB_XSUB(j)  (1280 + 64 * (j))
#define XB_XGEN(j)  (2304 + 64 * (j))
#define XB_TOP      3328
#define XB_TOPGEN   3392
#define XCD_BAR_WORDS 3456
#define XB_SPIN_CAP (1u << 18)
__device__ __forceinline__ unsigned xb_ld(unsigned* p)              { return __hip_atomic_load(p, __ATOMIC_RELAXED, __HIP_MEMORY_SCOPE_AGENT); }
__device__ __forceinline__ unsigned xb_add(unsigned* p, unsigned v) { return __hip_atomic_fetch_add(p, v, __ATOMIC_RELAXED, __HIP_MEMORY_SCOPE_AGENT); }
__device__ __forceinline__ unsigned xb_xcc_id() { return (unsigned)__builtin_amdgcn_s_getreg((3 << 11) | 20) & 0xFu; }
#define XB_SPIN(cond, bar) do { unsigned _sp = 0; while (cond) { __builtin_amdgcn_s_sleep(1); \
    if ((++_sp & 255u) == 0u) { if (xb_ld(&(bar)[XB_TMO])) break; if (_sp > XB_SPIN_CAP) { atomicAdd(&(bar)[XB_TMO], 1u); break; } } } } while (0)
struct XcdBarrier { unsigned* bar; unsigned x; volatile LAS unsigned* st; };
__device__ __forceinline__ XcdBarrier xcd_barrier_post(unsigned* bar, volatile LAS unsigned* st) {
    XcdBarrier b; b.bar = bar; b.x = xb_xcc_id(); b.st = st;
    if (threadIdx.x == 0) (void)xb_add(&bar[XB_XCNT(b.x)], 1u);
    return b;
}
__device__ __forceinline__ void xcd_barrier_complete(unsigned* bar, unsigned x, unsigned& nloc, unsigned& nx) {
    const unsigned G = gridDim.x * gridDim.y * gridDim.z;
    unsigned sum, cnt, mine, sp = 0u;
    for (;;) {
        sum = 0u; cnt = 0u; mine = 0u;
#pragma unroll
        for (unsigned j = 0; j < 16; ++j) { const unsigned c = xb_ld(&bar[XB_XCNT(j)]); sum += c; cnt += (c > 0u) ? 1u : 0u; mine = (j == x) ? c : mine; }
        if (sum == G) break;
        __builtin_amdgcn_s_sleep(1);
        if ((++sp & 255u) == 0u) { if (xb_ld(&bar[XB_TMO])) break; if (sp > XB_SPIN_CAP) { atomicAdd(&bar[XB_TMO], 1u); break; } }
    }
    nloc = mine > 0u ? mine : 1u; nx = cnt > 0u ? cnt : 1u;
}
__device__ __forceinline__ void xcd_barrier(const XcdBarrier& b) {
    asm volatile("s_waitcnt vmcnt(0)" ::: "memory");
    __syncthreads();
    if (threadIdx.x == 0) {
        unsigned* bar = b.bar;
        __builtin_amdgcn_s_waitcnt(0);
        unsigned nloc = b.st[0], nx = b.st[1];
        if (nloc == 0u) { xcd_barrier_complete(bar, b.x, nloc, nx); b.st[0] = nloc; b.st[1] = nx; }
        const unsigned old = xb_add(&bar[XB_XSUB(b.x)], 1u);
        const unsigned gen = old / nloc;
        if (old + 1u == (gen + 1u) * nloc) {
            __builtin_amdgcn_fence(__ATOMIC_RELEASE, "agent");
            asm volatile("s_waitcnt vmcnt(0)" ::: "memory");
            const unsigned og = xb_add(&bar[XB_TOP], 1u);
            const unsigned tg = og / nx;
            if (og + 1u == (tg + 1u) * nx) xb_add(&bar[XB_TOPGEN], 1u);
            else XB_SPIN(xb_ld(&bar[XB_TOPGEN]) == tg, bar);
            __builtin_amdgcn_fence(__ATOMIC_ACQUIRE, "agent");
            xb_add(&bar[XB_XGEN(b.x)], 1u);
            asm volatile("s_waitcnt vmcnt(0)" ::: "memory");
        } else {
            XB_SPIN(xb_ld(&bar[XB_XGEN(b.x)]) == gen, bar);
            __builtin_amdgcn_fence(__ATOMIC_ACQUIRE, "agent");
            asm volatile("s_waitcnt vmcnt(0)" ::: "memory");
        }
    }
    __syncthreads();
}

struct Frame {
    LAS unsigned char* lds;
    volatile LAS unsigned* MISC;
    gu32* ctl;
    int tid, lane, wave;
    int vcu, G;
    const float *x, *p, *g_mix, *w_in, *sinks, *w_pool, *pool_scale, *w_out, *g_ffn, *w_query, *sub_keys, *expert_u, *expert_v, *g_ple, *w_ple_gate, *w_ple_proj, *g_final;
    const int* positions;
    float* out;
    unsigned char* ws;
};
#define F_Win_t  ((bf16*)(F.ws + WS_WIN))
#define F_Wout_t ((bf16*)(F.ws + WS_WOUT))
#define F_Wq_t   ((bf16*)(F.ws + WS_WQ))
#define F_Wg_t   ((bf16*)(F.ws + WS_WG))
#define F_Wp_t   ((bf16*)(F.ws + WS_WP))
#define F_Wpool_t ((bf16*)(F.ws + WS_WPOOL))
#define F_SKH    ((bf16*)(F.ws + WS_SKH))
#define F_SKL    ((bf16*)(F.ws + WS_SKL))
#define F_EU     ((bf16*)(F.ws + WS_EU))
#define F_EV     ((bf16*)(F.ws + WS_EV))
#define F_XB     ((bf16*)(F.ws + WS_XB))
#define F_PB     ((bf16*)(F.ws + WS_PB))
#define F_QB     ((bf16*)(F.ws + WS_Q))
#define F_KB     ((bf16*)(F.ws + WS_K))
#define F_VB     ((bf16*)(F.ws + WS_V))
#define F_UB     ((bf16*)(F.ws + WS_U))
#define F_POOLED ((bf16*)(F.ws + WS_POOLED))
#define F_MIX    ((bf16*)(F.ws + WS_MIX))
#define F_H1B    ((bf16*)(F.ws + WS_H1B))
#define F_PP     ((bf16*)(F.ws + WS_PP))
#define F_H2B    ((bf16*)(F.ws + WS_H2B))
#define F_ROPE   ((float*)(F.ws + WS_ROPE))
#define F_RSTD1  ((float*)(F.ws + WS_RSTD1))
#define F_RSTD3  ((float*)(F.ws + WS_RSTD3))
#define F_QP     ((float*)(F.ws + WS_QP))
#define F_GATE   ((float*)(F.ws + WS_GATE))
#define F_H1     ((float*)(F.ws + WS_H1))
#define F_SSQ2   ((float*)(F.ws + WS_CTL) + CW_SSQ2)
#define F_SSQ4   ((float*)(F.ws + WS_CTL) + CW_SSQ4)
#define F_EIDX   ((int*)(F.ws + WS_EIDX))

__device__ __forceinline__ void p0_transpose_item(const float* W, int ldw, int N, const float* gain, bf16* WT, int ldt, LAS float* scr, int item, int lane) {
    const int nblk = N / 32, kb = item / nblk, nb = item % nblk, k0 = 64 * kb, n0 = 32 * nb;
#pragma unroll 8
    for (int i = 0; i < 32; ++i) { const int kk = 2 * i + (lane >> 5); float w = W[(size_t)(k0 + kk) * ldw + n0 + (lane & 31)]; if (gain) w *= gain[k0 + kk]; scr[kk * 33 + (lane & 31)] = w; }
    LDS_WAIT(); asm volatile("" ::: "memory");
    const int c = lane & 7;
#pragma unroll
    for (int j = 0; j < 4; ++j) { const int n = (lane >> 3) + 8 * j; const LAS float* s = scr + (8 * c) * 33 + n;
        v4u o; o.x = pk2(s[0 * 33], s[1 * 33]); o.y = pk2(s[2 * 33], s[3 * 33]); o.z = pk2(s[4 * 33], s[5 * 33]); o.w = pk2(s[6 * 33], s[7 * 33]);
        *(GAS v4u*)(WT + (size_t)(n0 + n) * ldt + k0 + 8 * c) = o; }
    LDS_WAIT(); asm volatile("" ::: "memory");
}
__device__ __forceinline__ void p0_prologue(Frame& F) {
    LAS float* scr = (LAS float*)(F.lds + RING_OFF + F.wave * 16384);
    const int gw = F.vcu * NWAVES + F.wave, NGW = F.G * NWAVES;
    const int gt = gw * 64 + F.lane, NGT = NGW * 64;
    constexpr int I_IN = (DM / 64) * (INW / 32), I_SQ = (DM / 64) * (DM / 32), I_P = (PLE / 64) * (DM / 32), I_POOL = 4 * (256 / 64) * (256 / 32);
    constexpr int NITEMS = I_IN + 3 * I_SQ + I_P + I_POOL;
    for (int it = gw; it < NITEMS; it += NGW) {
        int r = it;
        if (r < I_IN) { p0_transpose_item(F.w_in, INW, INW, F.g_mix, F_Win_t, DM, scr, r, F.lane); continue; } r -= I_IN;
        if (r < I_SQ) { p0_transpose_item(F.w_out, DM, DM, nullptr, F_Wout_t, DM, scr, r, F.lane); continue; } r -= I_SQ;
        if (r < I_SQ) { p0_transpose_item(F.w_query, DM, DM, F.g_ffn, F_Wq_t, DM, scr, r, F.lane); continue; } r -= I_SQ;
        if (r < I_SQ) { p0_transpose_item(F.w_ple_gate, DM, DM, F.g_ple, F_Wg_t, DM, scr, r, F.lane); continue; } r -= I_SQ;
        if (r < I_P) { p0_transpose_item(F.w_ple_proj, DM, DM, nullptr, F_Wp_t, PLE, scr, r, F.lane); continue; } r -= I_P;
        { const int g = r / 32, rr = r % 32; p0_transpose_item(F.w_pool + (size_t)g * 65536, 256, 256, nullptr, F_Wpool_t + (size_t)g * 65536, 256, scr, rr, F.lane); }
    }
    for (int m = gw; m < M; m += NGW) {
        const GAS f32x4* xr = (const GAS f32x4*)(F.x + (size_t)m * DM) + F.lane;
        f32x4 v[8]; float s = 0.f;
#pragma unroll
        for (int j = 0; j < 8; ++j) { v[j] = xr[64 * j]; s += (v[j].x * v[j].x + v[j].y * v[j].y) + (v[j].z * v[j].z + v[j].w * v[j].w); }
        s = wave_sum(s);
        if (F.lane == 0) F_RSTD1[m] = 1.0f / sqrtf(s * (1.0f / DM) + EPS);
        GAS v2u* o8 = (GAS v2u*)(F_XB + (size_t)m * DM) + F.lane;
#pragma unroll
        for (int j = 0; j < 8; ++j) { v2u o; o.x = pk2(v[j].x, v[j].y); o.y = pk2(v[j].z, v[j].w); o8[64 * j] = o; }
    }
    for (int c = gt; c < M * PLE / 8; c += NGT) {
        const GAS f32x4* s = (const GAS f32x4*)F.p + 2 * (size_t)c; const f32x4 a = s[0], b = s[1];
        v4u o; o.x = pk2(a.x, a.y); o.y = pk2(a.z, a.w); o.z = pk2(b.x, b.y); o.w = pk2(b.z, b.w);
        *((GAS v4u*)F_PB + c) = o;
    }
    for (int c = gt; c < NEXP * DM / 16; c += NGT) {
        const int e = c >> 7, d0 = (c & 127) * 16; const size_t dst = ((size_t)(d0 >> 7) * NEXP + e) * 128 + (d0 & 127);
        const GAS f32x4* s = (const GAS f32x4*)F.expert_u + 4 * (size_t)c; const GAS f32x4* gp = (const GAS f32x4*)(F.g_ffn + d0);
        v4u o;
#pragma unroll
        for (int q = 0; q < 4; ++q) { const f32x4 a = s[q] * gp[q] * EU_SCALE; int w = 0; w = __builtin_amdgcn_cvt_pk_fp8_f32(a.x, a.y, w, false); w = __builtin_amdgcn_cvt_pk_fp8_f32(a.z, a.w, w, true); o[q] = (unsigned)w; }
        *(GAS v4u*)((GAS unsigned char*)F_EU + dst) = o;
    }
    for (int c = gt; c < NEXP * DM / 16; c += NGT) {
        const int e = c >> 7, d0 = (c & 127) * 16; const size_t dst = ((size_t)(d0 >> 7) * NEXP + e) * 128 + (d0 & 127);
        const GAS f32x4* s = (const GAS f32x4*)F.expert_v + 4 * (size_t)c;
        v4u o;
#pragma unroll
        for (int q = 0; q < 4; ++q) { const f32x4 a = s[q] * EV_SCALE; int w = 0; w = __builtin_amdgcn_cvt_pk_fp8_f32(a.x, a.y, w, false); w = __builtin_amdgcn_cvt_pk_fp8_f32(a.z, a.w, w, true); o[q] = (unsigned)w; }
        *(GAS v4u*)((GAS unsigned char*)F_EV + dst) = o;
    }
    for (int c = gt; c < M * 8; c += NGT) {
        const int t = c >> 3, i = c & 7;
        const float inv = 1.0f / (float)pow(500000.0, (double)(2 * i) / 16.0);
        const float ang = (float)F.positions[t] * inv;
        F_ROPE[t * 16 + i] = (float)cos((double)ang); F_ROPE[t * 16 + 8 + i] = (float)sin((double)ang);
    }
    for (int c = gt; c < 2 * 128 * 128; c += NGT) {
        const float v = F.sub_keys[c]; const unsigned h = pk2(v, 0.f) & 0xffffu; const float hf = __uint_as_float(h << 16);
        F_SKH[c] = (bf16)h; F_SKL[c] = (bf16)(pk2(v - hf, 0.f) & 0xffffu);
    }
}

struct EpiG1 {
    static constexpr bool PERM = true, AFTER_DRAIN = false;
    bf16 *Q, *Kb, *Vb, *U; const float* rstd; const float* rope;
    __device__ __forceinline__ void operator()(const f32x4 (&acc)[2][2][4][2], const pg8::Unit& u, int wr, int wc, int fr, int fq) const {
        const int pn = u.pn; bf16* base; int ldc, colt;
        if (pn < 4) { base = Q; ldc = ATTW; colt = pn * 256; } else if (pn == 4) { base = Kb; ldc = KVW; colt = 0; } else if (pn == 5) { base = Vb; ldc = KVW; colt = 0; } else { base = U; ldc = POOLW; colt = (pn - 6) * 256; }
        const bool rot = (pn <= 4) && ((wc & 1) == 0);
        const float qs = (pn < 4) ? 0.125f : 1.0f;
#pragma unroll
        for (int ai = 0; ai < 2; ++ai)
#pragma unroll
            for (int m = 0; m < 4; ++m) {
                const int row = u.pm * 256 + ai * 128 + wr * 64 + m * 16 + fr;
                const float rs = rstd[row] * qs;
                const GAS f32x4* rp = (const GAS f32x4*)(rope + (size_t)row * 16);
#pragma unroll
                for (int bj = 0; bj < 2; ++bj) {
                    f32x4 v0 = acc[ai][bj][m][0] * rs, v1 = acc[ai][bj][m][1] * rs;
                    if (rot) {
                        { const f32x4 c = rp[0], s = rp[2]; f32x4 p;
#pragma unroll
                          for (int i = 0; i < 4; ++i) p[i] = __shfl_xor(v0[i], 16);
                          if (fq == 0) v0 = v0 * c - p * s; else if (fq == 1) v0 = v0 * c + p * s; }
                        { const f32x4 c = rp[1], s = rp[3]; f32x4 p;
#pragma unroll
                          for (int i = 0; i < 4; ++i) p[i] = __shfl_xor(v1[i], 16);
                          if (fq == 0) v1 = v1 * c - p * s; else if (fq == 1) v1 = v1 * c + p * s; }
                    }
                    v4u w; w.x = pk2(v0[0], v0[1]); w.y = pk2(v0[2], v0[3]); w.z = pk2(v1[0], v1[1]); w.w = pk2(v1[2], v1[3]);
                    *(GAS v4u*)(base + (size_t)row * ldc + colt + bj * 128 + wc * 32 + 8 * fq) = w;
                }
            }
    }
};
template <bool HAS_SCALE> struct EpiBf16Scale {
    static constexpr bool PERM = true, AFTER_DRAIN = false;
    bf16* O; int ldc, col_off; const float* cscale;
    __device__ __forceinline__ void operator()(const f32x4 (&acc)[2][2][4][2], const pg8::Unit& u, int wr, int wc, int fr, int fq) const {
        const int c0 = u.pn * 256 + wc * 32 + 8 * fq;
#pragma unroll
        for (int ai = 0; ai < 2; ++ai)
#pragma unroll
            for (int m = 0; m < 4; ++m) {
                const int row = u.pm * 256 + ai * 128 + wr * 64 + m * 16 + fr;
#pragma unroll
                for (int bj = 0; bj < 2; ++bj) {
                    f32x4 v0 = acc[ai][bj][m][0], v1 = acc[ai][bj][m][1];
                    if constexpr (HAS_SCALE) { v0 = v0 * *(const GAS f32x4*)(cscale + c0 + bj * 128); v1 = v1 * *(const GAS f32x4*)(cscale + c0 + bj * 128 + 4); }
                    v4u w; w.x = pk2(v0[0], v0[1]); w.y = pk2(v0[2], v0[3]); w.z = pk2(v1[0], v1[1]); w.w = pk2(v1[2], v1[3]);
                    *(GAS v4u*)(O + (size_t)row * ldc + col_off + c0 + bj * 128) = w;
                }
            }
    }
};
struct EpiG3 {
    static constexpr bool PERM = false, AFTER_DRAIN = false;
    const float* x; float* h1; bf16* h1b; float* ssq;
    __device__ __forceinline__ void operator()(const f32x4 (&acc)[2][2][4][2], const pg8::Unit& u, int wr, int wc, int fr, int fq) const {
        const int col0 = u.pn * 256 + wc * 32 + 4 * fq;
#pragma unroll
        for (int ai = 0; ai < 2; ++ai)
#pragma unroll
            for (int m = 0; m < 4; ++m) {
                const int row = u.pm * 256 + ai * 128 + wr * 64 + m * 16 + fr; float ss = 0.f;
#pragma unroll
                for (int bj = 0; bj < 2; ++bj)
#pragma unroll
                    for (int n = 0; n < 2; ++n) {
                        const size_t off = (size_t)row * DM + col0 + bj * 128 + n * 16;
                        const f32x4 h = DBG_NO_MIX ? *(const GAS f32x4*)(x + off) : *(const GAS f32x4*)(x + off) + acc[ai][bj][m][n];
                        *(GAS f32x4*)(h1 + off) = h;
                        v2u w; w.x = pk2(h[0], h[1]); w.y = pk2(h[2], h[3]); *(GAS v2u*)(h1b + off) = w;
                        ss += (h[0] * h[0] + h[1] * h[1]) + (h[2] * h[2] + h[3] * h[3]);
                    }
                ss += __shfl_xor(ss, 16); ss += __shfl_xor(ss, 32);
                if (fq == 0) atomicAdd(ssq + row, ss);
            }
    }
};
struct EpiG4 {
    static constexpr bool PERM = false, AFTER_DRAIN = false;
    float* qp; const float* ssq;
    __device__ __forceinline__ void operator()(const f32x4 (&acc)[2][2][4][2], const pg8::Unit& u, int wr, int wc, int fr, int fq) const {
        const int col0 = u.pn * 256 + wc * 32 + 4 * fq;
#pragma unroll
        for (int ai = 0; ai < 2; ++ai)
#pragma unroll
            for (int m = 0; m < 4; ++m) {
                const int row = u.pm * 256 + ai * 128 + wr * 64 + m * 16 + fr;
                const float rs = 1.0f / sqrtf(__hip_atomic_load(ssq + row, RLX_AGENT) * (1.0f / DM) + EPS);
#pragma unroll
                for (int bj = 0; bj < 2; ++bj)
#pragma unroll
                    for (int n = 0; n < 2; ++n) *(GAS f32x4*)(qp + (size_t)row * DM + col0 + bj * 128 + n * 16) = acc[ai][bj][m][n] * rs;
            }
    }
};
struct EpiG5 {
    static constexpr bool PERM = false, AFTER_DRAIN = false;
    const float* h2; const bf16* pp; const float* rstd3; float* out; float* ssq;
    __device__ __forceinline__ void operator()(const f32x4 (&acc)[2][2][4][2], const pg8::Unit& u, int wr, int wc, int fr, int fq) const {
        const int col0 = u.pn * 256 + wc * 32 + 4 * fq;
#pragma unroll
        for (int ai = 0; ai < 2; ++ai)
#pragma unroll
            for (int m = 0; m < 4; ++m) {
                const int row = u.pm * 256 + ai * 128 + wr * 64 + m * 16 + fr; float ss = 0.f;
                const float rs = rstd3[row];
#pragma unroll
                for (int bj = 0; bj < 2; ++bj)
#pragma unroll
                    for (int n = 0; n < 2; ++n) {
                        const size_t off = (size_t)row * DM + col0 + bj * 128 + n * 16;
                        const f32x4 z = DBG_NO_PLE ? (f32x4){-1e30f, -1e30f, -1e30f, -1e30f} : acc[ai][bj][m][n] * rs; const v2u pw = *(const GAS v2u*)(pp + off); const f32x4 hv = *(const GAS f32x4*)(h2 + off);
                        f32x4 o;
                        o[0] = hv[0] + bf_lo(pw.x) / (1.0f + __expf(-z[0])); o[1] = hv[1] + bf_hi(pw.x) / (1.0f + __expf(-z[1]));
                        o[2] = hv[2] + bf_lo(pw.y) / (1.0f + __expf(-z[2])); o[3] = hv[3] + bf_hi(pw.y) / (1.0f + __expf(-z[3]));
                        *(GAS f32x4*)(out + off) = o;
                        ss += (o[0] * o[0] + o[1] * o[1]) + (o[2] * o[2] + o[3] * o[3]);
                    }
                ss += __shfl_xor(ss, 16); ss += __shfl_xor(ss, 32);
                if (fq == 0) atomicAdd(ssq + row, ss);
            }
    }
};
struct SingleUnit {
    int pm, pn;
    __device__ __forceinline__ bool next(int i, pg8::Unit& u) const { if (i != 0) return false; u.pm = pm; u.pn = pn; return true; }
    __device__ __forceinline__ void a_ready(const pg8::Unit&) const {}
    __device__ __forceinline__ void done(const pg8::Unit&) const {}
};

__device__ __forceinline__ int crow(int r, int hi) { return (r & 3) + 8 * (r >> 2) + 4 * hi; }
constexpr int KS_STRIDE = 144, VT_STRIDE = 520, VT_OFF = 256 * KS_STRIDE;
__device__ __forceinline__ void attn_unit(Frame& F, int unit) {
    const int g = unit & 3, nblk = (unit >> 2) & 31, b = unit >> 7;
    const int t0 = b * SEQ + nblk * 128;
    LAS unsigned char* Ks = F.lds + RING_OFF;
    LAS unsigned char* Vt = F.lds + RING_OFF + VT_OFF;
    for (int c = F.tid; c < 2048; c += NWAVES * 64) {
        const int j = c >> 3, ch = c & 7;
        v4u kv = {0u, 0u, 0u, 0u}, vv = {0u, 0u, 0u, 0u};
        if (nblk > 0 || j >= 128) { const size_t row = (size_t)(t0 - 128 + j); kv = *(const GAS v4u*)(F_KB + row * KVW + g * 64 + ch * 8); vv = *(const GAS v4u*)(F_VB + row * KVW + g * 64 + ch * 8); }
        *(LAS v4u*)(Ks + j * KS_STRIDE + ch * 16) = kv;
#pragma unroll
        for (int e = 0; e < 8; ++e) *(LAS unsigned short*)(Vt + (ch * 8 + e) * VT_STRIDE + j * 2) = (unsigned short)((vv[e >> 1] >> (16 * (e & 1))) & 0xffffu);
    }
    __syncthreads();
    const int hq = 4 * g + (F.wave >> 1);
    const float sink = F.sinks[hq];
    const int q = F.lane & 31, h = F.lane >> 5;
#pragma unroll 1
    for (int sub = 0; sub < 2; ++sub) {
        const int i0 = (F.wave & 1) * 64 + sub * 32;
        bf16x8 qf[4];
#pragma unroll
        for (int ks = 0; ks < 4; ++ks) qf[ks] = *(const GAS bf16x8*)(F_QB + (size_t)(t0 + i0 + q) * ATTW + hq * 64 + 16 * ks + 8 * h);
        f32x16 s[5];
#pragma unroll
        for (int kt = 0; kt < 5; ++kt) {
#pragma unroll
            for (int r = 0; r < 16; ++r) s[kt][r] = 0.f;
#pragma unroll
            for (int ks = 0; ks < 4; ++ks) {
                const bf16x8 a = *(const LAS bf16x8*)(Ks + (i0 + 32 * kt + q) * KS_STRIDE + (16 * ks + 8 * h) * 2);
                s[kt] = __builtin_amdgcn_mfma_f32_32x32x16_bf16(a, qf[ks], s[kt], 0, 0, 0);
            }
        }
        float mx = sink;
#pragma unroll
        for (int kt = 0; kt < 5; ++kt)
#pragma unroll
            for (int r = 0; r < 16; ++r) {
                const bool tv = (nblk > 0) || (i0 + 32 * kt >= 128);
                const bool ok = (kt == 0) ? (crow(r, h) > q) : (kt == 4) ? (crow(r, h) <= q) : true;
                const float v = (ok && tv) ? s[kt][r] : -INFINITY;
                s[kt][r] = v; mx = fmaxf(mx, v);
            }
        mx = fmaxf(mx, __shfl_xor(mx, 32));
        float sum = 0.f;
#pragma unroll
        for (int kt = 0; kt < 5; ++kt)
#pragma unroll
            for (int r = 0; r < 16; ++r) { const float pv = __expf(s[kt][r] - mx); s[kt][r] = pv; sum += pv; }
        sum += __shfl_xor(sum, 32);
        sum += __expf(sink - mx);
        const float inv = 1.0f / sum;
        f32x16 o[2];
#pragma unroll
        for (int dt = 0; dt < 2; ++dt)
#pragma unroll
            for (int r = 0; r < 16; ++r) o[dt][r] = 0.f;
#pragma unroll
        for (int kt = 0; kt < 5; ++kt)
#pragma unroll
            for (int st = 0; st < 2; ++st) {
                v4u pw; pw.x = pk2(s[kt][8 * st + 0], s[kt][8 * st + 1]); pw.y = pk2(s[kt][8 * st + 2], s[kt][8 * st + 3]); pw.z = pk2(s[kt][8 * st + 4], s[kt][8 * st + 5]); pw.w = pk2(s[kt][8 * st + 6], s[kt][8 * st + 7]);
                const bf16x8 pb = __builtin_bit_cast(bf16x8, pw);
#pragma unroll
                for (int dt = 0; dt < 2; ++dt) {
                    const LAS unsigned char* vb = Vt + (32 * dt + q) * VT_STRIDE + (i0 + 32 * kt + 16 * st + 4 * h) * 2;
                    const v2u lo = *(const LAS v2u*)vb, hi2 = *(const LAS v2u*)(vb + 16);
                    v4u aw; aw.x = lo.x; aw.y = lo.y; aw.z = hi2.x; aw.w = hi2.y;
                    o[dt] = __builtin_amdgcn_mfma_f32_32x32x16_bf16(__builtin_bit_cast(bf16x8, aw), pb, o[dt], 0, 0, 0);
                }
            }
        bf16* orow = F_MIX + (size_t)(t0 + i0 + q) * DM + hq * 64;
#pragma unroll
        for (int dt = 0; dt < 2; ++dt)
#pragma unroll
            for (int g4 = 0; g4 < 4; ++g4) {
                v2u w; w.x = pk2(o[dt][4 * g4] * inv, o[dt][4 * g4 + 1] * inv); w.y = pk2(o[dt][4 * g4 + 2] * inv, o[dt][4 * g4 + 3] * inv);
                *(GAS v2u*)(orow + 32 * dt + 8 * g4 + 4 * h) = w;
            }
    }
    __syncthreads();
}
__device__ __forceinline__ void pool_tile(Frame& F, int pm, int g) {
    const int w = 2 << g;
    const int cg = F.tid & 31, rg = F.tid >> 5;
    const int r0 = pm * 256 + rg * 16;
    const int col = g * 256 + cg * 8;
    float sum[8];
#pragma unroll
    for (int e = 0; e < 8; ++e) sum[e] = 0.f;
    const int tseq0 = r0 & (SEQ - 1);
    for (int j = 1; j < w; ++j) { if (tseq0 - j >= 0) { const v4u v = *(const GAS v4u*)(F_UB + (size_t)(r0 - j) * POOLW + col);
#pragma unroll
            for (int e = 0; e < 4; ++e) { sum[2 * e] += bf_lo(v[e]); sum[2 * e + 1] += bf_hi(v[e]); } } }
    for (int i = 0; i < 16; ++i) {
        const int r = r0 + i, ts = tseq0 + i;
        const v4u v = *(const GAS v4u*)(F_UB + (size_t)r * POOLW + col);
        float cur[8];
#pragma unroll
        for (int e = 0; e < 4; ++e) { cur[2 * e] = bf_lo(v[e]); cur[2 * e + 1] = bf_hi(v[e]); }
#pragma unroll
        for (int e = 0; e < 8; ++e) sum[e] += cur[e];
        const int cnt = (ts + 1 < w) ? ts + 1 : w; const float ic = 1.0f / (float)cnt;
        v4u o;
        o.x = pk2(sum[0] * ic - cur[0], sum[1] * ic - cur[1]); o.y = pk2(sum[2] * ic - cur[2], sum[3] * ic - cur[3]);
        o.z = pk2(sum[4] * ic - cur[4], sum[5] * ic - cur[5]); o.w = pk2(sum[6] * ic - cur[6], sum[7] * ic - cur[7]);
        *(GAS v4u*)(F_POOLED + (size_t)r * POOLW + col) = o;
        if (ts - (w - 1) >= 0) { const v4u ov = *(const GAS v4u*)(F_UB + (size_t)(r - (w - 1)) * POOLW + col);
#pragma unroll
            for (int e = 0; e < 4; ++e) { sum[2 * e] -= bf_lo(ov[e]); sum[2 * e + 1] -= bf_hi(ov[e]); } }
    }
}

template <int N> __device__ __forceinline__ void insert_desc(float (&val)[N], float x) {
#pragma unroll
    for (int k = 0; k < N; ++k) { const float hi = max2f(x, val[k]); x = min2f(x, val[k]); val[k] = hi; }
}
__device__ __forceinline__ void bitonic_merge16(float (&m)[16]) {
#pragma unroll
    for (int st = 8; st >= 1; st >>= 1)
#pragma unroll
        for (int i = 0; i < 16; ++i) if ((i & st) == 0) { const float hi = max2f(m[i], m[i + st]), lo = min2f(m[i], m[i + st]); m[i] = hi; m[i + st] = lo; }
}
__device__ __forceinline__ void merge_partner16(float (&val)[16]) {
    float pr[16];
#pragma unroll
    for (int k = 0; k < 16; ++k) pr[k] = __shfl_xor(val[k], 32);
#pragma unroll
    for (int k = 0; k < 16; ++k) val[k] = max2f(val[k], pr[15 - k]);
    bitonic_merge16(val);
}
__device__ __forceinline__ void pin16(float (&v)[16]) {
#pragma unroll
    for (int k = 0; k < 16; ++k) asm volatile("" : "+v"(v[k]));
}
struct CandTab { int a[50], b[50]; };
__host__ __device__ constexpr CandTab make_cands() { CandTab t{}; int n = 0; for (int a = 0; a < 16; ++a) for (int b = 0; b < 16; ++b) if ((a + 1) * (b + 1) <= 16) { t.a[n] = a; t.b[n] = b; ++n; } return t; }
__device__ __forceinline__ float vsel(unsigned long long m, float a, float b) { float r; asm("v_cndmask_b32_e64 %0, %1, %2, %3" : "=v"(r) : "v"(b), "v"(a), "s"(m)); return r; }
__device__ __forceinline__ float sel16(const float (&L)[16], int a) { float r = L[0];
#pragma unroll
    for (int k = 1; k < 16; ++k) r = vsel(__ballot(a == k), L[k], r);
    return r; }
template <int HALF_>
__device__ __forceinline__ void route_half(Frame& F, const float* qrow, int r, int h, float (&Lout)[16]) {
    f32x16 acc[4];
#pragma unroll
    for (int kt = 0; kt < 4; ++kt)
#pragma unroll
        for (int i = 0; i < 16; ++i) acc[kt][i] = 0.f;
    const bf16* skh = F_SKH + HALF_ * 16384; const bf16* skl = F_SKL + HALF_ * 16384;
#pragma unroll 2
    for (int ks = 0; ks < 8; ++ks) {
        const f32x4 qa = *(const GAS f32x4*)(qrow + HALF_ * 128 + 16 * ks + 8 * h), qb = *(const GAS f32x4*)(qrow + HALF_ * 128 + 16 * ks + 8 * h + 4);
        v4u hw, lw;
        hw.x = pk2(qa.x, qa.y); hw.y = pk2(qa.z, qa.w); hw.z = pk2(qb.x, qb.y); hw.w = pk2(qb.z, qb.w);
        lw.x = pk2(qa.x - bf_lo(hw.x), qa.y - bf_hi(hw.x)); lw.y = pk2(qa.z - bf_lo(hw.y), qa.w - bf_hi(hw.y));
        lw.z = pk2(qb.x - bf_lo(hw.z), qb.y - bf_hi(hw.z)); lw.w = pk2(qb.z - bf_lo(hw.w), qb.w - bf_hi(hw.w));
        const bf16x8 bh = __builtin_bit_cast(bf16x8, hw), bl = __builtin_bit_cast(bf16x8, lw);
#pragma unroll
        for (int kt = 0; kt < 4; ++kt) {
            const bf16x8 ah = *(const GAS bf16x8*)(skh + (32 * kt + r) * 128 + 16 * ks + 8 * h), al = *(const GAS bf16x8*)(skl + (32 * kt + r) * 128 + 16 * ks + 8 * h);
            acc[kt] = __builtin_amdgcn_mfma_f32_32x32x16_bf16(ah, bh, acc[kt], 0, 0, 0);
            acc[kt] = __builtin_amdgcn_mfma_f32_32x32x16_bf16(al, bh, acc[kt], 0, 0, 0);
            acc[kt] = __builtin_amdgcn_mfma_f32_32x32x16_bf16(ah, bl, acc[kt], 0, 0, 0);
        }
    }
#pragma unroll
    for (int k = 0; k < 16; ++k) Lout[k] = -INFINITY;
#pragma unroll
    for (int kt = 0; kt < 4; ++kt)
#pragma unroll
        for (int i = 0; i < 16; ++i) {
            const unsigned n = (unsigned)(32 * kt + (i & 3) + 8 * (i >> 2) + 4 * h);
            insert_desc<16>(Lout, __uint_as_float((__float_as_uint(acc[kt][i]) & ~127u) | n));
        }
    merge_partner16(Lout);
}
__device__ __forceinline__ void route_task(Frame& F, int task) {
    const int r = F.lane & 31, h = F.lane >> 5;
    const int item = task * 32 + r, tok = item >> 3, head = item & 7;
    const float* qrow = F_QP + (size_t)tok * DM + head * 256;
    float L0[16], L1[16];
    route_half<0>(F, qrow, r, h, L0);
    route_half<1>(F, qrow, r, h, L1);
    pin16(L0); pin16(L1);
    constexpr CandTab CT = make_cands();
    const unsigned long long hm = __ballot(h != 0);
    float cand[16];
#pragma unroll
    for (int k = 0; k < 16; ++k) cand[k] = -INFINITY;
#pragma unroll
    for (int i = 0; i < 25; ++i) {
        const float v1 = vsel(hm, L0[CT.a[2 * i + 1]], L0[CT.a[2 * i]]);
        const float v2 = vsel(hm, L1[CT.b[2 * i + 1]], L1[CT.b[2 * i]]);
        const unsigned id = h ? (unsigned)(CT.a[2 * i + 1] * 16 + CT.b[2 * i + 1]) : (unsigned)(CT.a[2 * i] * 16 + CT.b[2 * i]);
        const float sm = __uint_as_float(__float_as_uint(v1) & ~127u) + __uint_as_float(__float_as_uint(v2) & ~127u);
        insert_desc<16>(cand, __uint_as_float((__float_as_uint(sm) & ~255u) | id));
    }
    merge_partner16(cand);
    pin16(cand);
    float se = 0.f;
#pragma unroll
    for (int k = 0; k < 16; ++k) se += __expf(cand[k] - cand[0]);
    const float ise = 1.0f / se;
    int eo[8]; float go[8];
#pragma unroll
    for (int kk = 0; kk < 8; ++kk) {
        const float cv = vsel(hm, cand[8 + kk], cand[kk]);
        const unsigned id = __float_as_uint(cv) & 255u; const int a = (int)(id >> 4), bb = (int)(id & 15u);
        const unsigned i1 = __float_as_uint(sel16(L0, a)) & 127u, i2 = __float_as_uint(sel16(L1, bb)) & 127u;
        eo[kk] = (int)(i1 * 128u + i2); go[kk] = __expf(cv - cand[0]) * ise;
    }
    int* ep = F_EIDX + (size_t)tok * 128 + head * 16 + 8 * h; float* gp = F_GATE + (size_t)tok * 128 + head * 16 + 8 * h;
    *(GAS v4u*)ep = (v4u){(unsigned)eo[0], (unsigned)eo[1], (unsigned)eo[2], (unsigned)eo[3]}; *(GAS v4u*)(ep + 4) = (v4u){(unsigned)eo[4], (unsigned)eo[5], (unsigned)eo[6], (unsigned)eo[7]};
    *(GAS f32x4*)gp = (f32x4){go[0], go[1], go[2], go[3]}; *(GAS f32x4*)(gp + 4) = (f32x4){go[4], go[5], go[6], go[7]};
}


#ifndef DBG_ROUTE_BF
#define DBG_ROUTE_BF 0
#endif
__device__ __forceinline__ void lds_insert(LAS float* V, LAS int* I, int tid, float x, int id) {
    if (x > V[15 * 256 + tid]) {
        int pos = 15;
        while (pos > 0 && V[(pos - 1) * 256 + tid] < x) { V[pos * 256 + tid] = V[(pos - 1) * 256 + tid]; I[pos * 256 + tid] = I[(pos - 1) * 256 + tid]; --pos; }
        V[pos * 256 + tid] = x; I[pos * 256 + tid] = id;
    }
}
__device__ __forceinline__ void route_bruteforce(Frame& F) {
    if (F.tid >= 256) return;
    const int tid = F.tid;
    LAS float* V0 = (LAS float*)(F.lds); LAS int* I0 = (LAS int*)(F.lds + 16384);
    LAS float* V1 = (LAS float*)(F.lds + 32768); LAS int* I1 = (LAS int*)(F.lds + 49152);
    LAS float* VC = (LAS float*)(F.lds + 65536); LAS int* IC = (LAS int*)(F.lds + 81920);
    for (int item = (int)blockIdx.x * 256 + tid; item < M * PKH; item += F.G * 256) {
        const int tok = item >> 3, head = item & 7;
        const float* qrow = F_QP + (size_t)tok * DM + head * 256;
        for (int k = 0; k < 16; ++k) { V0[k * 256 + tid] = -INFINITY; I0[k * 256 + tid] = 0; V1[k * 256 + tid] = -INFINITY; I1[k * 256 + tid] = 0; VC[k * 256 + tid] = -INFINITY; IC[k * 256 + tid] = 0; }
        for (int half = 0; half < 2; ++half) {
            float q[128];
#pragma unroll
            for (int d = 0; d < 128; d += 4) { const f32x4 t = *(const GAS f32x4*)(qrow + half * 128 + d); q[d] = t.x; q[d + 1] = t.y; q[d + 2] = t.z; q[d + 3] = t.w; }
            for (int n = 0; n < 128; ++n) {
                const float* sk = F.sub_keys + (size_t)half * 16384 + n * 128;
                float s = 0.f;
#pragma unroll
                for (int d = 0; d < 128; ++d) s += q[d] * sk[d];
                if (half == 0) lds_insert(V0, I0, tid, s, n); else lds_insert(V1, I1, tid, s, n);
            }
        }
        for (int a = 0; a < 16; ++a) for (int b = 0; b < 16; ++b) lds_insert(VC, IC, tid, V0[a * 256 + tid] + V1[b * 256 + tid], I0[a * 256 + tid] * 128 + I1[b * 256 + tid]);
        const float mx = VC[tid]; float se = 0.f;
        for (int k = 0; k < 16; ++k) se += __expf(VC[k * 256 + tid] - mx);
        for (int k = 0; k < 16; ++k) { F_EIDX[(size_t)tok * 128 + head * 16 + k] = IC[k * 256 + tid]; F_GATE[(size_t)tok * 128 + head * 16 + k] = __expf(VC[k * 256 + tid] - mx) / se; }
    }
}

template <int N> __device__ __forceinline__ void treduce(float (&v)[N], int lane, int d) {
    const bool up = (lane & d) != 0;
#pragma unroll
    for (int i = 0; i < N / 2; ++i) { const float send = up ? v[i] : v[i + N / 2], keep = up ? v[i + N / 2] : v[i]; v[i] = keep + __shfl_xor(send, d); }
}
constexpr int SLICE_BYTES = NEXP * 128;
constexpr int NSLICE = 16;
typedef float f32x2v __attribute__((ext_vector_type(2)));
__device__ __forceinline__ void peer_phase(Frame& F) {
    const int lane = F.lane, g = lane >> 3, p = lane & 7;
    const int tbase = (int)blockIdx.x * 32 + F.wave * 4;
    LAS float* alds = (LAS float*)(F.lds + RING_OFF + F.wave * 2048);
    const __amdgpu_buffer_rsrc_t rsu = __builtin_amdgcn_make_buffer_rsrc((void*)F_EU, 0, NEXP * DM, 0x00020000);
    const __amdgpu_buffer_rsrc_t rsv = __builtin_amdgcn_make_buffer_rsrc((void*)F_EV, 0, NEXP * DM, 0x00020000);
    const __amdgpu_buffer_rsrc_t rsx = __builtin_amdgcn_make_buffer_rsrc((void*)F_H1B, 0, M * DM * 2, 0x00020000);
    const __amdgpu_buffer_rsrc_t rsh = __builtin_amdgcn_make_buffer_rsrc((void*)F_H1, 0, M * DM * 4, 0x00020000);
    const __amdgpu_buffer_rsrc_t rsb = __builtin_amdgcn_make_buffer_rsrc((void*)F_H2B, 0, M * DM * 2, 0x00020000);
    const unsigned p16 = (unsigned)p * 16u;
    const unsigned cl = (unsigned)(16 * p + 8 * (g & 1) + 4 * ((g >> 1) & 1) + 2 * ((g >> 2) & 1));
    for (int tb = tbase; tb < M; tb += F.G * 32) {
        unsigned ev[4][8];
        float hacc[4][2];
#pragma unroll
        for (int tk = 0; tk < 4; ++tk) {
#pragma unroll
            for (int i = 0; i < 8; ++i) ev[tk][i] = (unsigned)F_EIDX[(size_t)(tb + tk) * 128 + 16 * i + g] | ((unsigned)F_EIDX[(size_t)(tb + tk) * 128 + 16 * i + 8 + g] << 16);
            hacc[tk][0] = 0.f; hacc[tk][1] = 0.f;
        }
#define PEER_VOFF(TK, i) ({ unsigned e_ = ev[TK][(i) >> 1]; asm volatile("" : "+v"(e_)); ((((i) & 1) ? (e_ >> 16) : (e_ & 0xffffu)) * 128u + p16); })
#define PEER_LOAD_X(X0, X1, S, TK) do { X0 = __builtin_amdgcn_raw_buffer_load_b128(rsx, 2u * p16, ((tb + (TK)) * DM + 128 * (S)) * 2, 0); X1 = __builtin_amdgcn_raw_buffer_load_b128(rsx, 2u * p16 + 16u, ((tb + (TK)) * DM + 128 * (S)) * 2, 0); } while (0)
#define PEER_LOAD_A(W, S, TK, H) do { _Pragma("unroll") for (int i = 0; i < 8; ++i) W[i] = __builtin_amdgcn_raw_buffer_load_b128(rsu, PEER_VOFF(TK, 8 * (H) + i), (S) * SLICE_BYTES, 0); } while (0)
#define PEER_COMP_A(W, H) do { \
        _Pragma("unroll") for (int i = 0; i < 8; ++i) { f32x2v a2 = {0.f, 0.f}; \
            _Pragma("unroll") for (int c = 0; c < 4; ++c) { const int wv = (int)W[i][c]; const f32x2v lo = __builtin_amdgcn_cvt_pk_f32_fp8(wv, false), hi = __builtin_amdgcn_cvt_pk_f32_fp8(wv, true); \
                a2 += lo * xf2[2 * c]; a2 += hi * xf2[2 * c + 1]; } \
            part[8 * (H) + i] = a2.x + a2.y; if (i & 1) __builtin_amdgcn_sched_barrier(0); } } while (0)
        for (int rep = 0; rep < NREP(6); ++rep) {
#pragma unroll
            for (int tk = 0; tk < 4; ++tk) { hacc[tk][0] = 0.f; hacc[tk][1] = 0.f; }
#pragma unroll 1
            for (int s = 0; s < NSLICE; ++s) {
#pragma unroll
                for (int tk = 0; tk < 4; ++tk) {
                    v4u w0[8], w1[8], x0, x1; f32x2v xf2[8]; float part[16];
                    PEER_LOAD_X(x0, x1, s, tk); PEER_LOAD_A(w0, s, tk, 0); PEER_LOAD_A(w1, s, tk, 1); __builtin_amdgcn_sched_barrier(0);
#pragma unroll
                    for (int c = 0; c < 4; ++c) { const unsigned a0 = x0[c], a1 = x1[c]; xf2[c] = (f32x2v){bf_lo(a0), bf_hi(a0)}; xf2[4 + c] = (f32x2v){bf_lo(a1), bf_hi(a1)}; }
                    PEER_COMP_A(w0, 0); __builtin_amdgcn_sched_barrier(0);
                    PEER_COMP_A(w1, 1); __builtin_amdgcn_sched_barrier(0);
                    treduce<16>(part, lane, 1); treduce<8>(reinterpret_cast<float (&)[8]>(part), lane, 2); treduce<4>(reinterpret_cast<float (&)[4]>(part), lane, 4);
                    hacc[tk][0] += part[0]; hacc[tk][1] += part[1]; __builtin_amdgcn_sched_barrier(0);
                }
                __builtin_amdgcn_s_barrier();
            }
        }
#undef PEER_LOAD_X
#undef PEER_LOAD_A
#undef PEER_COMP_A
#pragma unroll
        for (int tk = 0; tk < 4; ++tk) {
            const int t = tb + tk;
            const float rs2 = (1.0f / EU_SCALE) / sqrtf(__hip_atomic_load(F_SSQ2 + t, RLX_AGENT) * (1.0f / DM) + EPS);
#pragma unroll
            for (int j = 0; j < 2; ++j) {
                const int i = 8 * (p & 1) + 4 * ((p >> 1) & 1) + 2 * ((p >> 2) & 1) + j;
                const float hv = hacc[tk][j] * rs2;
                const float ge = 0.5f * hv * (1.0f + erff(hv * 0.70710678118654752f));
                alds[tk * 128 + g * 16 + i] = F_GATE[(size_t)t * 128 + 8 * i + g] * ge * (1.0f / EV_SCALE);
            }
        }
        LDS_WAIT(); asm volatile("" ::: "memory");
        float ssq[4] = {0.f, 0.f, 0.f, 0.f};
#define PEER_LOAD_B(W, S, TK, H) do { _Pragma("unroll") for (int i = 0; i < 8; ++i) W[i] = __builtin_amdgcn_raw_buffer_load_b128(rsv, PEER_VOFF(TK, 8 * (H) + i), (S) * SLICE_BYTES, 0); } while (0)
#define PEER_COMP_B(W, TK, H) do { f32x4 av[2]; \
        _Pragma("unroll") for (int q4 = 0; q4 < 2; ++q4) av[q4] = *(const LAS f32x4*)(alds + (TK) * 128 + g * 16 + 8 * (H) + 4 * q4); \
        _Pragma("unroll") for (int i = 0; i < 8; ++i) { const float a = av[i >> 2][i & 3]; const f32x2v a2 = {a, a}; \
            _Pragma("unroll") for (int c = 0; c < 4; ++c) { const int wv = (int)W[i][c]; const f32x2v lo = __builtin_amdgcn_cvt_pk_f32_fp8(wv, false), hi = __builtin_amdgcn_cvt_pk_f32_fp8(wv, true); \
                oc2[2 * c] += a2 * lo; oc2[2 * c + 1] += a2 * hi; } if (i & 1) __builtin_amdgcn_sched_barrier(0); } } while (0)
        {
#pragma unroll 1
            for (int s = 0; s < NSLICE; ++s) {
#pragma unroll
                for (int tk = 0; tk < 4; ++tk) {
                    v4u w0[8], w1[8]; f32x2v oc2[8]; float oc[16];
                    PEER_LOAD_B(w0, s, tk, 0); PEER_LOAD_B(w1, s, tk, 1); __builtin_amdgcn_sched_barrier(0);
#pragma unroll
                    for (int c = 0; c < 8; ++c) oc2[c] = (f32x2v){0.f, 0.f};
                    PEER_COMP_B(w0, tk, 0); __builtin_amdgcn_sched_barrier(0);
                    PEER_COMP_B(w1, tk, 1); __builtin_amdgcn_sched_barrier(0);
#pragma unroll
                    for (int c = 0; c < 8; ++c) { oc[2 * c] = oc2[c].x; oc[2 * c + 1] = oc2[c].y; }
                    treduce<16>(oc, lane, 8); treduce<8>(reinterpret_cast<float (&)[8]>(oc), lane, 16); treduce<4>(reinterpret_cast<float (&)[4]>(oc), lane, 32);
                    const int so = (tb + tk) * DM + 128 * s;
                    const v2u hv2 = __builtin_amdgcn_raw_buffer_load_b64(rsh, cl * 4u, so * 4, 0);
                    const float h2a = __uint_as_float(hv2.x) + oc[0], h2b = __uint_as_float(hv2.y) + oc[1];
                    v2u st; st.x = __float_as_uint(h2a); st.y = __float_as_uint(h2b);
                    __builtin_amdgcn_raw_buffer_store_b64(st, rsh, cl * 4u, so * 4, 0);
                    __builtin_amdgcn_raw_buffer_store_b32(pk2(h2a, h2b), rsb, cl * 2u, so * 2, 0); ssq[tk] += h2a * h2a + h2b * h2b;
                    __builtin_amdgcn_sched_barrier(0);
                }
                __builtin_amdgcn_s_barrier();
            }
        }
#undef PEER_LOAD_B
#undef PEER_COMP_B
#pragma unroll
        for (int tk = 0; tk < 4; ++tk) { const float ss = wave_sum(ssq[tk]); if (lane == 0) F_RSTD3[tb + tk] = 1.0f / sqrtf(ss * (1.0f / DM) + EPS); }
        LDS_WAIT(); asm volatile("" ::: "memory");
    }
}

struct Args { const void* in[18]; float* out; unsigned char* ws; int ph_lo, ph_hi, li, pad; };
__global__ void __launch_bounds__(NWAVES * 64, 2) hymba_fwd(Args args) {
    extern __shared__ __attribute__((aligned(16))) unsigned char lds[];
    Frame F;
    F.lds = (LAS unsigned char*)lds;
    F.MISC = (volatile LAS unsigned*)(F.lds + MISC_OFF);
    F.tid = threadIdx.x; F.lane = F.tid & 63; F.wave = __builtin_amdgcn_readfirstlane(F.tid >> 6);
    F.G = gridDim.x; { const int bx = blockIdx.x; F.vcu = (F.G % 8 == 0) ? (bx % 8) * (F.G / 8) + bx / 8 : bx; }
    F.ws = args.ws;
    F.ctl = (gu32*)(F.ws + WS_CTL);
    F.x = (const float*)args.in[0]; F.p = (const float*)args.in[1]; F.positions = (const int*)args.in[2]; F.g_mix = (const float*)args.in[3]; F.w_in = (const float*)args.in[4];
    F.sinks = (const float*)args.in[5]; F.w_pool = (const float*)args.in[6]; F.pool_scale = (const float*)args.in[7]; F.w_out = (const float*)args.in[8]; F.g_ffn = (const float*)args.in[9];
    F.w_query = (const float*)args.in[10]; F.sub_keys = (const float*)args.in[11]; F.expert_u = (const float*)args.in[12]; F.expert_v = (const float*)args.in[13]; F.g_ple = (const float*)args.in[14];
    F.w_ple_gate = (const float*)args.in[15]; F.w_ple_proj = (const float*)args.in[16]; F.g_final = (const float*)args.in[17]; F.out = args.out;
    for (int u = F.tid; u < (LDS_BYTES - LDSCTL_OFF) / 4; u += NWAVES * 64) ((LAS unsigned*)(F.lds + LDSCTL_OFF))[u] = 0u;
    __syncthreads();
    const bool one_phase = (args.ph_hi - args.ph_lo) == 1;
    XcdBarrier bar; bar.bar = (unsigned*)(F.ctl + CW_BAR); bar.x = 0; bar.st = nullptr;
    if (!one_phase) bar = xcd_barrier_post((unsigned*)(F.ctl + CW_BAR), F.MISC + 8);
    const int lo = args.ph_lo, hi = args.ph_hi;
#define IN(k) (lo <= (k) && (k) < hi)
#define BOTH(k) (IN(k) && IN((k) + 1))
#define GRID_BAR() xcd_barrier(bar)

    if (IN(0)) { for (int rep = 0; rep < NREP(0); ++rep) p0_prologue(F); if (BOTH(0)) GRID_BAR(); }

    if (IN(1)) {
        for (int rep = 0; rep < NREP(1); ++rep) {
        { pg8::Gemm g{F_XB, F_Win_t, M, INW, DM, DM, DM}; pg8::StaticOrder S; S.init(M, INW, F.G, (int)blockIdx.x);
          EpiG1 E{F_QB, F_KB, F_VB, F_UB, F_RSTD1, F_ROPE};
          pg8::gemm_phase<EpiG1, pg8::StaticOrder, true, true>(F.lds + RING_OFF, g, S, E); }
        { pg8::Gemm g{F_PB, F_Wp_t, M, DM, PLE, PLE, PLE}; pg8::StaticOrder S; S.init(M, DM, F.G, (int)blockIdx.x);
          EpiBf16Scale<false> E{F_PP, DM, 0, nullptr};
          pg8::gemm_phase<EpiBf16Scale<false>, pg8::StaticOrder, true, true>(F.lds + RING_OFF, g, S, E); }
        }
        if (BOTH(1)) GRID_BAR();
    }

    if (IN(2)) {
        for (int rep = 0; rep < NREP(2); ++rep) {
        for (int u = (int)blockIdx.x; u < BATCH * 32 * NKVH; u += F.G) attn_unit(F, u);
        if ((int)blockIdx.x < 128) {
            const int pu = (int)blockIdx.x, pm = pu >> 2, g = pu & 3;
            pool_tile(F, pm, g);
            VM_WAIT(); __syncthreads();
            pg8::Gemm gm{F_POOLED + g * 256, F_Wpool_t + (size_t)g * 65536, M, 256, 256, POOLW, 256}; SingleUnit S{pm, 0};
            EpiBf16Scale<true> E{F_MIX, DM, ATTW + g * 256, F.pool_scale + g * 256};
            pg8::gemm_phase<EpiBf16Scale<true>, SingleUnit, false, true>(F.lds + RING_OFF, gm, S, E);
            __syncthreads();
        }
        }
        if (BOTH(2)) GRID_BAR();
    }

    if (IN(3)) {
        pg8::Gemm g{F_MIX, F_Wout_t, M, DM, DM, DM, DM}; pg8::StaticOrder S; S.init(M, DM, F.G, (int)blockIdx.x);
        EpiG3 E{F.x, F_H1, F_H1B, F_SSQ2};
        pg8::gemm_phase<EpiG3, pg8::StaticOrder, true, true>(F.lds + RING_OFF, g, S, E);
        if (BOTH(3)) GRID_BAR();
    }

    if (IN(4)) {
        pg8::Gemm g{F_H1B, F_Wq_t, M, DM, DM, DM, DM}; pg8::StaticOrder S; S.init(M, DM, F.G, (int)blockIdx.x);
        EpiG4 E{F_QP, F_SSQ2};
        for (int rep = 0; rep < NREP(4); ++rep)
        pg8::gemm_phase<EpiG4, pg8::StaticOrder, true, true>(F.lds + RING_OFF, g, S, E);
        if (BOTH(4)) GRID_BAR();
    }

    if (IN(5)) {
        const int gw = F.vcu * NWAVES + F.wave, NGW = F.G * NWAVES;
        for (int rep = 0; rep < NREP(5); ++rep)
        for (int task = gw; task < M * PKH / 32; task += NGW) route_task(F, task);
        if (BOTH(5)) GRID_BAR();
    }

    if (IN(6)) {
        peer_phase(F);
        __syncthreads();
        if (BOTH(6)) GRID_BAR();
    }

    if (IN(7)) {
        pg8::Gemm g{F_H2B, F_Wg_t, M, DM, DM, DM, DM}; pg8::StaticOrder S; S.init(M, DM, F.G, (int)blockIdx.x);
        EpiG5 E{F_H1, F_PP, F_RSTD3, F.out, F_SSQ4};
        pg8::gemm_phase<EpiG5, pg8::StaticOrder, true, true>(F.lds + RING_OFF, g, S, E);
        if (BOTH(7)) GRID_BAR();
    }

    if (IN(8)) {
        const int gw = F.vcu * NWAVES + F.wave, NGW = F.G * NWAVES;
        for (int m = gw; m < M; m += NGW) {
            const float rs = 1.0f / sqrtf(__hip_atomic_load(F_SSQ4 + m, RLX_AGENT) * (1.0f / DM) + EPS);
            GAS f32x4* orow = (GAS f32x4*)(F.out + (size_t)m * DM) + F.lane; const GAS f32x4* gr = (const GAS f32x4*)F.g_final + F.lane;
#pragma unroll
            for (int j = 0; j < 8; ++j) { const f32x4 v = orow[64 * j]; orow[64 * j] = v * rs * gr[64 * j]; }
        }
    }
#undef IN
#undef BOTH
#undef GRID_BAR
}


#if DBG_ROUTE_BF
__global__ void __launch_bounds__(NWAVES * 64, 2) dbg_route_kernel(Args args) {
    extern __shared__ __attribute__((aligned(16))) unsigned char lds[];
    Frame F; F.lds = (LAS unsigned char*)lds; F.tid = threadIdx.x; F.lane = F.tid & 63; F.wave = F.tid >> 6; F.G = gridDim.x; F.vcu = blockIdx.x; F.ws = args.ws; F.sub_keys = (const float*)args.in[11];
    route_bruteforce(F);
}
#endif
extern "C" void kernel_launch(void* const* d_in, const int* in_sizes, int n_in, void* d_out, int out_size, void* d_ws, size_t ws_size, hipStream_t stream) {
    static int grid = 0;
    if (grid == 0) {
        if (n_in != 18 || out_size != M * DM || ws_size < WS_END) { fprintf(stderr, "kernel_launch: unexpected shapes (n_in %d, out %d, ws %zu)\n", n_in, out_size, ws_size); grid = -1; return; }
        int dev = 0, cus = 0, per_cu = 0;
        if (hipGetDevice(&dev) != hipSuccess || hipDeviceGetAttribute(&cus, hipDeviceAttributeMultiprocessorCount, dev) != hipSuccess) { grid = -1; return; }
#if DBG_ROUTE_BF
        (void)hipFuncSetAttribute((const void*)dbg_route_kernel, hipFuncAttributeMaxDynamicSharedMemorySize, 98304);
#endif
        if (hipFuncSetAttribute((const void*)hymba_fwd, hipFuncAttributeMaxDynamicSharedMemorySize, LDS_BYTES) != hipSuccess) { fprintf(stderr, "kernel_launch: hipFuncSetAttribute failed\n"); grid = -1; return; }
        if (hipOccupancyMaxActiveBlocksPerMultiprocessor(&per_cu, (const void*)hymba_fwd, NWAVES * 64, LDS_BYTES) != hipSuccess || per_cu < 1)
            fprintf(stderr, "kernel_launch: note: occupancy query reports %d workgroups per CU\n", per_cu);
        (void)hipGetLastError();
        if (cus < 128) { fprintf(stderr, "kernel_launch: needs >= 128 CUs\n"); grid = -1; return; }
        grid = cus;
    }
    if (grid < 0) return;
    if (hipMemsetAsync((char*)d_ws + WS_CTL, 0, CTL_ZERO_BYTES, stream) != hipSuccess) return;
    Args a{};
    for (int i = 0; i < 18; ++i) a.in[i] = d_in[i];
    a.out = (float*)d_out; a.ws = (unsigned char*)d_ws;
    constexpr int NL = MK_N_LAUNCHES;
    for (int li = 0; li < NL; ++li) {
        a.ph_lo = (NL == 1) ? 0 : li; a.ph_hi = (NL == 1) ? N_PHASES : li + 1; a.li = li;
#if DBG_ROUTE_BF
        if (NL == 9 && li == 5) { hipLaunchKernelGGL(dbg_route_kernel, dim3(grid), dim3(NWAVES * 64), 98304, stream, a); continue; }
#endif
        hipLaunchKernelGGL(hymba_fwd, dim3(grid), dim3(NWAVES * 64), LDS_BYTES, stream, a);
    }
}
```

```cpp
#include <hip/hip_runtime.h>
#include <cstdio>
#include <cstdint>
namespace pg8 {
#define PG8_LAS __attribute__((address_space(3)))
typedef unsigned short bf16_t;
typedef short bf16x8 __attribute__((ext_vector_type(8)));
typedef float f32x4 __attribute__((ext_vector_type(4)));
typedef unsigned u32x4 __attribute__((ext_vector_type(4)));
constexpr int BM = 256, BK = 64, HALF = 128, HTB = HALF * BK * 2  , STAGE_BYTES = 8 * HTB, NXCD = 8, WGM = 8;

__host__ __device__ __forceinline__ int lds_byte(int r, int c) { const int st = (r >> 4) * 2 + (c >> 5), rr = r & 15, cc = c & 31, ob = rr * 64 + cc * 2; return st * 1024 + (ob ^ (((ob >> 9) & 1) << 5)); }
__host__ __device__ __forceinline__ void stage_rc(int b, int& R, int& C) { const int st = b / 1024, sb = b % 1024, swz = sb ^ (((sb >> 9) & 1) << 5); R = (st >> 1) * 16 + swz / 64; C = (st & 1) * 32 + (swz % 64) / 2; }
__host__ __device__ __forceinline__ int perm32(int rho) { const int n = rho >> 4, i = rho & 15; return 8 * (i >> 2) + 4 * n + (i & 3); }

struct Unit { int pm, pn; };
struct Gemm { const bf16_t* A; const bf16_t* Bt; int M, N, K, lda, ldb; };

struct StaticOrder {
    int nM, nN, nwg, G, c;
    __host__ __device__ void init(int M, int N, int G_, int c_) { nM = M / BM; nN = N / BM; nwg = nM * nN; G = G_; c = c_; }
    __host__ __device__ bool next(int i, Unit& u) const {
        const long L = (long)i * G + c; if (L >= nwg) return false;
        int wgid = (int)L; { const int q = nwg / NXCD, r = nwg % NXCD, xcd = wgid % NXCD, off = wgid / NXCD; wgid = (xcd < r ? xcd * (q + 1) : r * (q + 1) + (xcd - r) * q) + off; }
        const int nig = WGM * nN, gid = wgid / nig, fm = gid * WGM, gsz = (nM - fm) < WGM ? (nM - fm) : WGM;
        u.pm = fm + ((wgid % nig) % gsz); u.pn = (wgid % nig) / gsz; return true;
    }
    __device__ __forceinline__ void a_ready(const Unit&) const {}
    __device__ __forceinline__ void done(const Unit&) const {}
};

__device__ __forceinline__ unsigned cvt_pk_bf16(float lo, float hi) { unsigned r; asm volatile("v_cvt_pk_bf16_f32 %0, %1, %2" : "=v"(r) : "v"(lo), "v"(hi)); return r; }
typedef float f32x2 __attribute__((ext_vector_type(2)));

template <class Epi, class Sched, bool ALIGN_EPI = false, bool SP2 = false>
__device__ __forceinline__ void gemm_phase(PG8_LAS unsigned char* lds, const Gemm g, const Sched& S, const Epi& E) {
    const int tid = threadIdx.x, wid = __builtin_amdgcn_readfirstlane(tid >> 6), lane = tid & 63, wr = wid >> 2, wc = wid & 3, fr = lane & 15, fq = lane >> 4;
    const int K = g.K, nt = K / BK;
    unsigned voffA[2], voffB[2];
#pragma unroll
    for (int i = 0; i < 2; ++i) { int R, C; stage_rc(tid * 16 + i * 8192, R, C); const int Rb = Epi::PERM ? ((R & ~31) + perm32(R & 31)) : R;
        voffA[i] = (unsigned)(R * g.lda + C) * 2u; voffB[i] = (unsigned)(Rb * g.ldb + C) * 2u; }
    const size_t kstep = (size_t)(BK * 2);
    const size_t hstepA = (size_t)HALF * g.lda * 2, hstepB = (size_t)HALF * g.ldb * 2;
    const size_t tstepA = 2 * hstepA, tstepB = 2 * hstepB;
    const unsigned ldsw = (unsigned)wid * 1024u;
    const int aoff = lds_byte(wr * 64 + fr, fq * 8), boff = lds_byte(wc * 32 + fr, fq * 8);
#define PG8_SA(b, h) (((b) * 2 + (h)) * HTB)
#define PG8_SB(b, h) ((4 + (b) * 2 + (h)) * HTB)
#define PG8_STAGE(bufoff, gbase, voff) do { _Pragma("unroll") for (int _i = 0; _i < 2; ++_i) \
        __builtin_amdgcn_global_load_lds((const unsigned*)((const char*)(gbase) + (voff)[_i]), (PG8_LAS unsigned*)(lds + (bufoff) + ldsw + _i * 8192), 16, 0, 0); } while (0)
#define PG8_LDA(dst, b, h) do { _Pragma("unroll") for (int m = 0; m < 4; ++m) _Pragma("unroll") for (int k = 0; k < 2; ++k) dst[m][k] = *(const PG8_LAS bf16x8*)(lds + PG8_SA(b, h) + aoff + m * 2048 + k * 1024); } while (0)
#define PG8_LDB(dst, b, h) do { _Pragma("unroll") for (int n = 0; n < 2; ++n) _Pragma("unroll") for (int k = 0; k < 2; ++k) dst[n][k] = *(const PG8_LAS bf16x8*)(lds + PG8_SB(b, h) + boff + n * 2048 + k * 1024); } while (0)
#define PG8_MMA(ai, bj, At, Bt) do { __builtin_amdgcn_s_setprio(1); _Pragma("unroll") for (int m = 0; m < 4; ++m) _Pragma("unroll") for (int n = 0; n < 2; ++n) _Pragma("unroll") for (int k = 0; k < 2; ++k) \
        acc[ai][bj][m][n] = __builtin_amdgcn_mfma_f32_16x16x32_bf16(Bt[n][k], At[m][k], acc[ai][bj][m][n], 0, 0, 0); __builtin_amdgcn_s_setprio(0); } while (0)
#define PG8_WAIT_V(n) asm volatile("s_waitcnt vmcnt(" #n ")" ::: "memory")
#define PG8_WAIT_L(n) asm volatile("s_waitcnt lgkmcnt(" #n ")" ::: "memory")
#define PG8_BAR __builtin_amdgcn_s_barrier()
#define PG8_SCHED __builtin_amdgcn_sched_barrier(0)
    Unit cur, nxt; int ui = 0;
    if (!S.next(0, cur)) return;
    f32x4 acc[2][2][4][2];
#pragma unroll
    for (int a = 0; a < 2; ++a)
#pragma unroll
        for (int b = 0; b < 2; ++b)
#pragma unroll
            for (int m = 0; m < 4; ++m)
#pragma unroll
                for (int n = 0; n < 2; ++n) acc[a][b][m][n] = (f32x4){0.f, 0.f, 0.f, 0.f};
    bf16x8 At[4][2], B0[2][2], B1[2][2];
    const char* cA = (const char*)g.A + (size_t)cur.pm * tstepA; const char* cB = (const char*)g.Bt + (size_t)cur.pn * tstepB;
    S.a_ready(cur);
    if constexpr (SP2) {
        PG8_STAGE(PG8_SB(0, 0), cB, voffB); PG8_STAGE(PG8_SB(0, 1), cB + hstepB, voffB); PG8_STAGE(PG8_SA(0, 0), cA, voffA); PG8_STAGE(PG8_SA(0, 1), cA + hstepA, voffA);
        if (wr == 1) PG8_BAR;
        PG8_WAIT_V(2); PG8_BAR;
        PG8_STAGE(PG8_SB(1, 0), cB + kstep, voffB); PG8_STAGE(PG8_SA(1, 0), cA + kstep, voffA); PG8_STAGE(PG8_SB(1, 1), cB + hstepB + kstep, voffB);
        PG8_WAIT_V(6); PG8_BAR;
    } else {
        PG8_STAGE(PG8_SB(0, 0), cB, voffB); PG8_STAGE(PG8_SA(0, 0), cA, voffA); PG8_STAGE(PG8_SB(0, 1), cB + hstepB, voffB); PG8_STAGE(PG8_SA(0, 1), cA + hstepA, voffA);
        if (wr == 1) PG8_BAR;
        PG8_WAIT_V(4); PG8_BAR;
        PG8_STAGE(PG8_SB(1, 0), cB + kstep, voffB); PG8_STAGE(PG8_SA(1, 0), cA + kstep, voffA); PG8_STAGE(PG8_SB(1, 1), cB + hstepB + kstep, voffB);
        PG8_WAIT_V(6); PG8_BAR;
    }
    for (;;) {
        const bool has_next = S.next(ui + 1, nxt);
        const char* nA = has_next ? (const char*)g.A + (size_t)nxt.pm * tstepA : cA; const char* nB = has_next ? (const char*)g.Bt + (size_t)nxt.pn * tstepB : cB;
        for (int t = 0; t < nt; t += 2) {
            const bool last = (t == nt - 2);
            const char* a1 = cA + (size_t)(t + 1) * kstep;
            const char* a2 = last ? nA : cA + (size_t)(t + 2) * kstep; const char* b2 = last ? nB : cB + (size_t)(t + 2) * kstep;
            const char* a3 = a2 + kstep; const char* b3 = b2 + kstep;
            if (last && has_next) S.a_ready(nxt);
            if constexpr (SP2) {
            PG8_LDB(B0, 0, 0); PG8_LDB(B1, 0, 1); PG8_SCHED; PG8_LDA(At, 0, 0); PG8_STAGE(PG8_SA(1, 1), a1 + hstepA, voffA);
            PG8_WAIT_V(8); PG8_WAIT_L(0); PG8_BAR; PG8_MMA(0, 0, At, B0); PG8_MMA(0, 1, At, B1); PG8_BAR; PG8_SCHED;
            PG8_LDA(At, 0, 1); PG8_STAGE(PG8_SB(0, 0), b2, voffB); PG8_STAGE(PG8_SB(0, 1), b2 + hstepB, voffB); PG8_STAGE(PG8_SA(0, 0), a2, voffA);
            PG8_WAIT_V(8); PG8_WAIT_L(0); PG8_BAR; PG8_MMA(1, 0, At, B0); PG8_MMA(1, 1, At, B1); PG8_BAR; PG8_SCHED;
            PG8_LDB(B0, 1, 0); PG8_LDB(B1, 1, 1); PG8_SCHED; PG8_LDA(At, 1, 0); PG8_STAGE(PG8_SA(0, 1), a2 + hstepA, voffA);
            PG8_WAIT_V(8); PG8_WAIT_L(0); PG8_BAR; PG8_MMA(0, 0, At, B0); PG8_MMA(0, 1, At, B1); PG8_BAR; PG8_SCHED;
            PG8_LDA(At, 1, 1); PG8_STAGE(PG8_SB(1, 0), b3, voffB); PG8_STAGE(PG8_SB(1, 1), b3 + hstepB, voffB); PG8_STAGE(PG8_SA(1, 0), a3, voffA);
            PG8_WAIT_V(8); PG8_WAIT_L(0); PG8_BAR; PG8_MMA(1, 0, At, B0); PG8_MMA(1, 1, At, B1); PG8_BAR; PG8_SCHED;
            } else {
            PG8_LDB(B0, 0, 0); PG8_SCHED; PG8_LDA(At, 0, 0); PG8_STAGE(PG8_SA(1, 1), a1 + hstepA, voffA);
            PG8_WAIT_L(8); PG8_BAR; PG8_WAIT_L(0); PG8_MMA(0, 0, At, B0); PG8_BAR; PG8_SCHED;
            PG8_LDB(B1, 0, 1); PG8_STAGE(PG8_SB(0, 0), b2, voffB);
            PG8_BAR; PG8_WAIT_L(0); PG8_MMA(0, 1, At, B1); PG8_BAR;
            PG8_LDA(At, 0, 1); PG8_STAGE(PG8_SA(0, 0), a2, voffA);
            PG8_BAR; PG8_WAIT_L(0); PG8_MMA(1, 0, At, B0); PG8_BAR; PG8_SCHED;
            PG8_STAGE(PG8_SB(0, 1), b2 + hstepB, voffB);
            PG8_WAIT_V(6); PG8_BAR; PG8_MMA(1, 1, At, B1); PG8_BAR;
            PG8_LDB(B0, 1, 0); PG8_SCHED; PG8_LDA(At, 1, 0); PG8_STAGE(PG8_SA(0, 1), a2 + hstepA, voffA);
            PG8_WAIT_L(8); PG8_BAR; PG8_WAIT_L(0); PG8_MMA(0, 0, At, B0); PG8_BAR; PG8_SCHED;
            PG8_LDB(B1, 1, 1); PG8_STAGE(PG8_SB(1, 0), b3, voffB);
            PG8_BAR; PG8_WAIT_L(0); PG8_MMA(0, 1, At, B1); PG8_BAR;
            PG8_LDA(At, 1, 1); PG8_STAGE(PG8_SA(1, 0), a3, voffA);
            PG8_BAR; PG8_WAIT_L(0); PG8_MMA(1, 0, At, B0); PG8_BAR; PG8_SCHED;
            PG8_STAGE(PG8_SB(1, 1), b3 + hstepB, voffB);
            PG8_WAIT_V(6); PG8_BAR; PG8_MMA(1, 1, At, B1); PG8_BAR;
            }
        }
        if constexpr (ALIGN_EPI) { if (wr == 0) PG8_BAR; }
        if constexpr (!Epi::AFTER_DRAIN) { E(acc, cur, wr, wc, fr, fq); S.done(cur); }
        if (!has_next) break;
#pragma unroll
        for (int a = 0; a < 2; ++a)
#pragma unroll
            for (int b = 0; b < 2; ++b)
#pragma unroll
                for (int m = 0; m < 4; ++m)
#pragma unroll
                    for (int n = 0; n < 2; ++n) acc[a][b][m][n] = (f32x4){0.f, 0.f, 0.f, 0.f};
        cur = nxt; cA = nA; cB = nB; ++ui;
        if constexpr (ALIGN_EPI) { if (wr == 1) PG8_BAR; }
    }
    PG8_WAIT_V(0);
    if constexpr (!ALIGN_EPI) { if (wr == 0) PG8_BAR; }
    PG8_BAR;
    if constexpr (Epi::AFTER_DRAIN) { E.fused(acc, cur, wr, wc, fr, fq, lds, wid, lane); S.done(cur); }
#undef PG8_SA
#undef PG8_SB
#undef PG8_STAGE
#undef PG8_LDA
#undef PG8_LDB
#undef PG8_MMA
#undef PG8_WAIT_V
#undef PG8_WAIT_L
#undef PG8_BAR
#undef PG8_SCHED
}
}


constexpr int NWAVES = 8;
constexpr int DM = 2048, BATCH = 2, SEQ = 4096, M = BATCH * SEQ;
constexpr int HD = 64, NQH = 16, NKVH = 4, ATTW = 1024, KVW = 256, POOLW = 1024, INW = 2560;
constexpr int PKH = 8, NEXP = 16384, PLE = 256;
constexpr float EPS = 1e-6f;
constexpr float EU_SCALE = 256.0f, EV_SCALE = 16.0f;
#ifndef MK_N_LAUNCHES
#define MK_N_LAUNCHES 1
#endif
constexpr int N_PHASES = 9;
#ifndef REP_MASK
#define REP_MASK 0
#endif
#define NREP(k) (((REP_MASK >> (k)) & 1) ? 2 : 1)
#ifndef DBG_NO_PEER
#define DBG_NO_PEER 0
#endif
#ifndef DBG_NO_PLE
#define DBG_NO_PLE 0
#endif
#ifndef DBG_NO_MIX
#define DBG_NO_MIX 0
#endif

constexpr size_t MiB = 1u << 20;
constexpr size_t WS_CTL = 0, CTL_ZERO_BYTES = 256 * 1024;
constexpr size_t WS_WIN = 1 * MiB, WS_WOUT = 11 * MiB, WS_WQ = 19 * MiB, WS_WG = 27 * MiB, WS_WP = 35 * MiB, WS_WPOOL = 36 * MiB;
constexpr size_t WS_SKH = 36 * MiB + 512 * 1024, WS_SKL = WS_SKH + 64 * 1024;
constexpr size_t WS_ROPE = 37 * MiB;
constexpr size_t WS_RSTD1 = 37 * MiB + 512 * 1024, WS_RSTD3 = WS_RSTD1 + 32 * 1024;
constexpr size_t WS_EU = 38 * MiB, WS_EV = 102 * MiB;
constexpr size_t WS_XB = 166 * MiB, WS_PB = 198 * MiB;
constexpr size_t WS_Q = 202 * MiB, WS_K = 218 * MiB, WS_V = 222 * MiB, WS_U = 226 * MiB, WS_POOLED = 242 * MiB, WS_MIX = 258 * MiB;
constexpr size_t WS_QP = 202 * MiB;
constexpr size_t WS_EIDX = 266 * MiB, WS_GATE = 270 * MiB;
constexpr size_t WS_H1 = 290 * MiB, WS_H1B = 354 * MiB, WS_PP = 386 * MiB, WS_H2B = 418 * MiB, WS_END = 450 * MiB;
constexpr int CW_QUEUE = 2048;
constexpr int CW_BAR = 4096;
constexpr int CW_SSQ2 = 16384, CW_SSQ4 = 16384 + 8192;
static_assert((CW_SSQ4 + 8192) * 4 <= (int)CTL_ZERO_BYTES, "ctl");

constexpr int RING_OFF = 0, RING_BYTES = 131072;
constexpr int LDSCTL_OFF = RING_BYTES, MISC_OFF = LDSCTL_OFF + 320;
constexpr int LDS_BYTES = 147456;

#define GAS __attribute__((address_space(1)))
#define LAS __attribute__((address_space(3)))
typedef unsigned short bf16;
typedef unsigned v4u __attribute__((ext_vector_type(4)));
typedef unsigned v2u __attribute__((ext_vector_type(2)));
typedef float f32x4 __attribute__((ext_vector_type(4)));
typedef float f32x16 __attribute__((ext_vector_type(16)));
typedef short bf16x8 __attribute__((ext_vector_type(8)));
typedef GAS unsigned gu32;
#define RLX_AGENT __ATOMIC_RELAXED, __HIP_MEMORY_SCOPE_AGENT
#define LDS_WAIT() asm volatile("s_waitcnt lgkmcnt(0)" ::: "memory")
#define VM_WAIT() asm volatile("s_waitcnt vmcnt(0)" ::: "memory")
typedef float f32x2_t __attribute__((ext_vector_type(2))); typedef __bf16 bf16x2_t __attribute__((ext_vector_type(2)));
__device__ __forceinline__ unsigned pk2(float lo, float hi) { f32x2_t v = {lo, hi}; bf16x2_t b = __builtin_convertvector(v, bf16x2_t); return __builtin_bit_cast(unsigned, b); }
__device__ __forceinline__ float bf_lo(unsigned w) { return __uint_as_float(w << 16); }
__device__ __forceinline__ float bf_hi(unsigned w) { return __uint_as_float(w & 0xffff0000u); }
__device__ __forceinline__ float dot2bf(unsigned a, unsigned b, float c) { return __builtin_amdgcn_fdot2_f32_bf16(__builtin_bit_cast(bf16x2_t, a), __builtin_bit_cast(bf16x2_t, b), c, false); }
__device__ __forceinline__ float max2f(float a, float b) { float r; asm("v_max_f32_e32 %0, %1, %2" : "=v"(r) : "v"(a), "v"(b)); return r; }
__device__ __forceinline__ float min2f(float a, float b) { float r; asm("v_min_f32_e32 %0, %1, %2" : "=v"(r) : "v"(a), "v"(b)); return r; }
__device__ __forceinline__ float wave_sum(float v) {
#pragma unroll
    for (int o = 1; o < 64; o <<= 1) v += __shfl_xor(v, o);
    return v;
}

#define XB_TMO      128
#define XB_XCNT(j)  (256  + 64 * (j))
#define XB_XSUB(j)  (1280 + 64 * (j))
#define XB_XGEN(j)  (2304 + 64 * (j))
#define XB_TOP      3328
#define XB_TOPGEN   3392
#define XCD_BAR_WORDS 3456
#define XB_SPIN_CAP (1u << 18)
__device__ __forceinline__ unsigned xb_ld(unsigned* p)              { return __hip_atomic_load(p, __ATOMIC_RELAXED, __HIP_MEMORY_SCOPE_AGENT); }
__device__ __forceinline__ unsigned xb_add(unsigned* p, unsigned v) { return __hip_atomic_fetch_add(p, v, __ATOMIC_RELAXED, __HIP_MEMORY_SCOPE_AGENT); }
__device__ __forceinline__ unsigned xb_xcc_id() { return (unsigned)__builtin_amdgcn_s_getreg((3 << 11) | 20) & 0xFu; }
#define XB_SPIN(cond, bar) do { unsigned _sp = 0; while (cond) { __builtin_amdgcn_s_sleep(1); \
    if ((++_sp & 255u) == 0u) { if (xb_ld(&(bar)[XB_TMO])) break; if (_sp > XB_SPIN_CAP) { atomicAdd(&(bar)[XB_TMO], 1u); break; } } } } while (0)
struct XcdBarrier { unsigned* bar; unsigned x; volatile LAS unsigned* st; };
__device__ __forceinline__ XcdBarrier xcd_barrier_post(unsigned* bar, volatile LAS unsigned* st) {
    XcdBarrier b; b.bar = bar; b.x = xb_xcc_id(); b.st = st;
    if (threadIdx.x == 0) (void)xb_add(&bar[XB_XCNT(b.x)], 1u);
    return b;
}
__device__ __forceinline__ void xcd_barrier_complete(unsigned* bar, unsigned x, unsigned& nloc, unsigned& nx) {
    const unsigned G = gridDim.x * gridDim.y * gridDim.z;
    unsigned sum, cnt, mine, sp = 0u;
    for (;;) {
        sum = 0u; cnt = 0u; mine = 0u;
#pragma unroll
        for (unsigned j = 0; j < 16; ++j) { const unsigned c = xb_ld(&bar[XB_XCNT(j)]); sum += c; cnt += (c > 0u) ? 1u : 0u; mine = (j == x) ? c : mine; }
        if (sum == G) break;
        __builtin_amdgcn_s_sleep(1);
        if ((++sp & 255u) == 0u) { if (xb_ld(&bar[XB_TMO])) break; if (sp > XB_SPIN_CAP) { atomicAdd(&bar[XB_TMO], 1u); break; } }
    }
    nloc = mine > 0u ? mine : 1u; nx = cnt > 0u ? cnt : 1u;
}
__device__ __forceinline__ void xcd_barrier(const XcdBarrier& b) {
    asm volatile("s_waitcnt vmcnt(0)" ::: "memory");
    __syncthreads();
    if (threadIdx.x == 0) {
        unsigned* bar = b.bar;
        __builtin_amdgcn_s_waitcnt(0);
        unsigned nloc = b.st[0], nx = b.st[1];
        if (nloc == 0u) { xcd_barrier_complete(bar, b.x, nloc, nx); b.st[0] = nloc; b.st[1] = nx; }
        const unsigned old = xb_add(&bar[XB_XSUB(b.x)], 1u);
        const unsigned gen = old / nloc;
        if (old + 1u == (gen + 1u) * nloc) {
            __builtin_amdgcn_fence(__ATOMIC_RELEASE, "agent");
            asm volatile("s_waitcnt vmcnt(0)" ::: "memory");
            const unsigned og = xb_add(&bar[XB_TOP], 1u);
            const unsigned tg = og / nx;
            if (og + 1u == (tg + 1u) * nx) xb_add(&bar[XB_TOPGEN], 1u);
            else XB_SPIN(xb_ld(&bar[XB_TOPGEN]) == tg, bar);
            __builtin_amdgcn_fence(__ATOMIC_ACQUIRE, "agent");
            xb_add(&bar[XB_XGEN(b.x)], 1u);
            asm volatile("s_waitcnt vmcnt(0)" ::: "memory");
        } else {
            XB_SPIN(xb_ld(&bar[XB_XGEN(b.x)]) == gen, bar);
            __builtin_amdgcn_fence(__ATOMIC_ACQUIRE, "agent");
            asm volatile("s_waitcnt vmcnt(0)" ::: "memory");
        }
    }
    __syncthreads();
}

struct Frame {
    LAS unsigned char* lds;
    volatile LAS unsigned* MISC;
    gu32* ctl;
    int tid, lane, wave;
    int vcu, G;
    const float *x, *p, *g_mix, *w_in, *sinks, *w_pool, *pool_scale, *w_out, *g_ffn, *w_query, *sub_keys, *expert_u, *expert_v, *g_ple, *w_ple_gate, *w_ple_proj, *g_final;
    const int* positions;
    float* out;
    unsigned char* ws;
};
#define F_Win_t  ((bf16*)(F.ws + WS_WIN))
#define F_Wout_t ((bf16*)(F.ws + WS_WOUT))
#define F_Wq_t   ((bf16*)(F.ws + WS_WQ))
#define F_Wg_t   ((bf16*)(F.ws + WS_WG))
#define F_Wp_t   ((bf16*)(F.ws + WS_WP))
#define F_Wpool_t ((bf16*)(F.ws + WS_WPOOL))
#define F_SKH    ((bf16*)(F.ws + WS_SKH))
#define F_SKL    ((bf16*)(F.ws + WS_SKL))
#define F_EU     ((bf16*)(F.ws + WS_EU))
#define F_EV     ((bf16*)(F.ws + WS_EV))
#define F_XB     ((bf16*)(F.ws + WS_XB))
#define F_PB     ((bf16*)(F.ws + WS_PB))
#define F_QB     ((bf16*)(F.ws + WS_Q))
#define F_KB     ((bf16*)(F.ws + WS_K))
#define F_VB     ((bf16*)(F.ws + WS_V))
#define F_UB     ((bf16*)(F.ws + WS_U))
#define F_POOLED ((bf16*)(F.ws + WS_POOLED))
#define F_MIX    ((bf16*)(F.ws + WS_MIX))
#define F_H1B    ((bf16*)(F.ws + WS_H1B))
#define F_PP     ((bf16*)(F.ws + WS_PP))
#define F_H2B    ((bf16*)(F.ws + WS_H2B))
#define F_ROPE   ((float*)(F.ws + WS_ROPE))
#define F_RSTD1  ((float*)(F.ws + WS_RSTD1))
#define F_RSTD3  ((float*)(F.ws + WS_RSTD3))
#define F_QP     ((float*)(F.ws + WS_QP))
#define F_GATE   ((float*)(F.ws + WS_GATE))
#define F_H1     ((float*)(F.ws + WS_H1))
#define F_SSQ2   ((float*)(F.ws + WS_CTL) + CW_SSQ2)
#define F_SSQ4   ((float*)(F.ws + WS_CTL) + CW_SSQ4)
#define F_EIDX   ((int*)(F.ws + WS_EIDX))

__device__ __forceinline__ void p0_transpose_item(const float* W, int ldw, int N, const float* gain, bf16* WT, int ldt, LAS float* scr, int item, int lane) {
    const int nblk = N / 32, kb = item / nblk, nb = item % nblk, k0 = 64 * kb, n0 = 32 * nb;
    float wv[32];
#pragma unroll
    for (int i = 0; i < 32; ++i) { const int kk = 2 * i + (lane >> 5); wv[i] = W[(size_t)(k0 + kk) * ldw + n0 + (lane & 31)]; }
    if (gain) {
#pragma unroll
        for (int i = 0; i < 32; ++i) wv[i] *= gain[k0 + 2 * i + (lane >> 5)];
    }
#pragma unroll
    for (int i = 0; i < 32; ++i) { const int kk = 2 * i + (lane >> 5); scr[kk * 33 + (lane & 31)] = wv[i]; }
    LDS_WAIT(); asm volatile("" ::: "memory");
    const int c = lane & 7;
#pragma unroll
    for (int j = 0; j < 4; ++j) { const int n = (lane >> 3) + 8 * j; const LAS float* s = scr + (8 * c) * 33 + n;
        v4u o; o.x = pk2(s[0 * 33], s[1 * 33]); o.y = pk2(s[2 * 33], s[3 * 33]); o.z = pk2(s[4 * 33], s[5 * 33]); o.w = pk2(s[6 * 33], s[7 * 33]);
        *(GAS v4u*)(WT + (size_t)(n0 + n) * ldt + k0 + 8 * c) = o; }
    LDS_WAIT(); asm volatile("" ::: "memory");
}
__device__ __forceinline__ void p0_prologue(Frame& F) {
    LAS float* scr = (LAS float*)(F.lds + RING_OFF + F.wave * 16384);
    const int gw = F.vcu * NWAVES + F.wave, NGW = F.G * NWAVES;
    const int gt = gw * 64 + F.lane, NGT = NGW * 64;
    constexpr int I_IN = (DM / 64) * (INW / 32), I_P = (PLE / 64) * (DM / 32);
    constexpr int NITEMS = I_IN + I_P;
    for (int it = gw; it < NITEMS; it += NGW) {
        int r = it;
        if (r < I_IN) { p0_transpose_item(F.w_in, INW, INW, F.g_mix, F_Win_t, DM, scr, r, F.lane); continue; } r -= I_IN;
        p0_transpose_item(F.w_ple_proj, DM, DM, nullptr, F_Wp_t, PLE, scr, r, F.lane);
    }
    for (int m = gw; m < M; m += NGW) {
        const GAS f32x4* xr = (const GAS f32x4*)(F.x + (size_t)m * DM) + F.lane;
        f32x4 v[8]; float s = 0.f;
#pragma unroll
        for (int j = 0; j < 8; ++j) { v[j] = xr[64 * j]; s += (v[j].x * v[j].x + v[j].y * v[j].y) + (v[j].z * v[j].z + v[j].w * v[j].w); }
        s = wave_sum(s);
        if (F.lane == 0) F_RSTD1[m] = 1.0f / sqrtf(s * (1.0f / DM) + EPS);
        GAS v2u* o8 = (GAS v2u*)(F_XB + (size_t)m * DM) + F.lane;
#pragma unroll
        for (int j = 0; j < 8; ++j) { v2u o; o.x = pk2(v[j].x, v[j].y); o.y = pk2(v[j].z, v[j].w); o8[64 * j] = o; }
    }
    for (int c = gt; c < M * PLE / 8; c += NGT) {
        const GAS f32x4* s = (const GAS f32x4*)F.p + 2 * (size_t)c; const f32x4 a = s[0], b = s[1];
        v4u o; o.x = pk2(a.x, a.y); o.y = pk2(a.z, a.w); o.z = pk2(b.x, b.y); o.w = pk2(b.z, b.w);
        *((GAS v4u*)F_PB + c) = o;
    }
    for (int c = gt; c < M * 8; c += NGT) {
        const int t = c >> 3, i = c & 7;
        const float inv = 1.0f / (float)pow(500000.0, (double)(2 * i) / 16.0);
        const float ang = (float)F.positions[t] * inv;
        F_ROPE[t * 16 + i] = (float)cos((double)ang); F_ROPE[t * 16 + 8 + i] = (float)sin((double)ang);
    }
    for (int c = gt; c < 2 * 128 * 128; c += NGT) {
        const float v = F.sub_keys[c]; const unsigned h = pk2(v, 0.f) & 0xffffu; const float hf = __uint_as_float(h << 16);
        F_SKH[c] = (bf16)h; F_SKL[c] = (bf16)(pk2(v - hf, 0.f) & 0xffffu);
    }
}


constexpr int Q_EXP = 1024, Q_SQ = 256, Q_POOL = 16, Q_ITEMS = Q_EXP + 3 * Q_SQ + Q_POOL;
__device__ __forceinline__ void conv_expert_item(Frame& F, int idx, int tid) {
    const bool isv = idx >= 512; const int e0 = (idx & 511) * 32;
    const float* src = isv ? F.expert_v : F.expert_u; unsigned char* dstb = (unsigned char*)(isv ? (void*)F_EV : (void*)F_EU);
    const float sc = isv ? EV_SCALE : EU_SCALE;
#pragma unroll 4
    for (int cl = tid; cl < 32 * 128; cl += NWAVES * 64) {
        const int e = e0 + (cl >> 7), d0 = (cl & 127) * 16; const size_t dst = ((size_t)(d0 >> 7) * NEXP + e) * 128 + (d0 & 127);
        const GAS f32x4* s = (const GAS f32x4*)(src + (size_t)e * DM + d0); const GAS f32x4* gp = (const GAS f32x4*)(F.g_ffn + d0);
        v4u o;
#pragma unroll
        for (int q = 0; q < 4; ++q) { f32x4 a = s[q] * sc; if (!isv) a = a * gp[q]; int w = 0; w = __builtin_amdgcn_cvt_pk_fp8_f32(a.x, a.y, w, false); w = __builtin_amdgcn_cvt_pk_fp8_f32(a.z, a.w, w, true); o[q] = (unsigned)w; }
        *(GAS v4u*)(dstb + dst) = o;
    }
}
__device__ __forceinline__ void p1_queue(Frame& F) {
    const int lane = (int)__builtin_amdgcn_mbcnt_hi(~0u, __builtin_amdgcn_mbcnt_lo(~0u, 0u)), tid = F.wave * 64 + lane;
    LAS float* scr = (LAS float*)(F.lds + RING_OFF + F.wave * 16384);
    volatile LAS unsigned* qslot = F.MISC + 12;
    unsigned mine = 0u;
    if (tid == 0) { qslot[0] = __hip_atomic_fetch_add((unsigned*)(F.ctl + CW_QUEUE), 1u, RLX_AGENT); }
    __syncthreads();
    int idx = (int)qslot[0];
    for (int n = 0;; ++n) {
        if (idx >= Q_ITEMS) break;
        if (tid == 0) mine = __hip_atomic_fetch_add((unsigned*)(F.ctl + CW_QUEUE), 1u, RLX_AGENT);
        if (idx < Q_EXP) conv_expert_item(F, idx, tid);
        else {
            int r = (idx - Q_EXP) * 8 + F.wave;
            if (r < 8 * Q_SQ) p0_transpose_item(F.w_out, DM, DM, nullptr, F_Wout_t, DM, scr, r, lane);
            else if (r < 16 * Q_SQ) p0_transpose_item(F.w_query, DM, DM, F.g_ffn, F_Wq_t, DM, scr, r - 8 * Q_SQ, lane);
            else if (r < 24 * Q_SQ) p0_transpose_item(F.w_ple_gate, DM, DM, F.g_ple, F_Wg_t, DM, scr, r - 16 * Q_SQ, lane);
            else { const int rp = r - 24 * Q_SQ, g = rp / 32, rr = rp % 32; p0_transpose_item(F.w_pool + (size_t)g * 65536, 256, 256, nullptr, F_Wpool_t + (size_t)g * 65536, 256, scr, rr, lane); }
        }
        if (tid == 0) qslot[1 - (n & 1)] = mine;
        __syncthreads();
        idx = (int)qslot[1 - (n & 1)];
    }
}
struct PpOrder {
    int first, stride;
    __device__ __forceinline__ void init(int G, int c) { const int heavy = (320 > G && 320 - G < G) ? 320 - G : 0; if (c < heavy) { first = 1 << 20; stride = 1; } else { first = c - heavy; stride = G - heavy; } }
    __device__ __forceinline__ bool next(int i, pg8::Unit& u) const { const long k = (long)first + (long)i * stride; if (k >= 256) return false; u.pm = (int)k >> 3; u.pn = (int)k & 7; return true; }
    __device__ __forceinline__ void a_ready(const pg8::Unit&) const {}
    __device__ __forceinline__ void done(const pg8::Unit&) const {}
};

struct EpiG1 {
    static constexpr bool PERM = true, AFTER_DRAIN = false;
    bf16 *Q, *Kb, *Vb, *U; const float* rstd; const float* rope;
    __device__ __forceinline__ void operator()(const f32x4 (&acc)[2][2][4][2], const pg8::Unit& u, int wr, int wc, int fr, int fq) const {
        const int pn = u.pn; bf16* base; int ldc, colt;
        if (pn < 4) { base = Q; ldc = ATTW; colt = pn * 256; } else if (pn == 4) { base = Kb; ldc = KVW; colt = 0; } else if (pn == 5) { base = Vb; ldc = KVW; colt = 0; } else { base = U; ldc = POOLW; colt = (pn - 6) * 256; }
        const bool rot = (pn <= 4) && ((wc & 1) == 0);
        const float qs = (pn < 4) ? 0.125f : 1.0f;
#pragma unroll
        for (int ai = 0; ai < 2; ++ai)
#pragma unroll
            for (int m = 0; m < 4; ++m) {
                const int row = u.pm * 256 + ai * 128 + wr * 64 + m * 16 + fr;
                const float rs = rstd[row] * qs;
                const GAS f32x4* rp = (const GAS f32x4*)(rope + (size_t)row * 16);
#pragma unroll
                for (int bj = 0; bj < 2; ++bj) {
                    f32x4 v0 = acc[ai][bj][m][0] * rs, v1 = acc[ai][bj][m][1] * rs;
                    if (rot) {
                        { const f32x4 c = rp[0], s = rp[2]; f32x4 p;
#pragma unroll
                          for (int i = 0; i < 4; ++i) p[i] = __shfl_xor(v0[i], 16);
                          if (fq == 0) v0 = v0 * c - p * s; else if (fq == 1) v0 = v0 * c + p * s; }
                        { const f32x4 c = rp[1], s = rp[3]; f32x4 p;
#pragma unroll
                          for (int i = 0; i < 4; ++i) p[i] = __shfl_xor(v1[i], 16);
                          if (fq == 0) v1 = v1 * c - p * s; else if (fq == 1) v1 = v1 * c + p * s; }
                    }
                    v4u w; w.x = pk2(v0[0], v0[1]); w.y = pk2(v0[2], v0[3]); w.z = pk2(v1[0], v1[1]); w.w = pk2(v1[2], v1[3]);
                    *(GAS v4u*)(base + (size_t)row * ldc + colt + bj * 128 + wc * 32 + 8 * fq) = w;
                }
            }
    }
};
template <bool HAS_SCALE> struct EpiBf16Scale {
    static constexpr bool PERM = true, AFTER_DRAIN = false;
    bf16* O; int ldc, col_off; const float* cscale;
    __device__ __forceinline__ void operator()(const f32x4 (&acc)[2][2][4][2], const pg8::Unit& u, int wr, int wc, int fr, int fq) const {
        const int c0 = u.pn * 256 + wc * 32 + 8 * fq;
#pragma unroll
        for (int ai = 0; ai < 2; ++ai)
#pragma unroll
            for (int m = 0; m < 4; ++m) {
                const int row = u.pm * 256 + ai * 128 + wr * 64 + m * 16 + fr;
#pragma unroll
                for (int bj = 0; bj < 2; ++bj) {
                    f32x4 v0 = acc[ai][bj][m][0], v1 = acc[ai][bj][m][1];
                    if constexpr (HAS_SCALE) { v0 = v0 * *(const GAS f32x4*)(cscale + c0 + bj * 128); v1 = v1 * *(const GAS f32x4*)(cscale + c0 + bj * 128 + 4); }
                    v4u w; w.x = pk2(v0[0], v0[1]); w.y = pk2(v0[2], v0[3]); w.z = pk2(v1[0], v1[1]); w.w = pk2(v1[2], v1[3]);
                    *(GAS v4u*)(O + (size_t)row * ldc + col_off + c0 + bj * 128) = w;
                }
            }
    }
};
struct EpiG3 {
    static constexpr bool PERM = false, AFTER_DRAIN = false;
    const float* x; float* h1; bf16* h1b; float* ssq;
    __device__ __forceinline__ void operator()(const f32x4 (&acc)[2][2][4][2], const pg8::Unit& u, int wr, int wc, int fr, int fq) const {
        const int col0 = u.pn * 256 + wc * 32 + 4 * fq;
#pragma unroll
        for (int ai = 0; ai < 2; ++ai)
#pragma unroll
            for (int m = 0; m < 4; ++m) {
                const int row = u.pm * 256 + ai * 128 + wr * 64 + m * 16 + fr; float ss = 0.f;
#pragma unroll
                for (int bj = 0; bj < 2; ++bj)
#pragma unroll
                    for (int n = 0; n < 2; ++n) {
                        const size_t off = (size_t)row * DM + col0 + bj * 128 + n * 16;
                        const f32x4 h = DBG_NO_MIX ? *(const GAS f32x4*)(x + off) : *(const GAS f32x4*)(x + off) + acc[ai][bj][m][n];
                        *(GAS f32x4*)(h1 + off) = h;
                        v2u w; w.x = pk2(h[0], h[1]); w.y = pk2(h[2], h[3]); *(GAS v2u*)(h1b + off) = w;
                        ss += (h[0] * h[0] + h[1] * h[1]) + (h[2] * h[2] + h[3] * h[3]);
                    }
                ss += __shfl_xor(ss, 16); ss += __shfl_xor(ss, 32);
                if (fq == 0) atomicAdd(ssq + row, ss);
            }
    }
};
struct EpiG4 {
    static constexpr bool PERM = false, AFTER_DRAIN = false;
    float* qp; const float* ssq;
    __device__ __forceinline__ void operator()(const f32x4 (&acc)[2][2][4][2], const pg8::Unit& u, int wr, int wc, int fr, int fq) const {
        const int col0 = u.pn * 256 + wc * 32 + 4 * fq;
#pragma unroll
        for (int ai = 0; ai < 2; ++ai)
#pragma unroll
            for (int m = 0; m < 4; ++m) {
                const int row = u.pm * 256 + ai * 128 + wr * 64 + m * 16 + fr;
                const float rs = 1.0f / sqrtf(__hip_atomic_load(ssq + row, RLX_AGENT) * (1.0f / DM) + EPS);
#pragma unroll
                for (int bj = 0; bj < 2; ++bj)
#pragma unroll
                    for (int n = 0; n < 2; ++n) *(GAS f32x4*)(qp + (size_t)row * DM + col0 + bj * 128 + n * 16) = acc[ai][bj][m][n] * rs;
            }
    }
};
struct EpiG5 {
    static constexpr bool PERM = false, AFTER_DRAIN = false;
    const float* h2; const bf16* pp; const float* rstd3; float* out; float* ssq;
    __device__ __forceinline__ void operator()(const f32x4 (&acc)[2][2][4][2], const pg8::Unit& u, int wr, int wc, int fr, int fq) const {
        const int col0 = u.pn * 256 + wc * 32 + 4 * fq;
#pragma unroll
        for (int ai = 0; ai < 2; ++ai)
#pragma unroll
            for (int m = 0; m < 4; ++m) {
                const int row = u.pm * 256 + ai * 128 + wr * 64 + m * 16 + fr; float ss = 0.f;
                const float rs = rstd3[row];
#pragma unroll
                for (int bj = 0; bj < 2; ++bj)
#pragma unroll
                    for (int n = 0; n < 2; ++n) {
                        const size_t off = (size_t)row * DM + col0 + bj * 128 + n * 16;
                        const f32x4 z = DBG_NO_PLE ? (f32x4){-1e30f, -1e30f, -1e30f, -1e30f} : acc[ai][bj][m][n] * rs; const v2u pw = *(const GAS v2u*)(pp + off); const f32x4 hv = *(const GAS f32x4*)(h2 + off);
                        f32x4 o;
                        o[0] = hv[0] + bf_lo(pw.x) / (1.0f + __expf(-z[0])); o[1] = hv[1] + bf_hi(pw.x) / (1.0f + __expf(-z[1]));
                        o[2] = hv[2] + bf_lo(pw.y) / (1.0f + __expf(-z[2])); o[3] = hv[3] + bf_hi(pw.y) / (1.0f + __expf(-z[3]));
                        *(GAS f32x4*)(out + off) = o;
                        ss += (o[0] * o[0] + o[1] * o[1]) + (o[2] * o[2] + o[3] * o[3]);
                    }
                ss += __shfl_xor(ss, 16); ss += __shfl_xor(ss, 32);
                if (fq == 0) atomicAdd(ssq + row, ss);
            }
    }
};
struct SingleUnit {
    int pm, pn;
    __device__ __forceinline__ bool next(int i, pg8::Unit& u) const { if (i != 0) return false; u.pm = pm; u.pn = pn; return true; }
    __device__ __forceinline__ void a_ready(const pg8::Unit&) const {}
    __device__ __forceinline__ void done(const pg8::Unit&) const {}
};

__device__ __forceinline__ int crow(int r, int hi) { return (r & 3) + 8 * (r >> 2) + 4 * hi; }
constexpr int KS_STRIDE = 144, VT_STRIDE = 520, VT_OFF = 256 * KS_STRIDE;
__device__ __forceinline__ void attn_unit(Frame& F, int unit) {
    const int g = unit & 3, nblk = (unit >> 2) & 31, b = unit >> 7;
    const int t0 = b * SEQ + nblk * 128;
    LAS unsigned char* Ks = F.lds + RING_OFF;
    LAS unsigned char* Vt = F.lds + RING_OFF + VT_OFF;
    for (int c = F.tid; c < 2048; c += NWAVES * 64) {
        const int j = c >> 3, ch = c & 7;
        v4u kv = {0u, 0u, 0u, 0u}, vv = {0u, 0u, 0u, 0u};
        if (nblk > 0 || j >= 128) { const size_t row = (size_t)(t0 - 128 + j); kv = *(const GAS v4u*)(F_KB + row * KVW + g * 64 + ch * 8); vv = *(const GAS v4u*)(F_VB + row * KVW + g * 64 + ch * 8); }
        *(LAS v4u*)(Ks + j * KS_STRIDE + ch * 16) = kv;
#pragma unroll
        for (int e = 0; e < 8; ++e) *(LAS unsigned short*)(Vt + (ch * 8 + e) * VT_STRIDE + j * 2) = (unsigned short)((vv[e >> 1] >> (16 * (e & 1))) & 0xffffu);
    }
    __syncthreads();
    const int hq = 4 * g + (F.wave >> 1);
    const float sink = F.sinks[hq];
    const int q = F.lane & 31, h = F.lane >> 5;
#pragma unroll 1
    for (int sub = 0; sub < 2; ++sub) {
        const int i0 = (F.wave & 1) * 64 + sub * 32;
        bf16x8 qf[4];
#pragma unroll
        for (int ks = 0; ks < 4; ++ks) qf[ks] = *(const GAS bf16x8*)(F_QB + (size_t)(t0 + i0 + q) * ATTW + hq * 64 + 16 * ks + 8 * h);
        f32x16 s[5];
#pragma unroll
        for (int kt = 0; kt < 5; ++kt) {
#pragma unroll
            for (int r = 0; r < 16; ++r) s[kt][r] = 0.f;
#pragma unroll
            for (int ks = 0; ks < 4; ++ks) {
                const bf16x8 a = *(const LAS bf16x8*)(Ks + (i0 + 32 * kt + q) * KS_STRIDE + (16 * ks + 8 * h) * 2);
                s[kt] = __builtin_amdgcn_mfma_f32_32x32x16_bf16(a, qf[ks], s[kt], 0, 0, 0);
            }
        }
        float mx = sink;
#pragma unroll
        for (int kt = 0; kt < 5; ++kt)
#pragma unroll
            for (int r = 0; r < 16; ++r) {
                const bool tv = (nblk > 0) || (i0 + 32 * kt >= 128);
                const bool ok = (kt == 0) ? (crow(r, h) > q) : (kt == 4) ? (crow(r, h) <= q) : true;
                const float v = (ok && tv) ? s[kt][r] : -INFINITY;
                s[kt][r] = v; mx = fmaxf(mx, v);
            }
        mx = fmaxf(mx, __shfl_xor(mx, 32));
        float sum = 0.f;
#pragma unroll
        for (int kt = 0; kt < 5; ++kt)
#pragma unroll
            for (int r = 0; r < 16; ++r) { const float pv = __expf(s[kt][r] - mx); s[kt][r] = pv; sum += pv; }
        sum += __shfl_xor(sum, 32);
        sum += __expf(sink - mx);
        const float inv = 1.0f / sum;
        f32x16 o[2];
#pragma unroll
        for (int dt = 0; dt < 2; ++dt)
#pragma unroll
            for (int r = 0; r < 16; ++r) o[dt][r] = 0.f;
#pragma unroll
        for (int kt = 0; kt < 5; ++kt)
#pragma unroll
            for (int st = 0; st < 2; ++st) {
                v4u pw; pw.x = pk2(s[kt][8 * st + 0], s[kt][8 * st + 1]); pw.y = pk2(s[kt][8 * st + 2], s[kt][8 * st + 3]); pw.z = pk2(s[kt][8 * st + 4], s[kt][8 * st + 5]); pw.w = pk2(s[kt][8 * st + 6], s[kt][8 * st + 7]);
                const bf16x8 pb = __builtin_bit_cast(bf16x8, pw);
#pragma unroll
                for (int dt = 0; dt < 2; ++dt) {
                    const LAS unsigned char* vb = Vt + (32 * dt + q) * VT_STRIDE + (i0 + 32 * kt + 16 * st + 4 * h) * 2;
                    const v2u lo = *(const LAS v2u*)vb, hi2 = *(const LAS v2u*)(vb + 16);
                    v4u aw; aw.x = lo.x; aw.y = lo.y; aw.z = hi2.x; aw.w = hi2.y;
                    o[dt] = __builtin_amdgcn_mfma_f32_32x32x16_bf16(__builtin_bit_cast(bf16x8, aw), pb, o[dt], 0, 0, 0);
                }
            }
        bf16* orow = F_MIX + (size_t)(t0 + i0 + q) * DM + hq * 64;
#pragma unroll
        for (int dt = 0; dt < 2; ++dt)
#pragma unroll
            for (int g4 = 0; g4 < 4; ++g4) {
                v2u w; w.x = pk2(o[dt][4 * g4] * inv, o[dt][4 * g4 + 1] * inv); w.y = pk2(o[dt][4 * g4 + 2] * inv, o[dt][4 * g4 + 3] * inv);
                *(GAS v2u*)(orow + 32 * dt + 8 * g4 + 4 * h) = w;
            }
    }
    __syncthreads();
}
__device__ __forceinline__ void pool_tile(Frame& F, int pm, int g) {
    const int w = 2 << g;
    const int cg = F.tid & 31, rg = F.tid >> 5;
    const int r0 = pm * 256 + rg * 16;
    const int col = g * 256 + cg * 8;
    float sum[8];
#pragma unroll
    for (int e = 0; e < 8; ++e) sum[e] = 0.f;
    const int tseq0 = r0 & (SEQ - 1);
    for (int j = 1; j < w; ++j) { if (tseq0 - j >= 0) { const v4u v = *(const GAS v4u*)(F_UB + (size_t)(r0 - j) * POOLW + col);
#pragma unroll
            for (int e = 0; e < 4; ++e) { sum[2 * e] += bf_lo(v[e]); sum[2 * e + 1] += bf_hi(v[e]); } } }
    for (int i = 0; i < 16; ++i) {
        const int r = r0 + i, ts = tseq0 + i;
        const v4u v = *(const GAS v4u*)(F_UB + (size_t)r * POOLW + col);
        float cur[8];
#pragma unroll
        for (int e = 0; e < 4; ++e) { cur[2 * e] = bf_lo(v[e]); cur[2 * e + 1] = bf_hi(v[e]); }
#pragma unroll
        for (int e = 0; e < 8; ++e) sum[e] += cur[e];
        const int cnt = (ts + 1 < w) ? ts + 1 : w; const float ic = 1.0f / (float)cnt;
        v4u o;
        o.x = pk2(sum[0] * ic - cur[0], sum[1] * ic - cur[1]); o.y = pk2(sum[2] * ic - cur[2], sum[3] * ic - cur[3]);
        o.z = pk2(sum[4] * ic - cur[4], sum[5] * ic - cur[5]); o.w = pk2(sum[6] * ic - cur[6], sum[7] * ic - cur[7]);
        *(GAS v4u*)(F_POOLED + (size_t)r * POOLW + col) = o;
        if (ts - (w - 1) >= 0) { const v4u ov = *(const GAS v4u*)(F_UB + (size_t)(r - (w - 1)) * POOLW + col);
#pragma unroll
            for (int e = 0; e < 4; ++e) { sum[2 * e] -= bf_lo(ov[e]); sum[2 * e + 1] -= bf_hi(ov[e]); } }
    }
}

template <int N> __device__ __forceinline__ void insert_desc(float (&val)[N], float x) {
#pragma unroll
    for (int k = 0; k < N; ++k) { const float hi = max2f(x, val[k]); x = min2f(x, val[k]); val[k] = hi; }
}
__device__ __forceinline__ void bitonic_merge16(float (&m)[16]) {
#pragma unroll
    for (int st = 8; st >= 1; st >>= 1)
#pragma unroll
        for (int i = 0; i < 16; ++i) if ((i & st) == 0) { const float hi = max2f(m[i], m[i + st]), lo = min2f(m[i], m[i + st]); m[i] = hi; m[i + st] = lo; }
}
__device__ __forceinline__ void merge_partner16(float (&val)[16]) {
    float pr[16];
#pragma unroll
    for (int k = 0; k < 16; ++k) pr[k] = __shfl_xor(val[k], 32);
#pragma unroll
    for (int k = 0; k < 16; ++k) val[k] = max2f(val[k], pr[15 - k]);
    bitonic_merge16(val);
}
__device__ __forceinline__ void pin16(float (&v)[16]) {
#pragma unroll
    for (int k = 0; k < 16; ++k) asm volatile("" : "+v"(v[k]));
}
struct CandTab { int a[50], b[50]; };
__host__ __device__ constexpr CandTab make_cands() { CandTab t{}; int n = 0; for (int a = 0; a < 16; ++a) for (int b = 0; b < 16; ++b) if ((a + 1) * (b + 1) <= 16) { t.a[n] = a; t.b[n] = b; ++n; } return t; }
__device__ __forceinline__ float vsel(unsigned long long m, float a, float b) { float r; asm("v_cndmask_b32_e64 %0, %1, %2, %3" : "=v"(r) : "v"(b), "v"(a), "s"(m)); return r; }
__device__ __forceinline__ float sel16(const float (&L)[16], int a) { float r = L[0];
#pragma unroll
    for (int k = 1; k < 16; ++k) r = vsel(__ballot(a == k), L[k], r);
    return r; }
template <int HALF_>
__device__ __forceinline__ void route_half(Frame& F, const float* qrow, int r, int h, float (&Lout)[16]) {
    f32x16 acc[4];
#pragma unroll
    for (int kt = 0; kt < 4; ++kt)
#pragma unroll
        for (int i = 0; i < 16; ++i) acc[kt][i] = 0.f;
    const bf16* skh = F_SKH + HALF_ * 16384; const bf16* skl = F_SKL + HALF_ * 16384;
#pragma unroll 2
    for (int ks = 0; ks < 8; ++ks) {
        const f32x4 qa = *(const GAS f32x4*)(qrow + HALF_ * 128 + 16 * ks + 8 * h), qb = *(const GAS f32x4*)(qrow + HALF_ * 128 + 16 * ks + 8 * h + 4);
        v4u hw, lw;
        hw.x = pk2(qa.x, qa.y); hw.y = pk2(qa.z, qa.w); hw.z = pk2(qb.x, qb.y); hw.w = pk2(qb.z, qb.w);
        lw.x = pk2(qa.x - bf_lo(hw.x), qa.y - bf_hi(hw.x)); lw.y = pk2(qa.z - bf_lo(hw.y), qa.w - bf_hi(hw.y));
        lw.z = pk2(qb.x - bf_lo(hw.z), qb.y - bf_hi(hw.z)); lw.w = pk2(qb.z - bf_lo(hw.w), qb.w - bf_hi(hw.w));
        const bf16x8 bh = __builtin_bit_cast(bf16x8, hw), bl = __builtin_bit_cast(bf16x8, lw);
#pragma unroll
        for (int kt = 0; kt < 4; ++kt) {
            const bf16x8 ah = *(const GAS bf16x8*)(skh + (32 * kt + r) * 128 + 16 * ks + 8 * h), al = *(const GAS bf16x8*)(skl + (32 * kt + r) * 128 + 16 * ks + 8 * h);
            acc[kt] = __builtin_amdgcn_mfma_f32_32x32x16_bf16(ah, bh, acc[kt], 0, 0, 0);
            acc[kt] = __builtin_amdgcn_mfma_f32_32x32x16_bf16(al, bh, acc[kt], 0, 0, 0);
            acc[kt] = __builtin_amdgcn_mfma_f32_32x32x16_bf16(ah, bl, acc[kt], 0, 0, 0);
        }
    }
#pragma unroll
    for (int k = 0; k < 16; ++k) Lout[k] = -INFINITY;
#pragma unroll
    for (int kt = 0; kt < 4; ++kt)
#pragma unroll
        for (int i = 0; i < 16; ++i) {
            const unsigned n = (unsigned)(32 * kt + (i & 3) + 8 * (i >> 2) + 4 * h);
            insert_desc<16>(Lout, __uint_as_float((__float_as_uint(acc[kt][i]) & ~127u) | n));
        }
    merge_partner16(Lout);
}
__device__ __forceinline__ void route_task(Frame& F, int task) {
    const int r = F.lane & 31, h = F.lane >> 5;
    const int item = task * 32 + r, tok = item >> 3, head = item & 7;
    const float* qrow = F_QP + (size_t)tok * DM + head * 256;
    float L0[16], L1[16];
    route_half<0>(F, qrow, r, h, L0);
    route_half<1>(F, qrow, r, h, L1);
    pin16(L0); pin16(L1);
    constexpr CandTab CT = make_cands();
    const unsigned long long hm = __ballot(h != 0);
    float cand[16];
#pragma unroll
    for (int k = 0; k < 16; ++k) cand[k] = -INFINITY;
#pragma unroll
    for (int i = 0; i < 25; ++i) {
        const float v1 = vsel(hm, L0[CT.a[2 * i + 1]], L0[CT.a[2 * i]]);
        const float v2 = vsel(hm, L1[CT.b[2 * i + 1]], L1[CT.b[2 * i]]);
        const unsigned id = h ? (unsigned)(CT.a[2 * i + 1] * 16 + CT.b[2 * i + 1]) : (unsigned)(CT.a[2 * i] * 16 + CT.b[2 * i]);
        const float sm = __uint_as_float(__float_as_uint(v1) & ~127u) + __uint_as_float(__float_as_uint(v2) & ~127u);
        insert_desc<16>(cand, __uint_as_float((__float_as_uint(sm) & ~255u) | id));
    }
    merge_partner16(cand);
    pin16(cand);
    float se = 0.f;
#pragma unroll
    for (int k = 0; k < 16; ++k) se += __expf(cand[k] - cand[0]);
    const float ise = 1.0f / se;
    int eo[8]; float go[8];
#pragma unroll
    for (int kk = 0; kk < 8; ++kk) {
        const float cv = vsel(hm, cand[8 + kk], cand[kk]);
        const unsigned id = __float_as_uint(cv) & 255u; const int a = (int)(id >> 4), bb = (int)(id & 15u);
        const unsigned i1 = __float_as_uint(sel16(L0, a)) & 127u, i2 = __float_as_uint(sel16(L1, bb)) & 127u;
        eo[kk] = (int)(i1 * 128u + i2); go[kk] = __expf(cv - cand[0]) * ise;
    }
    int* ep = F_EIDX + (size_t)tok * 128 + head * 16 + 8 * h; float* gp = F_GATE + (size_t)tok * 128 + head * 16 + 8 * h;
    *(GAS v4u*)ep = (v4u){(unsigned)eo[0], (unsigned)eo[1], (unsigned)eo[2], (unsigned)eo[3]}; *(GAS v4u*)(ep + 4) = (v4u){(unsigned)eo[4], (unsigned)eo[5], (unsigned)eo[6], (unsigned)eo[7]};
    *(GAS f32x4*)gp = (f32x4){go[0], go[1], go[2], go[3]}; *(GAS f32x4*)(gp + 4) = (f32x4){go[4], go[5], go[6], go[7]};
}


#ifndef DBG_ROUTE_BF
#define DBG_ROUTE_BF 0
#endif
__device__ __forceinline__ void lds_insert(LAS float* V, LAS int* I, int tid, float x, int id) {
    if (x > V[15 * 256 + tid]) {
        int pos = 15;
        while (pos > 0 && V[(pos - 1) * 256 + tid] < x) { V[pos * 256 + tid] = V[(pos - 1) * 256 + tid]; I[pos * 256 + tid] = I[(pos - 1) * 256 + tid]; --pos; }
        V[pos * 256 + tid] = x; I[pos * 256 + tid] = id;
    }
}
__device__ __forceinline__ void route_bruteforce(Frame& F) {
    if (F.tid >= 256) return;
    const int tid = F.tid;
    LAS float* V0 = (LAS float*)(F.lds); LAS int* I0 = (LAS int*)(F.lds + 16384);
    LAS float* V1 = (LAS float*)(F.lds + 32768); LAS int* I1 = (LAS int*)(F.lds + 49152);
    LAS float* VC = (LAS float*)(F.lds + 65536); LAS int* IC = (LAS int*)(F.lds + 81920);
    for (int item = (int)blockIdx.x * 256 + tid; item < M * PKH; item += F.G * 256) {
        const int tok = item >> 3, head = item & 7;
        const float* qrow = F_QP + (size_t)tok * DM + head * 256;
        for (int k = 0; k < 16; ++k) { V0[k * 256 + tid] = -INFINITY; I0[k * 256 + tid] = 0; V1[k * 256 + tid] = -INFINITY; I1[k * 256 + tid] = 0; VC[k * 256 + tid] = -INFINITY; IC[k * 256 + tid] = 0; }
        for (int half = 0; half < 2; ++half) {
            float q[128];
#pragma unroll
            for (int d = 0; d < 128; d += 4) { const f32x4 t = *(const GAS f32x4*)(qrow + half * 128 + d); q[d] = t.x; q[d + 1] = t.y; q[d + 2] = t.z; q[d + 3] = t.w; }
            for (int n = 0; n < 128; ++n) {
                const float* sk = F.sub_keys + (size_t)half * 16384 + n * 128;
                float s = 0.f;
#pragma unroll
                for (int d = 0; d < 128; ++d) s += q[d] * sk[d];
                if (half == 0) lds_insert(V0, I0, tid, s, n); else lds_insert(V1, I1, tid, s, n);
            }
        }
        for (int a = 0; a < 16; ++a) for (int b = 0; b < 16; ++b) lds_insert(VC, IC, tid, V0[a * 256 + tid] + V1[b * 256 + tid], I0[a * 256 + tid] * 128 + I1[b * 256 + tid]);
        const float mx = VC[tid]; float se = 0.f;
        for (int k = 0; k < 16; ++k) se += __expf(VC[k * 256 + tid] - mx);
        for (int k = 0; k < 16; ++k) { F_EIDX[(size_t)tok * 128 + head * 16 + k] = IC[k * 256 + tid]; F_GATE[(size_t)tok * 128 + head * 16 + k] = __expf(VC[k * 256 + tid] - mx) / se; }
    }
}

template <int N> __device__ __forceinline__ void treduce(float (&v)[N], int lane, int d) {
    const bool up = (lane & d) != 0;
#pragma unroll
    for (int i = 0; i < N / 2; ++i) { const float send = up ? v[i] : v[i + N / 2], keep = up ? v[i + N / 2] : v[i]; v[i] = keep + __shfl_xor(send, d); }
}
constexpr int SLICE_BYTES = NEXP * 128;
constexpr int NSLICE = 16;
typedef float f32x2v __attribute__((ext_vector_type(2)));
__device__ __forceinline__ void peer_phase(Frame& F) {
    const int lane = F.lane, g = lane >> 3, p = lane & 7;
    const int tbase = (int)blockIdx.x * 32 + F.wave * 4;
    LAS float* alds = (LAS float*)(F.lds + RING_OFF + F.wave * 2048);
    const __amdgpu_buffer_rsrc_t rsu = __builtin_amdgcn_make_buffer_rsrc((void*)F_EU, 0, NEXP * DM, 0x00020000);
    const __amdgpu_buffer_rsrc_t rsv = __builtin_amdgcn_make_buffer_rsrc((void*)F_EV, 0, NEXP * DM, 0x00020000);
    const __amdgpu_buffer_rsrc_t rsx = __builtin_amdgcn_make_buffer_rsrc((void*)F_H1B, 0, M * DM * 2, 0x00020000);
    const __amdgpu_buffer_rsrc_t rsh = __builtin_amdgcn_make_buffer_rsrc((void*)F_H1, 0, M * DM * 4, 0x00020000);
    const __amdgpu_buffer_rsrc_t rsb = __builtin_amdgcn_make_buffer_rsrc((void*)F_H2B, 0, M * DM * 2, 0x00020000);
    const unsigned p16 = (unsigned)p * 16u;
    const unsigned cl = (unsigned)(16 * p + 8 * (g & 1) + 4 * ((g >> 1) & 1) + 2 * ((g >> 2) & 1));
    for (int tb = tbase; tb < M; tb += F.G * 32) {
        unsigned ev[4][8];
        float hacc[4][2];
#pragma unroll
        for (int tk = 0; tk < 4; ++tk) {
#pragma unroll
            for (int i = 0; i < 8; ++i) ev[tk][i] = (unsigned)F_EIDX[(size_t)(tb + tk) * 128 + 16 * i + g] | ((unsigned)F_EIDX[(size_t)(tb + tk) * 128 + 16 * i + 8 + g] << 16);
            hacc[tk][0] = 0.f; hacc[tk][1] = 0.f;
        }
#define PEER_VOFF(TK, i) ({ unsigned e_ = ev[TK][(i) >> 1]; asm volatile("" : "+v"(e_)); ((((i) & 1) ? (e_ >> 16) : (e_ & 0xffffu)) * 128u + p16); })
#define PEER_LOAD_X(X0, X1, S, TK) do { X0 = __builtin_amdgcn_raw_buffer_load_b128(rsx, 2u * p16, ((tb + (TK)) * DM + 128 * (S)) * 2, 0); X1 = __builtin_amdgcn_raw_buffer_load_b128(rsx, 2u * p16 + 16u, ((tb + (TK)) * DM + 128 * (S)) * 2, 0); } while (0)
#define PEER_LOAD_A(W, S, TK, H) do { _Pragma("unroll") for (int i = 0; i < 8; ++i) W[i] = __builtin_amdgcn_raw_buffer_load_b128(rsu, PEER_VOFF(TK, 8 * (H) + i), (S) * SLICE_BYTES, 0); } while (0)
#define PEER_COMP_A(W, H) do { \
        _Pragma("unroll") for (int i = 0; i < 8; ++i) { f32x2v a2 = {0.f, 0.f}; \
            _Pragma("unroll") for (int c = 0; c < 4; ++c) { const int wv = (int)W[i][c]; const f32x2v lo = __builtin_amdgcn_cvt_pk_f32_fp8(wv, false), hi = __builtin_amdgcn_cvt_pk_f32_fp8(wv, true); \
                a2 += lo * xf2[2 * c]; a2 += hi * xf2[2 * c + 1]; } \
            part[8 * (H) + i] = a2.x + a2.y; if (i & 1) __builtin_amdgcn_sched_barrier(0); } } while (0)
        for (int rep = 0; rep < NREP(6); ++rep) {
#pragma unroll
            for (int tk = 0; tk < 4; ++tk) { hacc[tk][0] = 0.f; hacc[tk][1] = 0.f; }
#pragma unroll 1
            for (int s = 0; s < NSLICE; ++s) {
#pragma unroll
                for (int tk = 0; tk < 4; ++tk) {
                    v4u w0[8], w1[8], x0, x1; f32x2v xf2[8]; float part[16];
                    PEER_LOAD_X(x0, x1, s, tk); PEER_LOAD_A(w0, s, tk, 0); PEER_LOAD_A(w1, s, tk, 1); __builtin_amdgcn_sched_barrier(0);
#pragma unroll
                    for (int c = 0; c < 4; ++c) { const unsigned a0 = x0[c], a1 = x1[c]; xf2[c] = (f32x2v){bf_lo(a0), bf_hi(a0)}; xf2[4 + c] = (f32x2v){bf_lo(a1), bf_hi(a1)}; }
                    PEER_COMP_A(w0, 0); __builtin_amdgcn_sched_barrier(0);
                    PEER_COMP_A(w1, 1); __builtin_amdgcn_sched_barrier(0);
                    treduce<16>(part, lane, 1); treduce<8>(reinterpret_cast<float (&)[8]>(part), lane, 2); treduce<4>(reinterpret_cast<float (&)[4]>(part), lane, 4);
                    hacc[tk][0] += part[0]; hacc[tk][1] += part[1]; __builtin_amdgcn_sched_barrier(0);
                }
                __builtin_amdgcn_s_barrier();
            }
        }
#undef PEER_LOAD_X
#undef PEER_LOAD_A
#undef PEER_COMP_A
#pragma unroll
        for (int tk = 0; tk < 4; ++tk) {
            const int t = tb + tk;
            const float rs2 = (1.0f / EU_SCALE) / sqrtf(__hip_atomic_load(F_SSQ2 + t, RLX_AGENT) * (1.0f / DM) + EPS);
#pragma unroll
            for (int j = 0; j < 2; ++j) {
                const int i = 8 * (p & 1) + 4 * ((p >> 1) & 1) + 2 * ((p >> 2) & 1) + j;
                const float hv = hacc[tk][j] * rs2;
                const float ge = 0.5f * hv * (1.0f + erff(hv * 0.70710678118654752f));
                alds[tk * 128 + g * 16 + i] = F_GATE[(size_t)t * 128 + 8 * i + g] * ge * (1.0f / EV_SCALE);
            }
        }
        LDS_WAIT(); asm volatile("" ::: "memory");
        float ssq[4] = {0.f, 0.f, 0.f, 0.f};
#define PEER_LOAD_B(W, S, TK, H) do { _Pragma("unroll") for (int i = 0; i < 8; ++i) W[i] = __builtin_amdgcn_raw_buffer_load_b128(rsv, PEER_VOFF(TK, 8 * (H) + i), (S) * SLICE_BYTES, 0); } while (0)
#define PEER_COMP_B(W, TK, H) do { f32x4 av[2]; \
        _Pragma("unroll") for (int q4 = 0; q4 < 2; ++q4) av[q4] = *(const LAS f32x4*)(alds + (TK) * 128 + g * 16 + 8 * (H) + 4 * q4); \
        _Pragma("unroll") for (int i = 0; i < 8; ++i) { const float a = av[i >> 2][i & 3]; const f32x2v a2 = {a, a}; \
            _Pragma("unroll") for (int c = 0; c < 4; ++c) { const int wv = (int)W[i][c]; const f32x2v lo = __builtin_amdgcn_cvt_pk_f32_fp8(wv, false), hi = __builtin_amdgcn_cvt_pk_f32_fp8(wv, true); \
                oc2[2 * c] += a2 * lo; oc2[2 * c + 1] += a2 * hi; } if (i & 1) __builtin_amdgcn_sched_barrier(0); } } while (0)
        {
#pragma unroll 1
            for (int s = 0; s < NSLICE; ++s) {
#pragma unroll
                for (int tk = 0; tk < 4; ++tk) {
                    v4u w0[8], w1[8]; f32x2v oc2[8]; float oc[16];
                    PEER_LOAD_B(w0, s, tk, 0); PEER_LOAD_B(w1, s, tk, 1); __builtin_amdgcn_sched_barrier(0);
#pragma unroll
                    for (int c = 0; c < 8; ++c) oc2[c] = (f32x2v){0.f, 0.f};
                    PEER_COMP_B(w0, tk, 0); __builtin_amdgcn_sched_barrier(0);
                    PEER_COMP_B(w1, tk, 1); __builtin_amdgcn_sched_barrier(0);
#pragma unroll
                    for (int c = 0; c < 8; ++c) { oc[2 * c] = oc2[c].x; oc[2 * c + 1] = oc2[c].y; }
                    treduce<16>(oc, lane, 8); treduce<8>(reinterpret_cast<float (&)[8]>(oc), lane, 16); treduce<4>(reinterpret_cast<float (&)[4]>(oc), lane, 32);
                    const int so = (tb + tk) * DM + 128 * s;
                    const v2u hv2 = __builtin_amdgcn_raw_buffer_load_b64(rsh, cl * 4u, so * 4, 0);
                    const float h2a = __uint_as_float(hv2.x) + oc[0], h2b = __uint_as_float(hv2.y) + oc[1];
                    v2u st; st.x = __float_as_uint(h2a); st.y = __float_as_uint(h2b);
                    __builtin_amdgcn_raw_buffer_store_b64(st, rsh, cl * 4u, so * 4, 0);
                    __builtin_amdgcn_raw_buffer_store_b32(pk2(h2a, h2b), rsb, cl * 2u, so * 2, 0); ssq[tk] += h2a * h2a + h2b * h2b;
                    __builtin_amdgcn_sched_barrier(0);
                }
                __builtin_amdgcn_s_barrier();
            }
        }
#undef PEER_LOAD_B
#undef PEER_COMP_B
#pragma unroll
        for (int tk = 0; tk < 4; ++tk) { const float ss = wave_sum(ssq[tk]); if (lane == 0) F_RSTD3[tb + tk] = 1.0f / sqrtf(ss * (1.0f / DM) + EPS); }
        LDS_WAIT(); asm volatile("" ::: "memory");
    }
}

struct Args { const void* in[18]; float* out; unsigned char* ws; int ph_lo, ph_hi, li, pad; };
__global__ void __launch_bounds__(NWAVES * 64, 2) hymba_fwd(Args args) {
    extern __shared__ __attribute__((aligned(16))) unsigned char lds[];
    Frame F;
    F.lds = (LAS unsigned char*)lds;
    F.MISC = (volatile LAS unsigned*)(F.lds + MISC_OFF);
    F.tid = threadIdx.x; F.lane = F.tid & 63; F.wave = __builtin_amdgcn_readfirstlane(F.tid >> 6);
    F.G = gridDim.x; { const int bx = blockIdx.x; F.vcu = (F.G % 8 == 0) ? (bx % 8) * (F.G / 8) + bx / 8 : bx; }
    F.ws = args.ws;
    F.ctl = (gu32*)(F.ws + WS_CTL);
    F.x = (const float*)args.in[0]; F.p = (const float*)args.in[1]; F.positions = (const int*)args.in[2]; F.g_mix = (const float*)args.in[3]; F.w_in = (const float*)args.in[4];
    F.sinks = (const float*)args.in[5]; F.w_pool = (const float*)args.in[6]; F.pool_scale = (const float*)args.in[7]; F.w_out = (const float*)args.in[8]; F.g_ffn = (const float*)args.in[9];
    F.w_query = (const float*)args.in[10]; F.sub_keys = (const float*)args.in[11]; F.expert_u = (const float*)args.in[12]; F.expert_v = (const float*)args.in[13]; F.g_ple = (const float*)args.in[14];
    F.w_ple_gate = (const float*)args.in[15]; F.w_ple_proj = (const float*)args.in[16]; F.g_final = (const float*)args.in[17]; F.out = args.out;
    for (int u = F.tid; u < (LDS_BYTES - LDSCTL_OFF) / 4; u += NWAVES * 64) ((LAS unsigned*)(F.lds + LDSCTL_OFF))[u] = 0u;
    __syncthreads();
    const bool one_phase = (args.ph_hi - args.ph_lo) == 1;
    XcdBarrier bar; bar.bar = (unsigned*)(F.ctl + CW_BAR); bar.x = 0; bar.st = nullptr;
    if (!one_phase) bar = xcd_barrier_post((unsigned*)(F.ctl + CW_BAR), F.MISC + 8);
    const int lo = args.ph_lo, hi = args.ph_hi;
#define IN(k) (lo <= (k) && (k) < hi)
#define BOTH(k) (IN(k) && IN((k) + 1))
#define GRID_BAR() xcd_barrier(bar)

    if (IN(0)) { for (int rep = 0; rep < NREP(0); ++rep) p0_prologue(F); if (BOTH(0)) GRID_BAR(); }

    if (IN(1)) {
        for (int rep = 0; rep < NREP(1); ++rep) {
        { pg8::Gemm g{F_XB, F_Win_t, M, INW, DM, DM, DM}; pg8::StaticOrder S; S.init(M, INW, F.G, (int)blockIdx.x);
          EpiG1 E{F_QB, F_KB, F_VB, F_UB, F_RSTD1, F_ROPE};
          pg8::gemm_phase<EpiG1, pg8::StaticOrder, true, true>(F.lds + RING_OFF, g, S, E); }
        { pg8::Gemm g{F_PB, F_Wp_t, M, DM, PLE, PLE, PLE}; PpOrder S; S.init(F.G, (int)blockIdx.x);
          EpiBf16Scale<false> E{F_PP, DM, 0, nullptr};
          pg8::gemm_phase<EpiBf16Scale<false>, PpOrder, false, true>(F.lds + RING_OFF, g, S, E); }
        __syncthreads();
        p1_queue(F);
        }
        if (BOTH(1)) GRID_BAR();
    }

    if (IN(2)) {
        for (int rep = 0; rep < NREP(2); ++rep) {
        for (int u = (int)blockIdx.x; u < BATCH * 32 * NKVH; u += F.G) attn_unit(F, u);
        if ((int)blockIdx.x < 128) {
            const int pu = (int)blockIdx.x, pm = pu >> 2, g = pu & 3;
            pool_tile(F, pm, g);
            VM_WAIT(); __syncthreads();
            pg8::Gemm gm{F_POOLED + g * 256, F_Wpool_t + (size_t)g * 65536, M, 256, 256, POOLW, 256}; SingleUnit S{pm, 0};
            EpiBf16Scale<true> E{F_MIX, DM, ATTW + g * 256, F.pool_scale + g * 256};
            pg8::gemm_phase<EpiBf16Scale<true>, SingleUnit, false, true>(F.lds + RING_OFF, gm, S, E);
            __syncthreads();
        }
        }
        if (BOTH(2)) GRID_BAR();
    }

    if (IN(3)) {
        pg8::Gemm g{F_MIX, F_Wout_t, M, DM, DM, DM, DM}; pg8::StaticOrder S; S.init(M, DM, F.G, (int)blockIdx.x);
        EpiG3 E{F.x, F_H1, F_H1B, F_SSQ2};
        pg8::gemm_phase<EpiG3, pg8::StaticOrder, true, true>(F.lds + RING_OFF, g, S, E);
        if (BOTH(3)) GRID_BAR();
    }

    if (IN(4)) {
        pg8::Gemm g{F_H1B, F_Wq_t, M, DM, DM, DM, DM}; pg8::StaticOrder S; S.init(M, DM, F.G, (int)blockIdx.x);
        EpiG4 E{F_QP, F_SSQ2};
        for (int rep = 0; rep < NREP(4); ++rep)
        pg8::gemm_phase<EpiG4, pg8::StaticOrder, true, true>(F.lds + RING_OFF, g, S, E);
        if (BOTH(4)) GRID_BAR();
    }

    if (IN(5)) {
        const int gw = F.vcu * NWAVES + F.wave, NGW = F.G * NWAVES;
        for (int rep = 0; rep < NREP(5); ++rep)
        for (int task = gw; task < M * PKH / 32; task += NGW) route_task(F, task);
        if (BOTH(5)) GRID_BAR();
    }

    if (IN(6)) {
        peer_phase(F);
        __syncthreads();
        if (BOTH(6)) GRID_BAR();
    }

    if (IN(7)) {
        pg8::Gemm g{F_H2B, F_Wg_t, M, DM, DM, DM, DM}; pg8::StaticOrder S; S.init(M, DM, F.G, (int)blockIdx.x);
        EpiG5 E{F_H1, F_PP, F_RSTD3, F.out, F_SSQ4};
        pg8::gemm_phase<EpiG5, pg8::StaticOrder, true, true>(F.lds + RING_OFF, g, S, E);
        if (BOTH(7)) GRID_BAR();
    }

    if (IN(8)) {
        const int gw = F.vcu * NWAVES + F.wave, NGW = F.G * NWAVES;
        for (int m = gw; m < M; m += NGW) {
            const float rs = 1.0f / sqrtf(__hip_atomic_load(F_SSQ4 + m, RLX_AGENT) * (1.0f / DM) + EPS);
            GAS f32x4* orow = (GAS f32x4*)(F.out + (size_t)m * DM) + F.lane; const GAS f32x4* gr = (const GAS f32x4*)F.g_final + F.lane;
#pragma unroll
            for (int j = 0; j < 8; ++j) { const f32x4 v = orow[64 * j]; orow[64 * j] = v * rs * gr[64 * j]; }
        }
    }
#undef IN
#undef BOTH
#undef GRID_BAR
}


#if DBG_ROUTE_BF
__global__ void __launch_bounds__(NWAVES * 64, 2) dbg_route_kernel(Args args) {
    extern __shared__ __attribute__((aligned(16))) unsigned char lds[];
    Frame F; F.lds = (LAS unsigned char*)lds; F.tid = threadIdx.x; F.lane = F.tid & 63; F.wave = F.tid >> 6; F.G = gridDim.x; F.vcu = blockIdx.x; F.ws = args.ws; F.sub_keys = (const float*)args.in[11];
    route_bruteforce(F);
}
#endif
extern "C" void kernel_launch(void* const* d_in, const int* in_sizes, int n_in, void* d_out, int out_size, void* d_ws, size_t ws_size, hipStream_t stream) {
    static int grid = 0;
    if (grid == 0) {
        if (n_in != 18 || out_size != M * DM || ws_size < WS_END) { fprintf(stderr, "kernel_launch: unexpected shapes (n_in %d, out %d, ws %zu)\n", n_in, out_size, ws_size); grid = -1; return; }
        int dev = 0, cus = 0, per_cu = 0;
        if (hipGetDevice(&dev) != hipSuccess || hipDeviceGetAttribute(&cus, hipDeviceAttributeMultiprocessorCount, dev) != hipSuccess) { grid = -1; return; }
#if DBG_ROUTE_BF
        (void)hipFuncSetAttribute((const void*)dbg_route_kernel, hipFuncAttributeMaxDynamicSharedMemorySize, 98304);
#endif
        if (hipFuncSetAttribute((const void*)hymba_fwd, hipFuncAttributeMaxDynamicSharedMemorySize, LDS_BYTES) != hipSuccess) { fprintf(stderr, "kernel_launch: hipFuncSetAttribute failed\n"); grid = -1; return; }
        if (hipOccupancyMaxActiveBlocksPerMultiprocessor(&per_cu, (const void*)hymba_fwd, NWAVES * 64, LDS_BYTES) != hipSuccess || per_cu < 1)
            fprintf(stderr, "kernel_launch: note: occupancy query reports %d workgroups per CU\n", per_cu);
        (void)hipGetLastError();
        if (cus < 128) { fprintf(stderr, "kernel_launch: needs >= 128 CUs\n"); grid = -1; return; }
        grid = cus;
    }
    if (grid < 0) return;
    if (hipMemsetAsync((char*)d_ws + WS_CTL, 0, CTL_ZERO_BYTES, stream) != hipSuccess) return;
    Args a{};
    for (int i = 0; i < 18; ++i) a.in[i] = d_in[i];
    a.out = (float*)d_out; a.ws = (unsigned char*)d_ws;
    constexpr int NL = MK_N_LAUNCHES;
    for (int li = 0; li < NL; ++li) {
        a.ph_lo = (NL == 1) ? 0 : li; a.ph_hi = (NL == 1) ? N_PHASES : li + 1; a.li = li;
#if DBG_ROUTE_BF
        if (NL == 9 && li == 5) { hipLaunchKernelGGL(dbg_route_kernel, dim3(grid), dim3(NWAVES * 64), 98304, stream, a); continue; }
#endif
        hipLaunchKernelGGL(hymba_fwd, dim3(grid), dim3(NWAVES * 64), LDS_BYTES, stream, a);
    }
}
```

```cpp
#include <hip/hip_runtime.h>
#include <cstdio>
#include <cstdint>
namespace pg8 {
#define PG8_LAS __attribute__((address_space(3)))
typedef unsigned short bf16_t;
typedef short bf16x8 __attribute__((ext_vector_type(8)));
typedef float f32x4 __attribute__((ext_vector_type(4)));
typedef unsigned u32x4 __attribute__((ext_vector_type(4)));
constexpr int BM = 256, BK = 64, HALF = 128, HTB = HALF * BK * 2  , STAGE_BYTES = 8 * HTB, NXCD = 8, WGM = 8;

__host__ __device__ __forceinline__ int lds_byte(int r, int c) { const int st = (r >> 4) * 2 + (c >> 5), rr = r & 15, cc = c & 31, ob = rr * 64 + cc * 2; return st * 1024 + (ob ^ (((ob >> 9) & 1) << 5)); }
__host__ __device__ __forceinline__ void stage_rc(int b, int& R, int& C) { const int st = b / 1024, sb = b % 1024, swz = sb ^ (((sb >> 9) & 1) << 5); R = (st >> 1) * 16 + swz / 64; C = (st & 1) * 32 + (swz % 64) / 2; }
__host__ __device__ __forceinline__ int perm32(int rho) { const int n = rho >> 4, i = rho & 15; return 8 * (i >> 2) + 4 * n + (i & 3); }

struct Unit { int pm, pn; };
struct Gemm { const bf16_t* A; const bf16_t* Bt; int M, N, K, lda, ldb; };

struct StaticOrder {
    int nM, nN, nwg, G, c;
    __host__ __device__ void init(int M, int N, int G_, int c_) { nM = M / BM; nN = N / BM; nwg = nM * nN; G = G_; c = c_; }
    __host__ __device__ bool next(int i, Unit& u) const {
        const long L = (long)i * G + c; if (L >= nwg) return false;
        int wgid = (int)L; { const int q = nwg / NXCD, r = nwg % NXCD, xcd = wgid % NXCD, off = wgid / NXCD; wgid = (xcd < r ? xcd * (q + 1) : r * (q + 1) + (xcd - r) * q) + off; }
        const int nig = WGM * nN, gid = wgid / nig, fm = gid * WGM, gsz = (nM - fm) < WGM ? (nM - fm) : WGM;
        u.pm = fm + ((wgid % nig) % gsz); u.pn = (wgid % nig) / gsz; return true;
    }
    __device__ __forceinline__ void a_ready(const Unit&) const {}
    __device__ __forceinline__ void done(const Unit&) const {}
};

__device__ __forceinline__ unsigned cvt_pk_bf16(float lo, float hi) { unsigned r; asm volatile("v_cvt_pk_bf16_f32 %0, %1, %2" : "=v"(r) : "v"(lo), "v"(hi)); return r; }
typedef float f32x2 __attribute__((ext_vector_type(2)));

template <class Epi, class Sched, bool ALIGN_EPI = false, bool SP2 = false>
__device__ __forceinline__ void gemm_phase(PG8_LAS unsigned char* lds, const Gemm g, const Sched& S, const Epi& E) {
    const int tid = threadIdx.x, wid = __builtin_amdgcn_readfirstlane(tid >> 6), lane = tid & 63, wr = wid >> 2, wc = wid & 3, fr = lane & 15, fq = lane >> 4;
    const int K = g.K, nt = K / BK;
    unsigned voffA[2], voffB[2];
#pragma unroll
    for (int i = 0; i < 2; ++i) { int R, C; stage_rc(tid * 16 + i * 8192, R, C); const int Rb = Epi::PERM ? ((R & ~31) + perm32(R & 31)) : R;
        voffA[i] = (unsigned)(R * g.lda + C) * 2u; voffB[i] = (unsigned)(Rb * g.ldb + C) * 2u; }
    const size_t kstep = (size_t)(BK * 2);
    const size_t hstepA = (size_t)HALF * g.lda * 2, hstepB = (size_t)HALF * g.ldb * 2;
    const size_t tstepA = 2 * hstepA, tstepB = 2 * hstepB;
    const unsigned ldsw = (unsigned)wid * 1024u;
    const int aoff = lds_byte(wr * 64 + fr, fq * 8), boff = lds_byte(wc * 32 + fr, fq * 8);
#define PG8_SA(b, h) (((b) * 2 + (h)) * HTB)
#define PG8_SB(b, h) ((4 + (b) * 2 + (h)) * HTB)
#define PG8_STAGE(bufoff, gbase, voff) do { _Pragma("unroll") for (int _i = 0; _i < 2; ++_i) \
        __builtin_amdgcn_global_load_lds((const unsigned*)((const char*)(gbase) + (voff)[_i]), (PG8_LAS unsigned*)(lds + (bufoff) + ldsw + _i * 8192), 16, 0, 0); } while (0)
#define PG8_LDA(dst, b, h) do { _Pragma("unroll") for (int m = 0; m < 4; ++m) _Pragma("unroll") for (int k = 0; k < 2; ++k) dst[m][k] = *(const PG8_LAS bf16x8*)(lds + PG8_SA(b, h) + aoff + m * 2048 + k * 1024); } while (0)
#define PG8_LDB(dst, b, h) do { _Pragma("unroll") for (int n = 0; n < 2; ++n) _Pragma("unroll") for (int k = 0; k < 2; ++k) dst[n][k] = *(const PG8_LAS bf16x8*)(lds + PG8_SB(b, h) + boff + n * 2048 + k * 1024); } while (0)
#define PG8_MMA(ai, bj, At, Bt) do { __builtin_amdgcn_s_setprio(1); _Pragma("unroll") for (int m = 0; m < 4; ++m) _Pragma("unroll") for (int n = 0; n < 2; ++n) _Pragma("unroll") for (int k = 0; k < 2; ++k) \
        acc[ai][bj][m][n] = __builtin_amdgcn_mfma_f32_16x16x32_bf16(Bt[n][k], At[m][k], acc[ai][bj][m][n], 0, 0, 0); __builtin_amdgcn_s_setprio(0); } while (0)
#define PG8_WAIT_V(n) asm volatile("s_waitcnt vmcnt(" #n ")" ::: "memory")
#define PG8_WAIT_L(n) asm volatile("s_waitcnt lgkmcnt(" #n ")" ::: "memory")
#define PG8_BAR __builtin_amdgcn_s_barrier()
#define PG8_SCHED __builtin_amdgcn_sched_barrier(0)
    Unit cur, nxt; int ui = 0;
    if (!S.next(0, cur)) return;
    f32x4 acc[2][2][4][2];
#pragma unroll
    for (int a = 0; a < 2; ++a)
#pragma unroll
        for (int b = 0; b < 2; ++b)
#pragma unroll
            for (int m = 0; m < 4; ++m)
#pragma unroll
                for (int n = 0; n < 2; ++n) acc[a][b][m][n] = (f32x4){0.f, 0.f, 0.f, 0.f};
    bf16x8 At[4][2], B0[2][2], B1[2][2];
    const char* cA = (const char*)g.A + (size_t)cur.pm * tstepA; const char* cB = (const char*)g.Bt + (size_t)cur.pn * tstepB;
    S.a_ready(cur);
    if constexpr (SP2) {
        PG8_STAGE(PG8_SB(0, 0), cB, voffB); PG8_STAGE(PG8_SB(0, 1), cB + hstepB, voffB); PG8_STAGE(PG8_SA(0, 0), cA, voffA); PG8_STAGE(PG8_SA(0, 1), cA + hstepA, voffA);
        if (wr == 1) PG8_BAR;
        PG8_WAIT_V(2); PG8_BAR;
        PG8_STAGE(PG8_SB(1, 0), cB + kstep, voffB); PG8_STAGE(PG8_SA(1, 0), cA + kstep, voffA); PG8_STAGE(PG8_SB(1, 1), cB + hstepB + kstep, voffB);
        PG8_WAIT_V(6); PG8_BAR;
    } else {
        PG8_STAGE(PG8_SB(0, 0), cB, voffB); PG8_STAGE(PG8_SA(0, 0), cA, voffA); PG8_STAGE(PG8_SB(0, 1), cB + hstepB, voffB); PG8_STAGE(PG8_SA(0, 1), cA + hstepA, voffA);
        if (wr == 1) PG8_BAR;
        PG8_WAIT_V(4); PG8_BAR;
        PG8_STAGE(PG8_SB(1, 0), cB + kstep, voffB); PG8_STAGE(PG8_SA(1, 0), cA + kstep, voffA); PG8_STAGE(PG8_SB(1, 1), cB + hstepB + kstep, voffB);
        PG8_WAIT_V(6); PG8_BAR;
    }
    for (;;) {
        const bool has_next = S.next(ui + 1, nxt);
        const char* nA = has_next ? (const char*)g.A + (size_t)nxt.pm * tstepA : cA; const char* nB = has_next ? (const char*)g.Bt + (size_t)nxt.pn * tstepB : cB;
        for (int t = 0; t < nt; t += 2) {
            const bool last = (t == nt - 2);
            const char* a1 = cA + (size_t)(t + 1) * kstep;
            const char* a2 = last ? nA : cA + (size_t)(t + 2) * kstep; const char* b2 = last ? nB : cB + (size_t)(t + 2) * kstep;
            const char* a3 = a2 + kstep; const char* b3 = b2 + kstep;
            if (last && has_next) S.a_ready(nxt);
            if constexpr (SP2) {
            PG8_LDB(B0, 0, 0); PG8_LDB(B1, 0, 1); PG8_SCHED; PG8_LDA(At, 0, 0); PG8_STAGE(PG8_SA(1, 1), a1 + hstepA, voffA);
            PG8_WAIT_V(8); PG8_WAIT_L(0); PG8_BAR; PG8_MMA(0, 0, At, B0); PG8_MMA(0, 1, At, B1); PG8_BAR; PG8_SCHED;
            PG8_LDA(At, 0, 1); PG8_STAGE(PG8_SB(0, 0), b2, voffB); PG8_STAGE(PG8_SB(0, 1), b2 + hstepB, voffB); PG8_STAGE(PG8_SA(0, 0), a2, voffA);
            PG8_WAIT_V(8); PG8_WAIT_L(0); PG8_BAR; PG8_MMA(1, 0, At, B0); PG8_MMA(1, 1, At, B1); PG8_BAR; PG8_SCHED;
            PG8_LDB(B0, 1, 0); PG8_LDB(B1, 1, 1); PG8_SCHED; PG8_LDA(At, 1, 0); PG8_STAGE(PG8_SA(0, 1), a2 + hstepA, voffA);
            PG8_WAIT_V(8); PG8_WAIT_L(0); PG8_BAR; PG8_MMA(0, 0, At, B0); PG8_MMA(0, 1, At, B1); PG8_BAR; PG8_SCHED;
            PG8_LDA(At, 1, 1); PG8_STAGE(PG8_SB(1, 0), b3, voffB); PG8_STAGE(PG8_SB(1, 1), b3 + hstepB, voffB); PG8_STAGE(PG8_SA(1, 0), a3, voffA);
            PG8_WAIT_V(8); PG8_WAIT_L(0); PG8_BAR; PG8_MMA(1, 0, At, B0); PG8_MMA(1, 1, At, B1); PG8_BAR; PG8_SCHED;
            } else {
            PG8_LDB(B0, 0, 0); PG8_SCHED; PG8_LDA(At, 0, 0); PG8_STAGE(PG8_SA(1, 1), a1 + hstepA, voffA);
            PG8_WAIT_L(8); PG8_BAR; PG8_WAIT_L(0); PG8_MMA(0, 0, At, B0); PG8_BAR; PG8_SCHED;
            PG8_LDB(B1, 0, 1); PG8_STAGE(PG8_SB(0, 0), b2, voffB);
            PG8_BAR; PG8_WAIT_L(0); PG8_MMA(0, 1, At, B1); PG8_BAR;
            PG8_LDA(At, 0, 1); PG8_STAGE(PG8_SA(0, 0), a2, voffA);
            PG8_BAR; PG8_WAIT_L(0); PG8_MMA(1, 0, At, B0); PG8_BAR; PG8_SCHED;
            PG8_STAGE(PG8_SB(0, 1), b2 + hstepB, voffB);
            PG8_WAIT_V(6); PG8_BAR; PG8_MMA(1, 1, At, B1); PG8_BAR;
            PG8_LDB(B0, 1, 0); PG8_SCHED; PG8_LDA(At, 1, 0); PG8_STAGE(PG8_SA(0, 1), a2 + hstepA, voffA);
            PG8_WAIT_L(8); PG8_BAR; PG8_WAIT_L(0); PG8_MMA(0, 0, At, B0); PG8_BAR; PG8_SCHED;
            PG8_LDB(B1, 1, 1); PG8_STAGE(PG8_SB(1, 0), b3, voffB);
            PG8_BAR; PG8_WAIT_L(0); PG8_MMA(0, 1, At, B1); PG8_BAR;
            PG8_LDA(At, 1, 1); PG8_STAGE(PG8_SA(1, 0), a3, voffA);
            PG8_BAR; PG8_WAIT_L(0); PG8_MMA(1, 0, At, B0); PG8_BAR; PG8_SCHED;
            PG8_STAGE(PG8_SB(1, 1), b3 + hstepB, voffB);
            PG8_WAIT_V(6); PG8_BAR; PG8_MMA(1, 1, At, B1); PG8_BAR;
            }
        }
        if constexpr (ALIGN_EPI) { if (wr == 0) PG8_BAR; }
        if constexpr (!Epi::AFTER_DRAIN) { E(acc, cur, wr, wc, fr, fq); S.done(cur); }
        if (!has_next) break;
#pragma unroll
        for (int a = 0; a < 2; ++a)
#pragma unroll
            for (int b = 0; b < 2; ++b)
#pragma unroll
                for (int m = 0; m < 4; ++m)
#pragma unroll
                    for (int n = 0; n < 2; ++n) acc[a][b][m][n] = (f32x4){0.f, 0.f, 0.f, 0.f};
        cur = nxt; cA = nA; cB = nB; ++ui;
        if constexpr (ALIGN_EPI) { if (wr == 1) PG8_BAR; }
    }
    PG8_WAIT_V(0);
    if constexpr (!ALIGN_EPI) { if (wr == 0) PG8_BAR; }
    PG8_BAR;
    if constexpr (Epi::AFTER_DRAIN) { E.fused(acc, cur, wr, wc, fr, fq, lds, wid, lane); S.done(cur); }
#undef PG8_SA
#undef PG8_SB
#undef PG8_STAGE
#undef PG8_LDA
#undef PG8_LDB
#undef PG8_MMA
#undef PG8_WAIT_V
#undef PG8_WAIT_L
#undef PG8_BAR
#undef PG8_SCHED
}
}


constexpr int NWAVES = 8;
constexpr int DM = 2048, BATCH = 2, SEQ = 4096, M = BATCH * SEQ;
constexpr int HD = 64, NQH = 16, NKVH = 4, ATTW = 1024, KVW = 256, POOLW = 1024, INW = 2560;
constexpr int PKH = 8, NEXP = 16384, PLE = 256;
constexpr float EPS = 1e-6f;
constexpr float EU_SCALE = 256.0f, EV_SCALE = 16.0f;
#ifndef MK_N_LAUNCHES
#define MK_N_LAUNCHES 1
#endif
constexpr int N_PHASES = 9;
#ifndef REP_MASK
#define REP_MASK 0
#endif
#define NREP(k) (((REP_MASK >> (k)) & 1) ? 2 : 1)
#ifndef DBG_NO_PEER
#define DBG_NO_PEER 0
#endif
#ifndef DBG_NO_PLE
#define DBG_NO_PLE 0
#endif
#ifndef DBG_NO_MIX
#define DBG_NO_MIX 0
#endif

constexpr size_t MiB = 1u << 20;
constexpr size_t WS_CTL = 0, CTL_ZERO_BYTES = 256 * 1024;
constexpr size_t WS_WIN = 1 * MiB, WS_WOUT = 11 * MiB, WS_WQ = 19 * MiB, WS_WG = 27 * MiB, WS_WP = 35 * MiB, WS_WPOOL = 36 * MiB;
constexpr size_t WS_SKH = 36 * MiB + 512 * 1024, WS_SKL = WS_SKH + 64 * 1024;
constexpr size_t WS_ROPE = 37 * MiB;
constexpr size_t WS_RSTD1 = 37 * MiB + 512 * 1024, WS_RSTD3 = WS_RSTD1 + 32 * 1024;
constexpr size_t WS_EU = 38 * MiB, WS_EV = 102 * MiB;
constexpr size_t WS_XB = 166 * MiB, WS_PB = 198 * MiB;
constexpr size_t WS_Q = 202 * MiB, WS_K = 218 * MiB, WS_V = 222 * MiB, WS_U = 226 * MiB, WS_POOLED = 242 * MiB, WS_MIX = 258 * MiB;
constexpr size_t WS_QP = 202 * MiB;
constexpr size_t WS_EIDX = 266 * MiB, WS_GATE = 270 * MiB;
constexpr size_t WS_H1 = 290 * MiB, WS_H1B = 354 * MiB, WS_PP = 386 * MiB, WS_H2B = 418 * MiB, WS_END = 450 * MiB;
constexpr int CW_QUEUE = 2048, CW_QUEUE0 = 2112;
#ifndef Q_SPLIT
#define Q_SPLIT 0
#endif
constexpr int CW_BAR = 4096;
constexpr int CW_SSQ2 = 16384, CW_SSQ4 = 16384 + 8192;
static_assert((CW_SSQ4 + 8192) * 4 <= (int)CTL_ZERO_BYTES, "ctl");

constexpr int RING_OFF = 0, RING_BYTES = 131072;
constexpr int LDSCTL_OFF = RING_BYTES, MISC_OFF = LDSCTL_OFF + 320;
constexpr int LDS_BYTES = 147456;

#define GAS __attribute__((address_space(1)))
#define LAS __attribute__((address_space(3)))
typedef unsigned short bf16;
typedef unsigned v4u __attribute__((ext_vector_type(4)));
typedef unsigned v2u __attribute__((ext_vector_type(2)));
typedef float f32x4 __attribute__((ext_vector_type(4)));
typedef float f32x16 __attribute__((ext_vector_type(16)));
typedef short bf16x8 __attribute__((ext_vector_type(8)));
typedef GAS unsigned gu32;
#define RLX_AGENT __ATOMIC_RELAXED, __HIP_MEMORY_SCOPE_AGENT
#define LDS_WAIT() asm volatile("s_waitcnt lgkmcnt(0)" ::: "memory")
#define VM_WAIT() asm volatile("s_waitcnt vmcnt(0)" ::: "memory")
typedef float f32x2_t __attribute__((ext_vector_type(2))); typedef __bf16 bf16x2_t __attribute__((ext_vector_type(2)));
__device__ __forceinline__ unsigned pk2(float lo, float hi) { f32x2_t v = {lo, hi}; bf16x2_t b = __builtin_convertvector(v, bf16x2_t); return __builtin_bit_cast(unsigned, b); }
__device__ __forceinline__ float bf_lo(unsigned w) { return __uint_as_float(w << 16); }
__device__ __forceinline__ float bf_hi(unsigned w) { return __uint_as_float(w & 0xffff0000u); }
__device__ __forceinline__ float dot2bf(unsigned a, unsigned b, float c) { return __builtin_amdgcn_fdot2_f32_bf16(__builtin_bit_cast(bf16x2_t, a), __builtin_bit_cast(bf16x2_t, b), c, false); }
__device__ __forceinline__ float max2f(float a, float b) { float r; asm("v_max_f32_e32 %0, %1, %2" : "=v"(r) : "v"(a), "v"(b)); return r; }
__device__ __forceinline__ float min2f(float a, float b) { float r; asm("v_min_f32_e32 %0, %1, %2" : "=v"(r) : "v"(a), "v"(b)); return r; }
__device__ __forceinline__ float wave_sum(float v) {
#pragma unroll
    for (int o = 1; o < 64; o <<= 1) v += __shfl_xor(v, o);
    return v;
}

#define XB_TMO      128
#define XB_XCNT(j)  (256  + 64 * (j))
#define XB_XSUB(j)  (1280 + 64 * (j))
#define XB_XGEN(j)  (2304 + 64 * (j))
#define XB_TOP      3328
#define XB_TOPGEN   3392
#define XCD_BAR_WORDS 3456
#define XB_SPIN_CAP (1u << 18)
__device__ __forceinline__ unsigned xb_ld(unsigned* p)              { return __hip_atomic_load(p, __ATOMIC_RELAXED, __HIP_MEMORY_SCOPE_AGENT); }
__device__ __forceinline__ unsigned xb_add(unsigned* p, unsigned v) { return __hip_atomic_fetch_add(p, v, __ATOMIC_RELAXED, __HIP_MEMORY_SCOPE_AGENT); }
__device__ __forceinline__ unsigned xb_xcc_id() { return (unsigned)__builtin_amdgcn_s_getreg((3 << 11) | 20) & 0xFu; }
#define XB_SPIN(cond, bar) do { unsigned _sp = 0; while (cond) { __builtin_amdgcn_s_sleep(1); \
    if ((++_sp & 255u) == 0u) { if (xb_ld(&(bar)[XB_TMO])) break; if (_sp > XB_SPIN_CAP) { atomicAdd(&(bar)[XB_TMO], 1u); break; } } } } while (0)
struct XcdBarrier { unsigned* bar; unsigned x; volatile LAS unsigned* st; };
__device__ __forceinline__ XcdBarrier xcd_barrier_post(unsigned* bar, volatile LAS unsigned* st) {
    XcdBarrier b; b.bar = bar; b.x = xb_xcc_id(); b.st = st;
    if (threadIdx.x == 0) (void)xb_add(&bar[XB_XCNT(b.x)], 1u);
    return b;
}
__device__ __forceinline__ void xcd_barrier_complete(unsigned* bar, unsigned x, unsigned& nloc, unsigned& nx) {
    const unsigned G = gridDim.x * gridDim.y * gridDim.z;
    unsigned sum, cnt, mine, sp = 0u;
    for (;;) {
        sum = 0u; cnt = 0u; mine = 0u;
#pragma unroll
        for (unsigned j = 0; j < 16; ++j) { const unsigned c = xb_ld(&bar[XB_XCNT(j)]); sum += c; cnt += (c > 0u) ? 1u : 0u; mine = (j == x) ? c : mine; }
        if (sum == G) break;
        __builtin_amdgcn_s_sleep(1);
        if ((++sp & 255u) == 0u) { if (xb_ld(&bar[XB_TMO])) break; if (sp > XB_SPIN_CAP) { atomicAdd(&bar[XB_TMO], 1u); break; } }
    }
    nloc = mine > 0u ? mine : 1u; nx = cnt > 0u ? cnt : 1u;
}
__device__ __forceinline__ void xcd_barrier(const XcdBarrier& b) {
    asm volatile("s_waitcnt vmcnt(0)" ::: "memory");
    __syncthreads();
    if (threadIdx.x == 0) {
        unsigned* bar = b.bar;
        __builtin_amdgcn_s_waitcnt(0);
        unsigned nloc = b.st[0], nx = b.st[1];
        if (nloc == 0u) { xcd_barrier_complete(bar, b.x, nloc, nx); b.st[0] = nloc; b.st[1] = nx; }
        const unsigned old = xb_add(&bar[XB_XSUB(b.x)], 1u);
        const unsigned gen = old / nloc;
        if (old + 1u == (gen + 1u) * nloc) {
            __builtin_amdgcn_fence(__ATOMIC_RELEASE, "agent");
            asm volatile("s_waitcnt vmcnt(0)" ::: "memory");
            const unsigned og = xb_add(&bar[XB_TOP], 1u);
            const unsigned tg = og / nx;
            if (og + 1u == (tg + 1u) * nx) xb_add(&bar[XB_TOPGEN], 1u);
            else XB_SPIN(xb_ld(&bar[XB_TOPGEN]) == tg, bar);
            __builtin_amdgcn_fence(__ATOMIC_ACQUIRE, "agent");
            xb_add(&bar[XB_XGEN(b.x)], 1u);
            asm volatile("s_waitcnt vmcnt(0)" ::: "memory");
        } else {
            XB_SPIN(xb_ld(&bar[XB_XGEN(b.x)]) == gen, bar);
            __builtin_amdgcn_fence(__ATOMIC_ACQUIRE, "agent");
            asm volatile("s_waitcnt vmcnt(0)" ::: "memory");
        }
    }
    __syncthreads();
}

struct Frame {
    LAS unsigned char* lds;
    volatile LAS unsigned* MISC;
    gu32* ctl;
    int tid, lane, wave;
    int vcu, G;
    const float *x, *p, *g_mix, *w_in, *sinks, *w_pool, *pool_scale, *w_out, *g_ffn, *w_query, *sub_keys, *expert_u, *expert_v, *g_ple, *w_ple_gate, *w_ple_proj, *g_final;
    const int* positions;
    float* out;
    unsigned char* ws;
};
#define F_Win_t  ((bf16*)(F.ws + WS_WIN))
#define F_Wout_t ((bf16*)(F.ws + WS_WOUT))
#define F_Wq_t   ((bf16*)(F.ws + WS_WQ))
#define F_Wg_t   ((bf16*)(F.ws + WS_WG))
#define F_Wp_t   ((bf16*)(F.ws + WS_WP))
#define F_Wpool_t ((bf16*)(F.ws + WS_WPOOL))
#define F_SKH    ((bf16*)(F.ws + WS_SKH))
#define F_SKL    ((bf16*)(F.ws + WS_SKL))
#define F_EU     ((bf16*)(F.ws + WS_EU))
#define F_EV     ((bf16*)(F.ws + WS_EV))
#define F_XB     ((bf16*)(F.ws + WS_XB))
#define F_PB     ((bf16*)(F.ws + WS_PB))
#define F_QB     ((bf16*)(F.ws + WS_Q))
#define F_KB     ((bf16*)(F.ws + WS_K))
#define F_VB     ((bf16*)(F.ws + WS_V))
#define F_UB     ((bf16*)(F.ws + WS_U))
#define F_POOLED ((bf16*)(F.ws + WS_POOLED))
#define F_MIX    ((bf16*)(F.ws + WS_MIX))
#define F_H1B    ((bf16*)(F.ws + WS_H1B))
#define F_PP     ((bf16*)(F.ws + WS_PP))
#define F_H2B    ((bf16*)(F.ws + WS_H2B))
#define F_ROPE   ((float*)(F.ws + WS_ROPE))
#define F_RSTD1  ((float*)(F.ws + WS_RSTD1))
#define F_RSTD3  ((float*)(F.ws + WS_RSTD3))
#define F_QP     ((float*)(F.ws + WS_QP))
#define F_GATE   ((float*)(F.ws + WS_GATE))
#define F_H1     ((float*)(F.ws + WS_H1))
#define F_SSQ2   ((float*)(F.ws + WS_CTL) + CW_SSQ2)
#define F_SSQ4   ((float*)(F.ws + WS_CTL) + CW_SSQ4)
#define F_EIDX   ((int*)(F.ws + WS_EIDX))

__device__ __forceinline__ void p0_transpose_item(const float* W, int ldw, int N, const float* gain, bf16* WT, int ldt, LAS float* scr, int item, int lane) {
    const int nblk = N / 32, kb = item / nblk, nb = item % nblk, k0 = 64 * kb, n0 = 32 * nb;
    float wv[32];
#pragma unroll
    for (int i = 0; i < 32; ++i) { const int kk = 2 * i + (lane >> 5); wv[i] = W[(size_t)(k0 + kk) * ldw + n0 + (lane & 31)]; }
    if (gain) {
#pragma unroll
        for (int i = 0; i < 32; ++i) wv[i] *= gain[k0 + 2 * i + (lane >> 5)];
    }
#pragma unroll
    for (int i = 0; i < 32; ++i) { const int kk = 2 * i + (lane >> 5); scr[kk * 33 + (lane & 31)] = wv[i]; }
    LDS_WAIT(); asm volatile("" ::: "memory");
    const int c = lane & 7;
#pragma unroll
    for (int j = 0; j < 4; ++j) { const int n = (lane >> 3) + 8 * j; const LAS float* s = scr + (8 * c) * 33 + n;
        v4u o; o.x = pk2(s[0 * 33], s[1 * 33]); o.y = pk2(s[2 * 33], s[3 * 33]); o.z = pk2(s[4 * 33], s[5 * 33]); o.w = pk2(s[6 * 33], s[7 * 33]);
        *(GAS v4u*)(WT + (size_t)(n0 + n) * ldt + k0 + 8 * c) = o; }
    LDS_WAIT(); asm volatile("" ::: "memory");
}
__device__ __forceinline__ void p0_prologue(Frame& F) {
    LAS float* scr = (LAS float*)(F.lds + RING_OFF + F.wave * 16384);
    const int gw = F.vcu * NWAVES + F.wave, NGW = F.G * NWAVES;
    const int gt = gw * 64 + F.lane, NGT = NGW * 64;
    constexpr int I_IN = (DM / 64) * (INW / 32), I_P = (PLE / 64) * (DM / 32);
    constexpr int NITEMS = I_IN + I_P;
    for (int it = gw; it < NITEMS; it += NGW) {
        int r = it;
        if (r < I_IN) { p0_transpose_item(F.w_in, INW, INW, F.g_mix, F_Win_t, DM, scr, r, F.lane); continue; } r -= I_IN;
        p0_transpose_item(F.w_ple_proj, DM, DM, nullptr, F_Wp_t, PLE, scr, r, F.lane);
    }
    for (int m = gw; m < M; m += NGW) {
        const GAS f32x4* xr = (const GAS f32x4*)(F.x + (size_t)m * DM) + F.lane;
        f32x4 v[8]; float s = 0.f;
#pragma unroll
        for (int j = 0; j < 8; ++j) { v[j] = xr[64 * j]; s += (v[j].x * v[j].x + v[j].y * v[j].y) + (v[j].z * v[j].z + v[j].w * v[j].w); }
        s = wave_sum(s);
        if (F.lane == 0) F_RSTD1[m] = 1.0f / sqrtf(s * (1.0f / DM) + EPS);
        GAS v2u* o8 = (GAS v2u*)(F_XB + (size_t)m * DM) + F.lane;
#pragma unroll
        for (int j = 0; j < 8; ++j) { v2u o; o.x = pk2(v[j].x, v[j].y); o.y = pk2(v[j].z, v[j].w); o8[64 * j] = o; }
    }
    for (int c = gt; c < M * PLE / 8; c += NGT) {
        const GAS f32x4* s = (const GAS f32x4*)F.p + 2 * (size_t)c; const f32x4 a = s[0], b = s[1];
        v4u o; o.x = pk2(a.x, a.y); o.y = pk2(a.z, a.w); o.z = pk2(b.x, b.y); o.w = pk2(b.z, b.w);
        *((GAS v4u*)F_PB + c) = o;
    }
    for (int c = gt; c < M * 8; c += NGT) {
        const int t = c >> 3, i = c & 7;
        const float inv = 1.0f / (float)pow(500000.0, (double)(2 * i) / 16.0);
        const float ang = (float)F.positions[t] * inv;
        F_ROPE[t * 16 + i] = (float)cos((double)ang); F_ROPE[t * 16 + 8 + i] = (float)sin((double)ang);
    }
    for (int c = gt; c < 2 * 128 * 128; c += NGT) {
        const float v = F.sub_keys[c]; const unsigned h = pk2(v, 0.f) & 0xffffu; const float hf = __uint_as_float(h << 16);
        F_SKH[c] = (bf16)h; F_SKL[c] = (bf16)(pk2(v - hf, 0.f) & 0xffffu);
    }
}


constexpr int Q_EXP = 1024, Q_SQ = 256, Q_POOL = 16, Q_ITEMS = Q_EXP + 3 * Q_SQ + Q_POOL;
__device__ __forceinline__ void conv_expert_item(Frame& F, int idx, int tid) {
    const bool isv = idx >= 512; const int e0 = (idx & 511) * 32;
    const float* src = isv ? F.expert_v : F.expert_u; unsigned char* dstb = (unsigned char*)(isv ? (void*)F_EV : (void*)F_EU);
    const float sc = isv ? EV_SCALE : EU_SCALE;
#pragma unroll 4
    for (int cl = tid; cl < 32 * 128; cl += NWAVES * 64) {
        const int e = e0 + (cl >> 7), d0 = (cl & 127) * 16; const size_t dst = ((size_t)(d0 >> 7) * NEXP + e) * 128 + (d0 & 127);
        const GAS f32x4* s = (const GAS f32x4*)(src + (size_t)e * DM + d0); const GAS f32x4* gp = (const GAS f32x4*)(F.g_ffn + d0);
        v4u o;
#pragma unroll
        for (int q = 0; q < 4; ++q) { f32x4 a = s[q] * sc; if (!isv) a = a * gp[q]; int w = 0; w = __builtin_amdgcn_cvt_pk_fp8_f32(a.x, a.y, w, false); w = __builtin_amdgcn_cvt_pk_fp8_f32(a.z, a.w, w, true); o[q] = (unsigned)w; }
        *(GAS v4u*)(dstb + dst) = o;
    }
}
constexpr int Q_W = 3 * Q_SQ + Q_POOL;
__device__ __forceinline__ void p1_queue(Frame& F, int lo, int hi, int cw) {
    const int lane = (int)__builtin_amdgcn_mbcnt_hi(~0u, __builtin_amdgcn_mbcnt_lo(~0u, 0u)), tid = F.wave * 64 + lane;
    LAS float* scr = (LAS float*)(F.lds + RING_OFF + F.wave * 16384);
    volatile LAS unsigned* qslot = F.MISC + 12;
    unsigned mine = 0u;
    __syncthreads();
    if (tid == 0) { qslot[0] = __hip_atomic_fetch_add((unsigned*)(F.ctl + cw), 1u, RLX_AGENT); }
    __syncthreads();
    int idx = lo + (int)qslot[0];
    for (int n = 0;; ++n) {
        if (idx >= hi) break;
        if (tid == 0) mine = __hip_atomic_fetch_add((unsigned*)(F.ctl + cw), 1u, RLX_AGENT);
        if (idx >= Q_W) conv_expert_item(F, idx - Q_W, tid);
        else {
            int r = idx * 8 + F.wave;
            if (r < 8 * Q_SQ) p0_transpose_item(F.w_out, DM, DM, nullptr, F_Wout_t, DM, scr, r, lane);
            else if (r < 16 * Q_SQ) p0_transpose_item(F.w_query, DM, DM, F.g_ffn, F_Wq_t, DM, scr, r - 8 * Q_SQ, lane);
            else if (r < 24 * Q_SQ) p0_transpose_item(F.w_ple_gate, DM, DM, F.g_ple, F_Wg_t, DM, scr, r - 16 * Q_SQ, lane);
            else { const int rp = r - 24 * Q_SQ, g = rp / 32, rr = rp % 32; p0_transpose_item(F.w_pool + (size_t)g * 65536, 256, 256, nullptr, F_Wpool_t + (size_t)g * 65536, 256, scr, rr, lane); }
        }
        if (tid == 0) qslot[1 - (n & 1)] = mine;
        __syncthreads();
        idx = lo + (int)qslot[1 - (n & 1)];
    }
    __syncthreads();
}
struct PpOrder {
    int first, stride;
    __device__ __forceinline__ void init(int G, int c) { const int heavy = (320 > G && 320 - G < G) ? 320 - G : 0; if (c < heavy) { first = 1 << 20; stride = 1; } else { first = c - heavy; stride = G - heavy; } }
    __device__ __forceinline__ bool next(int i, pg8::Unit& u) const { const long k = (long)first + (long)i * stride; if (k >= 256) return false; u.pm = (int)k >> 3; u.pn = (int)k & 7; return true; }
    __device__ __forceinline__ void a_ready(const pg8::Unit&) const {}
    __device__ __forceinline__ void done(const pg8::Unit&) const {}
};

struct EpiG1 {
    static constexpr bool PERM = true, AFTER_DRAIN = false;
    bf16 *Q, *Kb, *Vb, *U; const float* rstd; const float* rope;
    __device__ __forceinline__ void operator()(const f32x4 (&acc)[2][2][4][2], const pg8::Unit& u, int wr, int wc, int fr, int fq) const {
        const int pn = u.pn; bf16* base; int ldc, colt;
        if (pn < 4) { base = Q; ldc = ATTW; colt = pn * 256; } else if (pn == 4) { base = Kb; ldc = KVW; colt = 0; } else if (pn == 5) { base = Vb; ldc = KVW; colt = 0; } else { base = U; ldc = POOLW; colt = (pn - 6) * 256; }
        const bool rot = (pn <= 4) && ((wc & 1) == 0);
        const float qs = (pn < 4) ? 0.125f : 1.0f;
#pragma unroll
        for (int ai = 0; ai < 2; ++ai)
#pragma unroll
            for (int m = 0; m < 4; ++m) {
                const int row = u.pm * 256 + ai * 128 + wr * 64 + m * 16 + fr;
                const float rs = rstd[row] * qs;
                const GAS f32x4* rp = (const GAS f32x4*)(rope + (size_t)row * 16);
#pragma unroll
                for (int bj = 0; bj < 2; ++bj) {
                    f32x4 v0 = acc[ai][bj][m][0] * rs, v1 = acc[ai][bj][m][1] * rs;
                    if (rot) {
                        { const f32x4 c = rp[0], s = rp[2]; f32x4 p;
#pragma unroll
                          for (int i = 0; i < 4; ++i) p[i] = __shfl_xor(v0[i], 16);
                          if (fq == 0) v0 = v0 * c - p * s; else if (fq == 1) v0 = v0 * c + p * s; }
                        { const f32x4 c = rp[1], s = rp[3]; f32x4 p;
#pragma unroll
                          for (int i = 0; i < 4; ++i) p[i] = __shfl_xor(v1[i], 16);
                          if (fq == 0) v1 = v1 * c - p * s; else if (fq == 1) v1 = v1 * c + p * s; }
                    }
                    v4u w; w.x = pk2(v0[0], v0[1]); w.y = pk2(v0[2], v0[3]); w.z = pk2(v1[0], v1[1]); w.w = pk2(v1[2], v1[3]);
                    *(GAS v4u*)(base + (size_t)row * ldc + colt + bj * 128 + wc * 32 + 8 * fq) = w;
                }
            }
    }
};
template <bool HAS_SCALE> struct EpiBf16Scale {
    static constexpr bool PERM = true, AFTER_DRAIN = false;
    bf16* O; int ldc, col_off; const float* cscale;
    __device__ __forceinline__ void operator()(const f32x4 (&acc)[2][2][4][2], const pg8::Unit& u, int wr, int wc, int fr, int fq) const {
        const int c0 = u.pn * 256 + wc * 32 + 8 * fq;
#pragma unroll
        for (int ai = 0; ai < 2; ++ai)
#pragma unroll
            for (int m = 0; m < 4; ++m) {
                const int row = u.pm * 256 + ai * 128 + wr * 64 + m * 16 + fr;
#pragma unroll
                for (int bj = 0; bj < 2; ++bj) {
                    f32x4 v0 = acc[ai][bj][m][0], v1 = acc[ai][bj][m][1];
                    if constexpr (HAS_SCALE) { v0 = v0 * *(const GAS f32x4*)(cscale + c0 + bj * 128); v1 = v1 * *(const GAS f32x4*)(cscale + c0 + bj * 128 + 4); }
                    v4u w; w.x = pk2(v0[0], v0[1]); w.y = pk2(v0[2], v0[3]); w.z = pk2(v1[0], v1[1]); w.w = pk2(v1[2], v1[3]);
                    *(GAS v4u*)(O + (size_t)row * ldc + col_off + c0 + bj * 128) = w;
                }
            }
    }
};
struct EpiG3 {
    static constexpr bool PERM = false, AFTER_DRAIN = false;
    const float* x; float* h1; bf16* h1b; float* ssq;
    __device__ __forceinline__ void operator()(const f32x4 (&acc)[2][2][4][2], const pg8::Unit& u, int wr, int wc, int fr, int fq) const {
        const int col0 = u.pn * 256 + wc * 32 + 4 * fq;
#pragma unroll
        for (int ai = 0; ai < 2; ++ai)
#pragma unroll
            for (int m = 0; m < 4; ++m) {
                const int row = u.pm * 256 + ai * 128 + wr * 64 + m * 16 + fr; float ss = 0.f;
#pragma unroll
                for (int bj = 0; bj < 2; ++bj)
#pragma unroll
                    for (int n = 0; n < 2; ++n) {
                        const size_t off = (size_t)row * DM + col0 + bj * 128 + n * 16;
                        const f32x4 h = DBG_NO_MIX ? *(const GAS f32x4*)(x + off) : *(const GAS f32x4*)(x + off) + acc[ai][bj][m][n];
                        *(GAS f32x4*)(h1 + off) = h;
                        v2u w; w.x = pk2(h[0], h[1]); w.y = pk2(h[2], h[3]); *(GAS v2u*)(h1b + off) = w;
                        ss += (h[0] * h[0] + h[1] * h[1]) + (h[2] * h[2] + h[3] * h[3]);
                    }
                ss += __shfl_xor(ss, 16); ss += __shfl_xor(ss, 32);
                if (fq == 0) atomicAdd(ssq + row, ss);
            }
    }
};
struct EpiG4 {
    static constexpr bool PERM = false, AFTER_DRAIN = false;
    float* qp; const float* ssq;
    __device__ __forceinline__ void operator()(const f32x4 (&acc)[2][2][4][2], const pg8::Unit& u, int wr, int wc, int fr, int fq) const {
        const int col0 = u.pn * 256 + wc * 32 + 4 * fq;
#pragma unroll
        for (int ai = 0; ai < 2; ++ai)
#pragma unroll
            for (int m = 0; m < 4; ++m) {
                const int row = u.pm * 256 + ai * 128 + wr * 64 + m * 16 + fr;
                const float rs = 1.0f / sqrtf(__hip_atomic_load(ssq + row, RLX_AGENT) * (1.0f / DM) + EPS);
#pragma unroll
                for (int bj = 0; bj < 2; ++bj)
#pragma unroll
                    for (int n = 0; n < 2; ++n) *(GAS f32x4*)(qp + (size_t)row * DM + col0 + bj * 128 + n * 16) = acc[ai][bj][m][n] * rs;
            }
    }
};
struct EpiG5 {
    static constexpr bool PERM = false, AFTER_DRAIN = false;
    const float* h2; const bf16* pp; const float* rstd3; float* out; float* ssq;
    __device__ __forceinline__ void operator()(const f32x4 (&acc)[2][2][4][2], const pg8::Unit& u, int wr, int wc, int fr, int fq) const {
        const int col0 = u.pn * 256 + wc * 32 + 4 * fq;
#pragma unroll
        for (int ai = 0; ai < 2; ++ai)
#pragma unroll
            for (int m = 0; m < 4; ++m) {
                const int row = u.pm * 256 + ai * 128 + wr * 64 + m * 16 + fr; float ss = 0.f;
                const float rs = rstd3[row];
#pragma unroll
                for (int bj = 0; bj < 2; ++bj)
#pragma unroll
                    for (int n = 0; n < 2; ++n) {
                        const size_t off = (size_t)row * DM + col0 + bj * 128 + n * 16;
                        const f32x4 z = DBG_NO_PLE ? (f32x4){-1e30f, -1e30f, -1e30f, -1e30f} : acc[ai][bj][m][n] * rs; const v2u pw = *(const GAS v2u*)(pp + off); const f32x4 hv = *(const GAS f32x4*)(h2 + off);
                        f32x4 o;
                        o[0] = hv[0] + bf_lo(pw.x) / (1.0f + __expf(-z[0])); o[1] = hv[1] + bf_hi(pw.x) / (1.0f + __expf(-z[1]));
                        o[2] = hv[2] + bf_lo(pw.y) / (1.0f + __expf(-z[2])); o[3] = hv[3] + bf_hi(pw.y) / (1.0f + __expf(-z[3]));
                        *(GAS f32x4*)(out + off) = o;
                        ss += (o[0] * o[0] + o[1] * o[1]) + (o[2] * o[2] + o[3] * o[3]);
                    }
                ss += __shfl_xor(ss, 16); ss += __shfl_xor(ss, 32);
                if (fq == 0) atomicAdd(ssq + row, ss);
            }
    }
};
struct SingleUnit {
    int pm, pn;
    __device__ __forceinline__ bool next(int i, pg8::Unit& u) const { if (i != 0) return false; u.pm = pm; u.pn = pn; return true; }
    __device__ __forceinline__ void a_ready(const pg8::Unit&) const {}
    __device__ __forceinline__ void done(const pg8::Unit&) const {}
};

__device__ __forceinline__ int crow(int r, int hi) { return (r & 3) + 8 * (r >> 2) + 4 * hi; }
constexpr int KS_STRIDE = 144, VT_STRIDE = 520, VT_OFF = 256 * KS_STRIDE;
__device__ __forceinline__ void attn_unit(Frame& F, int unit) {
    const int g = unit & 3, nblk = (unit >> 2) & 31, b = unit >> 7;
    const int t0 = b * SEQ + nblk * 128;
    LAS unsigned char* Ks = F.lds + RING_OFF;
    LAS unsigned char* Vt = F.lds + RING_OFF + VT_OFF;
    for (int c = F.tid; c < 2048; c += NWAVES * 64) {
        const int j = c >> 3, ch = c & 7;
        v4u kv = {0u, 0u, 0u, 0u}, vv = {0u, 0u, 0u, 0u};
        if (nblk > 0 || j >= 128) { const size_t row = (size_t)(t0 - 128 + j); kv = *(const GAS v4u*)(F_KB + row * KVW + g * 64 + ch * 8); vv = *(const GAS v4u*)(F_VB + row * KVW + g * 64 + ch * 8); }
        *(LAS v4u*)(Ks + j * KS_STRIDE + ch * 16) = kv;
#pragma unroll
        for (int e = 0; e < 8; ++e) *(LAS unsigned short*)(Vt + (ch * 8 + e) * VT_STRIDE + j * 2) = (unsigned short)((vv[e >> 1] >> (16 * (e & 1))) & 0xffffu);
    }
    __syncthreads();
    const int hq = 4 * g + (F.wave >> 1);
    const float sink = F.sinks[hq];
    const int q = F.lane & 31, h = F.lane >> 5;
#pragma unroll 1
    for (int sub = 0; sub < 2; ++sub) {
        const int i0 = (F.wave & 1) * 64 + sub * 32;
        bf16x8 qf[4];
#pragma unroll
        for (int ks = 0; ks < 4; ++ks) qf[ks] = *(const GAS bf16x8*)(F_QB + (size_t)(t0 + i0 + q) * ATTW + hq * 64 + 16 * ks + 8 * h);
        f32x16 s[5];
#pragma unroll
        for (int kt = 0; kt < 5; ++kt) {
#pragma unroll
            for (int r = 0; r < 16; ++r) s[kt][r] = 0.f;
#pragma unroll
            for (int ks = 0; ks < 4; ++ks) {
                const bf16x8 a = *(const LAS bf16x8*)(Ks + (i0 + 32 * kt + q) * KS_STRIDE + (16 * ks + 8 * h) * 2);
                s[kt] = __builtin_amdgcn_mfma_f32_32x32x16_bf16(a, qf[ks], s[kt], 0, 0, 0);
            }
        }
        float mx = sink;
#pragma unroll
        for (int kt = 0; kt < 5; ++kt)
#pragma unroll
            for (int r = 0; r < 16; ++r) {
                const bool tv = (nblk > 0) || (i0 + 32 * kt >= 128);
                const bool ok = (kt == 0) ? (crow(r, h) > q) : (kt == 4) ? (crow(r, h) <= q) : true;
                const float v = (ok && tv) ? s[kt][r] : -INFINITY;
                s[kt][r] = v; mx = fmaxf(mx, v);
            }
        mx = fmaxf(mx, __shfl_xor(mx, 32));
        float sum = 0.f;
#pragma unroll
        for (int kt = 0; kt < 5; ++kt)
#pragma unroll
            for (int r = 0; r < 16; ++r) { const float pv = __expf(s[kt][r] - mx); s[kt][r] = pv; sum += pv; }
        sum += __shfl_xor(sum, 32);
        sum += __expf(sink - mx);
        const float inv = 1.0f / sum;
        f32x16 o[2];
#pragma unroll
        for (int dt = 0; dt < 2; ++dt)
#pragma unroll
            for (int r = 0; r < 16; ++r) o[dt][r] = 0.f;
#pragma unroll
        for (int kt = 0; kt < 5; ++kt)
#pragma unroll
            for (int st = 0; st < 2; ++st) {
                v4u pw; pw.x = pk2(s[kt][8 * st + 0], s[kt][8 * st + 1]); pw.y = pk2(s[kt][8 * st + 2], s[kt][8 * st + 3]); pw.z = pk2(s[kt][8 * st + 4], s[kt][8 * st + 5]); pw.w = pk2(s[kt][8 * st + 6], s[kt][8 * st + 7]);
                const bf16x8 pb = __builtin_bit_cast(bf16x8, pw);
#pragma unroll
                for (int dt = 0; dt < 2; ++dt) {
                    const LAS unsigned char* vb = Vt + (32 * dt + q) * VT_STRIDE + (i0 + 32 * kt + 16 * st + 4 * h) * 2;
                    const v2u lo = *(const LAS v2u*)vb, hi2 = *(const LAS v2u*)(vb + 16);
                    v4u aw; aw.x = lo.x; aw.y = lo.y; aw.z = hi2.x; aw.w = hi2.y;
                    o[dt] = __builtin_amdgcn_mfma_f32_32x32x16_bf16(__builtin_bit_cast(bf16x8, aw), pb, o[dt], 0, 0, 0);
                }
            }
        bf16* orow = F_MIX + (size_t)(t0 + i0 + q) * DM + hq * 64;
#pragma unroll
        for (int dt = 0; dt < 2; ++dt)
#pragma unroll
            for (int g4 = 0; g4 < 4; ++g4) {
                v2u w; w.x = pk2(o[dt][4 * g4] * inv, o[dt][4 * g4 + 1] * inv); w.y = pk2(o[dt][4 * g4 + 2] * inv, o[dt][4 * g4 + 3] * inv);
                *(GAS v2u*)(orow + 32 * dt + 8 * g4 + 4 * h) = w;
            }
    }
    __syncthreads();
}
template <int W> __device__ __forceinline__ void pool_tile_w(Frame& F, int pm, int g) {
    const int cg = F.tid & 31, rg = F.tid >> 5;
    const int r0 = pm * 256 + rg * 16;
    const int col = g * 256 + cg * 8;
    const int tseq0 = r0 & (SEQ - 1);
    const __amdgpu_buffer_rsrc_t rsu = __builtin_amdgcn_make_buffer_rsrc((void*)F_UB, 0, M * POOLW * 2, 0x00020000);
    const __amdgpu_buffer_rsrc_t rsp = __builtin_amdgcn_make_buffer_rsrc((void*)F_POOLED, 0, M * POOLW * 2, 0x00020000);
    v4u rows[W - 1 + 16];
#pragma unroll
    for (int j = 0; j < W - 1 + 16; ++j) { const int rr = r0 - (W - 1) + j; const bool ok = (tseq0 - (W - 1) + j) >= 0;
        rows[j] = __builtin_amdgcn_raw_buffer_load_b128(rsu, ok ? (unsigned)(rr * POOLW + col) * 2u : 0xFFFFFFF0u, 0, 0); }
    float sum[8];
#pragma unroll
    for (int e = 0; e < 8; ++e) sum[e] = 0.f;
#pragma unroll
    for (int j = 0; j < W - 1; ++j)
#pragma unroll
        for (int e = 0; e < 4; ++e) { const unsigned wv = rows[j][e]; sum[2 * e] += bf_lo(wv); sum[2 * e + 1] += bf_hi(wv); }
#pragma unroll
    for (int i = 0; i < 16; ++i) {
        const int ts = tseq0 + i;
        float cur[8];
#pragma unroll
        for (int e = 0; e < 4; ++e) { const unsigned wv = rows[W - 1 + i][e]; cur[2 * e] = bf_lo(wv); cur[2 * e + 1] = bf_hi(wv); }
#pragma unroll
        for (int e = 0; e < 8; ++e) sum[e] += cur[e];
        const int cnt = (ts + 1 < W) ? ts + 1 : W; const float ic = 1.0f / (float)cnt;
        v4u o;
        o.x = pk2(sum[0] * ic - cur[0], sum[1] * ic - cur[1]); o.y = pk2(sum[2] * ic - cur[2], sum[3] * ic - cur[3]);
        o.z = pk2(sum[4] * ic - cur[4], sum[5] * ic - cur[5]); o.w = pk2(sum[6] * ic - cur[6], sum[7] * ic - cur[7]);
        __builtin_amdgcn_raw_buffer_store_b128(o, rsp, (unsigned)((r0 + i) * POOLW + col) * 2u, 0, 0);
#pragma unroll
        for (int e = 0; e < 4; ++e) { const unsigned wv = rows[i][e]; sum[2 * e] -= bf_lo(wv); sum[2 * e + 1] -= bf_hi(wv); }
    }
}
__device__ __forceinline__ void pool_tile(Frame& F, int pm, int g) {
    if (g == 0) pool_tile_w<2>(F, pm, g); else if (g == 1) pool_tile_w<4>(F, pm, g); else if (g == 2) pool_tile_w<8>(F, pm, g); else pool_tile_w<16>(F, pm, g);
}

template <int N> __device__ __forceinline__ void insert_desc(float (&val)[N], float x) {
#pragma unroll
    for (int k = 0; k < N; ++k) { const float hi = max2f(x, val[k]); x = min2f(x, val[k]); val[k] = hi; }
}
__device__ __forceinline__ void bitonic_merge16(float (&m)[16]) {
#pragma unroll
    for (int st = 8; st >= 1; st >>= 1)
#pragma unroll
        for (int i = 0; i < 16; ++i) if ((i & st) == 0) { const float hi = max2f(m[i], m[i + st]), lo = min2f(m[i], m[i + st]); m[i] = hi; m[i + st] = lo; }
}
__device__ __forceinline__ void merge_partner16(float (&val)[16]) {
    float pr[16];
#pragma unroll
    for (int k = 0; k < 16; ++k) pr[k] = __shfl_xor(val[k], 32);
#pragma unroll
    for (int k = 0; k < 16; ++k) val[k] = max2f(val[k], pr[15 - k]);
    bitonic_merge16(val);
}
__device__ __forceinline__ void pin16(float (&v)[16]) {
#pragma unroll
    for (int k = 0; k < 16; ++k) asm volatile("" : "+v"(v[k]));
}
struct CandTab { int a[50], b[50]; };
__host__ __device__ constexpr CandTab make_cands() { CandTab t{}; int n = 0; for (int a = 0; a < 16; ++a) for (int b = 0; b < 16; ++b) if ((a + 1) * (b + 1) <= 16) { t.a[n] = a; t.b[n] = b; ++n; } return t; }
__device__ __forceinline__ float vsel(unsigned long long m, float a, float b) { float r; asm("v_cndmask_b32_e64 %0, %1, %2, %3" : "=v"(r) : "v"(b), "v"(a), "s"(m)); return r; }
__device__ __forceinline__ float sel16(const float (&L)[16], int a) { float r = L[0];
#pragma unroll
    for (int k = 1; k < 16; ++k) r = vsel(__ballot(a == k), L[k], r);
    return r; }
template <int HALF_>
__device__ __forceinline__ void route_half(Frame& F, const float* qrow, int r, int h, float (&Lout)[16]) {
    f32x16 acc[4];
#pragma unroll
    for (int kt = 0; kt < 4; ++kt)
#pragma unroll
        for (int i = 0; i < 16; ++i) acc[kt][i] = 0.f;
    const bf16* skh = F_SKH + HALF_ * 16384; const bf16* skl = F_SKL + HALF_ * 16384;
#pragma unroll 2
    for (int ks = 0; ks < 8; ++ks) {
        const f32x4 qa = *(const GAS f32x4*)(qrow + HALF_ * 128 + 16 * ks + 8 * h), qb = *(const GAS f32x4*)(qrow + HALF_ * 128 + 16 * ks + 8 * h + 4);
        v4u hw, lw;
        hw.x = pk2(qa.x, qa.y); hw.y = pk2(qa.z, qa.w); hw.z = pk2(qb.x, qb.y); hw.w = pk2(qb.z, qb.w);
        lw.x = pk2(qa.x - bf_lo(hw.x), qa.y - bf_hi(hw.x)); lw.y = pk2(qa.z - bf_lo(hw.y), qa.w - bf_hi(hw.y));
        lw.z = pk2(qb.x - bf_lo(hw.z), qb.y - bf_hi(hw.z)); lw.w = pk2(qb.z - bf_lo(hw.w), qb.w - bf_hi(hw.w));
        const bf16x8 bh = __builtin_bit_cast(bf16x8, hw), bl = __builtin_bit_cast(bf16x8, lw);
#pragma unroll
        for (int kt = 0; kt < 4; ++kt) {
            const bf16x8 ah = *(const GAS bf16x8*)(skh + (32 * kt + r) * 128 + 16 * ks + 8 * h), al = *(const GAS bf16x8*)(skl + (32 * kt + r) * 128 + 16 * ks + 8 * h);
            acc[kt] = __builtin_amdgcn_mfma_f32_32x32x16_bf16(ah, bh, acc[kt], 0, 0, 0);
            acc[kt] = __builtin_amdgcn_mfma_f32_32x32x16_bf16(al, bh, acc[kt], 0, 0, 0);
            acc[kt] = __builtin_amdgcn_mfma_f32_32x32x16_bf16(ah, bl, acc[kt], 0, 0, 0);
        }
    }
#pragma unroll
    for (int k = 0; k < 16; ++k) Lout[k] = -INFINITY;
#pragma unroll
    for (int kt = 0; kt < 4; ++kt)
#pragma unroll
        for (int i = 0; i < 16; ++i) {
            const unsigned n = (unsigned)(32 * kt + (i & 3) + 8 * (i >> 2) + 4 * h);
            insert_desc<16>(Lout, __uint_as_float((__float_as_uint(acc[kt][i]) & ~127u) | n));
        }
    merge_partner16(Lout);
}
__device__ __forceinline__ void route_task(Frame& F, int task) {
    const int r = F.lane & 31, h = F.lane >> 5;
    const int item = task * 32 + r, tok = item >> 3, head = item & 7;
    const float* qrow = F_QP + (size_t)tok * DM + head * 256;
    float L0[16], L1[16];
    route_half<0>(F, qrow, r, h, L0);
    route_half<1>(F, qrow, r, h, L1);
    pin16(L0); pin16(L1);
    constexpr CandTab CT = make_cands();
    const unsigned long long hm = __ballot(h != 0);
    float cand[16];
#pragma unroll
    for (int k = 0; k < 16; ++k) cand[k] = -INFINITY;
#pragma unroll
    for (int i = 0; i < 25; ++i) {
        const float v1 = vsel(hm, L0[CT.a[2 * i + 1]], L0[CT.a[2 * i]]);
        const float v2 = vsel(hm, L1[CT.b[2 * i + 1]], L1[CT.b[2 * i]]);
        const unsigned id = h ? (unsigned)(CT.a[2 * i + 1] * 16 + CT.b[2 * i + 1]) : (unsigned)(CT.a[2 * i] * 16 + CT.b[2 * i]);
        const float sm = __uint_as_float(__float_as_uint(v1) & ~127u) + __uint_as_float(__float_as_uint(v2) & ~127u);
        insert_desc<16>(cand, __uint_as_float((__float_as_uint(sm) & ~255u) | id));
    }
    merge_partner16(cand);
    pin16(cand);
    float se = 0.f;
#pragma unroll
    for (int k = 0; k < 16; ++k) se += __expf(cand[k] - cand[0]);
    const float ise = 1.0f / se;
    int eo[8]; float go[8];
#pragma unroll
    for (int kk = 0; kk < 8; ++kk) {
        const float cv = vsel(hm, cand[8 + kk], cand[kk]);
        const unsigned id = __float_as_uint(cv) & 255u; const int a = (int)(id >> 4), bb = (int)(id & 15u);
        const unsigned i1 = __float_as_uint(sel16(L0, a)) & 127u, i2 = __float_as_uint(sel16(L1, bb)) & 127u;
        eo[kk] = (int)(i1 * 128u + i2); go[kk] = __expf(cv - cand[0]) * ise;
    }
    int* ep = F_EIDX + (size_t)tok * 128 + head * 16 + 8 * h; float* gp = F_GATE + (size_t)tok * 128 + head * 16 + 8 * h;
    *(GAS v4u*)ep = (v4u){(unsigned)eo[0], (unsigned)eo[1], (unsigned)eo[2], (unsigned)eo[3]}; *(GAS v4u*)(ep + 4) = (v4u){(unsigned)eo[4], (unsigned)eo[5], (unsigned)eo[6], (unsigned)eo[7]};
    *(GAS f32x4*)gp = (f32x4){go[0], go[1], go[2], go[3]}; *(GAS f32x4*)(gp + 4) = (f32x4){go[4], go[5], go[6], go[7]};
}


#ifndef DBG_ROUTE_BF
#define DBG_ROUTE_BF 0
#endif
__device__ __forceinline__ void lds_insert(LAS float* V, LAS int* I, int tid, float x, int id) {
    if (x > V[15 * 256 + tid]) {
        int pos = 15;
        while (pos > 0 && V[(pos - 1) * 256 + tid] < x) { V[pos * 256 + tid] = V[(pos - 1) * 256 + tid]; I[pos * 256 + tid] = I[(pos - 1) * 256 + tid]; --pos; }
        V[pos * 256 + tid] = x; I[pos * 256 + tid] = id;
    }
}
__device__ __forceinline__ void route_bruteforce(Frame& F) {
    if (F.tid >= 256) return;
    const int tid = F.tid;
    LAS float* V0 = (LAS float*)(F.lds); LAS int* I0 = (LAS int*)(F.lds + 16384);
    LAS float* V1 = (LAS float*)(F.lds + 32768); LAS int* I1 = (LAS int*)(F.lds + 49152);
    LAS float* VC = (LAS float*)(F.lds + 65536); LAS int* IC = (LAS int*)(F.lds + 81920);
    for (int item = (int)blockIdx.x * 256 + tid; item < M * PKH; item += F.G * 256) {
        const int tok = item >> 3, head = item & 7;
        const float* qrow = F_QP + (size_t)tok * DM + head * 256;
        for (int k = 0; k < 16; ++k) { V0[k * 256 + tid] = -INFINITY; I0[k * 256 + tid] = 0; V1[k * 256 + tid] = -INFINITY; I1[k * 256 + tid] = 0; VC[k * 256 + tid] = -INFINITY; IC[k * 256 + tid] = 0; }
        for (int half = 0; half < 2; ++half) {
            float q[128];
#pragma unroll
            for (int d = 0; d < 128; d += 4) { const f32x4 t = *(const GAS f32x4*)(qrow + half * 128 + d); q[d] = t.x; q[d + 1] = t.y; q[d + 2] = t.z; q[d + 3] = t.w; }
            for (int n = 0; n < 128; ++n) {
                const float* sk = F.sub_keys + (size_t)half * 16384 + n * 128;
                float s = 0.f;
#pragma unroll
                for (int d = 0; d < 128; ++d) s += q[d] * sk[d];
                if (half == 0) lds_insert(V0, I0, tid, s, n); else lds_insert(V1, I1, tid, s, n);
            }
        }
        for (int a = 0; a < 16; ++a) for (int b = 0; b < 16; ++b) lds_insert(VC, IC, tid, V0[a * 256 + tid] + V1[b * 256 + tid], I0[a * 256 + tid] * 128 + I1[b * 256 + tid]);
        const float mx = VC[tid]; float se = 0.f;
        for (int k = 0; k < 16; ++k) se += __expf(VC[k * 256 + tid] - mx);
        for (int k = 0; k < 16; ++k) { F_EIDX[(size_t)tok * 128 + head * 16 + k] = IC[k * 256 + tid]; F_GATE[(size_t)tok * 128 + head * 16 + k] = __expf(VC[k * 256 + tid] - mx) / se; }
    }
}

template <int N> __device__ __forceinline__ void treduce(float (&v)[N], int lane, int d) {
    const bool up = (lane & d) != 0;
#pragma unroll
    for (int i = 0; i < N / 2; ++i) { const float send = up ? v[i] : v[i + N / 2], keep = up ? v[i + N / 2] : v[i]; v[i] = keep + __shfl_xor(send, d); }
}
constexpr int SLICE_BYTES = NEXP * 128;
constexpr int NSLICE = 16;
typedef float f32x2v __attribute__((ext_vector_type(2)));
__device__ __forceinline__ void peer_phase(Frame& F) {
    const int lane = F.lane, g = lane >> 3, p = lane & 7;
    const int tbase = (int)blockIdx.x * 32 + F.wave * 4;
    LAS float* alds = (LAS float*)(F.lds + RING_OFF + F.wave * 2048);
    const __amdgpu_buffer_rsrc_t rsu = __builtin_amdgcn_make_buffer_rsrc((void*)F_EU, 0, NEXP * DM, 0x00020000);
    const __amdgpu_buffer_rsrc_t rsv = __builtin_amdgcn_make_buffer_rsrc((void*)F_EV, 0, NEXP * DM, 0x00020000);
    const __amdgpu_buffer_rsrc_t rsx = __builtin_amdgcn_make_buffer_rsrc((void*)F_H1B, 0, M * DM * 2, 0x00020000);
    const __amdgpu_buffer_rsrc_t rsh = __builtin_amdgcn_make_buffer_rsrc((void*)F_H1, 0, M * DM * 4, 0x00020000);
    const __amdgpu_buffer_rsrc_t rsb = __builtin_amdgcn_make_buffer_rsrc((void*)F_H2B, 0, M * DM * 2, 0x00020000);
    const unsigned p16 = (unsigned)p * 16u;
    const unsigned cl = (unsigned)(16 * p + 8 * (g & 1) + 4 * ((g >> 1) & 1) + 2 * ((g >> 2) & 1));
    for (int tb = tbase; tb < M; tb += F.G * 32) {
        unsigned ev[4][8];
        float hacc[4][2];
#pragma unroll
        for (int tk = 0; tk < 4; ++tk) {
#pragma unroll
            for (int i = 0; i < 8; ++i) ev[tk][i] = (unsigned)F_EIDX[(size_t)(tb + tk) * 128 + 16 * i + g] | ((unsigned)F_EIDX[(size_t)(tb + tk) * 128 + 16 * i + 8 + g] << 16);
            hacc[tk][0] = 0.f; hacc[tk][1] = 0.f;
        }
#define PEER_VOFF(TK, i) ({ unsigned e_ = ev[TK][(i) >> 1]; asm volatile("" : "+v"(e_)); ((((i) & 1) ? (e_ >> 16) : (e_ & 0xffffu)) * 128u + p16); })
#define PEER_LOAD_X(X0, X1, S, TK) do { X0 = __builtin_amdgcn_raw_buffer_load_b128(rsx, 2u * p16, ((tb + (TK)) * DM + 128 * (S)) * 2, 0); X1 = __builtin_amdgcn_raw_buffer_load_b128(rsx, 2u * p16 + 16u, ((tb + (TK)) * DM + 128 * (S)) * 2, 0); } while (0)
#define PEER_LOAD_A(W, S, TK, H) do { _Pragma("unroll") for (int i = 0; i < 8; ++i) W[i] = __builtin_amdgcn_raw_buffer_load_b128(rsu, PEER_VOFF(TK, 8 * (H) + i), (S) * SLICE_BYTES, 0); } while (0)
#define PEER_COMP_A(W, H) do { \
        _Pragma("unroll") for (int i = 0; i < 8; ++i) { f32x2v a2 = {0.f, 0.f}; \
            _Pragma("unroll") for (int c = 0; c < 4; ++c) { const int wv = (int)W[i][c]; const f32x2v lo = __builtin_amdgcn_cvt_pk_f32_fp8(wv, false), hi = __builtin_amdgcn_cvt_pk_f32_fp8(wv, true); \
                a2 += lo * xf2[2 * c]; a2 += hi * xf2[2 * c + 1]; } \
            part[8 * (H) + i] = a2.x + a2.y; if (i & 1) __builtin_amdgcn_sched_barrier(0); } } while (0)
        for (int rep = 0; rep < NREP(6); ++rep) {
#pragma unroll
            for (int tk = 0; tk < 4; ++tk) { hacc[tk][0] = 0.f; hacc[tk][1] = 0.f; }
#pragma unroll 1
            for (int s = 0; s < NSLICE; ++s) {
#pragma unroll
                for (int tk = 0; tk < 4; ++tk) {
                    v4u w0[8], w1[8], x0, x1; f32x2v xf2[8]; float part[16];
                    PEER_LOAD_X(x0, x1, s, tk); PEER_LOAD_A(w0, s, tk, 0); PEER_LOAD_A(w1, s, tk, 1); __builtin_amdgcn_sched_barrier(0);
#pragma unroll
                    for (int c = 0; c < 4; ++c) { const unsigned a0 = x0[c], a1 = x1[c]; xf2[c] = (f32x2v){bf_lo(a0), bf_hi(a0)}; xf2[4 + c] = (f32x2v){bf_lo(a1), bf_hi(a1)}; }
                    PEER_COMP_A(w0, 0); __builtin_amdgcn_sched_barrier(0);
                    PEER_COMP_A(w1, 1); __builtin_amdgcn_sched_barrier(0);
                    treduce<16>(part, lane, 1); treduce<8>(reinterpret_cast<float (&)[8]>(part), lane, 2); treduce<4>(reinterpret_cast<float (&)[4]>(part), lane, 4);
                    hacc[tk][0] += part[0]; hacc[tk][1] += part[1]; __builtin_amdgcn_sched_barrier(0);
                }
                __builtin_amdgcn_s_barrier();
            }
        }
#undef PEER_LOAD_X
#undef PEER_LOAD_A
#undef PEER_COMP_A
#pragma unroll
        for (int tk = 0; tk < 4; ++tk) {
            const int t = tb + tk;
            const float rs2 = (1.0f / EU_SCALE) / sqrtf(__hip_atomic_load(F_SSQ2 + t, RLX_AGENT) * (1.0f / DM) + EPS);
#pragma unroll
            for (int j = 0; j < 2; ++j) {
                const int i = 8 * (p & 1) + 4 * ((p >> 1) & 1) + 2 * ((p >> 2) & 1) + j;
                const float hv = hacc[tk][j] * rs2;
                const float ge = 0.5f * hv * (1.0f + erff(hv * 0.70710678118654752f));
                alds[tk * 128 + g * 16 + i] = F_GATE[(size_t)t * 128 + 8 * i + g] * ge * (1.0f / EV_SCALE);
            }
        }
        LDS_WAIT(); asm volatile("" ::: "memory");
        float ssq[4] = {0.f, 0.f, 0.f, 0.f};
#define PEER_LOAD_B(W, S, TK, H) do { _Pragma("unroll") for (int i = 0; i < 8; ++i) W[i] = __builtin_amdgcn_raw_buffer_load_b128(rsv, PEER_VOFF(TK, 8 * (H) + i), (S) * SLICE_BYTES, 0); } while (0)
#define PEER_COMP_B(W, TK, H) do { f32x4 av[2]; \
        _Pragma("unroll") for (int q4 = 0; q4 < 2; ++q4) av[q4] = *(const LAS f32x4*)(alds + (TK) * 128 + g * 16 + 8 * (H) + 4 * q4); \
        _Pragma("unroll") for (int i = 0; i < 8; ++i) { const float a = av[i >> 2][i & 3]; const f32x2v a2 = {a, a}; \
            _Pragma("unroll") for (int c = 0; c < 4; ++c) { const int wv = (int)W[i][c]; const f32x2v lo = __builtin_amdgcn_cvt_pk_f32_fp8(wv, false), hi = __builtin_amdgcn_cvt_pk_f32_fp8(wv, true); \
                oc2[2 * c] += a2 * lo; oc2[2 * c + 1] += a2 * hi; } if (i & 1) __builtin_amdgcn_sched_barrier(0); } } while (0)
        {
#pragma unroll 1
            for (int s = 0; s < NSLICE; ++s) {
#pragma unroll
                for (int tk = 0; tk < 4; ++tk) {
                    v4u w0[8], w1[8]; f32x2v oc2[8]; float oc[16];
                    PEER_LOAD_B(w0, s, tk, 0); PEER_LOAD_B(w1, s, tk, 1); __builtin_amdgcn_sched_barrier(0);
#pragma unroll
                    for (int c = 0; c < 8; ++c) oc2[c] = (f32x2v){0.f, 0.f};
                    PEER_COMP_B(w0, tk, 0); __builtin_amdgcn_sched_barrier(0);
                    PEER_COMP_B(w1, tk, 1); __builtin_amdgcn_sched_barrier(0);
#pragma unroll
                    for (int c = 0; c < 8; ++c) { oc[2 * c] = oc2[c].x; oc[2 * c + 1] = oc2[c].y; }
                    treduce<16>(oc, lane, 8); treduce<8>(reinterpret_cast<float (&)[8]>(oc), lane, 16); treduce<4>(reinterpret_cast<float (&)[4]>(oc), lane, 32);
                    const int so = (tb + tk) * DM + 128 * s;
                    const v2u hv2 = __builtin_amdgcn_raw_buffer_load_b64(rsh, cl * 4u, so * 4, 0);
                    const float h2a = __uint_as_float(hv2.x) + oc[0], h2b = __uint_as_float(hv2.y) + oc[1];
                    v2u st; st.x = __float_as_uint(h2a); st.y = __float_as_uint(h2b);
                    __builtin_amdgcn_raw_buffer_store_b64(st, rsh, cl * 4u, so * 4, 0);
                    __builtin_amdgcn_raw_buffer_store_b32(pk2(h2a, h2b), rsb, cl * 2u, so * 2, 0); ssq[tk] += h2a * h2a + h2b * h2b;
                    __builtin_amdgcn_sched_barrier(0);
                }
                __builtin_amdgcn_s_barrier();
            }
        }
#undef PEER_LOAD_B
#undef PEER_COMP_B
#pragma unroll
        for (int tk = 0; tk < 4; ++tk) { const float ss = wave_sum(ssq[tk]); if (lane == 0) F_RSTD3[tb + tk] = 1.0f / sqrtf(ss * (1.0f / DM) + EPS); }
        LDS_WAIT(); asm volatile("" ::: "memory");
    }
}

struct Args { const void* in[18]; float* out; unsigned char* ws; int ph_lo, ph_hi, li, pad; };
__global__ void __launch_bounds__(NWAVES * 64, 2) hymba_fwd(Args args) {
    extern __shared__ __attribute__((aligned(16))) unsigned char lds[];
    Frame F;
    F.lds = (LAS unsigned char*)lds;
    F.MISC = (volatile LAS unsigned*)(F.lds + MISC_OFF);
    F.tid = threadIdx.x; F.lane = F.tid & 63; F.wave = __builtin_amdgcn_readfirstlane(F.tid >> 6);
    F.G = gridDim.x; { const int bx = blockIdx.x; F.vcu = (F.G % 8 == 0) ? (bx % 8) * (F.G / 8) + bx / 8 : bx; }
    F.ws = args.ws;
    F.ctl = (gu32*)(F.ws + WS_CTL);
    F.x = (const float*)args.in[0]; F.p = (const float*)args.in[1]; F.positions = (const int*)args.in[2]; F.g_mix = (const float*)args.in[3]; F.w_in = (const float*)args.in[4];
    F.sinks = (const float*)args.in[5]; F.w_pool = (const float*)args.in[6]; F.pool_scale = (const float*)args.in[7]; F.w_out = (const float*)args.in[8]; F.g_ffn = (const float*)args.in[9];
    F.w_query = (const float*)args.in[10]; F.sub_keys = (const float*)args.in[11]; F.expert_u = (const float*)args.in[12]; F.expert_v = (const float*)args.in[13]; F.g_ple = (const float*)args.in[14];
    F.w_ple_gate = (const float*)args.in[15]; F.w_ple_proj = (const float*)args.in[16]; F.g_final = (const float*)args.in[17]; F.out = args.out;
    for (int u = F.tid; u < (LDS_BYTES - LDSCTL_OFF) / 4; u += NWAVES * 64) ((LAS unsigned*)(F.lds + LDSCTL_OFF))[u] = 0u;
    __syncthreads();
    const bool one_phase = (args.ph_hi - args.ph_lo) == 1;
    XcdBarrier bar; bar.bar = (unsigned*)(F.ctl + CW_BAR); bar.x = 0; bar.st = nullptr;
    if (!one_phase) bar = xcd_barrier_post((unsigned*)(F.ctl + CW_BAR), F.MISC + 8);
    const int lo = args.ph_lo, hi = args.ph_hi;
#define IN(k) (lo <= (k) && (k) < hi)
#define BOTH(k) (IN(k) && IN((k) + 1))
#define GRID_BAR() xcd_barrier(bar)

    if (IN(0)) { for (int rep = 0; rep < NREP(0); ++rep) p0_prologue(F); p1_queue(F, 0, Q_SPLIT, CW_QUEUE0); if (BOTH(0)) GRID_BAR(); }

    if (IN(1)) {
        for (int rep = 0; rep < NREP(1); ++rep) {
        { pg8::Gemm g{F_XB, F_Win_t, M, INW, DM, DM, DM}; pg8::StaticOrder S; S.init(M, INW, F.G, (int)blockIdx.x);
          EpiG1 E{F_QB, F_KB, F_VB, F_UB, F_RSTD1, F_ROPE};
          pg8::gemm_phase<EpiG1, pg8::StaticOrder, true, true>(F.lds + RING_OFF, g, S, E); }
        { pg8::Gemm g{F_PB, F_Wp_t, M, DM, PLE, PLE, PLE}; PpOrder S; S.init(F.G, (int)blockIdx.x);
          EpiBf16Scale<false> E{F_PP, DM, 0, nullptr};
          pg8::gemm_phase<EpiBf16Scale<false>, PpOrder, false, true>(F.lds + RING_OFF, g, S, E); }
        p1_queue(F, Q_SPLIT, Q_ITEMS, CW_QUEUE);
        }
        if (BOTH(1)) GRID_BAR();
    }

    if (IN(2)) {
        for (int rep = 0; rep < NREP(2); ++rep) {
        if (F.G >= 256) { if ((int)blockIdx.x >= 128) for (int u = (int)blockIdx.x - 128; u < BATCH * 32 * NKVH; u += F.G - 128) attn_unit(F, u); }
        else for (int u = (int)blockIdx.x; u < BATCH * 32 * NKVH; u += F.G) attn_unit(F, u);
        if ((int)blockIdx.x < 128) {
            const int pu = (int)blockIdx.x, pm = pu >> 2, g = pu & 3;
            pool_tile(F, pm, g);
            VM_WAIT(); __syncthreads();
            pg8::Gemm gm{F_POOLED + g * 256, F_Wpool_t + (size_t)g * 65536, M, 256, 256, POOLW, 256}; SingleUnit S{pm, 0};
            EpiBf16Scale<true> E{F_MIX, DM, ATTW + g * 256, F.pool_scale + g * 256};
            pg8::gemm_phase<EpiBf16Scale<true>, SingleUnit, false, true>(F.lds + RING_OFF, gm, S, E);
            __syncthreads();
        }
        }
        if (BOTH(2)) GRID_BAR();
    }

    if (IN(3)) {
        pg8::Gemm g{F_MIX, F_Wout_t, M, DM, DM, DM, DM}; pg8::StaticOrder S; S.init(M, DM, F.G, (int)blockIdx.x);
        EpiG3 E{F.x, F_H1, F_H1B, F_SSQ2};
        pg8::gemm_phase<EpiG3, pg8::StaticOrder, true, true>(F.lds + RING_OFF, g, S, E);
        if (BOTH(3)) GRID_BAR();
    }

    if (IN(4)) {
        pg8::Gemm g{F_H1B, F_Wq_t, M, DM, DM, DM, DM}; pg8::StaticOrder S; S.init(M, DM, F.G, (int)blockIdx.x);
        EpiG4 E{F_QP, F_SSQ2};
        for (int rep = 0; rep < NREP(4); ++rep)
        pg8::gemm_phase<EpiG4, pg8::StaticOrder, true, true>(F.lds + RING_OFF, g, S, E);
        if (BOTH(4)) GRID_BAR();
    }

    if (IN(5)) {
        const int gw = F.vcu * NWAVES + F.wave, NGW = F.G * NWAVES;
        for (int rep = 0; rep < NREP(5); ++rep)
        for (int task = gw; task < M * PKH / 32; task += NGW) route_task(F, task);
        if (BOTH(5)) GRID_BAR();
    }

    if (IN(6)) {
        peer_phase(F);
        __syncthreads();
        if (BOTH(6)) GRID_BAR();
    }

    if (IN(7)) {
        pg8::Gemm g{F_H2B, F_Wg_t, M, DM, DM, DM, DM}; pg8::StaticOrder S; S.init(M, DM, F.G, (int)blockIdx.x);
        EpiG5 E{F_H1, F_PP, F_RSTD3, F.out, F_SSQ4};
        pg8::gemm_phase<EpiG5, pg8::StaticOrder, true, true>(F.lds + RING_OFF, g, S, E);
        if (BOTH(7)) GRID_BAR();
    }

    if (IN(8)) {
        const int gw = F.vcu * NWAVES + F.wave, NGW = F.G * NWAVES;
        for (int m = gw; m < M; m += NGW) {
            const float rs = 1.0f / sqrtf(__hip_atomic_load(F_SSQ4 + m, RLX_AGENT) * (1.0f / DM) + EPS);
            GAS f32x4* orow = (GAS f32x4*)(F.out + (size_t)m * DM) + F.lane; const GAS f32x4* gr = (const GAS f32x4*)F.g_final + F.lane;
#pragma unroll
            for (int j = 0; j < 8; ++j) { const f32x4 v = orow[64 * j]; orow[64 * j] = v * rs * gr[64 * j]; }
        }
    }
#undef IN
#undef BOTH
#undef GRID_BAR
}


#if DBG_ROUTE_BF
__global__ void __launch_bounds__(NWAVES * 64, 2) dbg_route_kernel(Args args) {
    extern __shared__ __attribute__((aligned(16))) unsigned char lds[];
    Frame F; F.lds = (LAS unsigned char*)lds; F.tid = threadIdx.x; F.lane = F.tid & 63; F.wave = F.tid >> 6; F.G = gridDim.x; F.vcu = blockIdx.x; F.ws = args.ws; F.sub_keys = (const float*)args.in[11];
    route_bruteforce(F);
}
#endif
extern "C" void kernel_launch(void* const* d_in, const int* in_sizes, int n_in, void* d_out, int out_size, void* d_ws, size_t ws_size, hipStream_t stream) {
    static int grid = 0;
    if (grid == 0) {
        if (n_in != 18 || out_size != M * DM || ws_size < WS_END) { fprintf(stderr, "kernel_launch: unexpected shapes (n_in %d, out %d, ws %zu)\n", n_in, out_size, ws_size); grid = -1; return; }
        int dev = 0, cus = 0, per_cu = 0;
        if (hipGetDevice(&dev) != hipSuccess || hipDeviceGetAttribute(&cus, hipDeviceAttributeMultiprocessorCount, dev) != hipSuccess) { grid = -1; return; }
#if DBG_ROUTE_BF
        (void)hipFuncSetAttribute((const void*)dbg_route_kernel, hipFuncAttributeMaxDynamicSharedMemorySize, 98304);
#endif
        if (hipFuncSetAttribute((const void*)hymba_fwd, hipFuncAttributeMaxDynamicSharedMemorySize, LDS_BYTES) != hipSuccess) { fprintf(stderr, "kernel_launch: hipFuncSetAttribute failed\n"); grid = -1; return; }
        if (hipOccupancyMaxActiveBlocksPerMultiprocessor(&per_cu, (const void*)hymba_fwd, NWAVES * 64, LDS_BYTES) != hipSuccess || per_cu < 1)
            fprintf(stderr, "kernel_launch: note: occupancy query reports %d workgroups per CU\n", per_cu);
        (void)hipGetLastError();
        if (cus < 128) { fprintf(stderr, "kernel_launch: needs >= 128 CUs\n"); grid = -1; return; }
        grid = cus;
    }
    if (grid < 0) return;
    if (hipMemsetAsync((char*)d_ws + WS_CTL, 0, CTL_ZERO_BYTES, stream) != hipSuccess) return;
    Args a{};
    for (int i = 0; i < 18; ++i) a.in[i] = d_in[i];
    a.out = (float*)d_out; a.ws = (unsigned char*)d_ws;
    constexpr int NL = MK_N_LAUNCHES;
    for (int li = 0; li < NL; ++li) {
        a.ph_lo = (NL == 1) ? 0 : li; a.ph_hi = (NL == 1) ? N_PHASES : li + 1; a.li = li;
#if DBG_ROUTE_BF
        if (NL == 9 && li == 5) { hipLaunchKernelGGL(dbg_route_kernel, dim3(grid), dim3(NWAVES * 64), 98304, stream, a); continue; }
#endif
        hipLaunchKernelGGL(hymba_fwd, dim3(grid), dim3(NWAVES * 64), LDS_BYTES, stream, a);
    }
}
```

```cpp
#include <hip/hip_runtime.h>
#include <cstdio>
#include <cstdint>
namespace pg8 {
#define PG8_LAS __attribute__((address_space(3)))
typedef unsigned short bf16_t;
typedef short bf16x8 __attribute__((ext_vector_type(8)));
typedef float f32x4 __attribute__((ext_vector_type(4)));
typedef unsigned u32x4 __attribute__((ext_vector_type(4)));
constexpr int BM = 256, BK = 64, HALF = 128, HTB = HALF * BK * 2  , STAGE_BYTES = 8 * HTB, NXCD = 8, WGM = 8;

__host__ __device__ __forceinline__ int lds_byte(int r, int c) { const int st = (r >> 4) * 2 + (c >> 5), rr = r & 15, cc = c & 31, ob = rr * 64 + cc * 2; return st * 1024 + (ob ^ (((ob >> 9) & 1) << 5)); }
__host__ __device__ __forceinline__ void stage_rc(int b, int& R, int& C) { const int st = b / 1024, sb = b % 1024, swz = sb ^ (((sb >> 9) & 1) << 5); R = (st >> 1) * 16 + swz / 64; C = (st & 1) * 32 + (swz % 64) / 2; }
__host__ __device__ __forceinline__ int perm32(int rho) { const int n = rho >> 4, i = rho & 15; return 8 * (i >> 2) + 4 * n + (i & 3); }

struct Unit { int pm, pn; };
struct Gemm { const bf16_t* A; const bf16_t* Bt; int M, N, K, lda, ldb; };

struct StaticOrder {
    int nM, nN, nwg, G, c;
    __host__ __device__ void init(int M, int N, int G_, int c_) { nM = M / BM; nN = N / BM; nwg = nM * nN; G = G_; c = c_; }
    __host__ __device__ bool next(int i, Unit& u) const {
        const long L = (long)i * G + c; if (L >= nwg) return false;
        int wgid = (int)L; { const int q = nwg / NXCD, r = nwg % NXCD, xcd = wgid % NXCD, off = wgid / NXCD; wgid = (xcd < r ? xcd * (q + 1) : r * (q + 1) + (xcd - r) * q) + off; }
        const int nig = WGM * nN, gid = wgid / nig, fm = gid * WGM, gsz = (nM - fm) < WGM ? (nM - fm) : WGM;
        u.pm = fm + ((wgid % nig) % gsz); u.pn = (wgid % nig) / gsz; return true;
    }
    __device__ __forceinline__ void a_ready(const Unit&) const {}
    __device__ __forceinline__ void done(const Unit&) const {}
};

__device__ __forceinline__ unsigned cvt_pk_bf16(float lo, float hi) { unsigned r; asm volatile("v_cvt_pk_bf16_f32 %0, %1, %2" : "=v"(r) : "v"(lo), "v"(hi)); return r; }
typedef float f32x2 __attribute__((ext_vector_type(2)));

template <class Epi, class Sched, bool ALIGN_EPI = false, bool SP2 = false>
__device__ __forceinline__ void gemm_phase(PG8_LAS unsigned char* lds, const Gemm g, const Sched& S, const Epi& E) {
    const int tid = threadIdx.x, wid = __builtin_amdgcn_readfirstlane(tid >> 6), lane = tid & 63, wr = wid >> 2, wc = wid & 3, fr = lane & 15, fq = lane >> 4;
    const int K = g.K, nt = K / BK;
    unsigned voffA[2], voffB[2];
#pragma unroll
    for (int i = 0; i < 2; ++i) { int R, C; stage_rc(tid * 16 + i * 8192, R, C); const int Rb = Epi::PERM ? ((R & ~31) + perm32(R & 31)) : R;
        voffA[i] = (unsigned)(R * g.lda + C) * 2u; voffB[i] = (unsigned)(Rb * g.ldb + C) * 2u; }
    const size_t kstep = (size_t)(BK * 2);
    const size_t hstepA = (size_t)HALF * g.lda * 2, hstepB = (size_t)HALF * g.ldb * 2;
    const size_t tstepA = 2 * hstepA, tstepB = 2 * hstepB;
    const unsigned ldsw = (unsigned)wid * 1024u;
    const int aoff = lds_byte(wr * 64 + fr, fq * 8), boff = lds_byte(wc * 32 + fr, fq * 8);
#define PG8_SA(b, h) (((b) * 2 + (h)) * HTB)
#define PG8_SB(b, h) ((4 + (b) * 2 + (h)) * HTB)
#define PG8_STAGE(bufoff, gbase, voff) do { _Pragma("unroll") for (int _i = 0; _i < 2; ++_i) \
        __builtin_amdgcn_global_load_lds((const unsigned*)((const char*)(gbase) + (voff)[_i]), (PG8_LAS unsigned*)(lds + (bufoff) + ldsw + _i * 8192), 16, 0, 0); } while (0)
#define PG8_LDA(dst, b, h) do { _Pragma("unroll") for (int m = 0; m < 4; ++m) _Pragma("unroll") for (int k = 0; k < 2; ++k) dst[m][k] = *(const PG8_LAS bf16x8*)(lds + PG8_SA(b, h) + aoff + m * 2048 + k * 1024); } while (0)
#define PG8_LDB(dst, b, h) do { _Pragma("unroll") for (int n = 0; n < 2; ++n) _Pragma("unroll") for (int k = 0; k < 2; ++k) dst[n][k] = *(const PG8_LAS bf16x8*)(lds + PG8_SB(b, h) + boff + n * 2048 + k * 1024); } while (0)
#define PG8_MMA(ai, bj, At, Bt) do { __builtin_amdgcn_s_setprio(1); _Pragma("unroll") for (int m = 0; m < 4; ++m) _Pragma("unroll") for (int n = 0; n < 2; ++n) _Pragma("unroll") for (int k = 0; k < 2; ++k) \
        acc[ai][bj][m][n] = __builtin_amdgcn_mfma_f32_16x16x32_bf16(Bt[n][k], At[m][k], acc[ai][bj][m][n], 0, 0, 0); __builtin_amdgcn_s_setprio(0); } while (0)
#define PG8_WAIT_V(n) asm volatile("s_waitcnt vmcnt(" #n ")" ::: "memory")
#define PG8_WAIT_L(n) asm volatile("s_waitcnt lgkmcnt(" #n ")" ::: "memory")
#define PG8_BAR __builtin_amdgcn_s_barrier()
#define PG8_SCHED __builtin_amdgcn_sched_barrier(0)
    Unit cur, nxt; int ui = 0;
    if (!S.next(0, cur)) return;
    f32x4 acc[2][2][4][2];
#pragma unroll
    for (int a = 0; a < 2; ++a)
#pragma unroll
        for (int b = 0; b < 2; ++b)
#pragma unroll
            for (int m = 0; m < 4; ++m)
#pragma unroll
                for (int n = 0; n < 2; ++n) acc[a][b][m][n] = (f32x4){0.f, 0.f, 0.f, 0.f};
    bf16x8 At[4][2], B0[2][2], B1[2][2];
    const char* cA = (const char*)g.A + (size_t)cur.pm * tstepA; const char* cB = (const char*)g.Bt + (size_t)cur.pn * tstepB;
    S.a_ready(cur);
    if constexpr (SP2) {
        PG8_STAGE(PG8_SB(0, 0), cB, voffB); PG8_STAGE(PG8_SB(0, 1), cB + hstepB, voffB); PG8_STAGE(PG8_SA(0, 0), cA, voffA); PG8_STAGE(PG8_SA(0, 1), cA + hstepA, voffA);
        if (wr == 1) PG8_BAR;
        PG8_WAIT_V(2); PG8_BAR;
        PG8_STAGE(PG8_SB(1, 0), cB + kstep, voffB); PG8_STAGE(PG8_SA(1, 0), cA + kstep, voffA); PG8_STAGE(PG8_SB(1, 1), cB + hstepB + kstep, voffB);
        PG8_WAIT_V(6); PG8_BAR;
    } else {
        PG8_STAGE(PG8_SB(0, 0), cB, voffB); PG8_STAGE(PG8_SA(0, 0), cA, voffA); PG8_STAGE(PG8_SB(0, 1), cB + hstepB, voffB); PG8_STAGE(PG8_SA(0, 1), cA + hstepA, voffA);
        if (wr == 1) PG8_BAR;
        PG8_WAIT_V(4); PG8_BAR;
        PG8_STAGE(PG8_SB(1, 0), cB + kstep, voffB); PG8_STAGE(PG8_SA(1, 0), cA + kstep, voffA); PG8_STAGE(PG8_SB(1, 1), cB + hstepB + kstep, voffB);
        PG8_WAIT_V(6); PG8_BAR;
    }
    for (;;) {
        const bool has_next = S.next(ui + 1, nxt);
        const char* nA = has_next ? (const char*)g.A + (size_t)nxt.pm * tstepA : cA; const char* nB = has_next ? (const char*)g.Bt + (size_t)nxt.pn * tstepB : cB;
        for (int t = 0; t < nt; t += 2) {
            const bool last = (t == nt - 2);
            const char* a1 = cA + (size_t)(t + 1) * kstep;
            const char* a2 = last ? nA : cA + (size_t)(t + 2) * kstep; const char* b2 = last ? nB : cB + (size_t)(t + 2) * kstep;
            const char* a3 = a2 + kstep; const char* b3 = b2 + kstep;
            if (last && has_next) S.a_ready(nxt);
            if constexpr (SP2) {
            PG8_LDB(B0, 0, 0); PG8_LDB(B1, 0, 1); PG8_SCHED; PG8_LDA(At, 0, 0); PG8_STAGE(PG8_SA(1, 1), a1 + hstepA, voffA);
            PG8_WAIT_V(8); PG8_WAIT_L(0); PG8_BAR; PG8_MMA(0, 0, At, B0); PG8_MMA(0, 1, At, B1); PG8_BAR; PG8_SCHED;
            PG8_LDA(At, 0, 1); PG8_STAGE(PG8_SB(0, 0), b2, voffB); PG8_STAGE(PG8_SB(0, 1), b2 + hstepB, voffB); PG8_STAGE(PG8_SA(0, 0), a2, voffA);
            PG8_WAIT_V(8); PG8_WAIT_L(0); PG8_BAR; PG8_MMA(1, 0, At, B0); PG8_MMA(1, 1, At, B1); PG8_BAR; PG8_SCHED;
            PG8_LDB(B0, 1, 0); PG8_LDB(B1, 1, 1); PG8_SCHED; PG8_LDA(At, 1, 0); PG8_STAGE(PG8_SA(0, 1), a2 + hstepA, voffA);
            PG8_WAIT_V(8); PG8_WAIT_L(0); PG8_BAR; PG8_MMA(0, 0, At, B0); PG8_MMA(0, 1, At, B1); PG8_BAR; PG8_SCHED;
            PG8_LDA(At, 1, 1); PG8_STAGE(PG8_SB(1, 0), b3, voffB); PG8_STAGE(PG8_SB(1, 1), b3 + hstepB, voffB); PG8_STAGE(PG8_SA(1, 0), a3, voffA);
            PG8_WAIT_V(8); PG8_WAIT_L(0); PG8_BAR; PG8_MMA(1, 0, At, B0); PG8_MMA(1, 1, At, B1); PG8_BAR; PG8_SCHED;
            } else {
            PG8_LDB(B0, 0, 0); PG8_SCHED; PG8_LDA(At, 0, 0); PG8_STAGE(PG8_SA(1, 1), a1 + hstepA, voffA);
            PG8_WAIT_L(8); PG8_BAR; PG8_WAIT_L(0); PG8_MMA(0, 0, At, B0); PG8_BAR; PG8_SCHED;
            PG8_LDB(B1, 0, 1); PG8_STAGE(PG8_SB(0, 0), b2, voffB);
            PG8_BAR; PG8_WAIT_L(0); PG8_MMA(0, 1, At, B1); PG8_BAR;
            PG8_LDA(At, 0, 1); PG8_STAGE(PG8_SA(0, 0), a2, voffA);
            PG8_BAR; PG8_WAIT_L(0); PG8_MMA(1, 0, At, B0); PG8_BAR; PG8_SCHED;
            PG8_STAGE(PG8_SB(0, 1), b2 + hstepB, voffB);
            PG8_WAIT_V(6); PG8_BAR; PG8_MMA(1, 1, At, B1); PG8_BAR;
            PG8_LDB(B0, 1, 0); PG8_SCHED; PG8_LDA(At, 1, 0); PG8_STAGE(PG8_SA(0, 1), a2 + hstepA, voffA);
            PG8_WAIT_L(8); PG8_BAR; PG8_WAIT_L(0); PG8_MMA(0, 0, At, B0); PG8_BAR; PG8_SCHED;
            PG8_LDB(B1, 1, 1); PG8_STAGE(PG8_SB(1, 0), b3, voffB);
            PG8_BAR; PG8_WAIT_L(0); PG8_MMA(0, 1, At, B1); PG8_BAR;
            PG8_LDA(At, 1, 1); PG8_STAGE(PG8_SA(1, 0), a3, voffA);
            PG8_BAR; PG8_WAIT_L(0); PG8_MMA(1, 0, At, B0); PG8_BAR; PG8_SCHED;
            PG8_STAGE(PG8_SB(1, 1), b3 + hstepB, voffB);
            PG8_WAIT_V(6); PG8_BAR; PG8_MMA(1, 1, At, B1); PG8_BAR;
            }
        }
        if constexpr (ALIGN_EPI) { if (wr == 0) PG8_BAR; }
        if constexpr (!Epi::AFTER_DRAIN) { E(acc, cur, wr, wc, fr, fq); S.done(cur); }
        if (!has_next) break;
#pragma unroll
        for (int a = 0; a < 2; ++a)
#pragma unroll
            for (int b = 0; b < 2; ++b)
#pragma unroll
                for (int m = 0; m < 4; ++m)
#pragma unroll
                    for (int n = 0; n < 2; ++n) acc[a][b][m][n] = (f32x4){0.f, 0.f, 0.f, 0.f};
        cur = nxt; cA = nA; cB = nB; ++ui;
        if constexpr (ALIGN_EPI) { if (wr == 1) PG8_BAR; }
    }
    PG8_WAIT_V(0);
    if constexpr (!ALIGN_EPI) { if (wr == 0) PG8_BAR; }
    PG8_BAR;
    if constexpr (Epi::AFTER_DRAIN) { E.fused(acc, cur, wr, wc, fr, fq, lds, wid, lane); S.done(cur); }
#undef PG8_SA
#undef PG8_SB
#undef PG8_STAGE
#undef PG8_LDA
#undef PG8_LDB
#undef PG8_MMA
#undef PG8_WAIT_V
#undef PG8_WAIT_L
#undef PG8_BAR
#undef PG8_SCHED
}
}


constexpr int NWAVES = 8;
constexpr int DM = 2048, BATCH = 2, SEQ = 4096, M = BATCH * SEQ;
constexpr int HD = 64, NQH = 16, NKVH = 4, ATTW = 1024, KVW = 256, POOLW = 1024, INW = 2560;
constexpr int PKH = 8, NEXP = 16384, PLE = 256;
constexpr float EPS = 1e-6f;
constexpr float EU_SCALE = 256.0f, EV_SCALE = 16.0f;
#ifndef MK_N_LAUNCHES
#define MK_N_LAUNCHES 1
#endif
constexpr int N_PHASES = 9;
#ifndef REP_MASK
#define REP_MASK 0
#endif
#define NREP(k) (((REP_MASK >> (k)) & 1) ? 2 : 1)
#ifndef DBG_NO_PEER
#define DBG_NO_PEER 0
#endif
#ifndef DBG_NO_PLE
#define DBG_NO_PLE 0
#endif
#ifndef DBG_NO_MIX
#define DBG_NO_MIX 0
#endif

constexpr size_t MiB = 1u << 20;
constexpr size_t WS_CTL = 0, CTL_ZERO_BYTES = 256 * 1024;
constexpr size_t WS_WIN = 1 * MiB, WS_WOUT = 11 * MiB, WS_WQ = 19 * MiB, WS_WG = 27 * MiB, WS_WP = 35 * MiB, WS_WPOOL = 36 * MiB;
constexpr size_t WS_SKH = 36 * MiB + 512 * 1024, WS_SKL = WS_SKH + 64 * 1024;
constexpr size_t WS_ROPE = 37 * MiB;
constexpr size_t WS_RSTD1 = 37 * MiB + 512 * 1024, WS_RSTD3 = WS_RSTD1 + 32 * 1024;
constexpr size_t WS_EU = 38 * MiB, WS_EV = 102 * MiB;
constexpr size_t WS_XB = 166 * MiB, WS_PB = 198 * MiB;
constexpr size_t WS_Q = 202 * MiB, WS_K = 218 * MiB, WS_V = 222 * MiB, WS_U = 226 * MiB, WS_POOLED = 242 * MiB, WS_MIX = 258 * MiB;
constexpr size_t WS_QP = 202 * MiB;
constexpr size_t WS_EIDX = 266 * MiB, WS_GATE = 270 * MiB;
constexpr size_t WS_H1 = 290 * MiB, WS_H1B = 354 * MiB, WS_PP = 386 * MiB, WS_H2B = 418 * MiB, WS_END = 450 * MiB;
constexpr int CW_QUEUE = 2048, CW_QUEUE0 = 2112;
#ifndef Q_SPLIT
#define Q_SPLIT 0
#endif
constexpr int CW_BAR = 4096;
constexpr int CW_SSQ2 = 16384, CW_SSQ4 = 16384 + 8192;
static_assert((CW_SSQ4 + 8192) * 4 <= (int)CTL_ZERO_BYTES, "ctl");

constexpr int RING_OFF = 0, RING_BYTES = 131072;
constexpr int LDSCTL_OFF = RING_BYTES, MISC_OFF = LDSCTL_OFF + 320;
constexpr int LDS_BYTES = 147456;

#define GAS __attribute__((address_space(1)))
#define LAS __attribute__((address_space(3)))
typedef unsigned short bf16;
typedef unsigned v4u __attribute__((ext_vector_type(4)));
typedef unsigned v2u __attribute__((ext_vector_type(2)));
typedef float f32x4 __attribute__((ext_vector_type(4)));
typedef float f32x16 __attribute__((ext_vector_type(16)));
typedef short bf16x8 __attribute__((ext_vector_type(8)));
typedef GAS unsigned gu32;
#define RLX_AGENT __ATOMIC_RELAXED, __HIP_MEMORY_SCOPE_AGENT
#define LDS_WAIT() asm volatile("s_waitcnt lgkmcnt(0)" ::: "memory")
#define VM_WAIT() asm volatile("s_waitcnt vmcnt(0)" ::: "memory")
typedef float f32x2_t __attribute__((ext_vector_type(2))); typedef __bf16 bf16x2_t __attribute__((ext_vector_type(2)));
__device__ __forceinline__ unsigned pk2(float lo, float hi) { f32x2_t v = {lo, hi}; bf16x2_t b = __builtin_convertvector(v, bf16x2_t); return __builtin_bit_cast(unsigned, b); }
__device__ __forceinline__ float bf_lo(unsigned w) { return __uint_as_float(w << 16); }
__device__ __forceinline__ float bf_hi(unsigned w) { return __uint_as_float(w & 0xffff0000u); }
__device__ __forceinline__ float dot2bf(unsigned a, unsigned b, float c) { return __builtin_amdgcn_fdot2_f32_bf16(__builtin_bit_cast(bf16x2_t, a), __builtin_bit_cast(bf16x2_t, b), c, false); }
__device__ __forceinline__ float max2f(float a, float b) { float r; asm("v_max_f32_e32 %0, %1, %2" : "=v"(r) : "v"(a), "v"(b)); return r; }
__device__ __forceinline__ float min2f(float a, float b) { float r; asm("v_min_f32_e32 %0, %1, %2" : "=v"(r) : "v"(a), "v"(b)); return r; }
__device__ __forceinline__ float wave_sum(float v) {
#pragma unroll
    for (int o = 1; o < 64; o <<= 1) v += __shfl_xor(v, o);
    return v;
}

#define XB_TMO      128
#define XB_XCNT(j)  (256  + 64 * (j))
#define XB_XSUB(j)  (1280 + 64 * (j))
#define XB_XGEN(j)  (2304 + 64 * (j))
#define XB_TOP      3328
#define XB_TOPGEN   3392
#define XCD_BAR_WORDS 3456
#define XB_SPIN_CAP (1u << 18)
__device__ __forceinline__ unsigned xb_ld(unsigned* p)              { return __hip_atomic_load(p, __ATOMIC_RELAXED, __HIP_MEMORY_SCOPE_AGENT); }
__device__ __forceinline__ unsigned xb_add(unsigned* p, unsigned v) { return __hip_atomic_fetch_add(p, v, __ATOMIC_RELAXED, __HIP_MEMORY_SCOPE_AGENT); }
__device__ __forceinline__ unsigned xb_xcc_id() { return (unsigned)__builtin_amdgcn_s_getreg((3 << 11) | 20) & 0xFu; }
#define XB_SPIN(cond, bar) do { unsigned _sp = 0; while (cond) { __builtin_amdgcn_s_sleep(1); \
    if ((++_sp & 255u) == 0u) { if (xb_ld(&(bar)[XB_TMO])) break; if (_sp > XB_SPIN_CAP) { atomicAdd(&(bar)[XB_TMO], 1u); break; } } } } while (0)
struct XcdBarrier { unsigned* bar; unsigned x; volatile LAS unsigned* st; };
__device__ __forceinline__ XcdBarrier xcd_barrier_post(unsigned* bar, volatile LAS unsigned* st) {
    XcdBarrier b; b.bar = bar; b.x = xb_xcc_id(); b.st = st;
    if (threadIdx.x == 0) (void)xb_add(&bar[XB_XCNT(b.x)], 1u);
    return b;
}
__device__ __forceinline__ void xcd_barrier_complete(unsigned* bar, unsigned x, unsigned& nloc, unsigned& nx) {
    const unsigned G = gridDim.x * gridDim.y * gridDim.z;
    unsigned sum, cnt, mine, sp = 0u;
    for (;;) {
        sum = 0u; cnt = 0u; mine = 0u;
#pragma unroll
        for (unsigned j = 0; j < 16; ++j) { const unsigned c = xb_ld(&bar[XB_XCNT(j)]); sum += c; cnt += (c > 0u) ? 1u : 0u; mine = (j == x) ? c : mine; }
        if (sum == G) break;
        __builtin_amdgcn_s_sleep(1);
        if ((++sp & 255u) == 0u) { if (xb_ld(&bar[XB_TMO])) break; if (sp > XB_SPIN_CAP) { atomicAdd(&bar[XB_TMO], 1u); break; } }
    }
    nloc = mine > 0u ? mine : 1u; nx = cnt > 0u ? cnt : 1u;
}
__device__ __forceinline__ void xcd_barrier(const XcdBarrier& b) {
    asm volatile("s_waitcnt vmcnt(0)" ::: "memory");
    __syncthreads();
    if (threadIdx.x == 0) {
        unsigned* bar = b.bar;
        __builtin_amdgcn_s_waitcnt(0);
        unsigned nloc = b.st[0], nx = b.st[1];
        if (nloc == 0u) { xcd_barrier_complete(bar, b.x, nloc, nx); b.st[0] = nloc; b.st[1] = nx; }
        const unsigned old = xb_add(&bar[XB_XSUB(b.x)], 1u);
        const unsigned gen = old / nloc;
        if (old + 1u == (gen + 1u) * nloc) {
            __builtin_amdgcn_fence(__ATOMIC_RELEASE, "agent");
            asm volatile("s_waitcnt vmcnt(0)" ::: "memory");
            const unsigned og = xb_add(&bar[XB_TOP], 1u);
            const unsigned tg = og / nx;
            if (og + 1u == (tg + 1u) * nx) xb_add(&bar[XB_TOPGEN], 1u);
            else XB_SPIN(xb_ld(&bar[XB_TOPGEN]) == tg, bar);
            __builtin_amdgcn_fence(__ATOMIC_ACQUIRE, "agent");
            xb_add(&bar[XB_XGEN(b.x)], 1u);
            asm volatile("s_waitcnt vmcnt(0)" ::: "memory");
        } else {
            XB_SPIN(xb_ld(&bar[XB_XGEN(b.x)]) == gen, bar);
            __builtin_amdgcn_fence(__ATOMIC_ACQUIRE, "agent");
            asm volatile("s_waitcnt vmcnt(0)" ::: "memory");
        }
    }
    __syncthreads();
}

struct Frame {
    LAS unsigned char* lds;
    volatile LAS unsigned* MISC;
    gu32* ctl;
    int tid, lane, wave;
    int vcu, G;
    const float *x, *p, *g_mix, *w_in, *sinks, *w_pool, *pool_scale, *w_out, *g_ffn, *w_query, *sub_keys, *expert_u, *expert_v, *g_ple, *w_ple_gate, *w_ple_proj, *g_final;
    const int* positions;
    float* out;
    unsigned char* ws;
};
#define F_Win_t  ((bf16*)(F.ws + WS_WIN))
#define F_Wout_t ((bf16*)(F.ws + WS_WOUT))
#define F_Wq_t   ((bf16*)(F.ws + WS_WQ))
#define F_Wg_t   ((bf16*)(F.ws + WS_WG))
#define F_Wp_t   ((bf16*)(F.ws + WS_WP))
#define F_Wpool_t ((bf16*)(F.ws + WS_WPOOL))
#define F_SKH    ((bf16*)(F.ws + WS_SKH))
#define F_SKL    ((bf16*)(F.ws + WS_SKL))
#define F_EU     ((bf16*)(F.ws + WS_EU))
#define F_EV     ((bf16*)(F.ws + WS_EV))
#define F_XB     ((bf16*)(F.ws + WS_XB))
#define F_PB     ((bf16*)(F.ws + WS_PB))
#define F_QB     ((bf16*)(F.ws + WS_Q))
#define F_KB     ((bf16*)(F.ws + WS_K))
#define F_VB     ((bf16*)(F.ws + WS_V))
#define F_UB     ((bf16*)(F.ws + WS_U))
#define F_POOLED ((bf16*)(F.ws + WS_POOLED))
#define F_MIX    ((bf16*)(F.ws + WS_MIX))
#define F_H1B    ((bf16*)(F.ws + WS_H1B))
#define F_PP     ((bf16*)(F.ws + WS_PP))
#define F_H2B    ((bf16*)(F.ws + WS_H2B))
#define F_ROPE   ((float*)(F.ws + WS_ROPE))
#define F_RSTD1  ((float*)(F.ws + WS_RSTD1))
#define F_RSTD3  ((float*)(F.ws + WS_RSTD3))
#define F_QP     ((float*)(F.ws + WS_QP))
#define F_GATE   ((float*)(F.ws + WS_GATE))
#define F_H1     ((float*)(F.ws + WS_H1))
#define F_SSQ2   ((float*)(F.ws + WS_CTL) + CW_SSQ2)
#define F_SSQ4   ((float*)(F.ws + WS_CTL) + CW_SSQ4)
#define F_EIDX   ((int*)(F.ws + WS_EIDX))

__device__ __forceinline__ void p0_transpose_item(const float* W, int ldw, int N, const float* gain, bf16* WT, int ldt, LAS float* scr, int item, int lane) {
    const int nblk = N / 32, kb = item / nblk, nb = item % nblk, k0 = 64 * kb, n0 = 32 * nb;
    float wv[32];
#pragma unroll
    for (int i = 0; i < 32; ++i) { const int kk = 2 * i + (lane >> 5); wv[i] = W[(size_t)(k0 + kk) * ldw + n0 + (lane & 31)]; }
    if (gain) {
#pragma unroll
        for (int i = 0; i < 32; ++i) wv[i] *= gain[k0 + 2 * i + (lane >> 5)];
    }
#pragma unroll
    for (int i = 0; i < 32; ++i) { const int kk = 2 * i + (lane >> 5); scr[kk * 33 + (lane & 31)] = wv[i]; }
    LDS_WAIT(); asm volatile("" ::: "memory");
    const int c = lane & 7;
#pragma unroll
    for (int j = 0; j < 4; ++j) { const int n = (lane >> 3) + 8 * j; const LAS float* s = scr + (8 * c) * 33 + n;
        v4u o; o.x = pk2(s[0 * 33], s[1 * 33]); o.y = pk2(s[2 * 33], s[3 * 33]); o.z = pk2(s[4 * 33], s[5 * 33]); o.w = pk2(s[6 * 33], s[7 * 33]);
        *(GAS v4u*)(WT + (size_t)(n0 + n) * ldt + k0 + 8 * c) = o; }
    LDS_WAIT(); asm volatile("" ::: "memory");
}
__device__ __forceinline__ void p0_prologue(Frame& F) {
    LAS float* scr = (LAS float*)(F.lds + RING_OFF + F.wave * 16384);
    const int gw = F.vcu * NWAVES + F.wave, NGW = F.G * NWAVES;
    const int gt = gw * 64 + F.lane, NGT = NGW * 64;
    constexpr int I_IN = (DM / 64) * (INW / 32), I_P = (PLE / 64) * (DM / 32);
    constexpr int NITEMS = I_IN + I_P;
    for (int it = gw; it < NITEMS; it += NGW) {
        int r = it;
        if (r < I_IN) { p0_transpose_item(F.w_in, INW, INW, F.g_mix, F_Win_t, DM, scr, r, F.lane); continue; } r -= I_IN;
        p0_transpose_item(F.w_ple_proj, DM, DM, nullptr, F_Wp_t, PLE, scr, r, F.lane);
    }
    for (int m = gw; m < M; m += NGW) {
        const GAS f32x4* xr = (const GAS f32x4*)(F.x + (size_t)m * DM) + F.lane;
        f32x4 v[8]; float s = 0.f;
#pragma unroll
        for (int j = 0; j < 8; ++j) { v[j] = xr[64 * j]; s += (v[j].x * v[j].x + v[j].y * v[j].y) + (v[j].z * v[j].z + v[j].w * v[j].w); }
        s = wave_sum(s);
        if (F.lane == 0) F_RSTD1[m] = 1.0f / sqrtf(s * (1.0f / DM) + EPS);
        GAS v2u* o8 = (GAS v2u*)(F_XB + (size_t)m * DM) + F.lane;
#pragma unroll
        for (int j = 0; j < 8; ++j) { v2u o; o.x = pk2(v[j].x, v[j].y); o.y = pk2(v[j].z, v[j].w); o8[64 * j] = o; }
    }
    for (int c = gt; c < M * PLE / 8; c += NGT) {
        const GAS f32x4* s = (const GAS f32x4*)F.p + 2 * (size_t)c; const f32x4 a = s[0], b = s[1];
        v4u o; o.x = pk2(a.x, a.y); o.y = pk2(a.z, a.w); o.z = pk2(b.x, b.y); o.w = pk2(b.z, b.w);
        *((GAS v4u*)F_PB + c) = o;
    }
    for (int c = gt; c < M * 8; c += NGT) {
        const int t = c >> 3, i = c & 7;
        const float inv = 1.0f / (float)pow(500000.0, (double)(2 * i) / 16.0);
        const float ang = (float)F.positions[t] * inv;
        F_ROPE[t * 16 + i] = (float)cos((double)ang); F_ROPE[t * 16 + 8 + i] = (float)sin((double)ang);
    }
    for (int c = gt; c < 2 * 128 * 128; c += NGT) {
        const float v = F.sub_keys[c]; const unsigned h = pk2(v, 0.f) & 0xffffu; const float hf = __uint_as_float(h << 16);
        F_SKH[c] = (bf16)h; F_SKL[c] = (bf16)(pk2(v - hf, 0.f) & 0xffffu);
    }
}


constexpr int Q_EXP = 1024, Q_SQ = 256, Q_POOL = 16, Q_ITEMS = Q_EXP + 3 * Q_SQ + Q_POOL;
__device__ __forceinline__ void conv_expert_item(Frame& F, int idx, int tid) {
    const bool isv = idx >= 512; const int e0 = (idx & 511) * 32;
    const float* src = isv ? F.expert_v : F.expert_u; unsigned char* dstb = (unsigned char*)(isv ? (void*)F_EV : (void*)F_EU);
    const float sc = isv ? EV_SCALE : EU_SCALE;
#pragma unroll 4
    for (int cl = tid; cl < 32 * 128; cl += NWAVES * 64) {
        const int e = e0 + (cl >> 7), d0 = (cl & 127) * 16; const size_t dst = ((size_t)(d0 >> 7) * NEXP + e) * 128 + (d0 & 127);
        const GAS f32x4* s = (const GAS f32x4*)(src + (size_t)e * DM + d0); const GAS f32x4* gp = (const GAS f32x4*)(F.g_ffn + d0);
        v4u o;
#pragma unroll
        for (int q = 0; q < 4; ++q) { f32x4 a = s[q] * sc; if (!isv) a = a * gp[q]; int w = 0; w = __builtin_amdgcn_cvt_pk_fp8_f32(a.x, a.y, w, false); w = __builtin_amdgcn_cvt_pk_fp8_f32(a.z, a.w, w, true); o[q] = (unsigned)w; }
        *(GAS v4u*)(dstb + dst) = o;
    }
}
constexpr int Q_W = 3 * Q_SQ + Q_POOL;
__device__ __forceinline__ void p1_queue(Frame& F, int lo, int hi, int cw) {
    const int lane = (int)__builtin_amdgcn_mbcnt_hi(~0u, __builtin_amdgcn_mbcnt_lo(~0u, 0u)), tid = F.wave * 64 + lane;
    LAS float* scr = (LAS float*)(F.lds + RING_OFF + F.wave * 16384);
    volatile LAS unsigned* qslot = F.MISC + 12;
    unsigned mine = 0u;
    __syncthreads();
    if (tid == 0) { qslot[0] = __hip_atomic_fetch_add((unsigned*)(F.ctl + cw), 1u, RLX_AGENT); }
    __syncthreads();
    int idx = lo + (int)qslot[0];
    for (int n = 0;; ++n) {
        if (idx >= hi) break;
        if (tid == 0) mine = __hip_atomic_fetch_add((unsigned*)(F.ctl + cw), 1u, RLX_AGENT);
        if (idx >= Q_W) conv_expert_item(F, idx - Q_W, tid);
        else {
            int r = idx * 8 + F.wave;
            if (r < 8 * Q_SQ) p0_transpose_item(F.w_out, DM, DM, nullptr, F_Wout_t, DM, scr, r, lane);
            else if (r < 16 * Q_SQ) p0_transpose_item(F.w_query, DM, DM, F.g_ffn, F_Wq_t, DM, scr, r - 8 * Q_SQ, lane);
            else if (r < 24 * Q_SQ) p0_transpose_item(F.w_ple_gate, DM, DM, F.g_ple, F_Wg_t, DM, scr, r - 16 * Q_SQ, lane);
            else { const int rp = r - 24 * Q_SQ, g = rp / 32, rr = rp % 32; p0_transpose_item(F.w_pool + (size_t)g * 65536, 256, 256, nullptr, F_Wpool_t + (size_t)g * 65536, 256, scr, rr, lane); }
        }
        if (tid == 0) qslot[1 - (n & 1)] = mine;
        __syncthreads();
        idx = lo + (int)qslot[1 - (n & 1)];
    }
    __syncthreads();
}
struct PpOrder {
    int first, stride;
    __device__ __forceinline__ void init(int G, int c) { const int heavy = (320 > G && 320 - G < G) ? 320 - G : 0; if (c < heavy) { first = 1 << 20; stride = 1; } else { first = c - heavy; stride = G - heavy; } }
    __device__ __forceinline__ bool next(int i, pg8::Unit& u) const { const long k = (long)first + (long)i * stride; if (k >= 256) return false; u.pm = (int)k >> 3; u.pn = (int)k & 7; return true; }
    __device__ __forceinline__ void a_ready(const pg8::Unit&) const {}
    __device__ __forceinline__ void done(const pg8::Unit&) const {}
};

struct EpiG1 {
    static constexpr bool PERM = true, AFTER_DRAIN = false;
    bf16 *Q, *Kb, *Vb, *U; const float* rstd; const float* rope;
    __device__ __forceinline__ void operator()(const f32x4 (&acc)[2][2][4][2], const pg8::Unit& u, int wr, int wc, int fr, int fq) const {
        const int pn = u.pn; bf16* base; int ldc, colt;
        if (pn < 4) { base = Q; ldc = ATTW; colt = pn * 256; } else if (pn == 4) { base = Kb; ldc = KVW; colt = 0; } else if (pn == 5) { base = Vb; ldc = KVW; colt = 0; } else { base = U; ldc = POOLW; colt = (pn - 6) * 256; }
        const bool rot = (pn <= 4) && ((wc & 1) == 0);
        const float qs = (pn < 4) ? 0.125f : 1.0f;
#pragma unroll
        for (int ai = 0; ai < 2; ++ai)
#pragma unroll
            for (int m = 0; m < 4; ++m) {
                const int row = u.pm * 256 + ai * 128 + wr * 64 + m * 16 + fr;
                const float rs = rstd[row] * qs;
                const GAS f32x4* rp = (const GAS f32x4*)(rope + (size_t)row * 16);
#pragma unroll
                for (int bj = 0; bj < 2; ++bj) {
                    f32x4 v0 = acc[ai][bj][m][0] * rs, v1 = acc[ai][bj][m][1] * rs;
                    if (rot) {
                        { const f32x4 c = rp[0], s = rp[2]; f32x4 p;
#pragma unroll
                          for (int i = 0; i < 4; ++i) p[i] = __shfl_xor(v0[i], 16);
                          if (fq == 0) v0 = v0 * c - p * s; else if (fq == 1) v0 = v0 * c + p * s; }
                        { const f32x4 c = rp[1], s = rp[3]; f32x4 p;
#pragma unroll
                          for (int i = 0; i < 4; ++i) p[i] = __shfl_xor(v1[i], 16);
                          if (fq == 0) v1 = v1 * c - p * s; else if (fq == 1) v1 = v1 * c + p * s; }
                    }
                    v4u w; w.x = pk2(v0[0], v0[1]); w.y = pk2(v0[2], v0[3]); w.z = pk2(v1[0], v1[1]); w.w = pk2(v1[2], v1[3]);
                    *(GAS v4u*)(base + (size_t)row * ldc + colt + bj * 128 + wc * 32 + 8 * fq) = w;
                }
            }
    }
};
template <bool HAS_SCALE> struct EpiBf16Scale {
    static constexpr bool PERM = true, AFTER_DRAIN = false;
    bf16* O; int ldc, col_off; const float* cscale;
    __device__ __forceinline__ void operator()(const f32x4 (&acc)[2][2][4][2], const pg8::Unit& u, int wr, int wc, int fr, int fq) const {
        const int c0 = u.pn * 256 + wc * 32 + 8 * fq;
#pragma unroll
        for (int ai = 0; ai < 2; ++ai)
#pragma unroll
            for (int m = 0; m < 4; ++m) {
                const int row = u.pm * 256 + ai * 128 + wr * 64 + m * 16 + fr;
#pragma unroll
                for (int bj = 0; bj < 2; ++bj) {
                    f32x4 v0 = acc[ai][bj][m][0], v1 = acc[ai][bj][m][1];
                    if constexpr (HAS_SCALE) { v0 = v0 * *(const GAS f32x4*)(cscale + c0 + bj * 128); v1 = v1 * *(const GAS f32x4*)(cscale + c0 + bj * 128 + 4); }
                    v4u w; w.x = pk2(v0[0], v0[1]); w.y = pk2(v0[2], v0[3]); w.z = pk2(v1[0], v1[1]); w.w = pk2(v1[2], v1[3]);
                    *(GAS v4u*)(O + (size_t)row * ldc + col_off + c0 + bj * 128) = w;
                }
            }
    }
};
struct EpiG3 {
    static constexpr bool PERM = false, AFTER_DRAIN = false;
    const float* x; float* h1; bf16* h1b; float* ssq;
    __device__ __forceinline__ void operator()(const f32x4 (&acc)[2][2][4][2], const pg8::Unit& u, int wr, int wc, int fr, int fq) const {
        const int col0 = u.pn * 256 + wc * 32 + 4 * fq;
#pragma unroll
        for (int ai = 0; ai < 2; ++ai)
#pragma unroll
            for (int m = 0; m < 4; ++m) {
                const int row = u.pm * 256 + ai * 128 + wr * 64 + m * 16 + fr; float ss = 0.f;
#pragma unroll
                for (int bj = 0; bj < 2; ++bj)
#pragma unroll
                    for (int n = 0; n < 2; ++n) {
                        const size_t off = (size_t)row * DM + col0 + bj * 128 + n * 16;
                        const f32x4 h = DBG_NO_MIX ? *(const GAS f32x4*)(x + off) : *(const GAS f32x4*)(x + off) + acc[ai][bj][m][n];
                        *(GAS f32x4*)(h1 + off) = h;
                        v2u w; w.x = pk2(h[0], h[1]); w.y = pk2(h[2], h[3]); *(GAS v2u*)(h1b + off) = w;
                        ss += (h[0] * h[0] + h[1] * h[1]) + (h[2] * h[2] + h[3] * h[3]);
                    }
                ss += __shfl_xor(ss, 16); ss += __shfl_xor(ss, 32);
                if (fq == 0) atomicAdd(ssq + row, ss);
            }
    }
};
struct EpiG4 {
    static constexpr bool PERM = false, AFTER_DRAIN = false;
    float* qp; const float* ssq;
    __device__ __forceinline__ void operator()(const f32x4 (&acc)[2][2][4][2], const pg8::Unit& u, int wr, int wc, int fr, int fq) const {
        const int col0 = u.pn * 256 + wc * 32 + 4 * fq;
#pragma unroll
        for (int ai = 0; ai < 2; ++ai)
#pragma unroll
            for (int m = 0; m < 4; ++m) {
                const int row = u.pm * 256 + ai * 128 + wr * 64 + m * 16 + fr;
                const float rs = 1.0f / sqrtf(__hip_atomic_load(ssq + row, RLX_AGENT) * (1.0f / DM) + EPS);
#pragma unroll
                for (int bj = 0; bj < 2; ++bj)
#pragma unroll
                    for (int n = 0; n < 2; ++n) *(GAS f32x4*)(qp + (size_t)row * DM + col0 + bj * 128 + n * 16) = acc[ai][bj][m][n] * rs;
            }
    }
};
struct EpiG5 {
    static constexpr bool PERM = false, AFTER_DRAIN = false;
    const float* h2; const bf16* pp; const float* rstd3; float* out; float* ssq;
    __device__ __forceinline__ void operator()(const f32x4 (&acc)[2][2][4][2], const pg8::Unit& u, int wr, int wc, int fr, int fq) const {
        const int col0 = u.pn * 256 + wc * 32 + 4 * fq;
#pragma unroll
        for (int ai = 0; ai < 2; ++ai)
#pragma unroll
            for (int m = 0; m < 4; ++m) {
                const int row = u.pm * 256 + ai * 128 + wr * 64 + m * 16 + fr; float ss = 0.f;
                const float rs = rstd3[row];
#pragma unroll
                for (int bj = 0; bj < 2; ++bj)
#pragma unroll
                    for (int n = 0; n < 2; ++n) {
                        const size_t off = (size_t)row * DM + col0 + bj * 128 + n * 16;
                        const f32x4 z = DBG_NO_PLE ? (f32x4){-1e30f, -1e30f, -1e30f, -1e30f} : acc[ai][bj][m][n] * rs; const v2u pw = *(const GAS v2u*)(pp + off); const f32x4 hv = *(const GAS f32x4*)(h2 + off);
                        f32x4 o;
                        o[0] = hv[0] + bf_lo(pw.x) / (1.0f + __expf(-z[0])); o[1] = hv[1] + bf_hi(pw.x) / (1.0f + __expf(-z[1]));
                        o[2] = hv[2] + bf_lo(pw.y) / (1.0f + __expf(-z[2])); o[3] = hv[3] + bf_hi(pw.y) / (1.0f + __expf(-z[3]));
                        *(GAS f32x4*)(out + off) = o;
                        ss += (o[0] * o[0] + o[1] * o[1]) + (o[2] * o[2] + o[3] * o[3]);
                    }
                ss += __shfl_xor(ss, 16); ss += __shfl_xor(ss, 32);
                if (fq == 0) atomicAdd(ssq + row, ss);
            }
    }
};
struct SingleUnit {
    int pm, pn;
    __device__ __forceinline__ bool next(int i, pg8::Unit& u) const { if (i != 0) return false; u.pm = pm; u.pn = pn; return true; }
    __device__ __forceinline__ void a_ready(const pg8::Unit&) const {}
    __device__ __forceinline__ void done(const pg8::Unit&) const {}
};

__device__ __forceinline__ int crow(int r, int hi) { return (r & 3) + 8 * (r >> 2) + 4 * hi; }
constexpr int KS_STRIDE = 144, VT_STRIDE = 520, VT_OFF = 256 * KS_STRIDE;
__device__ __forceinline__ void attn_unit(Frame& F, int unit) {
    const int g = unit & 3, nblk = (unit >> 2) & 31, b = unit >> 7;
    const int t0 = b * SEQ + nblk * 128;
    LAS unsigned char* Ks = F.lds + RING_OFF;
    LAS unsigned char* Vt = F.lds + RING_OFF + VT_OFF;
    for (int c = F.tid; c < 2048; c += NWAVES * 64) {
        const int j = c >> 3, ch = c & 7;
        v4u kv = {0u, 0u, 0u, 0u}, vv = {0u, 0u, 0u, 0u};
        if (nblk > 0 || j >= 128) { const size_t row = (size_t)(t0 - 128 + j); kv = *(const GAS v4u*)(F_KB + row * KVW + g * 64 + ch * 8); vv = *(const GAS v4u*)(F_VB + row * KVW + g * 64 + ch * 8); }
        *(LAS v4u*)(Ks + j * KS_STRIDE + ch * 16) = kv;
#pragma unroll
        for (int e = 0; e < 8; ++e) *(LAS unsigned short*)(Vt + (ch * 8 + e) * VT_STRIDE + j * 2) = (unsigned short)((vv[e >> 1] >> (16 * (e & 1))) & 0xffffu);
    }
    __syncthreads();
    const int hq = 4 * g + (F.wave >> 1);
    const float sink = F.sinks[hq];
    const int q = F.lane & 31, h = F.lane >> 5;
#pragma unroll 1
    for (int sub = 0; sub < 2; ++sub) {
        const int i0 = (F.wave & 1) * 64 + sub * 32;
        bf16x8 qf[4];
#pragma unroll
        for (int ks = 0; ks < 4; ++ks) qf[ks] = *(const GAS bf16x8*)(F_QB + (size_t)(t0 + i0 + q) * ATTW + hq * 64 + 16 * ks + 8 * h);
        f32x16 s[5];
#pragma unroll
        for (int kt = 0; kt < 5; ++kt) {
#pragma unroll
            for (int r = 0; r < 16; ++r) s[kt][r] = 0.f;
#pragma unroll
            for (int ks = 0; ks < 4; ++ks) {
                const bf16x8 a = *(const LAS bf16x8*)(Ks + (i0 + 32 * kt + q) * KS_STRIDE + (16 * ks + 8 * h) * 2);
                s[kt] = __builtin_amdgcn_mfma_f32_32x32x16_bf16(a, qf[ks], s[kt], 0, 0, 0);
            }
        }
        float mx = sink;
#pragma unroll
        for (int kt = 0; kt < 5; ++kt)
#pragma unroll
            for (int r = 0; r < 16; ++r) {
                const bool tv = (nblk > 0) || (i0 + 32 * kt >= 128);
                const bool ok = (kt == 0) ? (crow(r, h) > q) : (kt == 4) ? (crow(r, h) <= q) : true;
                const float v = (ok && tv) ? s[kt][r] : -INFINITY;
                s[kt][r] = v; mx = fmaxf(mx, v);
            }
        mx = fmaxf(mx, __shfl_xor(mx, 32));
        float sum = 0.f;
#pragma unroll
        for (int kt = 0; kt < 5; ++kt)
#pragma unroll
            for (int r = 0; r < 16; ++r) { const float pv = __expf(s[kt][r] - mx); s[kt][r] = pv; sum += pv; }
        sum += __shfl_xor(sum, 32);
        sum += __expf(sink - mx);
        const float inv = 1.0f / sum;
        f32x16 o[2];
#pragma unroll
        for (int dt = 0; dt < 2; ++dt)
#pragma unroll
            for (int r = 0; r < 16; ++r) o[dt][r] = 0.f;
#pragma unroll
        for (int kt = 0; kt < 5; ++kt)
#pragma unroll
            for (int st = 0; st < 2; ++st) {
                v4u pw; pw.x = pk2(s[kt][8 * st + 0], s[kt][8 * st + 1]); pw.y = pk2(s[kt][8 * st + 2], s[kt][8 * st + 3]); pw.z = pk2(s[kt][8 * st + 4], s[kt][8 * st + 5]); pw.w = pk2(s[kt][8 * st + 6], s[kt][8 * st + 7]);
                const bf16x8 pb = __builtin_bit_cast(bf16x8, pw);
#pragma unroll
                for (int dt = 0; dt < 2; ++dt) {
                    const LAS unsigned char* vb = Vt + (32 * dt + q) * VT_STRIDE + (i0 + 32 * kt + 16 * st + 4 * h) * 2;
                    const v2u lo = *(const LAS v2u*)vb, hi2 = *(const LAS v2u*)(vb + 16);
                    v4u aw; aw.x = lo.x; aw.y = lo.y; aw.z = hi2.x; aw.w = hi2.y;
                    o[dt] = __builtin_amdgcn_mfma_f32_32x32x16_bf16(__builtin_bit_cast(bf16x8, aw), pb, o[dt], 0, 0, 0);
                }
            }
        bf16* orow = F_MIX + (size_t)(t0 + i0 + q) * DM + hq * 64;
#pragma unroll
        for (int dt = 0; dt < 2; ++dt)
#pragma unroll
            for (int g4 = 0; g4 < 4; ++g4) {
                v2u w; w.x = pk2(o[dt][4 * g4] * inv, o[dt][4 * g4 + 1] * inv); w.y = pk2(o[dt][4 * g4 + 2] * inv, o[dt][4 * g4 + 3] * inv);
                *(GAS v2u*)(orow + 32 * dt + 8 * g4 + 4 * h) = w;
            }
    }
    __syncthreads();
}
template <int W> __device__ __forceinline__ void pool_tile_w(Frame& F, int pm, int g) {
    const int cg = F.tid & 31, rg = F.tid >> 5;
    const int r0 = pm * 256 + rg * 16;
    const int col = g * 256 + cg * 8;
    const int tseq0 = r0 & (SEQ - 1);
    const __amdgpu_buffer_rsrc_t rsu = __builtin_amdgcn_make_buffer_rsrc((void*)F_UB, 0, M * POOLW * 2, 0x00020000);
    const __amdgpu_buffer_rsrc_t rsp = __builtin_amdgcn_make_buffer_rsrc((void*)F_POOLED, 0, M * POOLW * 2, 0x00020000);
    v4u rows[W - 1 + 16];
#pragma unroll
    for (int j = 0; j < W - 1 + 16; ++j) { const int rr = r0 - (W - 1) + j; const bool ok = (tseq0 - (W - 1) + j) >= 0;
        rows[j] = __builtin_amdgcn_raw_buffer_load_b128(rsu, ok ? (unsigned)(rr * POOLW + col) * 2u : 0xFFFFFFF0u, 0, 0); }
    float sum[8];
#pragma unroll
    for (int e = 0; e < 8; ++e) sum[e] = 0.f;
#pragma unroll
    for (int j = 0; j < W - 1; ++j)
#pragma unroll
        for (int e = 0; e < 4; ++e) { const unsigned wv = rows[j][e]; sum[2 * e] += bf_lo(wv); sum[2 * e + 1] += bf_hi(wv); }
#pragma unroll
    for (int i = 0; i < 16; ++i) {
        const int ts = tseq0 + i;
        float cur[8];
#pragma unroll
        for (int e = 0; e < 4; ++e) { const unsigned wv = rows[W - 1 + i][e]; cur[2 * e] = bf_lo(wv); cur[2 * e + 1] = bf_hi(wv); }
#pragma unroll
        for (int e = 0; e < 8; ++e) sum[e] += cur[e];
        const int cnt = (ts + 1 < W) ? ts + 1 : W; const float ic = 1.0f / (float)cnt;
        v4u o;
        o.x = pk2(sum[0] * ic - cur[0], sum[1] * ic - cur[1]); o.y = pk2(sum[2] * ic - cur[2], sum[3] * ic - cur[3]);
        o.z = pk2(sum[4] * ic - cur[4], sum[5] * ic - cur[5]); o.w = pk2(sum[6] * ic - cur[6], sum[7] * ic - cur[7]);
        __builtin_amdgcn_raw_buffer_store_b128(o, rsp, (unsigned)((r0 + i) * POOLW + col) * 2u, 0, 0);
#pragma unroll
        for (int e = 0; e < 4; ++e) { const unsigned wv = rows[i][e]; sum[2 * e] -= bf_lo(wv); sum[2 * e + 1] -= bf_hi(wv); }
    }
}
__device__ __forceinline__ void pool_tile(Frame& F, int pm, int g) {
    if (g == 0) pool_tile_w<2>(F, pm, g); else if (g == 1) pool_tile_w<4>(F, pm, g); else if (g == 2) pool_tile_w<8>(F, pm, g); else pool_tile_w<16>(F, pm, g);
}

template <int N> __device__ __forceinline__ void insert_desc(float (&val)[N], float x) {
#pragma unroll
    for (int k = 0; k < N; ++k) { const float hi = max2f(x, val[k]); x = min2f(x, val[k]); val[k] = hi; }
}
__device__ __forceinline__ void bitonic_merge16(float (&m)[16]) {
#pragma unroll
    for (int st = 8; st >= 1; st >>= 1)
#pragma unroll
        for (int i = 0; i < 16; ++i) if ((i & st) == 0) { const float hi = max2f(m[i], m[i + st]), lo = min2f(m[i], m[i + st]); m[i] = hi; m[i + st] = lo; }
}
__device__ __forceinline__ void merge_partner16(float (&val)[16]) {
    float pr[16];
#pragma unroll
    for (int k = 0; k < 16; ++k) pr[k] = __shfl_xor(val[k], 32);
#pragma unroll
    for (int k = 0; k < 16; ++k) val[k] = max2f(val[k], pr[15 - k]);
    bitonic_merge16(val);
}
__device__ __forceinline__ void pin16(float (&v)[16]) {
#pragma unroll
    for (int k = 0; k < 16; ++k) asm volatile("" : "+v"(v[k]));
}
struct CandTab { int a[50], b[50]; };
__host__ __device__ constexpr CandTab make_cands() { CandTab t{}; int n = 0; for (int a = 0; a < 16; ++a) for (int b = 0; b < 16; ++b) if ((a + 1) * (b + 1) <= 16) { t.a[n] = a; t.b[n] = b; ++n; } return t; }
__device__ __forceinline__ float vsel(unsigned long long m, float a, float b) { float r; asm("v_cndmask_b32_e64 %0, %1, %2, %3" : "=v"(r) : "v"(b), "v"(a), "s"(m)); return r; }
__device__ __forceinline__ float sel16(const float (&L)[16], int a) { float r = L[0];
#pragma unroll
    for (int k = 1; k < 16; ++k) r = vsel(__ballot(a == k), L[k], r);
    return r; }
constexpr int SK_ROW = 272;
template <int HALF_>
__device__ __forceinline__ void route_stage(Frame& F) {
    for (int c = F.tid; c < 2 * 128 * 16; c += NWAVES * 64) {
        const int tab = c >> 11, row = (c >> 4) & 127, ch = c & 15;
        const v4u v = *(const GAS v4u*)((tab ? F_SKL : F_SKH) + HALF_ * 16384 + row * 128 + ch * 8);
        *(LAS v4u*)(F.lds + RING_OFF + tab * 128 * SK_ROW + row * SK_ROW + ch * 16) = v;
    }
}
template <int HALF_>
__device__ __forceinline__ void route_half(Frame& F, const float* qrow, int r, int h, float (&Lout)[16]) {
    f32x16 acc[4];
#pragma unroll
    for (int kt = 0; kt < 4; ++kt)
#pragma unroll
        for (int i = 0; i < 16; ++i) acc[kt][i] = 0.f;
    const LAS unsigned char* skh = F.lds + RING_OFF; const LAS unsigned char* skl = F.lds + RING_OFF + 128 * SK_ROW;
#pragma unroll
    for (int ks = 0; ks < 8; ++ks) {
        const f32x4 qa = *(const GAS f32x4*)(qrow + HALF_ * 128 + 16 * ks + 8 * h), qb = *(const GAS f32x4*)(qrow + HALF_ * 128 + 16 * ks + 8 * h + 4);
        v4u hw, lw;
        hw.x = pk2(qa.x, qa.y); hw.y = pk2(qa.z, qa.w); hw.z = pk2(qb.x, qb.y); hw.w = pk2(qb.z, qb.w);
        lw.x = pk2(qa.x - bf_lo(hw.x), qa.y - bf_hi(hw.x)); lw.y = pk2(qa.z - bf_lo(hw.y), qa.w - bf_hi(hw.y));
        lw.z = pk2(qb.x - bf_lo(hw.z), qb.y - bf_hi(hw.z)); lw.w = pk2(qb.z - bf_lo(hw.w), qb.w - bf_hi(hw.w));
        const bf16x8 bh = __builtin_bit_cast(bf16x8, hw), bl = __builtin_bit_cast(bf16x8, lw);
#pragma unroll
        for (int kt = 0; kt < 4; ++kt) {
            const bf16x8 ah = *(const LAS bf16x8*)(skh + (32 * kt + r) * SK_ROW + (16 * ks + 8 * h) * 2), al = *(const LAS bf16x8*)(skl + (32 * kt + r) * SK_ROW + (16 * ks + 8 * h) * 2);
            acc[kt] = __builtin_amdgcn_mfma_f32_32x32x16_bf16(ah, bh, acc[kt], 0, 0, 0);
            acc[kt] = __builtin_amdgcn_mfma_f32_32x32x16_bf16(al, bh, acc[kt], 0, 0, 0);
            acc[kt] = __builtin_amdgcn_mfma_f32_32x32x16_bf16(ah, bl, acc[kt], 0, 0, 0);
        }
    }
#pragma unroll
    for (int k = 0; k < 16; ++k) Lout[k] = -INFINITY;
#pragma unroll
    for (int kt = 0; kt < 4; ++kt)
#pragma unroll
        for (int i = 0; i < 16; ++i) {
            const unsigned n = (unsigned)(32 * kt + (i & 3) + 8 * (i >> 2) + 4 * h);
            insert_desc<16>(Lout, __uint_as_float((__float_as_uint(acc[kt][i]) & ~127u) | n));
        }
    merge_partner16(Lout);
}
__device__ __forceinline__ void route_task(Frame& F, int task, bool valid) {
    const int r = F.lane & 31, h = F.lane >> 5;
    const int item = task * 32 + r, tok = item >> 3, head = item & 7;
    const float* qrow = F_QP + (size_t)tok * DM + head * 256;
    float L0[16], L1[16];
    __syncthreads(); route_stage<0>(F); __syncthreads();
    if (valid) route_half<0>(F, qrow, r, h, L0);
    __syncthreads(); route_stage<1>(F); __syncthreads();
    if (valid) route_half<1>(F, qrow, r, h, L1);
    if (!valid) return;
    pin16(L0); pin16(L1);
    constexpr CandTab CT = make_cands();
    const unsigned long long hm = __ballot(h != 0);
    float cand[16];
#pragma unroll
    for (int k = 0; k < 16; ++k) cand[k] = -INFINITY;
#pragma unroll
    for (int i = 0; i < 25; ++i) {
        const float v1 = vsel(hm, L0[CT.a[2 * i + 1]], L0[CT.a[2 * i]]);
        const float v2 = vsel(hm, L1[CT.b[2 * i + 1]], L1[CT.b[2 * i]]);
        const unsigned id = h ? (unsigned)(CT.a[2 * i + 1] * 16 + CT.b[2 * i + 1]) : (unsigned)(CT.a[2 * i] * 16 + CT.b[2 * i]);
        const float sm = __uint_as_float(__float_as_uint(v1) & ~127u) + __uint_as_float(__float_as_uint(v2) & ~127u);
        insert_desc<16>(cand, __uint_as_float((__float_as_uint(sm) & ~255u) | id));
    }
    merge_partner16(cand);
    pin16(cand);
    float se = 0.f;
#pragma unroll
    for (int k = 0; k < 16; ++k) se += __expf(cand[k] - cand[0]);
    const float ise = 1.0f / se;
    int eo[8]; float go[8];
#pragma unroll
    for (int kk = 0; kk < 8; ++kk) {
        const float cv = vsel(hm, cand[8 + kk], cand[kk]);
        const unsigned id = __float_as_uint(cv) & 255u; const int a = (int)(id >> 4), bb = (int)(id & 15u);
        const unsigned i1 = __float_as_uint(sel16(L0, a)) & 127u, i2 = __float_as_uint(sel16(L1, bb)) & 127u;
        eo[kk] = (int)(i1 * 128u + i2); go[kk] = __expf(cv - cand[0]) * ise;
    }
    int* ep = F_EIDX + (size_t)tok * 128 + head * 16 + 8 * h; float* gp = F_GATE + (size_t)tok * 128 + head * 16 + 8 * h;
    *(GAS v4u*)ep = (v4u){(unsigned)eo[0], (unsigned)eo[1], (unsigned)eo[2], (unsigned)eo[3]}; *(GAS v4u*)(ep + 4) = (v4u){(unsigned)eo[4], (unsigned)eo[5], (unsigned)eo[6], (unsigned)eo[7]};
    *(GAS f32x4*)gp = (f32x4){go[0], go[1], go[2], go[3]}; *(GAS f32x4*)(gp + 4) = (f32x4){go[4], go[5], go[6], go[7]};
}


#ifndef DBG_ROUTE_BF
#define DBG_ROUTE_BF 0
#endif
__device__ __forceinline__ void lds_insert(LAS float* V, LAS int* I, int tid, float x, int id) {
    if (x > V[15 * 256 + tid]) {
        int pos = 15;
        while (pos > 0 && V[(pos - 1) * 256 + tid] < x) { V[pos * 256 + tid] = V[(pos - 1) * 256 + tid]; I[pos * 256 + tid] = I[(pos - 1) * 256 + tid]; --pos; }
        V[pos * 256 + tid] = x; I[pos * 256 + tid] = id;
    }
}
__device__ __forceinline__ void route_bruteforce(Frame& F) {
    if (F.tid >= 256) return;
    const int tid = F.tid;
    LAS float* V0 = (LAS float*)(F.lds); LAS int* I0 = (LAS int*)(F.lds + 16384);
    LAS float* V1 = (LAS float*)(F.lds + 32768); LAS int* I1 = (LAS int*)(F.lds + 49152);
    LAS float* VC = (LAS float*)(F.lds + 65536); LAS int* IC = (LAS int*)(F.lds + 81920);
    for (int item = (int)blockIdx.x * 256 + tid; item < M * PKH; item += F.G * 256) {
        const int tok = item >> 3, head = item & 7;
        const float* qrow = F_QP + (size_t)tok * DM + head * 256;
        for (int k = 0; k < 16; ++k) { V0[k * 256 + tid] = -INFINITY; I0[k * 256 + tid] = 0; V1[k * 256 + tid] = -INFINITY; I1[k * 256 + tid] = 0; VC[k * 256 + tid] = -INFINITY; IC[k * 256 + tid] = 0; }
        for (int half = 0; half < 2; ++half) {
            float q[128];
#pragma unroll
            for (int d = 0; d < 128; d += 4) { const f32x4 t = *(const GAS f32x4*)(qrow + half * 128 + d); q[d] = t.x; q[d + 1] = t.y; q[d + 2] = t.z; q[d + 3] = t.w; }
            for (int n = 0; n < 128; ++n) {
                const float* sk = F.sub_keys + (size_t)half * 16384 + n * 128;
                float s = 0.f;
#pragma unroll
                for (int d = 0; d < 128; ++d) s += q[d] * sk[d];
                if (half == 0) lds_insert(V0, I0, tid, s, n); else lds_insert(V1, I1, tid, s, n);
            }
        }
        for (int a = 0; a < 16; ++a) for (int b = 0; b < 16; ++b) lds_insert(VC, IC, tid, V0[a * 256 + tid] + V1[b * 256 + tid], I0[a * 256 + tid] * 128 + I1[b * 256 + tid]);
        const float mx = VC[tid]; float se = 0.f;
        for (int k = 0; k < 16; ++k) se += __expf(VC[k * 256 + tid] - mx);
        for (int k = 0; k < 16; ++k) { F_EIDX[(size_t)tok * 128 + head * 16 + k] = IC[k * 256 + tid]; F_GATE[(size_t)tok * 128 + head * 16 + k] = __expf(VC[k * 256 + tid] - mx) / se; }
    }
}

template <int N> __device__ __forceinline__ void treduce(float (&v)[N], int lane, int d) {
    const bool up = (lane & d) != 0;
#pragma unroll
    for (int i = 0; i < N / 2; ++i) { const float send = up ? v[i] : v[i + N / 2], keep = up ? v[i + N / 2] : v[i]; v[i] = keep + __shfl_xor(send, d); }
}
constexpr int SLICE_BYTES = NEXP * 128;
constexpr int NSLICE = 16;
typedef float f32x2v __attribute__((ext_vector_type(2)));
__device__ __forceinline__ void peer_phase(Frame& F) {
    const int lane = F.lane, g = lane >> 3, p = lane & 7;
    const int tbase = (int)blockIdx.x * 32 + F.wave * 4;
    LAS float* alds = (LAS float*)(F.lds + RING_OFF + F.wave * 2048);
    const __amdgpu_buffer_rsrc_t rsu = __builtin_amdgcn_make_buffer_rsrc((void*)F_EU, 0, NEXP * DM, 0x00020000);
    const __amdgpu_buffer_rsrc_t rsv = __builtin_amdgcn_make_buffer_rsrc((void*)F_EV, 0, NEXP * DM, 0x00020000);
    const __amdgpu_buffer_rsrc_t rsx = __builtin_amdgcn_make_buffer_rsrc((void*)F_H1B, 0, M * DM * 2, 0x00020000);
    const __amdgpu_buffer_rsrc_t rsh = __builtin_amdgcn_make_buffer_rsrc((void*)F_H1, 0, M * DM * 4, 0x00020000);
    const __amdgpu_buffer_rsrc_t rsb = __builtin_amdgcn_make_buffer_rsrc((void*)F_H2B, 0, M * DM * 2, 0x00020000);
    const unsigned p16 = (unsigned)p * 16u;
    const unsigned cl = (unsigned)(16 * p + 8 * (g & 1) + 4 * ((g >> 1) & 1) + 2 * ((g >> 2) & 1));
    for (int tb = tbase; tb < M; tb += F.G * 32) {
        unsigned ev[4][8];
        float hacc[4][2];
#pragma unroll
        for (int tk = 0; tk < 4; ++tk) {
#pragma unroll
            for (int i = 0; i < 8; ++i) ev[tk][i] = (unsigned)F_EIDX[(size_t)(tb + tk) * 128 + 16 * i + g] | ((unsigned)F_EIDX[(size_t)(tb + tk) * 128 + 16 * i + 8 + g] << 16);
            hacc[tk][0] = 0.f; hacc[tk][1] = 0.f;
        }
#define PEER_VOFF(TK, i) ({ unsigned e_ = ev[TK][(i) >> 1]; asm volatile("" : "+v"(e_)); ((((i) & 1) ? (e_ >> 16) : (e_ & 0xffffu)) * 128u + p16); })
#define PEER_LOAD_X(X0, X1, S, TK) do { X0 = __builtin_amdgcn_raw_buffer_load_b128(rsx, 2u * p16, ((tb + (TK)) * DM + 128 * (S)) * 2, 0); X1 = __builtin_amdgcn_raw_buffer_load_b128(rsx, 2u * p16 + 16u, ((tb + (TK)) * DM + 128 * (S)) * 2, 0); } while (0)
#define PEER_LOAD_A(W, S, TK, H) do { _Pragma("unroll") for (int i = 0; i < 8; ++i) W[i] = __builtin_amdgcn_raw_buffer_load_b128(rsu, PEER_VOFF(TK, 8 * (H) + i), (S) * SLICE_BYTES, 0); } while (0)
#define PEER_COMP_A(W, H) do { \
        _Pragma("unroll") for (int i = 0; i < 8; ++i) { f32x2v a2 = {0.f, 0.f}; \
            _Pragma("unroll") for (int c = 0; c < 4; ++c) { const int wv = (int)W[i][c]; const f32x2v lo = __builtin_amdgcn_cvt_pk_f32_fp8(wv, false), hi = __builtin_amdgcn_cvt_pk_f32_fp8(wv, true); \
                a2 += lo * xf2[2 * c]; a2 += hi * xf2[2 * c + 1]; } \
            part[8 * (H) + i] = a2.x + a2.y; if (i & 1) __builtin_amdgcn_sched_barrier(0); } } while (0)
        for (int rep = 0; rep < NREP(6); ++rep) {
#pragma unroll
            for (int tk = 0; tk < 4; ++tk) { hacc[tk][0] = 0.f; hacc[tk][1] = 0.f; }
#pragma unroll 1
            for (int s = 0; s < NSLICE; ++s) {
#pragma unroll
                for (int tk = 0; tk < 4; ++tk) {
                    v4u w0[8], w1[8], x0, x1; f32x2v xf2[8]; float part[16];
                    PEER_LOAD_X(x0, x1, s, tk); PEER_LOAD_A(w0, s, tk, 0); PEER_LOAD_A(w1, s, tk, 1); __builtin_amdgcn_sched_barrier(0);
#pragma unroll
                    for (int c = 0; c < 4; ++c) { const unsigned a0 = x0[c], a1 = x1[c]; xf2[c] = (f32x2v){bf_lo(a0), bf_hi(a0)}; xf2[4 + c] = (f32x2v){bf_lo(a1), bf_hi(a1)}; }
                    PEER_COMP_A(w0, 0); __builtin_amdgcn_sched_barrier(0);
                    PEER_COMP_A(w1, 1); __builtin_amdgcn_sched_barrier(0);
                    treduce<16>(part, lane, 1); treduce<8>(reinterpret_cast<float (&)[8]>(part), lane, 2); treduce<4>(reinterpret_cast<float (&)[4]>(part), lane, 4);
                    hacc[tk][0] += part[0]; hacc[tk][1] += part[1]; __builtin_amdgcn_sched_barrier(0);
                }
                __builtin_amdgcn_s_barrier();
            }
        }
#undef PEER_LOAD_X
#undef PEER_LOAD_A
#undef PEER_COMP_A
#pragma unroll
        for (int tk = 0; tk < 4; ++tk) {
            const int t = tb + tk;
            const float rs2 = (1.0f / EU_SCALE) / sqrtf(__hip_atomic_load(F_SSQ2 + t, RLX_AGENT) * (1.0f / DM) + EPS);
#pragma unroll
            for (int j = 0; j < 2; ++j) {
                const int i = 8 * (p & 1) + 4 * ((p >> 1) & 1) + 2 * ((p >> 2) & 1) + j;
                const float hv = hacc[tk][j] * rs2;
                const float ge = 0.5f * hv * (1.0f + erff(hv * 0.70710678118654752f));
                alds[tk * 128 + g * 16 + i] = F_GATE[(size_t)t * 128 + 8 * i + g] * ge * (1.0f / EV_SCALE);
            }
        }
        LDS_WAIT(); asm volatile("" ::: "memory");
        float ssq[4] = {0.f, 0.f, 0.f, 0.f};
#define PEER_LOAD_B(W, S, TK, H) do { _Pragma("unroll") for (int i = 0; i < 8; ++i) W[i] = __builtin_amdgcn_raw_buffer_load_b128(rsv, PEER_VOFF(TK, 8 * (H) + i), (S) * SLICE_BYTES, 0); } while (0)
#define PEER_COMP_B(W, TK, H) do { f32x4 av[2]; \
        _Pragma("unroll") for (int q4 = 0; q4 < 2; ++q4) av[q4] = *(const LAS f32x4*)(alds + (TK) * 128 + g * 16 + 8 * (H) + 4 * q4); \
        _Pragma("unroll") for (int i = 0; i < 8; ++i) { const float a = av[i >> 2][i & 3]; const f32x2v a2 = {a, a}; \
            _Pragma("unroll") for (int c = 0; c < 4; ++c) { const int wv = (int)W[i][c]; const f32x2v lo = __builtin_amdgcn_cvt_pk_f32_fp8(wv, false), hi = __builtin_amdgcn_cvt_pk_f32_fp8(wv, true); \
                oc2[2 * c] += a2 * lo; oc2[2 * c + 1] += a2 * hi; } if (i & 1) __builtin_amdgcn_sched_barrier(0); } } while (0)
        {
#pragma unroll 1
            for (int s = 0; s < NSLICE; ++s) {
#pragma unroll
                for (int tk = 0; tk < 4; ++tk) {
                    v4u w0[8], w1[8]; f32x2v oc2[8]; float oc[16];
                    PEER_LOAD_B(w0, s, tk, 0); PEER_LOAD_B(w1, s, tk, 1); __builtin_amdgcn_sched_barrier(0);
#pragma unroll
                    for (int c = 0; c < 8; ++c) oc2[c] = (f32x2v){0.f, 0.f};
                    PEER_COMP_B(w0, tk, 0); __builtin_amdgcn_sched_barrier(0);
                    PEER_COMP_B(w1, tk, 1); __builtin_amdgcn_sched_barrier(0);
#pragma unroll
                    for (int c = 0; c < 8; ++c) { oc[2 * c] = oc2[c].x; oc[2 * c + 1] = oc2[c].y; }
                    treduce<16>(oc, lane, 8); treduce<8>(reinterpret_cast<float (&)[8]>(oc), lane, 16); treduce<4>(reinterpret_cast<float (&)[4]>(oc), lane, 32);
                    const int so = (tb + tk) * DM + 128 * s;
                    const v2u hv2 = __builtin_amdgcn_raw_buffer_load_b64(rsh, cl * 4u, so * 4, 0);
                    const float h2a = __uint_as_float(hv2.x) + oc[0], h2b = __uint_as_float(hv2.y) + oc[1];
                    v2u st; st.x = __float_as_uint(h2a); st.y = __float_as_uint(h2b);
                    __builtin_amdgcn_raw_buffer_store_b64(st, rsh, cl * 4u, so * 4, 0);
                    __builtin_amdgcn_raw_buffer_store_b32(pk2(h2a, h2b), rsb, cl * 2u, so * 2, 0); ssq[tk] += h2a * h2a + h2b * h2b;
                    __builtin_amdgcn_sched_barrier(0);
                }
                __builtin_amdgcn_s_barrier();
            }
        }
#undef PEER_LOAD_B
#undef PEER_COMP_B
#pragma unroll
        for (int tk = 0; tk < 4; ++tk) { const float ss = wave_sum(ssq[tk]); if (lane == 0) F_RSTD3[tb + tk] = 1.0f / sqrtf(ss * (1.0f / DM) + EPS); }
        LDS_WAIT(); asm volatile("" ::: "memory");
    }
}

struct Args { const void* in[18]; float* out; unsigned char* ws; int ph_lo, ph_hi, li, pad; };
__global__ void __launch_bounds__(NWAVES * 64, 2) hymba_fwd(Args args) {
    extern __shared__ __attribute__((aligned(16))) unsigned char lds[];
    Frame F;
    F.lds = (LAS unsigned char*)lds;
    F.MISC = (volatile LAS unsigned*)(F.lds + MISC_OFF);
    F.tid = threadIdx.x; F.lane = F.tid & 63; F.wave = __builtin_amdgcn_readfirstlane(F.tid >> 6);
    F.G = gridDim.x; { const int bx = blockIdx.x; F.vcu = (F.G % 8 == 0) ? (bx % 8) * (F.G / 8) + bx / 8 : bx; }
    F.ws = args.ws;
    F.ctl = (gu32*)(F.ws + WS_CTL);
    F.x = (const float*)args.in[0]; F.p = (const float*)args.in[1]; F.positions = (const int*)args.in[2]; F.g_mix = (const float*)args.in[3]; F.w_in = (const float*)args.in[4];
    F.sinks = (const float*)args.in[5]; F.w_pool = (const float*)args.in[6]; F.pool_scale = (const float*)args.in[7]; F.w_out = (const float*)args.in[8]; F.g_ffn = (const float*)args.in[9];
    F.w_query = (const float*)args.in[10]; F.sub_keys = (const float*)args.in[11]; F.expert_u = (const float*)args.in[12]; F.expert_v = (const float*)args.in[13]; F.g_ple = (const float*)args.in[14];
    F.w_ple_gate = (const float*)args.in[15]; F.w_ple_proj = (const float*)args.in[16]; F.g_final = (const float*)args.in[17]; F.out = args.out;
    for (int u = F.tid; u < (LDS_BYTES - LDSCTL_OFF) / 4; u += NWAVES * 64) ((LAS unsigned*)(F.lds + LDSCTL_OFF))[u] = 0u;
    __syncthreads();
    const bool one_phase = (args.ph_hi - args.ph_lo) == 1;
    XcdBarrier bar; bar.bar = (unsigned*)(F.ctl + CW_BAR); bar.x = 0; bar.st = nullptr;
    if (!one_phase) bar = xcd_barrier_post((unsigned*)(F.ctl + CW_BAR), F.MISC + 8);
    const int lo = args.ph_lo, hi = args.ph_hi;
#define IN(k) (lo <= (k) && (k) < hi)
#define BOTH(k) (IN(k) && IN((k) + 1))
#define GRID_BAR() xcd_barrier(bar)

    if (IN(0)) { for (int rep = 0; rep < NREP(0); ++rep) p0_prologue(F); p1_queue(F, 0, Q_SPLIT, CW_QUEUE0); if (BOTH(0)) GRID_BAR(); }

    if (IN(1)) {
        for (int rep = 0; rep < NREP(1); ++rep) {
        { pg8::Gemm g{F_XB, F_Win_t, M, INW, DM, DM, DM}; pg8::StaticOrder S; S.init(M, INW, F.G, (int)blockIdx.x);
          EpiG1 E{F_QB, F_KB, F_VB, F_UB, F_RSTD1, F_ROPE};
          pg8::gemm_phase<EpiG1, pg8::StaticOrder, true, true>(F.lds + RING_OFF, g, S, E); }
        { pg8::Gemm g{F_PB, F_Wp_t, M, DM, PLE, PLE, PLE}; PpOrder S; S.init(F.G, (int)blockIdx.x);
          EpiBf16Scale<false> E{F_PP, DM, 0, nullptr};
          pg8::gemm_phase<EpiBf16Scale<false>, PpOrder, false, true>(F.lds + RING_OFF, g, S, E); }
        p1_queue(F, Q_SPLIT, Q_ITEMS, CW_QUEUE);
        }
        if (BOTH(1)) GRID_BAR();
    }

    if (IN(2)) {
        for (int rep = 0; rep < NREP(2); ++rep) {
        if (F.G >= 256) { if ((int)blockIdx.x >= 128) for (int u = (int)blockIdx.x - 128; u < BATCH * 32 * NKVH; u += F.G - 128) attn_unit(F, u); }
        else for (int u = (int)blockIdx.x; u < BATCH * 32 * NKVH; u += F.G) attn_unit(F, u);
        if ((int)blockIdx.x < 128) {
            const int pu = (int)blockIdx.x, pm = pu >> 2, g = pu & 3;
            pool_tile(F, pm, g);
            VM_WAIT(); __syncthreads();
            pg8::Gemm gm{F_POOLED + g * 256, F_Wpool_t + (size_t)g * 65536, M, 256, 256, POOLW, 256}; SingleUnit S{pm, 0};
            EpiBf16Scale<true> E{F_MIX, DM, ATTW + g * 256, F.pool_scale + g * 256};
            pg8::gemm_phase<EpiBf16Scale<true>, SingleUnit, false, true>(F.lds + RING_OFF, gm, S, E);
            __syncthreads();
        }
        }
        if (BOTH(2)) GRID_BAR();
    }

    if (IN(3)) {
        pg8::Gemm g{F_MIX, F_Wout_t, M, DM, DM, DM, DM}; pg8::StaticOrder S; S.init(M, DM, F.G, (int)blockIdx.x);
        EpiG3 E{F.x, F_H1, F_H1B, F_SSQ2};
        pg8::gemm_phase<EpiG3, pg8::StaticOrder, true, true>(F.lds + RING_OFF, g, S, E);
        if (BOTH(3)) GRID_BAR();
    }

    if (IN(4)) {
        pg8::Gemm g{F_H1B, F_Wq_t, M, DM, DM, DM, DM}; pg8::StaticOrder S; S.init(M, DM, F.G, (int)blockIdx.x);
        EpiG4 E{F_QP, F_SSQ2};
        for (int rep = 0; rep < NREP(4); ++rep)
        pg8::gemm_phase<EpiG4, pg8::StaticOrder, true, true>(F.lds + RING_OFF, g, S, E);
        if (BOTH(4)) GRID_BAR();
    }

    if (IN(5)) {
        for (int rep = 0; rep < NREP(5); ++rep)
        for (int base = (int)blockIdx.x * NWAVES; base < M * PKH / 32; base += F.G * NWAVES) { const int task = base + F.wave; route_task(F, task < M * PKH / 32 ? task : 0, task < M * PKH / 32); }
        __syncthreads();
        if (BOTH(5)) GRID_BAR();
    }

    if (IN(6)) {
        peer_phase(F);
        __syncthreads();
        if (BOTH(6)) GRID_BAR();
    }

    if (IN(7)) {
        pg8::Gemm g{F_H2B, F_Wg_t, M, DM, DM, DM, DM}; pg8::StaticOrder S; S.init(M, DM, F.G, (int)blockIdx.x);
        EpiG5 E{F_H1, F_PP, F_RSTD3, F.out, F_SSQ4};
        pg8::gemm_phase<EpiG5, pg8::StaticOrder, true, true>(F.lds + RING_OFF, g, S, E);
        if (BOTH(7)) GRID_BAR();
    }

    if (IN(8)) {
        const int gw = F.vcu * NWAVES + F.wave, NGW = F.G * NWAVES;
        for (int m = gw; m < M; m += NGW) {
            const float rs = 1.0f / sqrtf(__hip_atomic_load(F_SSQ4 + m, RLX_AGENT) * (1.0f / DM) + EPS);
            GAS f32x4* orow = (GAS f32x4*)(F.out + (size_t)m * DM) + F.lane; const GAS f32x4* gr = (const GAS f32x4*)F.g_final + F.lane;
#pragma unroll
            for (int j = 0; j < 8; ++j) { const f32x4 v = orow[64 * j]; orow[64 * j] = v * rs * gr[64 * j]; }
        }
    }
#undef IN
#undef BOTH
#undef GRID_BAR
}


#if DBG_ROUTE_BF
__global__ void __launch_bounds__(NWAVES * 64, 2) dbg_route_kernel(Args args) {
    extern __shared__ __attribute__((aligned(16))) unsigned char lds[];
    Frame F; F.lds = (LAS unsigned char*)lds; F.tid = threadIdx.x; F.lane = F.tid & 63; F.wave = F.tid >> 6; F.G = gridDim.x; F.vcu = blockIdx.x; F.ws = args.ws; F.sub_keys = (const float*)args.in[11];
    route_bruteforce(F);
}
#endif
extern "C" void kernel_launch(void* const* d_in, const int* in_sizes, int n_in, void* d_out, int out_size, void* d_ws, size_t ws_size, hipStream_t stream) {
    static int grid = 0;
    if (grid == 0) {
        if (n_in != 18 || out_size != M * DM || ws_size < WS_END) { fprintf(stderr, "kernel_launch: unexpected shapes (n_in %d, out %d, ws %zu)\n", n_in, out_size, ws_size); grid = -1; return; }
        int dev = 0, cus = 0, per_cu = 0;
        if (hipGetDevice(&dev) != hipSuccess || hipDeviceGetAttribute(&cus, hipDeviceAttributeMultiprocessorCount, dev) != hipSuccess) { grid = -1; return; }
#if DBG_ROUTE_BF
        (void)hipFuncSetAttribute((const void*)dbg_route_kernel, hipFuncAttributeMaxDynamicSharedMemorySize, 98304);
#endif
        if (hipFuncSetAttribute((const void*)hymba_fwd, hipFuncAttributeMaxDynamicSharedMemorySize, LDS_BYTES) != hipSuccess) { fprintf(stderr, "kernel_launch: hipFuncSetAttribute failed\n"); grid = -1; return; }
        if (hipOccupancyMaxActiveBlocksPerMultiprocessor(&per_cu, (const void*)hymba_fwd, NWAVES * 64, LDS_BYTES) != hipSuccess || per_cu < 1)
            fprintf(stderr, "kernel_launch: note: occupancy query reports %d workgroups per CU\n", per_cu);
        (void)hipGetLastError();
        if (cus < 128) { fprintf(stderr, "kernel_launch: needs >= 128 CUs\n"); grid = -1; return; }
        grid = cus;
    }
    if (grid < 0) return;
    if (hipMemsetAsync((char*)d_ws + WS_CTL, 0, CTL_ZERO_BYTES, stream) != hipSuccess) return;
    Args a{};
    for (int i = 0; i < 18; ++i) a.in[i] = d_in[i];
    a.out = (float*)d_out; a.ws = (unsigned char*)d_ws;
    constexpr int NL = MK_N_LAUNCHES;
    for (int li = 0; li < NL; ++li) {
        a.ph_lo = (NL == 1) ? 0 : li; a.ph_hi = (NL == 1) ? N_PHASES : li + 1; a.li = li;
#if DBG_ROUTE_BF
        if (NL == 9 && li == 5) { hipLaunchKernelGGL(dbg_route_kernel, dim3(grid), dim3(NWAVES * 64), 98304, stream, a); continue; }
#endif
        hipLaunchKernelGGL(hymba_fwd, dim3(grid), dim3(NWAVES * 64), LDS_BYTES, stream, a);
    }
}
```

```cpp
#include <hip/hip_runtime.h>
#include <cstdio>
#include <cstdint>
namespace pg8 {
#define PG8_LAS __attribute__((address_space(3)))
typedef unsigned short bf16_t;
typedef short bf16x8 __attribute__((ext_vector_type(8)));
typedef float f32x4 __attribute__((ext_vector_type(4)));
typedef unsigned u32x4 __attribute__((ext_vector_type(4)));
constexpr int BM = 256, BK = 64, HALF = 128, HTB = HALF * BK * 2  , STAGE_BYTES = 8 * HTB, NXCD = 8, WGM = 8;

__host__ __device__ __forceinline__ int lds_byte(int r, int c) { const int st = (r >> 4) * 2 + (c >> 5), rr = r & 15, cc = c & 31, ob = rr * 64 + cc * 2; return st * 1024 + (ob ^ (((ob >> 9) & 1) << 5)); }
__host__ __device__ __forceinline__ void stage_rc(int b, int& R, int& C) { const int st = b / 1024, sb = b % 1024, swz = sb ^ (((sb >> 9) & 1) << 5); R = (st >> 1) * 16 + swz / 64; C = (st & 1) * 32 + (swz % 64) / 2; }
__host__ __device__ __forceinline__ int perm32(int rho) { const int n = rho >> 4, i = rho & 15; return 8 * (i >> 2) + 4 * n + (i & 3); }

struct Unit { int pm, pn; };
struct Gemm { const bf16_t* A; const bf16_t* Bt; int M, N, K, lda, ldb; };

struct StaticOrder {
    int nM, nN, nwg, G, c;
    __host__ __device__ void init(int M, int N, int G_, int c_) { nM = M / BM; nN = N / BM; nwg = nM * nN; G = G_; c = c_; }
    __host__ __device__ bool next(int i, Unit& u) const {
        const long L = (long)i * G + c; if (L >= nwg) return false;
        int wgid = (int)L; { const int q = nwg / NXCD, r = nwg % NXCD, xcd = wgid % NXCD, off = wgid / NXCD; wgid = (xcd < r ? xcd * (q + 1) : r * (q + 1) + (xcd - r) * q) + off; }
        const int nig = WGM * nN, gid = wgid / nig, fm = gid * WGM, gsz = (nM - fm) < WGM ? (nM - fm) : WGM;
        u.pm = fm + ((wgid % nig) % gsz); u.pn = (wgid % nig) / gsz; return true;
    }
    __device__ __forceinline__ void a_ready(const Unit&) const {}
    __device__ __forceinline__ void done(const Unit&) const {}
};

__device__ __forceinline__ unsigned cvt_pk_bf16(float lo, float hi) { unsigned r; asm volatile("v_cvt_pk_bf16_f32 %0, %1, %2" : "=v"(r) : "v"(lo), "v"(hi)); return r; }
typedef float f32x2 __attribute__((ext_vector_type(2)));

template <class Epi, class Sched, bool ALIGN_EPI = false, bool SP2 = false>
__device__ __forceinline__ void gemm_phase(PG8_LAS unsigned char* lds, const Gemm g, const Sched& S, const Epi& E) {
    const int tid = threadIdx.x, wid = __builtin_amdgcn_readfirstlane(tid >> 6), lane = tid & 63, wr = wid >> 2, wc = wid & 3, fr = lane & 15, fq = lane >> 4;
    const int K = g.K, nt = K / BK;
    unsigned voffA[2], voffB[2];
#pragma unroll
    for (int i = 0; i < 2; ++i) { int R, C; stage_rc(tid * 16 + i * 8192, R, C); const int Rb = Epi::PERM ? ((R & ~31) + perm32(R & 31)) : R;
        voffA[i] = (unsigned)(R * g.lda + C) * 2u; voffB[i] = (unsigned)(Rb * g.ldb + C) * 2u; }
    const size_t kstep = (size_t)(BK * 2);
    const size_t hstepA = (size_t)HALF * g.lda * 2, hstepB = (size_t)HALF * g.ldb * 2;
    const size_t tstepA = 2 * hstepA, tstepB = 2 * hstepB;
    const unsigned ldsw = (unsigned)wid * 1024u;
    const int aoff = lds_byte(wr * 64 + fr, fq * 8), boff = lds_byte(wc * 32 + fr, fq * 8);
#define PG8_SA(b, h) (((b) * 2 + (h)) * HTB)
#define PG8_SB(b, h) ((4 + (b) * 2 + (h)) * HTB)
#define PG8_STAGE(bufoff, gbase, voff) do { _Pragma("unroll") for (int _i = 0; _i < 2; ++_i) \
        __builtin_amdgcn_global_load_lds((const unsigned*)((const char*)(gbase) + (voff)[_i]), (PG8_LAS unsigned*)(lds + (bufoff) + ldsw + _i * 8192), 16, 0, 0); } while (0)
#define PG8_LDA(dst, b, h) do { _Pragma("unroll") for (int m = 0; m < 4; ++m) _Pragma("unroll") for (int k = 0; k < 2; ++k) dst[m][k] = *(const PG8_LAS bf16x8*)(lds + PG8_SA(b, h) + aoff + m * 2048 + k * 1024); } while (0)
#define PG8_LDB(dst, b, h) do { _Pragma("unroll") for (int n = 0; n < 2; ++n) _Pragma("unroll") for (int k = 0; k < 2; ++k) dst[n][k] = *(const PG8_LAS bf16x8*)(lds + PG8_SB(b, h) + boff + n * 2048 + k * 1024); } while (0)
#define PG8_MMA(ai, bj, At, Bt) do { __builtin_amdgcn_s_setprio(1); _Pragma("unroll") for (int m = 0; m < 4; ++m) _Pragma("unroll") for (int n = 0; n < 2; ++n) _Pragma("unroll") for (int k = 0; k < 2; ++k) \
        acc[ai][bj][m][n] = __builtin_amdgcn_mfma_f32_16x16x32_bf16(Bt[n][k], At[m][k], acc[ai][bj][m][n], 0, 0, 0); __builtin_amdgcn_s_setprio(0); } while (0)
#define PG8_WAIT_V(n) asm volatile("s_waitcnt vmcnt(" #n ")" ::: "memory")
#define PG8_WAIT_L(n) asm volatile("s_waitcnt lgkmcnt(" #n ")" ::: "memory")
#define PG8_BAR __builtin_amdgcn_s_barrier()
#define PG8_SCHED __builtin_amdgcn_sched_barrier(0)
    Unit cur, nxt; int ui = 0;
    if (!S.next(0, cur)) return;
    f32x4 acc[2][2][4][2];
#pragma unroll
    for (int a = 0; a < 2; ++a)
#pragma unroll
        for (int b = 0; b < 2; ++b)
#pragma unroll
            for (int m = 0; m < 4; ++m)
#pragma unroll
                for (int n = 0; n < 2; ++n) acc[a][b][m][n] = (f32x4){0.f, 0.f, 0.f, 0.f};
    bf16x8 At[4][2], B0[2][2], B1[2][2];
    const char* cA = (const char*)g.A + (size_t)cur.pm * tstepA; const char* cB = (const char*)g.Bt + (size_t)cur.pn * tstepB;
    S.a_ready(cur);
    if constexpr (SP2) {
        PG8_STAGE(PG8_SB(0, 0), cB, voffB); PG8_STAGE(PG8_SB(0, 1), cB + hstepB, voffB); PG8_STAGE(PG8_SA(0, 0), cA, voffA); PG8_STAGE(PG8_SA(0, 1), cA + hstepA, voffA);
        if (wr == 1) PG8_BAR;
        PG8_WAIT_V(2); PG8_BAR;
        PG8_STAGE(PG8_SB(1, 0), cB + kstep, voffB); PG8_STAGE(PG8_SA(1, 0), cA + kstep, voffA); PG8_STAGE(PG8_SB(1, 1), cB + hstepB + kstep, voffB);
        PG8_WAIT_V(6); PG8_BAR;
    } else {
        PG8_STAGE(PG8_SB(0, 0), cB, voffB); PG8_STAGE(PG8_SA(0, 0), cA, voffA); PG8_STAGE(PG8_SB(0, 1), cB + hstepB, voffB); PG8_STAGE(PG8_SA(0, 1), cA + hstepA, voffA);
        if (wr == 1) PG8_BAR;
        PG8_WAIT_V(4); PG8_BAR;
        PG8_STAGE(PG8_SB(1, 0), cB + kstep, voffB); PG8_STAGE(PG8_SA(1, 0), cA + kstep, voffA); PG8_STAGE(PG8_SB(1, 1), cB + hstepB + kstep, voffB);
        PG8_WAIT_V(6); PG8_BAR;
    }
    for (;;) {
        const bool has_next = S.next(ui + 1, nxt);
        const char* nA = has_next ? (const char*)g.A + (size_t)nxt.pm * tstepA : cA; const char* nB = has_next ? (const char*)g.Bt + (size_t)nxt.pn * tstepB : cB;
        for (int t = 0; t < nt; t += 2) {
            const bool last = (t == nt - 2);
            const char* a1 = cA + (size_t)(t + 1) * kstep;
            const char* a2 = last ? nA : cA + (size_t)(t + 2) * kstep; const char* b2 = last ? nB : cB + (size_t)(t + 2) * kstep;
            const char* a3 = a2 + kstep; const char* b3 = b2 + kstep;
            if (last && has_next) S.a_ready(nxt);
            if constexpr (SP2) {
            PG8_LDB(B0, 0, 0); PG8_LDB(B1, 0, 1); PG8_SCHED; PG8_LDA(At, 0, 0); PG8_STAGE(PG8_SA(1, 1), a1 + hstepA, voffA);
            PG8_WAIT_V(8); PG8_WAIT_L(0); PG8_BAR; PG8_MMA(0, 0, At, B0); PG8_MMA(0, 1, At, B1); PG8_BAR; PG8_SCHED;
            PG8_LDA(At, 0, 1); PG8_STAGE(PG8_SB(0, 0), b2, voffB); PG8_STAGE(PG8_SB(0, 1), b2 + hstepB, voffB); PG8_STAGE(PG8_SA(0, 0), a2, voffA);
            PG8_WAIT_V(8); PG8_WAIT_L(0); PG8_BAR; PG8_MMA(1, 0, At, B0); PG8_MMA(1, 1, At, B1); PG8_BAR; PG8_SCHED;
            PG8_LDB(B0, 1, 0); PG8_LDB(B1, 1, 1); PG8_SCHED; PG8_LDA(At, 1, 0); PG8_STAGE(PG8_SA(0, 1), a2 + hstepA, voffA);
            PG8_WAIT_V(8); PG8_WAIT_L(0); PG8_BAR; PG8_MMA(0, 0, At, B0); PG8_MMA(0, 1, At, B1); PG8_BAR; PG8_SCHED;
            PG8_LDA(At, 1, 1); PG8_STAGE(PG8_SB(1, 0), b3, voffB); PG8_STAGE(PG8_SB(1, 1), b3 + hstepB, voffB); PG8_STAGE(PG8_SA(1, 0), a3, voffA);
            PG8_WAIT_V(8); PG8_WAIT_L(0); PG8_BAR; PG8_MMA(1, 0, At, B0); PG8_MMA(1, 1, At, B1); PG8_BAR; PG8_SCHED;
            } else {
            PG8_LDB(B0, 0, 0); PG8_SCHED; PG8_LDA(At, 0, 0); PG8_STAGE(PG8_SA(1, 1), a1 + hstepA, voffA);
            PG8_WAIT_L(8); PG8_BAR; PG8_WAIT_L(0); PG8_MMA(0, 0, At, B0); PG8_BAR; PG8_SCHED;
            PG8_LDB(B1, 0, 1); PG8_STAGE(PG8_SB(0, 0), b2, voffB);
            PG8_BAR; PG8_WAIT_L(0); PG8_MMA(0, 1, At, B1); PG8_BAR;
            PG8_LDA(At, 0, 1); PG8_STAGE(PG8_SA(0, 0), a2, voffA);
            PG8_BAR; PG8_WAIT_L(0); PG8_MMA(1, 0, At, B0); PG8_BAR; PG8_SCHED;
            PG8_STAGE(PG8_SB(0, 1), b2 + hstepB, voffB);
            PG8_WAIT_V(6); PG8_BAR; PG8_MMA(1, 1, At, B1); PG8_BAR;
            PG8_LDB(B0, 1, 0); PG8_SCHED; PG8_LDA(At, 1, 0); PG8_STAGE(PG8_SA(0, 1), a2 + hstepA, voffA);
            PG8_WAIT_L(8); PG8_BAR; PG8_WAIT_L(0); PG8_MMA(0, 0, At, B0); PG8_BAR; PG8_SCHED;
            PG8_LDB(B1, 1, 1); PG8_STAGE(PG8_SB(1, 0), b3, voffB);
            PG8_BAR; PG8_WAIT_L(0); PG8_MMA(0, 1, At, B1); PG8_BAR;
            PG8_LDA(At, 1, 1); PG8_STAGE(PG8_SA(1, 0), a3, voffA);
            PG8_BAR; PG8_WAIT_L(0); PG8_MMA(1, 0, At, B0); PG8_BAR; PG8_SCHED;
            PG8_STAGE(PG8_SB(1, 1), b3 + hstepB, voffB);
            PG8_WAIT_V(6); PG8_BAR; PG8_MMA(1, 1, At, B1); PG8_BAR;
            }
        }
        if constexpr (ALIGN_EPI) { if (wr == 0) PG8_BAR; }
        if constexpr (!Epi::AFTER_DRAIN) { E(acc, cur, wr, wc, fr, fq); S.done(cur); }
        if (!has_next) break;
#pragma unroll
        for (int a = 0; a < 2; ++a)
#pragma unroll
            for (int b = 0; b < 2; ++b)
#pragma unroll
                for (int m = 0; m < 4; ++m)
#pragma unroll
                    for (int n = 0; n < 2; ++n) acc[a][b][m][n] = (f32x4){0.f, 0.f, 0.f, 0.f};
        cur = nxt; cA = nA; cB = nB; ++ui;
        if constexpr (ALIGN_EPI) { if (wr == 1) PG8_BAR; }
    }
    PG8_WAIT_V(0);
    if constexpr (!ALIGN_EPI) { if (wr == 0) PG8_BAR; }
    PG8_BAR;
    if constexpr (Epi::AFTER_DRAIN) { E.fused(acc, cur, wr, wc, fr, fq, lds, wid, lane); S.done(cur); }
#undef PG8_SA
#undef PG8_SB
#undef PG8_STAGE
#undef PG8_LDA
#undef PG8_LDB
#undef PG8_MMA
#undef PG8_WAIT_V
#undef PG8_WAIT_L
#undef PG8_BAR
#undef PG8_SCHED
}
}


constexpr int NWAVES = 8;
constexpr int DM = 2048, BATCH = 2, SEQ = 4096, M = BATCH * SEQ;
constexpr int HD = 64, NQH = 16, NKVH = 4, ATTW = 1024, KVW = 256, POOLW = 1024, INW = 2560;
constexpr int PKH = 8, NEXP = 16384, PLE = 256;
constexpr float EPS = 1e-6f;
constexpr float EU_SCALE = 256.0f, EV_SCALE = 16.0f;
#ifndef MK_N_LAUNCHES
#define MK_N_LAUNCHES 1
#endif
constexpr int N_PHASES = 9;
#ifndef REP_MASK
#define REP_MASK 0
#endif
#define NREP(k) (((REP_MASK >> (k)) & 1) ? 2 : 1)
#ifndef DBG_NO_PEER
#define DBG_NO_PEER 0
#endif
#ifndef DBG_NO_PLE
#define DBG_NO_PLE 0
#endif
#ifndef DBG_NO_MIX
#define DBG_NO_MIX 0
#endif

constexpr size_t MiB = 1u << 20;
constexpr size_t WS_CTL = 0, CTL_ZERO_BYTES = 256 * 1024;
constexpr size_t WS_WIN = 1 * MiB, WS_WOUT = 11 * MiB, WS_WQ = 19 * MiB, WS_WG = 27 * MiB, WS_WP = 35 * MiB, WS_WPOOL = 36 * MiB;
constexpr size_t WS_SKH = 36 * MiB + 512 * 1024, WS_SKL = WS_SKH + 64 * 1024;
constexpr size_t WS_ROPE = 37 * MiB;
constexpr size_t WS_RSTD1 = 37 * MiB + 512 * 1024, WS_RSTD3 = WS_RSTD1 + 32 * 1024;
constexpr size_t WS_EU = 38 * MiB, WS_EV = 102 * MiB;
constexpr size_t WS_XB = 166 * MiB, WS_PB = 198 * MiB;
constexpr size_t WS_Q = 202 * MiB, WS_K = 218 * MiB, WS_V = 222 * MiB, WS_U = 226 * MiB, WS_POOLED = 242 * MiB, WS_MIX = 258 * MiB;
constexpr size_t WS_QP = 202 * MiB;
constexpr size_t WS_EIDX = 266 * MiB, WS_GATE = 270 * MiB;
constexpr size_t WS_H1 = 290 * MiB, WS_H1B = 354 * MiB, WS_PP = 386 * MiB, WS_H2B = 418 * MiB, WS_END = 450 * MiB;
constexpr int CW_QUEUE = 2048, CW_QUEUE0 = 2112;
#ifndef NCONV
#define NCONV 96
#endif
#ifndef Q_SPLIT
#define Q_SPLIT 0
#endif
constexpr int CW_BAR = 4096;
constexpr int CW_SSQ2 = 16384, CW_SSQ4 = 16384 + 8192;
static_assert((CW_SSQ4 + 8192) * 4 <= (int)CTL_ZERO_BYTES, "ctl");

constexpr int RING_OFF = 0, RING_BYTES = 131072;
constexpr int LDSCTL_OFF = RING_BYTES, MISC_OFF = LDSCTL_OFF + 320;
constexpr int LDS_BYTES = 147456;

#define GAS __attribute__((address_space(1)))
#define LAS __attribute__((address_space(3)))
typedef unsigned short bf16;
typedef unsigned v4u __attribute__((ext_vector_type(4)));
typedef unsigned v2u __attribute__((ext_vector_type(2)));
typedef float f32x4 __attribute__((ext_vector_type(4)));
typedef float f32x16 __attribute__((ext_vector_type(16)));
typedef short bf16x8 __attribute__((ext_vector_type(8)));
typedef GAS unsigned gu32;
#define RLX_AGENT __ATOMIC_RELAXED, __HIP_MEMORY_SCOPE_AGENT
#define LDS_WAIT() asm volatile("s_waitcnt lgkmcnt(0)" ::: "memory")
#define VM_WAIT() asm volatile("s_waitcnt vmcnt(0)" ::: "memory")
typedef float f32x2_t __attribute__((ext_vector_type(2))); typedef __bf16 bf16x2_t __attribute__((ext_vector_type(2)));
__device__ __forceinline__ unsigned pk2(float lo, float hi) { f32x2_t v = {lo, hi}; bf16x2_t b = __builtin_convertvector(v, bf16x2_t); return __builtin_bit_cast(unsigned, b); }
__device__ __forceinline__ float bf_lo(unsigned w) { return __uint_as_float(w << 16); }
__device__ __forceinline__ float bf_hi(unsigned w) { return __uint_as_float(w & 0xffff0000u); }
__device__ __forceinline__ float dot2bf(unsigned a, unsigned b, float c) { return __builtin_amdgcn_fdot2_f32_bf16(__builtin_bit_cast(bf16x2_t, a), __builtin_bit_cast(bf16x2_t, b), c, false); }
__device__ __forceinline__ float max2f(float a, float b) { float r; asm("v_max_f32_e32 %0, %1, %2" : "=v"(r) : "v"(a), "v"(b)); return r; }
__device__ __forceinline__ float min2f(float a, float b) { float r; asm("v_min_f32_e32 %0, %1, %2" : "=v"(r) : "v"(a), "v"(b)); return r; }
__device__ __forceinline__ float wave_sum(float v) {
#pragma unroll
    for (int o = 1; o < 64; o <<= 1) v += __shfl_xor(v, o);
    return v;
}

#define XB_TMO      128
#define XB_XCNT(j)  (256  + 64 * (j))
#define XB_XSUB(j)  (1280 + 64 * (j))
#define XB_XGEN(j)  (2304 + 64 * (j))
#define XB_TOP      3328
#define XB_TOPGEN   3392
#define XCD_BAR_WORDS 3456
#define XB_SPIN_CAP (1u << 18)
__device__ __forceinline__ unsigned xb_ld(unsigned* p)              { return __hip_atomic_load(p, __ATOMIC_RELAXED, __HIP_MEMORY_SCOPE_AGENT); }
__device__ __forceinline__ unsigned xb_add(unsigned* p, unsigned v) { return __hip_atomic_fetch_add(p, v, __ATOMIC_RELAXED, __HIP_MEMORY_SCOPE_AGENT); }
__device__ __forceinline__ unsigned xb_xcc_id() { return (unsigned)__builtin_amdgcn_s_getreg((3 << 11) | 20) & 0xFu; }
#define XB_SPIN(cond, bar) do { unsigned _sp = 0; while (cond) { __builtin_amdgcn_s_sleep(1); \
    if ((++_sp & 255u) == 0u) { if (xb_ld(&(bar)[XB_TMO])) break; if (_sp > XB_SPIN_CAP) { atomicAdd(&(bar)[XB_TMO], 1u); break; } } } } while (0)
struct XcdBarrier { unsigned* bar; unsigned x; volatile LAS unsigned* st; };
__device__ __forceinline__ XcdBarrier xcd_barrier_post(unsigned* bar, volatile LAS unsigned* st) {
    XcdBarrier b; b.bar = bar; b.x = xb_xcc_id(); b.st = st;
    if (threadIdx.x == 0) (void)xb_add(&bar[XB_XCNT(b.x)], 1u);
    return b;
}
__device__ __forceinline__ void xcd_barrier_complete(unsigned* bar, unsigned x, unsigned& nloc, unsigned& nx) {
    const unsigned G = gridDim.x * gridDim.y * gridDim.z;
    unsigned sum, cnt, mine, sp = 0u;
    for (;;) {
        sum = 0u; cnt = 0u; mine = 0u;
#pragma unroll
        for (unsigned j = 0; j < 16; ++j) { const unsigned c = xb_ld(&bar[XB_XCNT(j)]); sum += c; cnt += (c > 0u) ? 1u : 0u; mine = (j == x) ? c : mine; }
        if (sum == G) break;
        __builtin_amdgcn_s_sleep(1);
        if ((++sp & 255u) == 0u) { if (xb_ld(&bar[XB_TMO])) break; if (sp > XB_SPIN_CAP) { atomicAdd(&bar[XB_TMO], 1u); break; } }
    }
    nloc = mine > 0u ? mine : 1u; nx = cnt > 0u ? cnt : 1u;
}
__device__ __forceinline__ void xcd_barrier(const XcdBarrier& b) {
    asm volatile("s_waitcnt vmcnt(0)" ::: "memory");
    __syncthreads();
    if (threadIdx.x == 0) {
        unsigned* bar = b.bar;
        __builtin_amdgcn_s_waitcnt(0);
        unsigned nloc = b.st[0], nx = b.st[1];
        if (nloc == 0u) { xcd_barrier_complete(bar, b.x, nloc, nx); b.st[0] = nloc; b.st[1] = nx; }
        const unsigned old = xb_add(&bar[XB_XSUB(b.x)], 1u);
        const unsigned gen = old / nloc;
        if (old + 1u == (gen + 1u) * nloc) {
            __builtin_amdgcn_fence(__ATOMIC_RELEASE, "agent");
            asm volatile("s_waitcnt vmcnt(0)" ::: "memory");
            const unsigned og = xb_add(&bar[XB_TOP], 1u);
            const unsigned tg = og / nx;
            if (og + 1u == (tg + 1u) * nx) xb_add(&bar[XB_TOPGEN], 1u);
            else XB_SPIN(xb_ld(&bar[XB_TOPGEN]) == tg, bar);
            __builtin_amdgcn_fence(__ATOMIC_ACQUIRE, "agent");
            xb_add(&bar[XB_XGEN(b.x)], 1u);
            asm volatile("s_waitcnt vmcnt(0)" ::: "memory");
        } else {
            XB_SPIN(xb_ld(&bar[XB_XGEN(b.x)]) == gen, bar);
            __builtin_amdgcn_fence(__ATOMIC_ACQUIRE, "agent");
            asm volatile("s_waitcnt vmcnt(0)" ::: "memory");
        }
    }
    __syncthreads();
}

struct Frame {
    LAS unsigned char* lds;
    volatile LAS unsigned* MISC;
    gu32* ctl;
    int tid, lane, wave;
    int vcu, G;
    const float *x, *p, *g_mix, *w_in, *sinks, *w_pool, *pool_scale, *w_out, *g_ffn, *w_query, *sub_keys, *expert_u, *expert_v, *g_ple, *w_ple_gate, *w_ple_proj, *g_final;
    const int* positions;
    float* out;
    unsigned char* ws;
};
#define F_Win_t  ((bf16*)(F.ws + WS_WIN))
#define F_Wout_t ((bf16*)(F.ws + WS_WOUT))
#define F_Wq_t   ((bf16*)(F.ws + WS_WQ))
#define F_Wg_t   ((bf16*)(F.ws + WS_WG))
#define F_Wp_t   ((bf16*)(F.ws + WS_WP))
#define F_Wpool_t ((bf16*)(F.ws + WS_WPOOL))
#define F_SKH    ((bf16*)(F.ws + WS_SKH))
#define F_SKL    ((bf16*)(F.ws + WS_SKL))
#define F_EU     ((bf16*)(F.ws + WS_EU))
#define F_EV     ((bf16*)(F.ws + WS_EV))
#define F_XB     ((bf16*)(F.ws + WS_XB))
#define F_PB     ((bf16*)(F.ws + WS_PB))
#define F_QB     ((bf16*)(F.ws + WS_Q))
#define F_KB     ((bf16*)(F.ws + WS_K))
#define F_VB     ((bf16*)(F.ws + WS_V))
#define F_UB     ((bf16*)(F.ws + WS_U))
#define F_POOLED ((bf16*)(F.ws + WS_POOLED))
#define F_MIX    ((bf16*)(F.ws + WS_MIX))
#define F_H1B    ((bf16*)(F.ws + WS_H1B))
#define F_PP     ((bf16*)(F.ws + WS_PP))
#define F_H2B    ((bf16*)(F.ws + WS_H2B))
#define F_ROPE   ((float*)(F.ws + WS_ROPE))
#define F_RSTD1  ((float*)(F.ws + WS_RSTD1))
#define F_RSTD3  ((float*)(F.ws + WS_RSTD3))
#define F_QP     ((float*)(F.ws + WS_QP))
#define F_GATE   ((float*)(F.ws + WS_GATE))
#define F_H1     ((float*)(F.ws + WS_H1))
#define F_SSQ2   ((float*)(F.ws + WS_CTL) + CW_SSQ2)
#define F_SSQ4   ((float*)(F.ws + WS_CTL) + CW_SSQ4)
#define F_EIDX   ((int*)(F.ws + WS_EIDX))

__device__ __forceinline__ void p0_transpose_item(const float* W, int ldw, int N, const float* gain, bf16* WT, int ldt, LAS float* scr, int item, int lane) {
    const int nblk = N / 32, kb = item / nblk, nb = item % nblk, k0 = 64 * kb, n0 = 32 * nb;
    float wv[32];
#pragma unroll
    for (int i = 0; i < 32; ++i) { const int kk = 2 * i + (lane >> 5); wv[i] = W[(size_t)(k0 + kk) * ldw + n0 + (lane & 31)]; }
    if (gain) {
#pragma unroll
        for (int i = 0; i < 32; ++i) wv[i] *= gain[k0 + 2 * i + (lane >> 5)];
    }
#pragma unroll
    for (int i = 0; i < 32; ++i) { const int kk = 2 * i + (lane >> 5); scr[kk * 33 + (lane & 31)] = wv[i]; }
    LDS_WAIT(); asm volatile("" ::: "memory");
    const int c = lane & 7;
#pragma unroll
    for (int j = 0; j < 4; ++j) { const int n = (lane >> 3) + 8 * j; const LAS float* s = scr + (8 * c) * 33 + n;
        v4u o; o.x = pk2(s[0 * 33], s[1 * 33]); o.y = pk2(s[2 * 33], s[3 * 33]); o.z = pk2(s[4 * 33], s[5 * 33]); o.w = pk2(s[6 * 33], s[7 * 33]);
        *(GAS v4u*)(WT + (size_t)(n0 + n) * ldt + k0 + 8 * c) = o; }
    LDS_WAIT(); asm volatile("" ::: "memory");
}
__device__ __forceinline__ void p0_prologue(Frame& F) {
    LAS float* scr = (LAS float*)(F.lds + RING_OFF + F.wave * 16384);
    const int gw = F.vcu * NWAVES + F.wave, NGW = F.G * NWAVES;
    const int gt = gw * 64 + F.lane, NGT = NGW * 64;
    constexpr int I_IN = (DM / 64) * (INW / 32), I_P = (PLE / 64) * (DM / 32);
    constexpr int NITEMS = I_IN + I_P;
    for (int it = gw; it < NITEMS; it += NGW) {
        int r = it;
        if (r < I_IN) { p0_transpose_item(F.w_in, INW, INW, F.g_mix, F_Win_t, DM, scr, r, F.lane); continue; } r -= I_IN;
        p0_transpose_item(F.w_ple_proj, DM, DM, nullptr, F_Wp_t, PLE, scr, r, F.lane);
    }
    for (int m = gw; m < M; m += NGW) {
        const GAS f32x4* xr = (const GAS f32x4*)(F.x + (size_t)m * DM) + F.lane;
        f32x4 v[8]; float s = 0.f;
#pragma unroll
        for (int j = 0; j < 8; ++j) { v[j] = xr[64 * j]; s += (v[j].x * v[j].x + v[j].y * v[j].y) + (v[j].z * v[j].z + v[j].w * v[j].w); }
        s = wave_sum(s);
        if (F.lane == 0) F_RSTD1[m] = 1.0f / sqrtf(s * (1.0f / DM) + EPS);
        GAS v2u* o8 = (GAS v2u*)(F_XB + (size_t)m * DM) + F.lane;
#pragma unroll
        for (int j = 0; j < 8; ++j) { v2u o; o.x = pk2(v[j].x, v[j].y); o.y = pk2(v[j].z, v[j].w); o8[64 * j] = o; }
    }
    for (int c = gt; c < M * PLE / 8; c += NGT) {
        const GAS f32x4* s = (const GAS f32x4*)F.p + 2 * (size_t)c; const f32x4 a = s[0], b = s[1];
        v4u o; o.x = pk2(a.x, a.y); o.y = pk2(a.z, a.w); o.z = pk2(b.x, b.y); o.w = pk2(b.z, b.w);
        *((GAS v4u*)F_PB + c) = o;
    }
    for (int c = gt; c < M * 8; c += NGT) {
        const int t = c >> 3, i = c & 7;
        const float inv = 1.0f / (float)pow(500000.0, (double)(2 * i) / 16.0);
        const float ang = (float)F.positions[t] * inv;
        F_ROPE[t * 16 + i] = (float)cos((double)ang); F_ROPE[t * 16 + 8 + i] = (float)sin((double)ang);
    }
    for (int c = gt; c < 2 * 128 * 128; c += NGT) {
        const float v = F.sub_keys[c]; const unsigned h = pk2(v, 0.f) & 0xffffu; const float hf = __uint_as_float(h << 16);
        F_SKH[c] = (bf16)h; F_SKL[c] = (bf16)(pk2(v - hf, 0.f) & 0xffffu);
    }
}


constexpr int Q_EXP = 1024, Q_SQ = 256, Q_POOL = 16, Q_ITEMS = Q_EXP + 3 * Q_SQ + Q_POOL;
template <bool ISV> __device__ __forceinline__ void conv_expert_rows(Frame& F, int e0, int tid) {
    const float* src = ISV ? F.expert_v : F.expert_u; unsigned char* dstb = (unsigned char*)(ISV ? (void*)F_EV : (void*)F_EU);
    const float sc = ISV ? EV_SCALE : EU_SCALE;
    const int lane = tid & 63, wv = tid >> 6;
#pragma unroll 4
    for (int it = 0; it < 8; ++it) {
        const int ix = it * 8 + wv, eg = ix >> 4, s = ix & 15;
        const int e = e0 + eg * 8 + (lane >> 3), d0 = s * 128 + (lane & 7) * 16;
        const GAS f32x4* sp = (const GAS f32x4*)(src + (size_t)e * DM + d0); const GAS f32x4* gp = (const GAS f32x4*)(F.g_ffn + d0);
        v4u o;
#pragma unroll
        for (int q = 0; q < 4; ++q) { f32x4 a = sp[q] * sc; if constexpr (!ISV) a = a * gp[q]; int w = 0; w = __builtin_amdgcn_cvt_pk_fp8_f32(a.x, a.y, w, false); w = __builtin_amdgcn_cvt_pk_fp8_f32(a.z, a.w, w, true); o[q] = (unsigned)w; }
        *(GAS v4u*)(dstb + ((size_t)s * NEXP + e) * 128 + (lane & 7) * 16) = o;
    }
}
__device__ __forceinline__ void conv_expert_item(Frame& F, int idx, int tid) {
    if (idx >= 512) conv_expert_rows<true>(F, (idx & 511) * 32, tid); else conv_expert_rows<false>(F, (idx & 511) * 32, tid);
}
constexpr int Q_W = 3 * Q_SQ + Q_POOL;
__device__ __forceinline__ void p1_queue(Frame& F, int lo, int hi, int cw) {
    const int lane = (int)__builtin_amdgcn_mbcnt_hi(~0u, __builtin_amdgcn_mbcnt_lo(~0u, 0u)), tid = F.wave * 64 + lane;
    LAS float* scr = (LAS float*)(F.lds + RING_OFF + F.wave * 16384);
    volatile LAS unsigned* qslot = F.MISC + 12;
    unsigned mine = 0u;
    __syncthreads();
    if (tid == 0) { qslot[0] = __hip_atomic_fetch_add((unsigned*)(F.ctl + cw), 1u, RLX_AGENT); }
    __syncthreads();
    int idx = lo + (int)qslot[0];
    for (int n = 0;; ++n) {
        if (idx >= hi) break;
        if (tid == 0) mine = __hip_atomic_fetch_add((unsigned*)(F.ctl + cw), 1u, RLX_AGENT);
        if (idx >= Q_W) conv_expert_item(F, idx - Q_W, tid);
        else {
            int r = idx * 8 + F.wave;
            if (r < 8 * Q_SQ) p0_transpose_item(F.w_out, DM, DM, nullptr, F_Wout_t, DM, scr, r, lane);
            else if (r < 16 * Q_SQ) p0_transpose_item(F.w_query, DM, DM, F.g_ffn, F_Wq_t, DM, scr, r - 8 * Q_SQ, lane);
            else if (r < 24 * Q_SQ) p0_transpose_item(F.w_ple_gate, DM, DM, F.g_ple, F_Wg_t, DM, scr, r - 16 * Q_SQ, lane);
            else { const int rp = r - 24 * Q_SQ, g = rp / 32, rr = rp % 32; p0_transpose_item(F.w_pool + (size_t)g * 65536, 256, 256, nullptr, F_Wpool_t + (size_t)g * 65536, 256, scr, rr, lane); }
        }
        if (tid == 0) qslot[1 - (n & 1)] = mine;
        __syncthreads();
        idx = lo + (int)qslot[1 - (n & 1)];
    }
    __syncthreads();
}
struct PpOrder {
    int first, stride;
    __device__ __forceinline__ void init(int G, int c, int nconv) { const int heavy = nconv > 0 ? nconv : ((320 > G && 320 - G < G) ? 320 - G : 0); if (c < heavy) { first = 1 << 20; stride = 1; } else { first = c - heavy; stride = G - heavy; } }
    __device__ __forceinline__ bool next(int i, pg8::Unit& u) const { const long k = (long)first + (long)i * stride; if (k >= 256) return false; u.pm = (int)k >> 3; u.pn = (int)k & 7; return true; }
    __device__ __forceinline__ void a_ready(const pg8::Unit&) const {}
    __device__ __forceinline__ void done(const pg8::Unit&) const {}
};

struct EpiG1 {
    static constexpr bool PERM = true, AFTER_DRAIN = false;
    bf16 *Q, *Kb, *Vb, *U; const float* rstd; const float* rope;
    __device__ __forceinline__ void operator()(const f32x4 (&acc)[2][2][4][2], const pg8::Unit& u, int wr, int wc, int fr, int fq) const {
        const int pn = u.pn; bf16* base; int ldc, colt;
        if (pn < 4) { base = Q; ldc = ATTW; colt = pn * 256; } else if (pn == 4) { base = Kb; ldc = KVW; colt = 0; } else if (pn == 5) { base = Vb; ldc = KVW; colt = 0; } else { base = U; ldc = POOLW; colt = (pn - 6) * 256; }
        const bool rot = (pn <= 4) && ((wc & 1) == 0);
        const float qs = (pn < 4) ? 0.125f : 1.0f;
#pragma unroll
        for (int ai = 0; ai < 2; ++ai)
#pragma unroll
            for (int m = 0; m < 4; ++m) {
                const int row = u.pm * 256 + ai * 128 + wr * 64 + m * 16 + fr;
                const float rs = rstd[row] * qs;
                const GAS f32x4* rp = (const GAS f32x4*)(rope + (size_t)row * 16);
#pragma unroll
                for (int bj = 0; bj < 2; ++bj) {
                    f32x4 v0 = acc[ai][bj][m][0] * rs, v1 = acc[ai][bj][m][1] * rs;
                    if (rot) {
                        { const f32x4 c = rp[0], s = rp[2]; f32x4 p;
#pragma unroll
                          for (int i = 0; i < 4; ++i) p[i] = __shfl_xor(v0[i], 16);
                          if (fq == 0) v0 = v0 * c - p * s; else if (fq == 1) v0 = v0 * c + p * s; }
                        { const f32x4 c = rp[1], s = rp[3]; f32x4 p;
#pragma unroll
                          for (int i = 0; i < 4; ++i) p[i] = __shfl_xor(v1[i], 16);
                          if (fq == 0) v1 = v1 * c - p * s; else if (fq == 1) v1 = v1 * c + p * s; }
                    }
                    v4u w; w.x = pk2(v0[0], v0[1]); w.y = pk2(v0[2], v0[3]); w.z = pk2(v1[0], v1[1]); w.w = pk2(v1[2], v1[3]);
                    *(GAS v4u*)(base + (size_t)row * ldc + colt + bj * 128 + wc * 32 + 8 * fq) = w;
                }
            }
    }
};
template <bool HAS_SCALE> struct EpiBf16Scale {
    static constexpr bool PERM = true, AFTER_DRAIN = false;
    bf16* O; int ldc, col_off; const float* cscale;
    __device__ __forceinline__ void operator()(const f32x4 (&acc)[2][2][4][2], const pg8::Unit& u, int wr, int wc, int fr, int fq) const {
        const int c0 = u.pn * 256 + wc * 32 + 8 * fq;
#pragma unroll
        for (int ai = 0; ai < 2; ++ai)
#pragma unroll
            for (int m = 0; m < 4; ++m) {
                const int row = u.pm * 256 + ai * 128 + wr * 64 + m * 16 + fr;
#pragma unroll
                for (int bj = 0; bj < 2; ++bj) {
                    f32x4 v0 = acc[ai][bj][m][0], v1 = acc[ai][bj][m][1];
                    if constexpr (HAS_SCALE) { v0 = v0 * *(const GAS f32x4*)(cscale + c0 + bj * 128); v1 = v1 * *(const GAS f32x4*)(cscale + c0 + bj * 128 + 4); }
                    v4u w; w.x = pk2(v0[0], v0[1]); w.y = pk2(v0[2], v0[3]); w.z = pk2(v1[0], v1[1]); w.w = pk2(v1[2], v1[3]);
                    *(GAS v4u*)(O + (size_t)row * ldc + col_off + c0 + bj * 128) = w;
                }
            }
    }
};
struct EpiG3 {
    static constexpr bool PERM = false, AFTER_DRAIN = false;
    const bf16* xb; bf16* h1b; float* ssq;
    __device__ __forceinline__ void operator()(const f32x4 (&acc)[2][2][4][2], const pg8::Unit& u, int wr, int wc, int fr, int fq) const {
        const int col0 = u.pn * 256 + wc * 32 + 4 * fq;
#pragma unroll
        for (int ai = 0; ai < 2; ++ai)
#pragma unroll
            for (int m = 0; m < 4; ++m) {
                const int row = u.pm * 256 + ai * 128 + wr * 64 + m * 16 + fr; float ss = 0.f;
#pragma unroll
                for (int bj = 0; bj < 2; ++bj)
#pragma unroll
                    for (int n = 0; n < 2; ++n) {
                        const size_t off = (size_t)row * DM + col0 + bj * 128 + n * 16;
                        const v2u xw = *(const GAS v2u*)(xb + off); const f32x4 xv = {bf_lo(xw.x), bf_hi(xw.x), bf_lo(xw.y), bf_hi(xw.y)};
                        const f32x4 h = DBG_NO_MIX ? xv : xv + acc[ai][bj][m][n];
                        v2u w; w.x = pk2(h[0], h[1]); w.y = pk2(h[2], h[3]); *(GAS v2u*)(h1b + off) = w;
                        ss += (h[0] * h[0] + h[1] * h[1]) + (h[2] * h[2] + h[3] * h[3]);
                    }
                ss += __shfl_xor(ss, 16); ss += __shfl_xor(ss, 32);
                if (fq == 0) atomicAdd(ssq + row, ss);
            }
    }
};
struct EpiG4 {
    static constexpr bool PERM = false, AFTER_DRAIN = false;
    float* qp; const float* ssq;
    __device__ __forceinline__ void operator()(const f32x4 (&acc)[2][2][4][2], const pg8::Unit& u, int wr, int wc, int fr, int fq) const {
        const int col0 = u.pn * 256 + wc * 32 + 4 * fq;
#pragma unroll
        for (int ai = 0; ai < 2; ++ai)
#pragma unroll
            for (int m = 0; m < 4; ++m) {
                const int row = u.pm * 256 + ai * 128 + wr * 64 + m * 16 + fr;
                const float rs = 1.0f / sqrtf(__hip_atomic_load(ssq + row, RLX_AGENT) * (1.0f / DM) + EPS);
#pragma unroll
                for (int bj = 0; bj < 2; ++bj)
#pragma unroll
                    for (int n = 0; n < 2; ++n) *(GAS f32x4*)(qp + (size_t)row * DM + col0 + bj * 128 + n * 16) = acc[ai][bj][m][n] * rs;
            }
    }
};
struct EpiG5 {
    static constexpr bool PERM = false, AFTER_DRAIN = false;
    const bf16* h2b; const bf16* pp; const float* rstd3; bf16* h3b; float* ssq;
    __device__ __forceinline__ void operator()(const f32x4 (&acc)[2][2][4][2], const pg8::Unit& u, int wr, int wc, int fr, int fq) const {
        const int col0 = u.pn * 256 + wc * 32 + 4 * fq;
#pragma unroll
        for (int ai = 0; ai < 2; ++ai)
#pragma unroll
            for (int m = 0; m < 4; ++m) {
                const int row = u.pm * 256 + ai * 128 + wr * 64 + m * 16 + fr; float ss = 0.f;
                const float rs = rstd3[row];
#pragma unroll
                for (int bj = 0; bj < 2; ++bj)
#pragma unroll
                    for (int n = 0; n < 2; ++n) {
                        const size_t off = (size_t)row * DM + col0 + bj * 128 + n * 16;
                        const f32x4 z = DBG_NO_PLE ? (f32x4){-1e30f, -1e30f, -1e30f, -1e30f} : acc[ai][bj][m][n] * rs; const v2u pw = *(const GAS v2u*)(pp + off); const v2u hw = *(const GAS v2u*)(h2b + off);
                        f32x4 o;
                        o[0] = bf_lo(hw.x) + bf_lo(pw.x) / (1.0f + __expf(-z[0])); o[1] = bf_hi(hw.x) + bf_hi(pw.x) / (1.0f + __expf(-z[1]));
                        o[2] = bf_lo(hw.y) + bf_lo(pw.y) / (1.0f + __expf(-z[2])); o[3] = bf_hi(hw.y) + bf_hi(pw.y) / (1.0f + __expf(-z[3]));
                        v2u w; w.x = pk2(o[0], o[1]); w.y = pk2(o[2], o[3]); *(GAS v2u*)(h3b + off) = w;
                        ss += (o[0] * o[0] + o[1] * o[1]) + (o[2] * o[2] + o[3] * o[3]);
                    }
                ss += __shfl_xor(ss, 16); ss += __shfl_xor(ss, 32);
                if (fq == 0) atomicAdd(ssq + row, ss);
            }
    }
};
struct SingleUnit {
    int pm, pn;
    __device__ __forceinline__ bool next(int i, pg8::Unit& u) const { if (i != 0) return false; u.pm = pm; u.pn = pn; return true; }
    __device__ __forceinline__ void a_ready(const pg8::Unit&) const {}
    __device__ __forceinline__ void done(const pg8::Unit&) const {}
};

__device__ __forceinline__ int crow(int r, int hi) { return (r & 3) + 8 * (r >> 2) + 4 * hi; }
constexpr int KS_STRIDE = 144, VT_STRIDE = 520, VT_OFF = 256 * KS_STRIDE;
__device__ __forceinline__ void attn_unit(Frame& F, int unit) {
    const int g = unit & 3, nblk = (unit >> 2) & 31, b = unit >> 7;
    const int t0 = b * SEQ + nblk * 128;
    LAS unsigned char* Ks = F.lds + RING_OFF;
    LAS unsigned char* Vt = F.lds + RING_OFF + VT_OFF;
    for (int c = F.tid; c < 2048; c += NWAVES * 64) {
        const int j = c >> 3, ch = c & 7;
        v4u kv = {0u, 0u, 0u, 0u}, vv = {0u, 0u, 0u, 0u};
        if (nblk > 0 || j >= 128) { const size_t row = (size_t)(t0 - 128 + j); kv = *(const GAS v4u*)(F_KB + row * KVW + g * 64 + ch * 8); vv = *(const GAS v4u*)(F_VB + row * KVW + g * 64 + ch * 8); }
        *(LAS v4u*)(Ks + j * KS_STRIDE + ch * 16) = kv;
#pragma unroll
        for (int e = 0; e < 8; ++e) *(LAS unsigned short*)(Vt + (ch * 8 + e) * VT_STRIDE + j * 2) = (unsigned short)((vv[e >> 1] >> (16 * (e & 1))) & 0xffffu);
    }
    __syncthreads();
    const int hq = 4 * g + (F.wave >> 1);
    const float sink = F.sinks[hq];
    const int q = F.lane & 31, h = F.lane >> 5;
#pragma unroll 1
    for (int sub = 0; sub < 2; ++sub) {
        const int i0 = (F.wave & 1) * 64 + sub * 32;
        bf16x8 qf[4];
#pragma unroll
        for (int ks = 0; ks < 4; ++ks) qf[ks] = *(const GAS bf16x8*)(F_QB + (size_t)(t0 + i0 + q) * ATTW + hq * 64 + 16 * ks + 8 * h);
        f32x16 s[5];
#pragma unroll
        for (int kt = 0; kt < 5; ++kt) {
#pragma unroll
            for (int r = 0; r < 16; ++r) s[kt][r] = 0.f;
#pragma unroll
            for (int ks = 0; ks < 4; ++ks) {
                const bf16x8 a = *(const LAS bf16x8*)(Ks + (i0 + 32 * kt + q) * KS_STRIDE + (16 * ks + 8 * h) * 2);
                s[kt] = __builtin_amdgcn_mfma_f32_32x32x16_bf16(a, qf[ks], s[kt], 0, 0, 0);
            }
        }
        float mx = sink;
#pragma unroll
        for (int kt = 0; kt < 5; ++kt)
#pragma unroll
            for (int r = 0; r < 16; ++r) {
                const bool tv = (nblk > 0) || (i0 + 32 * kt >= 128);
                const bool ok = (kt == 0) ? (crow(r, h) > q) : (kt == 4) ? (crow(r, h) <= q) : true;
                const float v = (ok && tv) ? s[kt][r] : -INFINITY;
                s[kt][r] = v; mx = fmaxf(mx, v);
            }
        mx = fmaxf(mx, __shfl_xor(mx, 32));
        float sum = 0.f;
#pragma unroll
        for (int kt = 0; kt < 5; ++kt)
#pragma unroll
            for (int r = 0; r < 16; ++r) { const float pv = __expf(s[kt][r] - mx); s[kt][r] = pv; sum += pv; }
        sum += __shfl_xor(sum, 32);
        sum += __expf(sink - mx);
        const float inv = 1.0f / sum;
        f32x16 o[2];
#pragma unroll
        for (int dt = 0; dt < 2; ++dt)
#pragma unroll
            for (int r = 0; r < 16; ++r) o[dt][r] = 0.f;
#pragma unroll
        for (int kt = 0; kt < 5; ++kt)
#pragma unroll
            for (int st = 0; st < 2; ++st) {
                v4u pw; pw.x = pk2(s[kt][8 * st + 0], s[kt][8 * st + 1]); pw.y = pk2(s[kt][8 * st + 2], s[kt][8 * st + 3]); pw.z = pk2(s[kt][8 * st + 4], s[kt][8 * st + 5]); pw.w = pk2(s[kt][8 * st + 6], s[kt][8 * st + 7]);
                const bf16x8 pb = __builtin_bit_cast(bf16x8, pw);
#pragma unroll
                for (int dt = 0; dt < 2; ++dt) {
                    const LAS unsigned char* vb = Vt + (32 * dt + q) * VT_STRIDE + (i0 + 32 * kt + 16 * st + 4 * h) * 2;
                    const v2u lo = *(const LAS v2u*)vb, hi2 = *(const LAS v2u*)(vb + 16);
                    v4u aw; aw.x = lo.x; aw.y = lo.y; aw.z = hi2.x; aw.w = hi2.y;
                    o[dt] = __builtin_amdgcn_mfma_f32_32x32x16_bf16(__builtin_bit_cast(bf16x8, aw), pb, o[dt], 0, 0, 0);
                }
            }
        bf16* orow = F_MIX + (size_t)(t0 + i0 + q) * DM + hq * 64;
#pragma unroll
        for (int dt = 0; dt < 2; ++dt)
#pragma unroll
            for (int g4 = 0; g4 < 4; ++g4) {
                v2u w; w.x = pk2(o[dt][4 * g4] * inv, o[dt][4 * g4 + 1] * inv); w.y = pk2(o[dt][4 * g4 + 2] * inv, o[dt][4 * g4 + 3] * inv);
                *(GAS v2u*)(orow + 32 * dt + 8 * g4 + 4 * h) = w;
            }
    }
    __syncthreads();
}
template <int W> __device__ __forceinline__ void pool_tile_w(Frame& F, int pm, int g) {
    const int cg = F.tid & 31, rg = F.tid >> 5;
    const int r0 = pm * 256 + rg * 16;
    const int col = g * 256 + cg * 8;
    const int tseq0 = r0 & (SEQ - 1);
    const __amdgpu_buffer_rsrc_t rsu = __builtin_amdgcn_make_buffer_rsrc((void*)F_UB, 0, M * POOLW * 2, 0x00020000);
    const __amdgpu_buffer_rsrc_t rsp = __builtin_amdgcn_make_buffer_rsrc((void*)F_POOLED, 0, M * POOLW * 2, 0x00020000);
    v4u rows[W - 1 + 16];
#pragma unroll
    for (int j = 0; j < W - 1 + 16; ++j) { const int rr = r0 - (W - 1) + j; const bool ok = (tseq0 - (W - 1) + j) >= 0;
        rows[j] = __builtin_amdgcn_raw_buffer_load_b128(rsu, ok ? (unsigned)(rr * POOLW + col) * 2u : 0xFFFFFFF0u, 0, 0); }
    float sum[8];
#pragma unroll
    for (int e = 0; e < 8; ++e) sum[e] = 0.f;
#pragma unroll
    for (int j = 0; j < W - 1; ++j)
#pragma unroll
        for (int e = 0; e < 4; ++e) { const unsigned wv = rows[j][e]; sum[2 * e] += bf_lo(wv); sum[2 * e + 1] += bf_hi(wv); }
#pragma unroll
    for (int i = 0; i < 16; ++i) {
        const int ts = tseq0 + i;
        float cur[8];
#pragma unroll
        for (int e = 0; e < 4; ++e) { const unsigned wv = rows[W - 1 + i][e]; cur[2 * e] = bf_lo(wv); cur[2 * e + 1] = bf_hi(wv); }
#pragma unroll
        for (int e = 0; e < 8; ++e) sum[e] += cur[e];
        const int cnt = (ts + 1 < W) ? ts + 1 : W; const float ic = 1.0f / (float)cnt;
        v4u o;
        o.x = pk2(sum[0] * ic - cur[0], sum[1] * ic - cur[1]); o.y = pk2(sum[2] * ic - cur[2], sum[3] * ic - cur[3]);
        o.z = pk2(sum[4] * ic - cur[4], sum[5] * ic - cur[5]); o.w = pk2(sum[6] * ic - cur[6], sum[7] * ic - cur[7]);
        __builtin_amdgcn_raw_buffer_store_b128(o, rsp, (unsigned)((r0 + i) * POOLW + col) * 2u, 0, 0);
#pragma unroll
        for (int e = 0; e < 4; ++e) { const unsigned wv = rows[i][e]; sum[2 * e] -= bf_lo(wv); sum[2 * e + 1] -= bf_hi(wv); }
    }
}
__device__ __forceinline__ void pool_tile(Frame& F, int pm, int g) {
    if (g == 0) pool_tile_w<2>(F, pm, g); else if (g == 1) pool_tile_w<4>(F, pm, g); else if (g == 2) pool_tile_w<8>(F, pm, g); else pool_tile_w<16>(F, pm, g);
}

template <int N> __device__ __forceinline__ void insert_desc(float (&val)[N], float x) {
#pragma unroll
    for (int k = 0; k < N; ++k) { const float hi = max2f(x, val[k]); x = min2f(x, val[k]); val[k] = hi; }
}
__device__ __forceinline__ void bitonic_merge16(float (&m)[16]) {
#pragma unroll
    for (int st = 8; st >= 1; st >>= 1)
#pragma unroll
        for (int i = 0; i < 16; ++i) if ((i & st) == 0) { const float hi = max2f(m[i], m[i + st]), lo = min2f(m[i], m[i + st]); m[i] = hi; m[i + st] = lo; }
}
__device__ __forceinline__ void merge_partner16(float (&val)[16]) {
    float pr[16];
#pragma unroll
    for (int k = 0; k < 16; ++k) pr[k] = __shfl_xor(val[k], 32);
#pragma unroll
    for (int k = 0; k < 16; ++k) val[k] = max2f(val[k], pr[15 - k]);
    bitonic_merge16(val);
}
__device__ __forceinline__ void pin16(float (&v)[16]) {
#pragma unroll
    for (int k = 0; k < 16; ++k) asm volatile("" : "+v"(v[k]));
}
struct CandTab { int a[50], b[50]; };
__host__ __device__ constexpr CandTab make_cands() { CandTab t{}; int n = 0; for (int a = 0; a < 16; ++a) for (int b = 0; b < 16; ++b) if ((a + 1) * (b + 1) <= 16) { t.a[n] = a; t.b[n] = b; ++n; } return t; }
__device__ __forceinline__ float vsel(unsigned long long m, float a, float b) { float r; asm("v_cndmask_b32_e64 %0, %1, %2, %3" : "=v"(r) : "v"(b), "v"(a), "s"(m)); return r; }
__device__ __forceinline__ float sel16(const float (&L)[16], int a) { float r = L[0];
#pragma unroll
    for (int k = 1; k < 16; ++k) r = vsel(__ballot(a == k), L[k], r);
    return r; }
constexpr int SK_ROW = 272;
template <int HALF_>
__device__ __forceinline__ void route_stage(Frame& F) {
    for (int c = F.tid; c < 2 * 128 * 16; c += NWAVES * 64) {
        const int tab = c >> 11, row = (c >> 4) & 127, ch = c & 15;
        const v4u v = *(const GAS v4u*)((tab ? F_SKL : F_SKH) + HALF_ * 16384 + row * 128 + ch * 8);
        *(LAS v4u*)(F.lds + RING_OFF + tab * 128 * SK_ROW + row * SK_ROW + ch * 16) = v;
    }
}
template <int HALF_>
__device__ __forceinline__ void route_half(Frame& F, const float* qrow, int r, int h, float (&Lout)[16]) {
    f32x16 acc[4];
#pragma unroll
    for (int kt = 0; kt < 4; ++kt)
#pragma unroll
        for (int i = 0; i < 16; ++i) acc[kt][i] = 0.f;
    const LAS unsigned char* skh = F.lds + RING_OFF; const LAS unsigned char* skl = F.lds + RING_OFF + 128 * SK_ROW;
#pragma unroll
    for (int ks = 0; ks < 8; ++ks) {
        const f32x4 qa = *(const GAS f32x4*)(qrow + HALF_ * 128 + 16 * ks + 8 * h), qb = *(const GAS f32x4*)(qrow + HALF_ * 128 + 16 * ks + 8 * h + 4);
        v4u hw, lw;
        hw.x = pk2(qa.x, qa.y); hw.y = pk2(qa.z, qa.w); hw.z = pk2(qb.x, qb.y); hw.w = pk2(qb.z, qb.w);
        lw.x = pk2(qa.x - bf_lo(hw.x), qa.y - bf_hi(hw.x)); lw.y = pk2(qa.z - bf_lo(hw.y), qa.w - bf_hi(hw.y));
        lw.z = pk2(qb.x - bf_lo(hw.z), qb.y - bf_hi(hw.z)); lw.w = pk2(qb.z - bf_lo(hw.w), qb.w - bf_hi(hw.w));
        const bf16x8 bh = __builtin_bit_cast(bf16x8, hw), bl = __builtin_bit_cast(bf16x8, lw);
#pragma unroll
        for (int kt = 0; kt < 4; ++kt) {
            const bf16x8 ah = *(const LAS bf16x8*)(skh + (32 * kt + r) * SK_ROW + (16 * ks + 8 * h) * 2), al = *(const LAS bf16x8*)(skl + (32 * kt + r) * SK_ROW + (16 * ks + 8 * h) * 2);
            acc[kt] = __builtin_amdgcn_mfma_f32_32x32x16_bf16(ah, bh, acc[kt], 0, 0, 0);
            acc[kt] = __builtin_amdgcn_mfma_f32_32x32x16_bf16(al, bh, acc[kt], 0, 0, 0);
            acc[kt] = __builtin_amdgcn_mfma_f32_32x32x16_bf16(ah, bl, acc[kt], 0, 0, 0);
        }
    }
#pragma unroll
    for (int k = 0; k < 16; ++k) Lout[k] = -INFINITY;
#pragma unroll
    for (int kt = 0; kt < 4; ++kt)
#pragma unroll
        for (int i = 0; i < 16; ++i) {
            const unsigned n = (unsigned)(32 * kt + (i & 3) + 8 * (i >> 2) + 4 * h);
            insert_desc<16>(Lout, __uint_as_float((__float_as_uint(acc[kt][i]) & ~127u) | n));
        }
    merge_partner16(Lout);
}
__device__ __forceinline__ void route_task(Frame& F, int task, bool valid) {
    const int r = F.lane & 31, h = F.lane >> 5;
    const int item = task * 32 + r, tok = item >> 3, head = item & 7;
    const float* qrow = F_QP + (size_t)tok * DM + head * 256;
    float L0[16], L1[16];
    __syncthreads(); route_stage<0>(F); __syncthreads();
    if (valid) route_half<0>(F, qrow, r, h, L0);
    __syncthreads(); route_stage<1>(F); __syncthreads();
    if (valid) route_half<1>(F, qrow, r, h, L1);
    if (!valid) return;
    pin16(L0); pin16(L1);
    constexpr CandTab CT = make_cands();
    const unsigned long long hm = __ballot(h != 0);
    float cand[16];
#pragma unroll
    for (int k = 0; k < 16; ++k) cand[k] = -INFINITY;
#pragma unroll
    for (int i = 0; i < 25; ++i) {
        const float v1 = vsel(hm, L0[CT.a[2 * i + 1]], L0[CT.a[2 * i]]);
        const float v2 = vsel(hm, L1[CT.b[2 * i + 1]], L1[CT.b[2 * i]]);
        const unsigned id = h ? (unsigned)(CT.a[2 * i + 1] * 16 + CT.b[2 * i + 1]) : (unsigned)(CT.a[2 * i] * 16 + CT.b[2 * i]);
        const float sm = __uint_as_float(__float_as_uint(v1) & ~127u) + __uint_as_float(__float_as_uint(v2) & ~127u);
        insert_desc<16>(cand, __uint_as_float((__float_as_uint(sm) & ~255u) | id));
    }
    merge_partner16(cand);
    pin16(cand);
    float se = 0.f;
#pragma unroll
    for (int k = 0; k < 16; ++k) se += __expf(cand[k] - cand[0]);
    const float ise = 1.0f / se;
    int eo[8]; float go[8];
#pragma unroll
    for (int kk = 0; kk < 8; ++kk) {
        const float cv = vsel(hm, cand[8 + kk], cand[kk]);
        const unsigned id = __float_as_uint(cv) & 255u; const int a = (int)(id >> 4), bb = (int)(id & 15u);
        const unsigned i1 = __float_as_uint(sel16(L0, a)) & 127u, i2 = __float_as_uint(sel16(L1, bb)) & 127u;
        eo[kk] = (int)(i1 * 128u + i2); go[kk] = __expf(cv - cand[0]) * ise;
    }
    int* ep = F_EIDX + (size_t)tok * 128 + head * 16 + 8 * h; float* gp = F_GATE + (size_t)tok * 128 + head * 16 + 8 * h;
    *(GAS v4u*)ep = (v4u){(unsigned)eo[0], (unsigned)eo[1], (unsigned)eo[2], (unsigned)eo[3]}; *(GAS v4u*)(ep + 4) = (v4u){(unsigned)eo[4], (unsigned)eo[5], (unsigned)eo[6], (unsigned)eo[7]};
    *(GAS f32x4*)gp = (f32x4){go[0], go[1], go[2], go[3]}; *(GAS f32x4*)(gp + 4) = (f32x4){go[4], go[5], go[6], go[7]};
}


#ifndef DBG_ROUTE_BF
#define DBG_ROUTE_BF 0
#endif
__device__ __forceinline__ void lds_insert(LAS float* V, LAS int* I, int tid, float x, int id) {
    if (x > V[15 * 256 + tid]) {
        int pos = 15;
        while (pos > 0 && V[(pos - 1) * 256 + tid] < x) { V[pos * 256 + tid] = V[(pos - 1) * 256 + tid]; I[pos * 256 + tid] = I[(pos - 1) * 256 + tid]; --pos; }
        V[pos * 256 + tid] = x; I[pos * 256 + tid] = id;
    }
}
__device__ __forceinline__ void route_bruteforce(Frame& F) {
    if (F.tid >= 256) return;
    const int tid = F.tid;
    LAS float* V0 = (LAS float*)(F.lds); LAS int* I0 = (LAS int*)(F.lds + 16384);
    LAS float* V1 = (LAS float*)(F.lds + 32768); LAS int* I1 = (LAS int*)(F.lds + 49152);
    LAS float* VC = (LAS float*)(F.lds + 65536); LAS int* IC = (LAS int*)(F.lds + 81920);
    for (int item = (int)blockIdx.x * 256 + tid; item < M * PKH; item += F.G * 256) {
        const int tok = item >> 3, head = item & 7;
        const float* qrow = F_QP + (size_t)tok * DM + head * 256;
        for (int k = 0; k < 16; ++k) { V0[k * 256 + tid] = -INFINITY; I0[k * 256 + tid] = 0; V1[k * 256 + tid] = -INFINITY; I1[k * 256 + tid] = 0; VC[k * 256 + tid] = -INFINITY; IC[k * 256 + tid] = 0; }
        for (int half = 0; half < 2; ++half) {
            float q[128];
#pragma unroll
            for (int d = 0; d < 128; d += 4) { const f32x4 t = *(const GAS f32x4*)(qrow + half * 128 + d); q[d] = t.x; q[d + 1] = t.y; q[d + 2] = t.z; q[d + 3] = t.w; }
            for (int n = 0; n < 128; ++n) {
                const float* sk = F.sub_keys + (size_t)half * 16384 + n * 128;
                float s = 0.f;
#pragma unroll
                for (int d = 0; d < 128; ++d) s += q[d] * sk[d];
                if (half == 0) lds_insert(V0, I0, tid, s, n); else lds_insert(V1, I1, tid, s, n);
            }
        }
        for (int a = 0; a < 16; ++a) for (int b = 0; b < 16; ++b) lds_insert(VC, IC, tid, V0[a * 256 + tid] + V1[b * 256 + tid], I0[a * 256 + tid] * 128 + I1[b * 256 + tid]);
        const float mx = VC[tid]; float se = 0.f;
        for (int k = 0; k < 16; ++k) se += __expf(VC[k * 256 + tid] - mx);
        for (int k = 0; k < 16; ++k) { F_EIDX[(size_t)tok * 128 + head * 16 + k] = IC[k * 256 + tid]; F_GATE[(size_t)tok * 128 + head * 16 + k] = __expf(VC[k * 256 + tid] - mx) / se; }
    }
}

template <int N> __device__ __forceinline__ void treduce(float (&v)[N], int lane, int d) {
    const bool up = (lane & d) != 0;
#pragma unroll
    for (int i = 0; i < N / 2; ++i) { const float send = up ? v[i] : v[i + N / 2], keep = up ? v[i + N / 2] : v[i]; v[i] = keep + __shfl_xor(send, d); }
}
constexpr int SLICE_BYTES = NEXP * 128;
constexpr int NSLICE = 16;
typedef float f32x2v __attribute__((ext_vector_type(2)));
__device__ __forceinline__ void peer_phase(Frame& F) {
    const int lane = F.lane, g = lane >> 3, p = lane & 7;
    const int tbase = (int)blockIdx.x * 32 + F.wave * 4;
    LAS float* alds = (LAS float*)(F.lds + RING_OFF + F.wave * 2048);
    const __amdgpu_buffer_rsrc_t rsu = __builtin_amdgcn_make_buffer_rsrc((void*)F_EU, 0, NEXP * DM, 0x00020000);
    const __amdgpu_buffer_rsrc_t rsv = __builtin_amdgcn_make_buffer_rsrc((void*)F_EV, 0, NEXP * DM, 0x00020000);
    const __amdgpu_buffer_rsrc_t rsx = __builtin_amdgcn_make_buffer_rsrc((void*)F_H1B, 0, M * DM * 2, 0x00020000);
    const __amdgpu_buffer_rsrc_t rsb = __builtin_amdgcn_make_buffer_rsrc((void*)F_H2B, 0, M * DM * 2, 0x00020000);
    const unsigned p16 = (unsigned)p * 16u;
    const unsigned cl = (unsigned)(16 * p + 8 * (g & 1) + 4 * ((g >> 1) & 1) + 2 * ((g >> 2) & 1));
    for (int tb = tbase; tb < M; tb += F.G * 32) {
        unsigned ev[4][8];
        float hacc[4][2];
#pragma unroll
        for (int tk = 0; tk < 4; ++tk) {
#pragma unroll
            for (int i = 0; i < 8; ++i) ev[tk][i] = (unsigned)F_EIDX[(size_t)(tb + tk) * 128 + 16 * i + g] | ((unsigned)F_EIDX[(size_t)(tb + tk) * 128 + 16 * i + 8 + g] << 16);
            hacc[tk][0] = 0.f; hacc[tk][1] = 0.f;
        }
#define PEER_VOFF(TK, i) ({ unsigned e_ = ev[TK][(i) >> 1]; asm volatile("" : "+v"(e_)); ((((i) & 1) ? (e_ >> 16) : (e_ & 0xffffu)) * 128u + p16); })
#define PEER_LOAD_X(X0, X1, S, TK) do { X0 = __builtin_amdgcn_raw_buffer_load_b128(rsx, 2u * p16, ((tb + (TK)) * DM + 128 * (S)) * 2, 0); X1 = __builtin_amdgcn_raw_buffer_load_b128(rsx, 2u * p16 + 16u, ((tb + (TK)) * DM + 128 * (S)) * 2, 0); } while (0)
#define PEER_LOAD_A(W, S, TK, H) do { _Pragma("unroll") for (int i = 0; i < 8; ++i) W[i] = __builtin_amdgcn_raw_buffer_load_b128(rsu, PEER_VOFF(TK, 8 * (H) + i), (S) * SLICE_BYTES, 0); } while (0)
#define PEER_COMP_A(W, H) do { \
        _Pragma("unroll") for (int i = 0; i < 8; ++i) { f32x2v a2 = {0.f, 0.f}; \
            _Pragma("unroll") for (int c = 0; c < 4; ++c) { const int wv = (int)W[i][c]; const f32x2v lo = __builtin_amdgcn_cvt_pk_f32_fp8(wv, false), hi = __builtin_amdgcn_cvt_pk_f32_fp8(wv, true); \
                a2 += lo * xf2[2 * c]; a2 += hi * xf2[2 * c + 1]; } \
            part[8 * (H) + i] = a2.x + a2.y; if (i & 1) __builtin_amdgcn_sched_barrier(0); } } while (0)
        for (int rep = 0; rep < NREP(6); ++rep) {
#pragma unroll
            for (int tk = 0; tk < 4; ++tk) { hacc[tk][0] = 0.f; hacc[tk][1] = 0.f; }
#pragma unroll 1
            for (int s = 0; s < NSLICE; ++s) {
#pragma unroll
                for (int tk = 0; tk < 4; ++tk) {
                    v4u w0[8], w1[8], x0, x1; f32x2v xf2[8]; float part[16];
                    PEER_LOAD_X(x0, x1, s, tk); PEER_LOAD_A(w0, s, tk, 0); PEER_LOAD_A(w1, s, tk, 1); __builtin_amdgcn_sched_barrier(0);
#pragma unroll
                    for (int c = 0; c < 4; ++c) { const unsigned a0 = x0[c], a1 = x1[c]; xf2[c] = (f32x2v){bf_lo(a0), bf_hi(a0)}; xf2[4 + c] = (f32x2v){bf_lo(a1), bf_hi(a1)}; }
                    PEER_COMP_A(w0, 0); __builtin_amdgcn_sched_barrier(0);
                    PEER_COMP_A(w1, 1); __builtin_amdgcn_sched_barrier(0);
                    treduce<16>(part, lane, 1); treduce<8>(reinterpret_cast<float (&)[8]>(part), lane, 2); treduce<4>(reinterpret_cast<float (&)[4]>(part), lane, 4);
                    hacc[tk][0] += part[0]; hacc[tk][1] += part[1]; __builtin_amdgcn_sched_barrier(0);
                }
                __builtin_amdgcn_s_barrier();
            }
        }
#undef PEER_LOAD_X
#undef PEER_LOAD_A
#undef PEER_COMP_A
#pragma unroll
        for (int tk = 0; tk < 4; ++tk) {
            const int t = tb + tk;
            const float rs2 = (1.0f / EU_SCALE) / sqrtf(__hip_atomic_load(F_SSQ2 + t, RLX_AGENT) * (1.0f / DM) + EPS);
#pragma unroll
            for (int j = 0; j < 2; ++j) {
                const int i = 8 * (p & 1) + 4 * ((p >> 1) & 1) + 2 * ((p >> 2) & 1) + j;
                const float hv = hacc[tk][j] * rs2;
                const float ge = 0.5f * hv * (1.0f + erff(hv * 0.70710678118654752f));
                alds[tk * 128 + g * 16 + i] = F_GATE[(size_t)t * 128 + 8 * i + g] * ge * (1.0f / EV_SCALE);
            }
        }
        LDS_WAIT(); asm volatile("" ::: "memory");
        float ssq[4] = {0.f, 0.f, 0.f, 0.f};
        constexpr int NREPB = ((REP_MASK >> 9) & 1) ? 2 : 1;
        for (int repb = 0; repb < NREPB; ++repb) {
#pragma unroll
        for (int tk = 0; tk < 4; ++tk) ssq[tk] = 0.f;
#define PEER_LOAD_B(W, S, TK, H) do { _Pragma("unroll") for (int i = 0; i < 8; ++i) W[i] = __builtin_amdgcn_raw_buffer_load_b128(rsv, PEER_VOFF(TK, 8 * (H) + i), (S) * SLICE_BYTES, 0); } while (0)
#define PEER_COMP_B(W, TK, H) do { f32x4 av[2]; \
        _Pragma("unroll") for (int q4 = 0; q4 < 2; ++q4) av[q4] = *(const LAS f32x4*)(alds + (TK) * 128 + g * 16 + 8 * (H) + 4 * q4); \
        _Pragma("unroll") for (int i = 0; i < 8; ++i) { const float a = av[i >> 2][i & 3] * (1.0f / NREPB); const f32x2v a2 = {a, a}; \
            _Pragma("unroll") for (int c = 0; c < 4; ++c) { const int wv = (int)W[i][c]; const f32x2v lo = __builtin_amdgcn_cvt_pk_f32_fp8(wv, false), hi = __builtin_amdgcn_cvt_pk_f32_fp8(wv, true); \
                oc2[2 * c] += a2 * lo; oc2[2 * c + 1] += a2 * hi; } if (i & 1) __builtin_amdgcn_sched_barrier(0); } } while (0)
        {
#pragma unroll 1
            for (int s = 0; s < NSLICE; ++s) {
#pragma unroll
                for (int tk = 0; tk < 4; ++tk) {
                    v4u w0[8], w1[8]; f32x2v oc2[8]; float oc[16];
                    const int so = (tb + tk) * DM + 128 * s;
                    PEER_LOAD_B(w0, s, tk, 0); PEER_LOAD_B(w1, s, tk, 1);
                    const unsigned hv2 = __builtin_amdgcn_raw_buffer_load_b32(rsx, cl * 2u, so * 2, 0);
                    __builtin_amdgcn_sched_barrier(0);
#pragma unroll
                    for (int c = 0; c < 8; ++c) oc2[c] = (f32x2v){0.f, 0.f};
                    PEER_COMP_B(w0, tk, 0); __builtin_amdgcn_sched_barrier(0);
                    PEER_COMP_B(w1, tk, 1); __builtin_amdgcn_sched_barrier(0);
#pragma unroll
                    for (int c = 0; c < 8; ++c) { oc[2 * c] = oc2[c].x; oc[2 * c + 1] = oc2[c].y; }
                    treduce<16>(oc, lane, 8); treduce<8>(reinterpret_cast<float (&)[8]>(oc), lane, 16); treduce<4>(reinterpret_cast<float (&)[4]>(oc), lane, 32);
                    const float h2a = bf_lo(hv2) + oc[0], h2b = bf_hi(hv2) + oc[1];
                    __builtin_amdgcn_raw_buffer_store_b32(pk2(h2a, h2b), rsb, cl * 2u, so * 2, 0); ssq[tk] += h2a * h2a + h2b * h2b;
                    __builtin_amdgcn_sched_barrier(0);
                }
                __builtin_amdgcn_s_barrier();
            }
        }
        }
#undef PEER_LOAD_B
#undef PEER_COMP_B
#pragma unroll
        for (int tk = 0; tk < 4; ++tk) { const float ss = wave_sum(ssq[tk]); if (lane == 0) F_RSTD3[tb + tk] = 1.0f / sqrtf(ss * (1.0f / DM) + EPS); }
        LDS_WAIT(); asm volatile("" ::: "memory");
    }
}

struct Args { const void* in[18]; float* out; unsigned char* ws; int ph_lo, ph_hi, li, pad; };
__global__ void __launch_bounds__(NWAVES * 64, 2) hymba_fwd(Args args) {
    extern __shared__ __attribute__((aligned(16))) unsigned char lds[];
    Frame F;
    F.lds = (LAS unsigned char*)lds;
    F.MISC = (volatile LAS unsigned*)(F.lds + MISC_OFF);
    F.tid = threadIdx.x; F.lane = F.tid & 63; F.wave = __builtin_amdgcn_readfirstlane(F.tid >> 6);
    F.G = gridDim.x; { const int bx = blockIdx.x; F.vcu = (F.G % 8 == 0) ? (bx % 8) * (F.G / 8) + bx / 8 : bx; }
    F.ws = args.ws;
    F.ctl = (gu32*)(F.ws + WS_CTL);
    F.x = (const float*)args.in[0]; F.p = (const float*)args.in[1]; F.positions = (const int*)args.in[2]; F.g_mix = (const float*)args.in[3]; F.w_in = (const float*)args.in[4];
    F.sinks = (const float*)args.in[5]; F.w_pool = (const float*)args.in[6]; F.pool_scale = (const float*)args.in[7]; F.w_out = (const float*)args.in[8]; F.g_ffn = (const float*)args.in[9];
    F.w_query = (const float*)args.in[10]; F.sub_keys = (const float*)args.in[11]; F.expert_u = (const float*)args.in[12]; F.expert_v = (const float*)args.in[13]; F.g_ple = (const float*)args.in[14];
    F.w_ple_gate = (const float*)args.in[15]; F.w_ple_proj = (const float*)args.in[16]; F.g_final = (const float*)args.in[17]; F.out = args.out;
    for (int u = F.tid; u < (LDS_BYTES - LDSCTL_OFF) / 4; u += NWAVES * 64) ((LAS unsigned*)(F.lds + LDSCTL_OFF))[u] = 0u;
    __syncthreads();
    const bool one_phase = (args.ph_hi - args.ph_lo) == 1;
    XcdBarrier bar; bar.bar = (unsigned*)(F.ctl + CW_BAR); bar.x = 0; bar.st = nullptr;
    if (!one_phase) bar = xcd_barrier_post((unsigned*)(F.ctl + CW_BAR), F.MISC + 8);
    const int lo = args.ph_lo, hi = args.ph_hi;
#define IN(k) (lo <= (k) && (k) < hi)
#define BOTH(k) (IN(k) && IN((k) + 1))
#define GRID_BAR() xcd_barrier(bar)

    if (IN(0)) { for (int rep = 0; rep < NREP(0); ++rep) p0_prologue(F); p1_queue(F, 0, Q_SPLIT, CW_QUEUE0); if (BOTH(0)) GRID_BAR(); }

    if (IN(1)) {
#if (REP_MASK >> 1) & 1
        { pg8::Gemm g{F_XB, F_Win_t, M, INW, DM, DM, DM}; pg8::StaticOrder S; S.init(M, INW, F.G, (int)blockIdx.x);
          EpiG1 E{F_QB, F_KB, F_VB, F_UB, F_RSTD1, F_ROPE};
          pg8::gemm_phase<EpiG1, pg8::StaticOrder, true, true>(F.lds + RING_OFF, g, S, E); }
        __syncthreads();
#endif
        const int nconv = (F.G == 256) ? NCONV : 0;
        if ((int)blockIdx.x >= nconv) {
        { pg8::Gemm g{F_XB, F_Win_t, M, INW, DM, DM, DM}; pg8::StaticOrder S; S.init(M, INW, F.G - nconv, (int)blockIdx.x - nconv);
          EpiG1 E{F_QB, F_KB, F_VB, F_UB, F_RSTD1, F_ROPE};
          pg8::gemm_phase<EpiG1, pg8::StaticOrder, true, true>(F.lds + RING_OFF, g, S, E); }
        { pg8::Gemm g{F_PB, F_Wp_t, M, DM, PLE, PLE, PLE}; PpOrder S; S.init(F.G, (int)blockIdx.x, nconv);
          EpiBf16Scale<false> E{F_PP, DM, 0, nullptr};
          pg8::gemm_phase<EpiBf16Scale<false>, PpOrder, false, true>(F.lds + RING_OFF, g, S, E); }
        }
        p1_queue(F, Q_SPLIT, Q_ITEMS, CW_QUEUE);
#if (REP_MASK >> 10) & 1
        p1_queue(F, 0, Q_ITEMS, CW_QUEUE0);
#endif
        if (BOTH(1)) GRID_BAR();
    }

    if (IN(2)) {
#if (REP_MASK >> 2) & 1
        if (F.G >= 256) { if ((int)blockIdx.x >= 128) for (int u = (int)blockIdx.x - 128; u < BATCH * 32 * NKVH; u += F.G - 128) attn_unit(F, u); }
#endif
        if (F.G >= 256) { if ((int)blockIdx.x >= 128) for (int u = (int)blockIdx.x - 128; u < BATCH * 32 * NKVH; u += F.G - 128) attn_unit(F, u); }
        else for (int u = (int)blockIdx.x; u < BATCH * 32 * NKVH; u += F.G) attn_unit(F, u);
        if ((int)blockIdx.x < 128) {
            const int pu = (int)blockIdx.x, pm = pu >> 2, g = pu & 3;
            pool_tile(F, pm, g);
            VM_WAIT(); __syncthreads();
            pg8::Gemm gm{F_POOLED + g * 256, F_Wpool_t + (size_t)g * 65536, M, 256, 256, POOLW, 256}; SingleUnit S{pm, 0};
            EpiBf16Scale<true> E{F_MIX, DM, ATTW + g * 256, F.pool_scale + g * 256};
            pg8::gemm_phase<EpiBf16Scale<true>, SingleUnit, false, true>(F.lds + RING_OFF, gm, S, E);
            __syncthreads();
        }
        if (BOTH(2)) GRID_BAR();
    }

    if (IN(3)) {
        pg8::Gemm g{F_MIX, F_Wout_t, M, DM, DM, DM, DM}; pg8::StaticOrder S; S.init(M, DM, F.G, (int)blockIdx.x);
#if (REP_MASK >> 3) & 1
        { EpiG3 E2{F_XB, F_H1B, (float*)(F.ws + WS_END)}; pg8::gemm_phase<EpiG3, pg8::StaticOrder, true, true>(F.lds + RING_OFF, g, S, E2); __syncthreads(); }
#endif
        EpiG3 E{F_XB, F_H1B, F_SSQ2};
        pg8::gemm_phase<EpiG3, pg8::StaticOrder, true, true>(F.lds + RING_OFF, g, S, E);
        if (BOTH(3)) GRID_BAR();
    }

    if (IN(4)) {
        pg8::Gemm g{F_H1B, F_Wq_t, M, DM, DM, DM, DM}; pg8::StaticOrder S; S.init(M, DM, F.G, (int)blockIdx.x);
        EpiG4 E{F_QP, F_SSQ2};
        for (int rep = 0; rep < NREP(4); ++rep)
        pg8::gemm_phase<EpiG4, pg8::StaticOrder, true, true>(F.lds + RING_OFF, g, S, E);
        if (BOTH(4)) GRID_BAR();
    }

    if (IN(5)) {
        for (int rep = 0; rep < NREP(5); ++rep)
        for (int base = (int)blockIdx.x * NWAVES; base < M * PKH / 32; base += F.G * NWAVES) { const int task = base + F.wave; route_task(F, task < M * PKH / 32 ? task : 0, task < M * PKH / 32); }
        __syncthreads();
        if (BOTH(5)) GRID_BAR();
    }

    if (IN(6)) {
        peer_phase(F);
        __syncthreads();
        if (BOTH(6)) GRID_BAR();
    }

    if (IN(7)) {
        pg8::Gemm g{F_H2B, F_Wg_t, M, DM, DM, DM, DM}; pg8::StaticOrder S; S.init(M, DM, F.G, (int)blockIdx.x);
#if (REP_MASK >> 7) & 1
        { EpiG5 E2{F_H2B, F_PP, F_RSTD3, F_H1B, (float*)(F.ws + WS_END)}; pg8::gemm_phase<EpiG5, pg8::StaticOrder, true, true>(F.lds + RING_OFF, g, S, E2); __syncthreads(); }
#endif
        EpiG5 E{F_H2B, F_PP, F_RSTD3, F_H1B, F_SSQ4};
        pg8::gemm_phase<EpiG5, pg8::StaticOrder, true, true>(F.lds + RING_OFF, g, S, E);
        if (BOTH(7)) GRID_BAR();
    }

    if (IN(8)) {
        const int gw = F.vcu * NWAVES + F.wave, NGW = F.G * NWAVES;
        for (int m = gw; m < M; m += NGW) {
            const float rs = 1.0f / sqrtf(__hip_atomic_load(F_SSQ4 + m, RLX_AGENT) * (1.0f / DM) + EPS);
            GAS f32x4* orow = (GAS f32x4*)(F.out + (size_t)m * DM) + F.lane; const GAS f32x4* gr = (const GAS f32x4*)F.g_final + F.lane; const GAS v2u* hr = (const GAS v2u*)(F_H1B + (size_t)m * DM) + F.lane;
#pragma unroll
            for (int j = 0; j < 8; ++j) { const v2u hw = hr[64 * j]; const f32x4 v = {bf_lo(hw.x), bf_hi(hw.x), bf_lo(hw.y), bf_hi(hw.y)}; orow[64 * j] = v * rs * gr[64 * j]; }
        }
    }
#undef IN
#undef BOTH
#undef GRID_BAR
}


#if DBG_ROUTE_BF
__global__ void __launch_bounds__(NWAVES * 64, 2) dbg_route_kernel(Args args) {
    extern __shared__ __attribute__((aligned(16))) unsigned char lds[];
    Frame F; F.lds = (LAS unsigned char*)lds; F.tid = threadIdx.x; F.lane = F.tid & 63; F.wave = F.tid >> 6; F.G = gridDim.x; F.vcu = blockIdx.x; F.ws = args.ws; F.sub_keys = (const float*)args.in[11];
    route_bruteforce(F);
}
#endif
extern "C" void kernel_launch(void* const* d_in, const int* in_sizes, int n_in, void* d_out, int out_size, void* d_ws, size_t ws_size, hipStream_t stream) {
    static int grid = 0;
    if (grid == 0) {
        if (n_in != 18 || out_size != M * DM || ws_size < WS_END + 65536) { fprintf(stderr, "kernel_launch: unexpected shapes (n_in %d, out %d, ws %zu)\n", n_in, out_size, ws_size); grid = -1; return; }
        int dev = 0, cus = 0, per_cu = 0;
        if (hipGetDevice(&dev) != hipSuccess || hipDeviceGetAttribute(&cus, hipDeviceAttributeMultiprocessorCount, dev) != hipSuccess) { grid = -1; return; }
#if DBG_ROUTE_BF
        (void)hipFuncSetAttribute((const void*)dbg_route_kernel, hipFuncAttributeMaxDynamicSharedMemorySize, 98304);
#endif
        if (hipFuncSetAttribute((const void*)hymba_fwd, hipFuncAttributeMaxDynamicSharedMemorySize, LDS_BYTES) != hipSuccess) { fprintf(stderr, "kernel_launch: hipFuncSetAttribute failed\n"); grid = -1; return; }
        if (hipOccupancyMaxActiveBlocksPerMultiprocessor(&per_cu, (const void*)hymba_fwd, NWAVES * 64, LDS_BYTES) != hipSuccess || per_cu < 1)
            fprintf(stderr, "kernel_launch: note: occupancy query reports %d workgroups per CU\n", per_cu);
        (void)hipGetLastError();
        if (cus < 128) { fprintf(stderr, "kernel_launch: needs >= 128 CUs\n"); grid = -1; return; }
        grid = cus;
    }
    if (grid < 0) return;
    if (hipMemsetAsync((char*)d_ws + WS_CTL, 0, CTL_ZERO_BYTES, stream) != hipSuccess) return;
    Args a{};
    for (int i = 0; i < 18; ++i) a.in[i] = d_in[i];
    a.out = (float*)d_out; a.ws = (unsigned char*)d_ws;
    constexpr int NL = MK_N_LAUNCHES;
    for (int li = 0; li < NL; ++li) {
        a.ph_lo = (NL == 1) ? 0 : li; a.ph_hi = (NL == 1) ? N_PHASES : li + 1; a.li = li;
#if DBG_ROUTE_BF
        if (NL == 9 && li == 5) { hipLaunchKernelGGL(dbg_route_kernel, dim3(grid), dim3(NWAVES * 64), 98304, stream, a); continue; }
#endif
        hipLaunchKernelGGL(hymba_fwd, dim3(grid), dim3(NWAVES * 64), LDS_BYTES, stream, a);
    }
}
```

```cpp
#include <hip/hip_runtime.h>
#include <cstdio>
#include <cstdint>
namespace pg8 {
#define PG8_LAS __attribute__((address_space(3)))
typedef unsigned short bf16_t;
typedef short bf16x8 __attribute__((ext_vector_type(8)));
typedef float f32x4 __attribute__((ext_vector_type(4)));
typedef unsigned u32x4 __attribute__((ext_vector_type(4)));
constexpr int BM = 256, BK = 64, HALF = 128, HTB = HALF * BK * 2  , STAGE_BYTES = 8 * HTB, NXCD = 8, WGM = 8;

__host__ __device__ __forceinline__ int lds_byte(int r, int c) { const int st = (r >> 4) * 2 + (c >> 5), rr = r & 15, cc = c & 31, ob = rr * 64 + cc * 2; return st * 1024 + (ob ^ (((ob >> 9) & 1) << 5)); }
__host__ __device__ __forceinline__ void stage_rc(int b, int& R, int& C) { const int st = b / 1024, sb = b % 1024, swz = sb ^ (((sb >> 9) & 1) << 5); R = (st >> 1) * 16 + swz / 64; C = (st & 1) * 32 + (swz % 64) / 2; }
__host__ __device__ __forceinline__ int perm32(int rho) { const int n = rho >> 4, i = rho & 15; return 8 * (i >> 2) + 4 * n + (i & 3); }

struct Unit { int pm, pn; };
struct Gemm { const bf16_t* A; const bf16_t* Bt; int M, N, K, lda, ldb; };

struct StaticOrder {
    int nM, nN, nwg, G, c;
    __host__ __device__ void init(int M, int N, int G_, int c_) { nM = M / BM; nN = N / BM; nwg = nM * nN; G = G_; c = c_; }
    __host__ __device__ bool next(int i, Unit& u) const {
        const long L = (long)i * G + c; if (L >= nwg) return false;
        int wgid = (int)L; { const int q = nwg / NXCD, r = nwg % NXCD, xcd = wgid % NXCD, off = wgid / NXCD; wgid = (xcd < r ? xcd * (q + 1) : r * (q + 1) + (xcd - r) * q) + off; }
        const int nig = WGM * nN, gid = wgid / nig, fm = gid * WGM, gsz = (nM - fm) < WGM ? (nM - fm) : WGM;
        u.pm = fm + ((wgid % nig) % gsz); u.pn = (wgid % nig) / gsz; return true;
    }
    __device__ __forceinline__ void a_ready(const Unit&) const {}
    __device__ __forceinline__ void done(const Unit&) const {}
};

__device__ __forceinline__ unsigned cvt_pk_bf16(float lo, float hi) { unsigned r; asm volatile("v_cvt_pk_bf16_f32 %0, %1, %2" : "=v"(r) : "v"(lo), "v"(hi)); return r; }
typedef float f32x2 __attribute__((ext_vector_type(2)));

template <class Epi, class Sched, bool ALIGN_EPI = false, bool SP2 = false>
__device__ __forceinline__ void gemm_phase(PG8_LAS unsigned char* lds, const Gemm g, const Sched& S, const Epi& E) {
    const int tid = threadIdx.x, wid = __builtin_amdgcn_readfirstlane(tid >> 6), lane = tid & 63, wr = wid >> 2, wc = wid & 3, fr = lane & 15, fq = lane >> 4;
    const int K = g.K, nt = K / BK;
    unsigned voffA[2], voffB[2];
#pragma unroll
    for (int i = 0; i < 2; ++i) { int R, C; stage_rc(tid * 16 + i * 8192, R, C); const int Rb = Epi::PERM ? ((R & ~31) + perm32(R & 31)) : R;
        voffA[i] = (unsigned)(R * g.lda + C) * 2u; voffB[i] = (unsigned)(Rb * g.ldb + C) * 2u; }
    const size_t kstep = (size_t)(BK * 2);
    const size_t hstepA = (size_t)HALF * g.lda * 2, hstepB = (size_t)HALF * g.ldb * 2;
    const size_t tstepA = 2 * hstepA, tstepB = 2 * hstepB;
    const unsigned ldsw = (unsigned)wid * 1024u;
    const int aoff = lds_byte(wr * 64 + fr, fq * 8), boff = lds_byte(wc * 32 + fr, fq * 8);
#define PG8_SA(b, h) (((b) * 2 + (h)) * HTB)
#define PG8_SB(b, h) ((4 + (b) * 2 + (h)) * HTB)
#define PG8_STAGE(bufoff, gbase, voff) do { _Pragma("unroll") for (int _i = 0; _i < 2; ++_i) \
        __builtin_amdgcn_global_load_lds((const unsigned*)((const char*)(gbase) + (voff)[_i]), (PG8_LAS unsigned*)(lds + (bufoff) + ldsw + _i * 8192), 16, 0, 0); } while (0)
#define PG8_LDA(dst, b, h) do { _Pragma("unroll") for (int m = 0; m < 4; ++m) _Pragma("unroll") for (int k = 0; k < 2; ++k) dst[m][k] = *(const PG8_LAS bf16x8*)(lds + PG8_SA(b, h) + aoff + m * 2048 + k * 1024); } while (0)
#define PG8_LDB(dst, b, h) do { _Pragma("unroll") for (int n = 0; n < 2; ++n) _Pragma("unroll") for (int k = 0; k < 2; ++k) dst[n][k] = *(const PG8_LAS bf16x8*)(lds + PG8_SB(b, h) + boff + n * 2048 + k * 1024); } while (0)
#define PG8_MMA(ai, bj, At, Bt) do { __builtin_amdgcn_s_setprio(1); _Pragma("unroll") for (int m = 0; m < 4; ++m) _Pragma("unroll") for (int n = 0; n < 2; ++n) _Pragma("unroll") for (int k = 0; k < 2; ++k) \
        acc[ai][bj][m][n] = __builtin_amdgcn_mfma_f32_16x16x32_bf16(Bt[n][k], At[m][k], acc[ai][bj][m][n], 0, 0, 0); __builtin_amdgcn_s_setprio(0); } while (0)
#define PG8_WAIT_V(n) asm volatile("s_waitcnt vmcnt(" #n ")" ::: "memory")
#define PG8_WAIT_L(n) asm volatile("s_waitcnt lgkmcnt(" #n ")" ::: "memory")
#define PG8_BAR __builtin_amdgcn_s_barrier()
#define PG8_SCHED __builtin_amdgcn_sched_barrier(0)
    Unit cur, nxt; int ui = 0;
    if (!S.next(0, cur)) return;
    f32x4 acc[2][2][4][2];
#pragma unroll
    for (int a = 0; a < 2; ++a)
#pragma unroll
        for (int b = 0; b < 2; ++b)
#pragma unroll
            for (int m = 0; m < 4; ++m)
#pragma unroll
                for (int n = 0; n < 2; ++n) acc[a][b][m][n] = (f32x4){0.f, 0.f, 0.f, 0.f};
    bf16x8 At[4][2], B0[2][2], B1[2][2];
    const char* cA = (const char*)g.A + (size_t)cur.pm * tstepA; const char* cB = (const char*)g.Bt + (size_t)cur.pn * tstepB;
    S.a_ready(cur);
    if constexpr (SP2) {
        PG8_STAGE(PG8_SB(0, 0), cB, voffB); PG8_STAGE(PG8_SB(0, 1), cB + hstepB, voffB); PG8_STAGE(PG8_SA(0, 0), cA, voffA); PG8_STAGE(PG8_SA(0, 1), cA + hstepA, voffA);
        if (wr == 1) PG8_BAR;
        PG8_WAIT_V(2); PG8_BAR;
        PG8_STAGE(PG8_SB(1, 0), cB + kstep, voffB); PG8_STAGE(PG8_SA(1, 0), cA + kstep, voffA); PG8_STAGE(PG8_SB(1, 1), cB + hstepB + kstep, voffB);
        PG8_WAIT_V(6); PG8_BAR;
    } else {
        PG8_STAGE(PG8_SB(0, 0), cB, voffB); PG8_STAGE(PG8_SA(0, 0), cA, voffA); PG8_STAGE(PG8_SB(0, 1), cB + hstepB, voffB); PG8_STAGE(PG8_SA(0, 1), cA + hstepA, voffA);
        if (wr == 1) PG8_BAR;
        PG8_WAIT_V(4); PG8_BAR;
        PG8_STAGE(PG8_SB(1, 0), cB + kstep, voffB); PG8_STAGE(PG8_SA(1, 0), cA + kstep, voffA); PG8_STAGE(PG8_SB(1, 1), cB + hstepB + kstep, voffB);
        PG8_WAIT_V(6); PG8_BAR;
    }
    for (;;) {
        const bool has_next = S.next(ui + 1, nxt);
        const char* nA = has_next ? (const char*)g.A + (size_t)nxt.pm * tstepA : cA; const char* nB = has_next ? (const char*)g.Bt + (size_t)nxt.pn * tstepB : cB;
        for (int t = 0; t < nt; t += 2) {
            const bool last = (t == nt - 2);
            const char* a1 = cA + (size_t)(t + 1) * kstep;
            const char* a2 = last ? nA : cA + (size_t)(t + 2) * kstep; const char* b2 = last ? nB : cB + (size_t)(t + 2) * kstep;
            const char* a3 = a2 + kstep; const char* b3 = b2 + kstep;
            if (last && has_next) S.a_ready(nxt);
            if constexpr (SP2) {
            PG8_LDB(B0, 0, 0); PG8_LDB(B1, 0, 1); PG8_SCHED; PG8_LDA(At, 0, 0); PG8_STAGE(PG8_SA(1, 1), a1 + hstepA, voffA);
            PG8_WAIT_V(8); PG8_WAIT_L(0); PG8_BAR; PG8_MMA(0, 0, At, B0); PG8_MMA(0, 1, At, B1); PG8_BAR; PG8_SCHED;
            PG8_LDA(At, 0, 1); PG8_STAGE(PG8_SB(0, 0), b2, voffB); PG8_STAGE(PG8_SB(0, 1), b2 + hstepB, voffB); PG8_STAGE(PG8_SA(0, 0), a2, voffA);
            PG8_WAIT_V(8); PG8_WAIT_L(0); PG8_BAR; PG8_MMA(1, 0, At, B0); PG8_MMA(1, 1, At, B1); PG8_BAR; PG8_SCHED;
            PG8_LDB(B0, 1, 0); PG8_LDB(B1, 1, 1); PG8_SCHED; PG8_LDA(At, 1, 0); PG8_STAGE(PG8_SA(0, 1), a2 + hstepA, voffA);
            PG8_WAIT_V(8); PG8_WAIT_L(0); PG8_BAR; PG8_MMA(0, 0, At, B0); PG8_MMA(0, 1, At, B1); PG8_BAR; PG8_SCHED;
            PG8_LDA(At, 1, 1); PG8_STAGE(PG8_SB(1, 0), b3, voffB); PG8_STAGE(PG8_SB(1, 1), b3 + hstepB, voffB); PG8_STAGE(PG8_SA(1, 0), a3, voffA);
            PG8_WAIT_V(8); PG8_WAIT_L(0); PG8_BAR; PG8_MMA(1, 0, At, B0); PG8_MMA(1, 1, At, B1); PG8_BAR; PG8_SCHED;
            } else {
            PG8_LDB(B0, 0, 0); PG8_SCHED; PG8_LDA(At, 0, 0); PG8_STAGE(PG8_SA(1, 1), a1 + hstepA, voffA);
            PG8_WAIT_L(8); PG8_BAR; PG8_WAIT_L(0); PG8_MMA(0, 0, At, B0); PG8_BAR; PG8_SCHED;
            PG8_LDB(B1, 0, 1); PG8_STAGE(PG8_SB(0, 0), b2, voffB);
            PG8_BAR; PG8_WAIT_L(0); PG8_MMA(0, 1, At, B1); PG8_BAR;
            PG8_LDA(At, 0, 1); PG8_STAGE(PG8_SA(0, 0), a2, voffA);
            PG8_BAR; PG8_WAIT_L(0); PG8_MMA(1, 0, At, B0); PG8_BAR; PG8_SCHED;
            PG8_STAGE(PG8_SB(0, 1), b2 + hstepB, voffB);
            PG8_WAIT_V(6); PG8_BAR; PG8_MMA(1, 1, At, B1); PG8_BAR;
            PG8_LDB(B0, 1, 0); PG8_SCHED; PG8_LDA(At, 1, 0); PG8_STAGE(PG8_SA(0, 1), a2 + hstepA, voffA);
            PG8_WAIT_L(8); PG8_BAR; PG8_WAIT_L(0); PG8_MMA(0, 0, At, B0); PG8_BAR; PG8_SCHED;
            PG8_LDB(B1, 1, 1); PG8_STAGE(PG8_SB(1, 0), b3, voffB);
            PG8_BAR; PG8_WAIT_L(0); PG8_MMA(0, 1, At, B1); PG8_BAR;
            PG8_LDA(At, 1, 1); PG8_STAGE(PG8_SA(1, 0), a3, voffA);
            PG8_BAR; PG8_WAIT_L(0); PG8_MMA(1, 0, At, B0); PG8_BAR; PG8_SCHED;
            PG8_STAGE(PG8_SB(1, 1), b3 + hstepB, voffB);
            PG8_WAIT_V(6); PG8_BAR; PG8_MMA(1, 1, At, B1); PG8_BAR;
            }
        }
        if constexpr (ALIGN_EPI) { if (wr == 0) PG8_BAR; }
        if constexpr (!Epi::AFTER_DRAIN) { E(acc, cur, wr, wc, fr, fq); S.done(cur); }
        if (!has_next) break;
#pragma unroll
        for (int a = 0; a < 2; ++a)
#pragma unroll
            for (int b = 0; b < 2; ++b)
#pragma unroll
                for (int m = 0; m < 4; ++m)
#pragma unroll
                    for (int n = 0; n < 2; ++n) acc[a][b][m][n] = (f32x4){0.f, 0.f, 0.f, 0.f};
        cur = nxt; cA = nA; cB = nB; ++ui;
        if constexpr (ALIGN_EPI) { if (wr == 1) PG8_BAR; }
    }
    PG8_WAIT_V(0);
    if constexpr (!ALIGN_EPI) { if (wr == 0) PG8_BAR; }
    PG8_BAR;
    if constexpr (Epi::AFTER_DRAIN) { E.fused(acc, cur, wr, wc, fr, fq, lds, wid, lane); S.done(cur); }
#undef PG8_SA
#undef PG8_SB
#undef PG8_STAGE
#undef PG8_LDA
#undef PG8_LDB
#undef PG8_MMA
#undef PG8_WAIT_V
#undef PG8_WAIT_L
#undef PG8_BAR
#undef PG8_SCHED
}
}


constexpr int NWAVES = 8;
constexpr int DM = 2048, BATCH = 2, SEQ = 4096, M = BATCH * SEQ;
constexpr int HD = 64, NQH = 16, NKVH = 4, ATTW = 1024, KVW = 256, POOLW = 1024, INW = 2560;
constexpr int PKH = 8, NEXP = 16384, PLE = 256;
constexpr float EPS = 1e-6f;
constexpr float EU_SCALE = 256.0f, EV_SCALE = 16.0f;
#ifndef MK_N_LAUNCHES
#define MK_N_LAUNCHES 1
#endif
constexpr int N_PHASES = 9;
#ifndef REP_MASK
#define REP_MASK 0
#endif
#define NREP(k) (((REP_MASK >> (k)) & 1) ? 2 : 1)
#ifndef DBG_NO_PEER
#define DBG_NO_PEER 0
#endif
#ifndef DBG_NO_PLE
#define DBG_NO_PLE 0
#endif
#ifndef DBG_NO_MIX
#define DBG_NO_MIX 0
#endif

constexpr size_t MiB = 1u << 20;
constexpr size_t WS_CTL = 0, CTL_ZERO_BYTES = 256 * 1024;
constexpr size_t WS_WIN = 1 * MiB, WS_WOUT = 11 * MiB, WS_WQ = 19 * MiB, WS_WG = 27 * MiB, WS_WP = 35 * MiB, WS_WPOOL = 36 * MiB;
constexpr size_t WS_SKH = 36 * MiB + 512 * 1024, WS_SKL = WS_SKH + 64 * 1024;
constexpr size_t WS_ROPE = 37 * MiB;
constexpr size_t WS_RSTD1 = 37 * MiB + 512 * 1024, WS_RSTD3 = WS_RSTD1 + 32 * 1024;
constexpr size_t WS_EU = 38 * MiB, WS_EV = 102 * MiB;
constexpr size_t WS_XB = 166 * MiB, WS_PB = 198 * MiB;
constexpr size_t WS_Q = 202 * MiB, WS_K = 218 * MiB, WS_V = 222 * MiB, WS_U = 226 * MiB, WS_POOLED = 242 * MiB, WS_MIX = 258 * MiB;
constexpr size_t WS_QP = 202 * MiB;
constexpr size_t WS_EIDX = 266 * MiB, WS_GATE = 270 * MiB;
constexpr size_t WS_H1 = 290 * MiB, WS_H1B = 354 * MiB, WS_PP = 386 * MiB, WS_H2B = 418 * MiB, WS_END = 450 * MiB;
constexpr int CW_QUEUE = 2048, CW_QUEUE0 = 2112;
#ifndef NCONV
#define NCONV 96
#endif
#ifndef Q_SPLIT
#define Q_SPLIT 0
#endif
constexpr int CW_BAR = 4096;
constexpr int CW_SSQ2 = 16384, CW_SSQ4 = 16384 + 8192;
static_assert((CW_SSQ4 + 8192) * 4 <= (int)CTL_ZERO_BYTES, "ctl");

constexpr int RING_OFF = 0, RING_BYTES = 131072;
constexpr int LDSCTL_OFF = RING_BYTES, MISC_OFF = LDSCTL_OFF + 320;
constexpr int LDS_BYTES = 147456;

#define GAS __attribute__((address_space(1)))
#define LAS __attribute__((address_space(3)))
typedef unsigned short bf16;
typedef unsigned v4u __attribute__((ext_vector_type(4)));
typedef unsigned v2u __attribute__((ext_vector_type(2)));
typedef float f32x4 __attribute__((ext_vector_type(4)));
typedef float f32x16 __attribute__((ext_vector_type(16)));
typedef short bf16x8 __attribute__((ext_vector_type(8)));
typedef GAS unsigned gu32;
#define RLX_AGENT __ATOMIC_RELAXED, __HIP_MEMORY_SCOPE_AGENT
#define LDS_WAIT() asm volatile("s_waitcnt lgkmcnt(0)" ::: "memory")
#define VM_WAIT() asm volatile("s_waitcnt vmcnt(0)" ::: "memory")
typedef float f32x2_t __attribute__((ext_vector_type(2))); typedef __bf16 bf16x2_t __attribute__((ext_vector_type(2)));
__device__ __forceinline__ unsigned pk2(float lo, float hi) { f32x2_t v = {lo, hi}; bf16x2_t b = __builtin_convertvector(v, bf16x2_t); return __builtin_bit_cast(unsigned, b); }
__device__ __forceinline__ float bf_lo(unsigned w) { return __uint_as_float(w << 16); }
__device__ __forceinline__ float bf_hi(unsigned w) { return __uint_as_float(w & 0xffff0000u); }
__device__ __forceinline__ float dot2bf(unsigned a, unsigned b, float c) { return __builtin_amdgcn_fdot2_f32_bf16(__builtin_bit_cast(bf16x2_t, a), __builtin_bit_cast(bf16x2_t, b), c, false); }
__device__ __forceinline__ float max2f(float a, float b) { float r; asm("v_max_f32_e32 %0, %1, %2" : "=v"(r) : "v"(a), "v"(b)); return r; }
__device__ __forceinline__ float min2f(float a, float b) { float r; asm("v_min_f32_e32 %0, %1, %2" : "=v"(r) : "v"(a), "v"(b)); return r; }
__device__ __forceinline__ float wave_sum(float v) {
#pragma unroll
    for (int o = 1; o < 64; o <<= 1) v += __shfl_xor(v, o);
    return v;
}

#define XB_TMO      128
#define XB_XCNT(j)  (256  + 64 * (j))
#define XB_XSUB(j)  (1280 + 64 * (j))
#define XB_XGEN(j)  (2304 + 64 * (j))
#define XB_TOP      3328
#define XB_TOPGEN   3392
#define XCD_BAR_WORDS 3456
#define XB_SPIN_CAP (1u << 18)
__device__ __forceinline__ unsigned xb_ld(unsigned* p)              { return __hip_atomic_load(p, __ATOMIC_RELAXED, __HIP_MEMORY_SCOPE_AGENT); }
__device__ __forceinline__ unsigned xb_add(unsigned* p, unsigned v) { return __hip_atomic_fetch_add(p, v, __ATOMIC_RELAXED, __HIP_MEMORY_SCOPE_AGENT); }
__device__ __forceinline__ unsigned xb_xcc_id() { return (unsigned)__builtin_amdgcn_s_getreg((3 << 11) | 20) & 0xFu; }
#define XB_SPIN(cond, bar) do { unsigned _sp = 0; while (cond) { __builtin_amdgcn_s_sleep(1); \
    if ((++_sp & 255u) == 0u) { if (xb_ld(&(bar)[XB_TMO])) break; if (_sp > XB_SPIN_CAP) { atomicAdd(&(bar)[XB_TMO], 1u); break; } } } } while (0)
struct XcdBarrier { unsigned* bar; unsigned x; volatile LAS unsigned* st; };
__device__ __forceinline__ XcdBarrier xcd_barrier_post(unsigned* bar, volatile LAS unsigned* st) {
    XcdBarrier b; b.bar = bar; b.x = xb_xcc_id(); b.st = st;
    if (threadIdx.x == 0) (void)xb_add(&bar[XB_XCNT(b.x)], 1u);
    return b;
}
__device__ __forceinline__ void xcd_barrier_complete(unsigned* bar, unsigned x, unsigned& nloc, unsigned& nx) {
    const unsigned G = gridDim.x * gridDim.y * gridDim.z;
    unsigned sum, cnt, mine, sp = 0u;
    for (;;) {
        sum = 0u; cnt = 0u; mine = 0u;
#pragma unroll
        for (unsigned j = 0; j < 16; ++j) { const unsigned c = xb_ld(&bar[XB_XCNT(j)]); sum += c; cnt += (c > 0u) ? 1u : 0u; mine = (j == x) ? c : mine; }
        if (sum == G) break;
        __builtin_amdgcn_s_sleep(1);
        if ((++sp & 255u) == 0u) { if (xb_ld(&bar[XB_TMO])) break; if (sp > XB_SPIN_CAP) { atomicAdd(&bar[XB_TMO], 1u); break; } }
    }
    nloc = mine > 0u ? mine : 1u; nx = cnt > 0u ? cnt : 1u;
}
__device__ __forceinline__ void xcd_barrier(const XcdBarrier& b) {
    asm volatile("s_waitcnt vmcnt(0)" ::: "memory");
    __syncthreads();
    if (threadIdx.x == 0) {
        unsigned* bar = b.bar;
        __builtin_amdgcn_s_waitcnt(0);
        unsigned nloc = b.st[0], nx = b.st[1];
        if (nloc == 0u) { xcd_barrier_complete(bar, b.x, nloc, nx); b.st[0] = nloc; b.st[1] = nx; }
        const unsigned old = xb_add(&bar[XB_XSUB(b.x)], 1u);
        const unsigned gen = old / nloc;
        if (old + 1u == (gen + 1u) * nloc) {
            __builtin_amdgcn_fence(__ATOMIC_RELEASE, "agent");
            asm volatile("s_waitcnt vmcnt(0)" ::: "memory");
            const unsigned og = xb_add(&bar[XB_TOP], 1u);
            const unsigned tg = og / nx;
            if (og + 1u == (tg + 1u) * nx) xb_add(&bar[XB_TOPGEN], 1u);
            else XB_SPIN(xb_ld(&bar[XB_TOPGEN]) == tg, bar);
            __builtin_amdgcn_fence(__ATOMIC_ACQUIRE, "agent");
            xb_add(&bar[XB_XGEN(b.x)], 1u);
            asm volatile("s_waitcnt vmcnt(0)" ::: "memory");
        } else {
            XB_SPIN(xb_ld(&bar[XB_XGEN(b.x)]) == gen, bar);
            __builtin_amdgcn_fence(__ATOMIC_ACQUIRE, "agent");
            asm volatile("s_waitcnt vmcnt(0)" ::: "memory");
        }
    }
    __syncthreads();
}

struct Frame {
    LAS unsigned char* lds;
    volatile LAS unsigned* MISC;
    gu32* ctl;
    int tid, lane, wave;
    int vcu, G;
    const float *x, *p, *g_mix, *w_in, *sinks, *w_pool, *pool_scale, *w_out, *g_ffn, *w_query, *sub_keys, *expert_u, *expert_v, *g_ple, *w_ple_gate, *w_ple_proj, *g_final;
    const int* positions;
    float* out;
    unsigned char* ws;
};
#define F_Win_t  ((bf16*)(F.ws + WS_WIN))
#define F_Wout_t ((bf16*)(F.ws + WS_WOUT))
#define F_Wq_t   ((bf16*)(F.ws + WS_WQ))
#define F_Wg_t   ((bf16*)(F.ws + WS_WG))
#define F_Wp_t   ((bf16*)(F.ws + WS_WP))
#define F_Wpool_t ((bf16*)(F.ws + WS_WPOOL))
#define F_SKH    ((bf16*)(F.ws + WS_SKH))
#define F_SKL    ((bf16*)(F.ws + WS_SKL))
#define F_EU     ((bf16*)(F.ws + WS_EU))
#define F_EV     ((bf16*)(F.ws + WS_EV))
#define F_XB     ((bf16*)(F.ws + WS_XB))
#define F_PB     ((bf16*)(F.ws + WS_PB))
#define F_QB     ((bf16*)(F.ws + WS_Q))
#define F_KB     ((bf16*)(F.ws + WS_K))
#define F_VB     ((bf16*)(F.ws + WS_V))
#define F_UB     ((bf16*)(F.ws + WS_U))
#define F_POOLED ((bf16*)(F.ws + WS_POOLED))
#define F_MIX    ((bf16*)(F.ws + WS_MIX))
#define F_H1B    ((bf16*)(F.ws + WS_H1B))
#define F_PP     ((bf16*)(F.ws + WS_PP))
#define F_H2B    ((bf16*)(F.ws + WS_H2B))
#define F_ROPE   ((float*)(F.ws + WS_ROPE))
#define F_RSTD1  ((float*)(F.ws + WS_RSTD1))
#define F_RSTD3  ((float*)(F.ws + WS_RSTD3))
#define F_QP     ((float*)(F.ws + WS_QP))
#define F_GATE   ((float*)(F.ws + WS_GATE))
#define F_H1     ((float*)(F.ws + WS_H1))
#define F_SSQ2   ((float*)(F.ws + WS_CTL) + CW_SSQ2)
#define F_SSQ4   ((float*)(F.ws + WS_CTL) + CW_SSQ4)
#define F_EIDX   ((int*)(F.ws + WS_EIDX))

__device__ __forceinline__ void p0_transpose_item(const float* W, int ldw, int N, const float* gain, bf16* WT, int ldt, LAS float* scr, int item, int lane) {
    const int nblk = N / 32, kb = item / nblk, nb = item % nblk, k0 = 64 * kb, n0 = 32 * nb;
    float wv[32];
#pragma unroll
    for (int i = 0; i < 32; ++i) { const int kk = 2 * i + (lane >> 5); wv[i] = W[(size_t)(k0 + kk) * ldw + n0 + (lane & 31)]; }
    if (gain) {
#pragma unroll
        for (int i = 0; i < 32; ++i) wv[i] *= gain[k0 + 2 * i + (lane >> 5)];
    }
#pragma unroll
    for (int i = 0; i < 32; ++i) { const int kk = 2 * i + (lane >> 5); scr[kk * 33 + (lane & 31)] = wv[i]; }
    LDS_WAIT(); asm volatile("" ::: "memory");
    const int c = lane & 7;
#pragma unroll
    for (int j = 0; j < 4; ++j) { const int n = (lane >> 3) + 8 * j; const LAS float* s = scr + (8 * c) * 33 + n;
        v4u o; o.x = pk2(s[0 * 33], s[1 * 33]); o.y = pk2(s[2 * 33], s[3 * 33]); o.z = pk2(s[4 * 33], s[5 * 33]); o.w = pk2(s[6 * 33], s[7 * 33]);
        *(GAS v4u*)(WT + (size_t)(n0 + n) * ldt + k0 + 8 * c) = o; }
    LDS_WAIT(); asm volatile("" ::: "memory");
}
__device__ __forceinline__ void p0_prologue(Frame& F) {
    LAS float* scr = (LAS float*)(F.lds + RING_OFF + F.wave * 16384);
    const int gw = F.vcu * NWAVES + F.wave, NGW = F.G * NWAVES;
    const int gt = gw * 64 + F.lane, NGT = NGW * 64;
    constexpr int I_IN = (DM / 64) * (INW / 32), I_P = (PLE / 64) * (DM / 32);
    constexpr int NITEMS = I_IN + I_P;
    for (int it = gw; it < NITEMS; it += NGW) {
        int r = it;
        if (r < I_IN) { p0_transpose_item(F.w_in, INW, INW, F.g_mix, F_Win_t, DM, scr, r, F.lane); continue; } r -= I_IN;
        p0_transpose_item(F.w_ple_proj, DM, DM, nullptr, F_Wp_t, PLE, scr, r, F.lane);
    }
    for (int m = gw; m < M; m += NGW) {
        const GAS f32x4* xr = (const GAS f32x4*)(F.x + (size_t)m * DM) + F.lane;
        f32x4 v[8]; float s = 0.f;
#pragma unroll
        for (int j = 0; j < 8; ++j) { v[j] = xr[64 * j]; s += (v[j].x * v[j].x + v[j].y * v[j].y) + (v[j].z * v[j].z + v[j].w * v[j].w); }
        s = wave_sum(s);
        if (F.lane == 0) F_RSTD1[m] = 1.0f / sqrtf(s * (1.0f / DM) + EPS);
        GAS v2u* o8 = (GAS v2u*)(F_XB + (size_t)m * DM) + F.lane;
#pragma unroll
        for (int j = 0; j < 8; ++j) { v2u o; o.x = pk2(v[j].x, v[j].y); o.y = pk2(v[j].z, v[j].w); o8[64 * j] = o; }
    }
    for (int c = gt; c < M * PLE / 8; c += NGT) {
        const GAS f32x4* s = (const GAS f32x4*)F.p + 2 * (size_t)c; const f32x4 a = s[0], b = s[1];
        v4u o; o.x = pk2(a.x, a.y); o.y = pk2(a.z, a.w); o.z = pk2(b.x, b.y); o.w = pk2(b.z, b.w);
        *((GAS v4u*)F_PB + c) = o;
    }
    for (int c = gt; c < M * 8; c += NGT) {
        const int t = c >> 3, i = c & 7;
        const float inv = 1.0f / (float)pow(500000.0, (double)(2 * i) / 16.0);
        const float ang = (float)F.positions[t] * inv;
        F_ROPE[t * 16 + i] = (float)cos((double)ang); F_ROPE[t * 16 + 8 + i] = (float)sin((double)ang);
    }
    for (int c = gt; c < 2 * 128 * 128; c += NGT) {
        const float v = F.sub_keys[c]; const unsigned h = pk2(v, 0.f) & 0xffffu; const float hf = __uint_as_float(h << 16);
        F_SKH[c] = (bf16)h; F_SKL[c] = (bf16)(pk2(v - hf, 0.f) & 0xffffu);
    }
}


constexpr int Q_EXP = 1024, Q_SQ = 256, Q_POOL = 16, Q_ITEMS = Q_EXP + 3 * Q_SQ + Q_POOL;
template <bool ISV> __device__ __forceinline__ void conv_expert_rows(Frame& F, int e0, int tid) {
    const float* src = ISV ? F.expert_v : F.expert_u; unsigned char* dstb = (unsigned char*)(ISV ? (void*)F_EV : (void*)F_EU);
    const float sc = ISV ? EV_SCALE : EU_SCALE;
    const int lane = tid & 63, wv = tid >> 6;
#pragma unroll 4
    for (int it = 0; it < 8; ++it) {
        const int ix = it * 8 + wv, eg = ix >> 4, s = ix & 15;
        const int e = e0 + eg * 8 + (lane >> 3), d0 = s * 128 + (lane & 7) * 16;
        const GAS f32x4* sp = (const GAS f32x4*)(src + (size_t)e * DM + d0); const GAS f32x4* gp = (const GAS f32x4*)(F.g_ffn + d0);
        v4u o;
#pragma unroll
        for (int q = 0; q < 4; ++q) { f32x4 a = sp[q] * sc; if constexpr (!ISV) a = a * gp[q]; int w = 0; w = __builtin_amdgcn_cvt_pk_fp8_f32(a.x, a.y, w, false); w = __builtin_amdgcn_cvt_pk_fp8_f32(a.z, a.w, w, true); o[q] = (unsigned)w; }
        *(GAS v4u*)(dstb + ((size_t)s * NEXP + e) * 128 + (lane & 7) * 16) = o;
    }
}
__device__ __forceinline__ void conv_expert_item(Frame& F, int idx, int tid) {
    if (idx >= 512) conv_expert_rows<true>(F, (idx & 511) * 32, tid); else conv_expert_rows<false>(F, (idx & 511) * 32, tid);
}
constexpr int Q_W = 3 * Q_SQ + Q_POOL;
__device__ __forceinline__ void p1_queue(Frame& F, int lo, int hi, int cw) {
    const int lane = (int)__builtin_amdgcn_mbcnt_hi(~0u, __builtin_amdgcn_mbcnt_lo(~0u, 0u)), tid = F.wave * 64 + lane;
    LAS float* scr = (LAS float*)(F.lds + RING_OFF + F.wave * 16384);
    volatile LAS unsigned* qslot = F.MISC + 12;
    unsigned mine = 0u;
    __syncthreads();
    if (tid == 0) { qslot[0] = __hip_atomic_fetch_add((unsigned*)(F.ctl + cw), 1u, RLX_AGENT); }
    __syncthreads();
    int idx = lo + (int)qslot[0];
    for (int n = 0;; ++n) {
        if (idx >= hi) break;
        if (tid == 0) mine = __hip_atomic_fetch_add((unsigned*)(F.ctl + cw), 1u, RLX_AGENT);
        if (idx >= Q_W) conv_expert_item(F, idx - Q_W, tid);
        else {
            int r = idx * 8 + F.wave;
            if (r < 8 * Q_SQ) p0_transpose_item(F.w_out, DM, DM, nullptr, F_Wout_t, DM, scr, r, lane);
            else if (r < 16 * Q_SQ) p0_transpose_item(F.w_query, DM, DM, F.g_ffn, F_Wq_t, DM, scr, r - 8 * Q_SQ, lane);
            else if (r < 24 * Q_SQ) p0_transpose_item(F.w_ple_gate, DM, DM, F.g_ple, F_Wg_t, DM, scr, r - 16 * Q_SQ, lane);
            else { const int rp = r - 24 * Q_SQ, g = rp / 32, rr = rp % 32; p0_transpose_item(F.w_pool + (size_t)g * 65536, 256, 256, nullptr, F_Wpool_t + (size_t)g * 65536, 256, scr, rr, lane); }
        }
        if (tid == 0) qslot[1 - (n & 1)] = mine;
        __syncthreads();
        idx = lo + (int)qslot[1 - (n & 1)];
    }
    __syncthreads();
}
struct PpOrder {
    int first, stride;
    __device__ __forceinline__ void init(int G, int c, int nconv) { const int heavy = nconv > 0 ? nconv : ((320 > G && 320 - G < G) ? 320 - G : 0); if (c < heavy) { first = 1 << 20; stride = 1; } else { first = c - heavy; stride = G - heavy; } }
    __device__ __forceinline__ bool next(int i, pg8::Unit& u) const { const long k = (long)first + (long)i * stride; if (k >= 256) return false; u.pm = (int)k >> 3; u.pn = (int)k & 7; return true; }
    __device__ __forceinline__ void a_ready(const pg8::Unit&) const {}
    __device__ __forceinline__ void done(const pg8::Unit&) const {}
};

struct EpiG1 {
    static constexpr bool PERM = true, AFTER_DRAIN = false;
    bf16 *Q, *Kb, *Vb, *U; const float* rstd; const float* rope;
    __device__ __forceinline__ void operator()(const f32x4 (&acc)[2][2][4][2], const pg8::Unit& u, int wr, int wc, int fr, int fq) const {
        const int pn = u.pn; bf16* base; int ldc, colt;
        if (pn < 4) { base = Q; ldc = ATTW; colt = pn * 256; } else if (pn == 4) { base = Kb; ldc = KVW; colt = 0; } else if (pn == 5) { base = Vb; ldc = KVW; colt = 0; } else { base = U; ldc = POOLW; colt = (pn - 6) * 256; }
        const bool rot = (pn <= 4) && ((wc & 1) == 0);
        const float qs = (pn < 4) ? 0.125f : 1.0f;
#pragma unroll
        for (int ai = 0; ai < 2; ++ai)
#pragma unroll
            for (int m = 0; m < 4; ++m) {
                const int row = u.pm * 256 + ai * 128 + wr * 64 + m * 16 + fr;
                const float rs = rstd[row] * qs;
                const GAS f32x4* rp = (const GAS f32x4*)(rope + (size_t)row * 16);
#pragma unroll
                for (int bj = 0; bj < 2; ++bj) {
                    f32x4 v0 = acc[ai][bj][m][0] * rs, v1 = acc[ai][bj][m][1] * rs;
                    if (rot) {
                        { const f32x4 c = rp[0], s = rp[2]; f32x4 p;
#pragma unroll
                          for (int i = 0; i < 4; ++i) p[i] = __shfl_xor(v0[i], 16);
                          if (fq == 0) v0 = v0 * c - p * s; else if (fq == 1) v0 = v0 * c + p * s; }
                        { const f32x4 c = rp[1], s = rp[3]; f32x4 p;
#pragma unroll
                          for (int i = 0; i < 4; ++i) p[i] = __shfl_xor(v1[i], 16);
                          if (fq == 0) v1 = v1 * c - p * s; else if (fq == 1) v1 = v1 * c + p * s; }
                    }
                    v4u w; w.x = pk2(v0[0], v0[1]); w.y = pk2(v0[2], v0[3]); w.z = pk2(v1[0], v1[1]); w.w = pk2(v1[2], v1[3]);
                    *(GAS v4u*)(base + (size_t)row * ldc + colt + bj * 128 + wc * 32 + 8 * fq) = w;
                }
            }
    }
};
template <bool HAS_SCALE> struct EpiBf16Scale {
    static constexpr bool PERM = true, AFTER_DRAIN = false;
    bf16* O; int ldc, col_off; const float* cscale;
    __device__ __forceinline__ void operator()(const f32x4 (&acc)[2][2][4][2], const pg8::Unit& u, int wr, int wc, int fr, int fq) const {
        const int c0 = u.pn * 256 + wc * 32 + 8 * fq;
#pragma unroll
        for (int ai = 0; ai < 2; ++ai)
#pragma unroll
            for (int m = 0; m < 4; ++m) {
                const int row = u.pm * 256 + ai * 128 + wr * 64 + m * 16 + fr;
#pragma unroll
                for (int bj = 0; bj < 2; ++bj) {
                    f32x4 v0 = acc[ai][bj][m][0], v1 = acc[ai][bj][m][1];
                    if constexpr (HAS_SCALE) { v0 = v0 * *(const GAS f32x4*)(cscale + c0 + bj * 128); v1 = v1 * *(const GAS f32x4*)(cscale + c0 + bj * 128 + 4); }
                    v4u w; w.x = pk2(v0[0], v0[1]); w.y = pk2(v0[2], v0[3]); w.z = pk2(v1[0], v1[1]); w.w = pk2(v1[2], v1[3]);
                    *(GAS v4u*)(O + (size_t)row * ldc + col_off + c0 + bj * 128) = w;
                }
            }
    }
};
struct EpiG3 {
    static constexpr bool PERM = false, AFTER_DRAIN = false;
    const bf16* xb; bf16* h1b; float* ssq;
    __device__ __forceinline__ void operator()(const f32x4 (&acc)[2][2][4][2], const pg8::Unit& u, int wr, int wc, int fr, int fq) const {
        const int col0 = u.pn * 256 + wc * 32 + 4 * fq;
#pragma unroll
        for (int ai = 0; ai < 2; ++ai)
#pragma unroll
            for (int m = 0; m < 4; ++m) {
                const int row = u.pm * 256 + ai * 128 + wr * 64 + m * 16 + fr; float ss = 0.f;
#pragma unroll
                for (int bj = 0; bj < 2; ++bj)
#pragma unroll
                    for (int n = 0; n < 2; ++n) {
                        const size_t off = (size_t)row * DM + col0 + bj * 128 + n * 16;
                        const v2u xw = *(const GAS v2u*)(xb + off); const f32x4 xv = {bf_lo(xw.x), bf_hi(xw.x), bf_lo(xw.y), bf_hi(xw.y)};
                        const f32x4 h = DBG_NO_MIX ? xv : xv + acc[ai][bj][m][n];
                        v2u w; w.x = pk2(h[0], h[1]); w.y = pk2(h[2], h[3]); *(GAS v2u*)(h1b + off) = w;
                        ss += (h[0] * h[0] + h[1] * h[1]) + (h[2] * h[2] + h[3] * h[3]);
                    }
                ss += __shfl_xor(ss, 16); ss += __shfl_xor(ss, 32);
                if (fq == 0) atomicAdd(ssq + row, ss);
            }
    }
};
struct EpiG4 {
    static constexpr bool PERM = false, AFTER_DRAIN = false;
    float* qp; const float* ssq;
    __device__ __forceinline__ void operator()(const f32x4 (&acc)[2][2][4][2], const pg8::Unit& u, int wr, int wc, int fr, int fq) const {
        const int col0 = u.pn * 256 + wc * 32 + 4 * fq;
#pragma unroll
        for (int ai = 0; ai < 2; ++ai)
#pragma unroll
            for (int m = 0; m < 4; ++m) {
                const int row = u.pm * 256 + ai * 128 + wr * 64 + m * 16 + fr;
                const float rs = 1.0f / sqrtf(__hip_atomic_load(ssq + row, RLX_AGENT) * (1.0f / DM) + EPS);
#pragma unroll
                for (int bj = 0; bj < 2; ++bj)
#pragma unroll
                    for (int n = 0; n < 2; ++n) *(GAS f32x4*)(qp + (size_t)row * DM + col0 + bj * 128 + n * 16) = acc[ai][bj][m][n] * rs;
            }
    }
};
struct EpiG5 {
    static constexpr bool PERM = false, AFTER_DRAIN = false;
    const bf16* h2b; const bf16* pp; const float* rstd3; bf16* h3b; float* ssq;
    __device__ __forceinline__ void operator()(const f32x4 (&acc)[2][2][4][2], const pg8::Unit& u, int wr, int wc, int fr, int fq) const {
        const int col0 = u.pn * 256 + wc * 32 + 4 * fq;
#pragma unroll
        for (int ai = 0; ai < 2; ++ai)
#pragma unroll
            for (int m = 0; m < 4; ++m) {
                const int row = u.pm * 256 + ai * 128 + wr * 64 + m * 16 + fr; float ss = 0.f;
                const float rs = rstd3[row];
#pragma unroll
                for (int bj = 0; bj < 2; ++bj)
#pragma unroll
                    for (int n = 0; n < 2; ++n) {
                        const size_t off = (size_t)row * DM + col0 + bj * 128 + n * 16;
                        const f32x4 z = DBG_NO_PLE ? (f32x4){-1e30f, -1e30f, -1e30f, -1e30f} : acc[ai][bj][m][n] * rs; const v2u pw = *(const GAS v2u*)(pp + off); const v2u hw = *(const GAS v2u*)(h2b + off);
                        f32x4 o;
                        o[0] = bf_lo(hw.x) + bf_lo(pw.x) / (1.0f + __expf(-z[0])); o[1] = bf_hi(hw.x) + bf_hi(pw.x) / (1.0f + __expf(-z[1]));
                        o[2] = bf_lo(hw.y) + bf_lo(pw.y) / (1.0f + __expf(-z[2])); o[3] = bf_hi(hw.y) + bf_hi(pw.y) / (1.0f + __expf(-z[3]));
                        v2u w; w.x = pk2(o[0], o[1]); w.y = pk2(o[2], o[3]); *(GAS v2u*)(h3b + off) = w;
                        ss += (o[0] * o[0] + o[1] * o[1]) + (o[2] * o[2] + o[3] * o[3]);
                    }
                ss += __shfl_xor(ss, 16); ss += __shfl_xor(ss, 32);
                if (fq == 0) atomicAdd(ssq + row, ss);
            }
    }
};
struct SingleUnit {
    int pm, pn;
    __device__ __forceinline__ bool next(int i, pg8::Unit& u) const { if (i != 0) return false; u.pm = pm; u.pn = pn; return true; }
    __device__ __forceinline__ void a_ready(const pg8::Unit&) const {}
    __device__ __forceinline__ void done(const pg8::Unit&) const {}
};

__device__ __forceinline__ int crow(int r, int hi) { return (r & 3) + 8 * (r >> 2) + 4 * hi; }
constexpr int KS_STRIDE = 144, VT_STRIDE = 520, VT_OFF = 256 * KS_STRIDE;
__device__ __forceinline__ void attn_unit(Frame& F, int unit) {
    const int g = unit & 3, nblk = (unit >> 2) & 31, b = unit >> 7;
    const int t0 = b * SEQ + nblk * 128;
    LAS unsigned char* Ks = F.lds + RING_OFF;
    LAS unsigned char* Vt = F.lds + RING_OFF + VT_OFF;
    for (int c = F.tid; c < 2048; c += NWAVES * 64) {
        const int j = c >> 3, ch = c & 7;
        v4u kv = {0u, 0u, 0u, 0u}, vv = {0u, 0u, 0u, 0u};
        if (nblk > 0 || j >= 128) { const size_t row = (size_t)(t0 - 128 + j); kv = *(const GAS v4u*)(F_KB + row * KVW + g * 64 + ch * 8); vv = *(const GAS v4u*)(F_VB + row * KVW + g * 64 + ch * 8); }
        *(LAS v4u*)(Ks + j * KS_STRIDE + ch * 16) = kv;
#pragma unroll
        for (int e = 0; e < 8; ++e) *(LAS unsigned short*)(Vt + (ch * 8 + e) * VT_STRIDE + j * 2) = (unsigned short)((vv[e >> 1] >> (16 * (e & 1))) & 0xffffu);
    }
    __syncthreads();
    const int hq = 4 * g + (F.wave >> 1);
    const float sink = F.sinks[hq];
    const int q = F.lane & 31, h = F.lane >> 5;
#pragma unroll 1
    for (int sub = 0; sub < 2; ++sub) {
        const int i0 = (F.wave & 1) * 64 + sub * 32;
        bf16x8 qf[4];
#pragma unroll
        for (int ks = 0; ks < 4; ++ks) qf[ks] = *(const GAS bf16x8*)(F_QB + (size_t)(t0 + i0 + q) * ATTW + hq * 64 + 16 * ks + 8 * h);
        f32x16 s[5];
#pragma unroll
        for (int kt = 0; kt < 5; ++kt) {
#pragma unroll
            for (int r = 0; r < 16; ++r) s[kt][r] = 0.f;
#pragma unroll
            for (int ks = 0; ks < 4; ++ks) {
                const bf16x8 a = *(const LAS bf16x8*)(Ks + (i0 + 32 * kt + q) * KS_STRIDE + (16 * ks + 8 * h) * 2);
                s[kt] = __builtin_amdgcn_mfma_f32_32x32x16_bf16(a, qf[ks], s[kt], 0, 0, 0);
            }
        }
        float mx = sink;
#pragma unroll
        for (int kt = 0; kt < 5; ++kt)
#pragma unroll
            for (int r = 0; r < 16; ++r) {
                const bool tv = (nblk > 0) || (i0 + 32 * kt >= 128);
                const bool ok = (kt == 0) ? (crow(r, h) > q) : (kt == 4) ? (crow(r, h) <= q) : true;
                const float v = (ok && tv) ? s[kt][r] : -INFINITY;
                s[kt][r] = v; mx = fmaxf(mx, v);
            }
        mx = fmaxf(mx, __shfl_xor(mx, 32));
        float sum = 0.f;
#pragma unroll
        for (int kt = 0; kt < 5; ++kt)
#pragma unroll
            for (int r = 0; r < 16; ++r) { const float pv = __expf(s[kt][r] - mx); s[kt][r] = pv; sum += pv; }
        sum += __shfl_xor(sum, 32);
        sum += __expf(sink - mx);
        const float inv = 1.0f / sum;
        f32x16 o[2];
#pragma unroll
        for (int dt = 0; dt < 2; ++dt)
#pragma unroll
            for (int r = 0; r < 16; ++r) o[dt][r] = 0.f;
#pragma unroll
        for (int kt = 0; kt < 5; ++kt)
#pragma unroll
            for (int st = 0; st < 2; ++st) {
                v4u pw; pw.x = pk2(s[kt][8 * st + 0], s[kt][8 * st + 1]); pw.y = pk2(s[kt][8 * st + 2], s[kt][8 * st + 3]); pw.z = pk2(s[kt][8 * st + 4], s[kt][8 * st + 5]); pw.w = pk2(s[kt][8 * st + 6], s[kt][8 * st + 7]);
                const bf16x8 pb = __builtin_bit_cast(bf16x8, pw);
#pragma unroll
                for (int dt = 0; dt < 2; ++dt) {
                    const LAS unsigned char* vb = Vt + (32 * dt + q) * VT_STRIDE + (i0 + 32 * kt + 16 * st + 4 * h) * 2;
                    const v2u lo = *(const LAS v2u*)vb, hi2 = *(const LAS v2u*)(vb + 16);
                    v4u aw; aw.x = lo.x; aw.y = lo.y; aw.z = hi2.x; aw.w = hi2.y;
                    o[dt] = __builtin_amdgcn_mfma_f32_32x32x16_bf16(__builtin_bit_cast(bf16x8, aw), pb, o[dt], 0, 0, 0);
                }
            }
        bf16* orow = F_MIX + (size_t)(t0 + i0 + q) * DM + hq * 64;
#pragma unroll
        for (int dt = 0; dt < 2; ++dt)
#pragma unroll
            for (int g4 = 0; g4 < 4; ++g4) {
                v2u w; w.x = pk2(o[dt][4 * g4] * inv, o[dt][4 * g4 + 1] * inv); w.y = pk2(o[dt][4 * g4 + 2] * inv, o[dt][4 * g4 + 3] * inv);
                *(GAS v2u*)(orow + 32 * dt + 8 * g4 + 4 * h) = w;
            }
    }
    __syncthreads();
}
template <int W> __device__ __forceinline__ void pool_tile_w(Frame& F, int pm, int g) {
    const int cg = F.tid & 31, rg = F.tid >> 5;
    const int r0 = pm * 256 + rg * 16;
    const int col = g * 256 + cg * 8;
    const int tseq0 = r0 & (SEQ - 1);
    const __amdgpu_buffer_rsrc_t rsu = __builtin_amdgcn_make_buffer_rsrc((void*)F_UB, 0, M * POOLW * 2, 0x00020000);
    const __amdgpu_buffer_rsrc_t rsp = __builtin_amdgcn_make_buffer_rsrc((void*)F_POOLED, 0, M * POOLW * 2, 0x00020000);
    v4u rows[W - 1 + 16];
#pragma unroll
    for (int j = 0; j < W - 1 + 16; ++j) { const int rr = r0 - (W - 1) + j; const bool ok = (tseq0 - (W - 1) + j) >= 0;
        rows[j] = __builtin_amdgcn_raw_buffer_load_b128(rsu, ok ? (unsigned)(rr * POOLW + col) * 2u : 0xFFFFFFF0u, 0, 0); }
    float sum[8];
#pragma unroll
    for (int e = 0; e < 8; ++e) sum[e] = 0.f;
#pragma unroll
    for (int j = 0; j < W - 1; ++j)
#pragma unroll
        for (int e = 0; e < 4; ++e) { const unsigned wv = rows[j][e]; sum[2 * e] += bf_lo(wv); sum[2 * e + 1] += bf_hi(wv); }
#pragma unroll
    for (int i = 0; i < 16; ++i) {
        const int ts = tseq0 + i;
        float cur[8];
#pragma unroll
        for (int e = 0; e < 4; ++e) { const unsigned wv = rows[W - 1 + i][e]; cur[2 * e] = bf_lo(wv); cur[2 * e + 1] = bf_hi(wv); }
#pragma unroll
        for (int e = 0; e < 8; ++e) sum[e] += cur[e];
        const int cnt = (ts + 1 < W) ? ts + 1 : W; const float ic = 1.0f / (float)cnt;
        v4u o;
        o.x = pk2(sum[0] * ic - cur[0], sum[1] * ic - cur[1]); o.y = pk2(sum[2] * ic - cur[2], sum[3] * ic - cur[3]);
        o.z = pk2(sum[4] * ic - cur[4], sum[5] * ic - cur[5]); o.w = pk2(sum[6] * ic - cur[6], sum[7] * ic - cur[7]);
        __builtin_amdgcn_raw_buffer_store_b128(o, rsp, (unsigned)((r0 + i) * POOLW + col) * 2u, 0, 0);
#pragma unroll
        for (int e = 0; e < 4; ++e) { const unsigned wv = rows[i][e]; sum[2 * e] -= bf_lo(wv); sum[2 * e + 1] -= bf_hi(wv); }
    }
}
__device__ __forceinline__ void pool_tile(Frame& F, int pm, int g) {
    if (g == 0) pool_tile_w<2>(F, pm, g); else if (g == 1) pool_tile_w<4>(F, pm, g); else if (g == 2) pool_tile_w<8>(F, pm, g); else pool_tile_w<16>(F, pm, g);
}

template <int N> __device__ __forceinline__ void insert_desc(float (&val)[N], float x) {
#pragma unroll
    for (int k = 0; k < N; ++k) { const float hi = max2f(x, val[k]); x = min2f(x, val[k]); val[k] = hi; }
}
__device__ __forceinline__ void bitonic_merge16(float (&m)[16]) {
#pragma unroll
    for (int st = 8; st >= 1; st >>= 1)
#pragma unroll
        for (int i = 0; i < 16; ++i) if ((i & st) == 0) { const float hi = max2f(m[i], m[i + st]), lo = min2f(m[i], m[i + st]); m[i] = hi; m[i + st] = lo; }
}
__device__ __forceinline__ void merge_partner16(float (&val)[16]) {
    float pr[16];
#pragma unroll
    for (int k = 0; k < 16; ++k) pr[k] = __shfl_xor(val[k], 32);
#pragma unroll
    for (int k = 0; k < 16; ++k) val[k] = max2f(val[k], pr[15 - k]);
    bitonic_merge16(val);
}
__device__ __forceinline__ void pin16(float (&v)[16]) {
#pragma unroll
    for (int k = 0; k < 16; ++k) asm volatile("" : "+v"(v[k]));
}
struct CandTab { int a[50], b[50]; };
__host__ __device__ constexpr CandTab make_cands() { CandTab t{}; int n = 0; for (int a = 0; a < 16; ++a) for (int b = 0; b < 16; ++b) if ((a + 1) * (b + 1) <= 16) { t.a[n] = a; t.b[n] = b; ++n; } return t; }
__device__ __forceinline__ float vsel(unsigned long long m, float a, float b) { float r; asm("v_cndmask_b32_e64 %0, %1, %2, %3" : "=v"(r) : "v"(b), "v"(a), "s"(m)); return r; }
__device__ __forceinline__ float sel16(const float (&L)[16], int a) { float r = L[0];
#pragma unroll
    for (int k = 1; k < 16; ++k) r = vsel(__ballot(a == k), L[k], r);
    return r; }
constexpr int SK_ROW = 272;
template <int HALF_>
__device__ __forceinline__ void route_stage(Frame& F) {
    for (int c = F.tid; c < 2 * 128 * 16; c += NWAVES * 64) {
        const int tab = c >> 11, row = (c >> 4) & 127, ch = c & 15;
        const v4u v = *(const GAS v4u*)((tab ? F_SKL : F_SKH) + HALF_ * 16384 + row * 128 + ch * 8);
        *(LAS v4u*)(F.lds + RING_OFF + tab * 128 * SK_ROW + row * SK_ROW + ch * 16) = v;
    }
}
template <int HALF_>
__device__ __forceinline__ void route_half(Frame& F, const float* qrow, int r, int h, float (&Lout)[16]) {
    f32x16 acc[4];
#pragma unroll
    for (int kt = 0; kt < 4; ++kt)
#pragma unroll
        for (int i = 0; i < 16; ++i) acc[kt][i] = 0.f;
    const LAS unsigned char* skh = F.lds + RING_OFF; const LAS unsigned char* skl = F.lds + RING_OFF + 128 * SK_ROW;
#pragma unroll
    for (int ks = 0; ks < 8; ++ks) {
        const f32x4 qa = *(const GAS f32x4*)(qrow + HALF_ * 128 + 16 * ks + 8 * h), qb = *(const GAS f32x4*)(qrow + HALF_ * 128 + 16 * ks + 8 * h + 4);
        v4u hw, lw;
        hw.x = pk2(qa.x, qa.y); hw.y = pk2(qa.z, qa.w); hw.z = pk2(qb.x, qb.y); hw.w = pk2(qb.z, qb.w);
        lw.x = pk2(qa.x - bf_lo(hw.x), qa.y - bf_hi(hw.x)); lw.y = pk2(qa.z - bf_lo(hw.y), qa.w - bf_hi(hw.y));
        lw.z = pk2(qb.x - bf_lo(hw.z), qb.y - bf_hi(hw.z)); lw.w = pk2(qb.z - bf_lo(hw.w), qb.w - bf_hi(hw.w));
        const bf16x8 bh = __builtin_bit_cast(bf16x8, hw), bl = __builtin_bit_cast(bf16x8, lw);
#pragma unroll
        for (int kt = 0; kt < 4; ++kt) {
            const bf16x8 ah = *(const LAS bf16x8*)(skh + (32 * kt + r) * SK_ROW + (16 * ks + 8 * h) * 2), al = *(const LAS bf16x8*)(skl + (32 * kt + r) * SK_ROW + (16 * ks + 8 * h) * 2);
            acc[kt] = __builtin_amdgcn_mfma_f32_32x32x16_bf16(ah, bh, acc[kt], 0, 0, 0);
            acc[kt] = __builtin_amdgcn_mfma_f32_32x32x16_bf16(al, bh, acc[kt], 0, 0, 0);
            acc[kt] = __builtin_amdgcn_mfma_f32_32x32x16_bf16(ah, bl, acc[kt], 0, 0, 0);
        }
    }
#pragma unroll
    for (int k = 0; k < 16; ++k) Lout[k] = -INFINITY;
#pragma unroll
    for (int kt = 0; kt < 4; ++kt)
#pragma unroll
        for (int i = 0; i < 16; ++i) {
            const unsigned n = (unsigned)(32 * kt + (i & 3) + 8 * (i >> 2) + 4 * h);
            insert_desc<16>(Lout, __uint_as_float((__float_as_uint(acc[kt][i]) & ~127u) | n));
        }
    merge_partner16(Lout);
}
__device__ __forceinline__ void route_task(Frame& F, int task, bool valid) {
    const int r = F.lane & 31, h = F.lane >> 5;
    const int item = task * 32 + r, tok = item >> 3, head = item & 7;
    const float* qrow = F_QP + (size_t)tok * DM + head * 256;
    float L0[16], L1[16];
    __syncthreads(); route_stage<0>(F); __syncthreads();
    if (valid) route_half<0>(F, qrow, r, h, L0);
    __syncthreads(); route_stage<1>(F); __syncthreads();
    if (valid) route_half<1>(F, qrow, r, h, L1);
    if (!valid) return;
    pin16(L0); pin16(L1);
    constexpr CandTab CT = make_cands();
    const unsigned long long hm = __ballot(h != 0);
    float cand[16];
#pragma unroll
    for (int k = 0; k < 16; ++k) cand[k] = -INFINITY;
#pragma unroll
    for (int i = 0; i < 25; ++i) {
        const float v1 = vsel(hm, L0[CT.a[2 * i + 1]], L0[CT.a[2 * i]]);
        const float v2 = vsel(hm, L1[CT.b[2 * i + 1]], L1[CT.b[2 * i]]);
        const unsigned id = h ? (unsigned)(CT.a[2 * i + 1] * 16 + CT.b[2 * i + 1]) : (unsigned)(CT.a[2 * i] * 16 + CT.b[2 * i]);
        const float sm = __uint_as_float(__float_as_uint(v1) & ~127u) + __uint_as_float(__float_as_uint(v2) & ~127u);
        insert_desc<16>(cand, __uint_as_float((__float_as_uint(sm) & ~255u) | id));
    }
    merge_partner16(cand);
    pin16(cand);
    float se = 0.f;
#pragma unroll
    for (int k = 0; k < 16; ++k) se += __expf(cand[k] - cand[0]);
    const float ise = 1.0f / se;
    int eo[8]; float go[8];
#pragma unroll
    for (int kk = 0; kk < 8; ++kk) {
        const float cv = vsel(hm, cand[8 + kk], cand[kk]);
        const unsigned id = __float_as_uint(cv) & 255u; const int a = (int)(id >> 4), bb = (int)(id & 15u);
        const unsigned i1 = __float_as_uint(sel16(L0, a)) & 127u, i2 = __float_as_uint(sel16(L1, bb)) & 127u;
        eo[kk] = (int)(i1 * 128u + i2); go[kk] = __expf(cv - cand[0]) * ise;
    }
    int* ep = F_EIDX + (size_t)tok * 128 + head * 16 + 8 * h; float* gp = F_GATE + (size_t)tok * 128 + head * 16 + 8 * h;
    *(GAS v4u*)ep = (v4u){(unsigned)eo[0], (unsigned)eo[1], (unsigned)eo[2], (unsigned)eo[3]}; *(GAS v4u*)(ep + 4) = (v4u){(unsigned)eo[4], (unsigned)eo[5], (unsigned)eo[6], (unsigned)eo[7]};
    *(GAS f32x4*)gp = (f32x4){go[0], go[1], go[2], go[3]}; *(GAS f32x4*)(gp + 4) = (f32x4){go[4], go[5], go[6], go[7]};
}


#ifndef DBG_ROUTE_BF
#define DBG_ROUTE_BF 0
#endif
__device__ __forceinline__ void lds_insert(LAS float* V, LAS int* I, int tid, float x, int id) {
    if (x > V[15 * 256 + tid]) {
        int pos = 15;
        while (pos > 0 && V[(pos - 1) * 256 + tid] < x) { V[pos * 256 + tid] = V[(pos - 1) * 256 + tid]; I[pos * 256 + tid] = I[(pos - 1) * 256 + tid]; --pos; }
        V[pos * 256 + tid] = x; I[pos * 256 + tid] = id;
    }
}
__device__ __forceinline__ void route_bruteforce(Frame& F) {
    if (F.tid >= 256) return;
    const int tid = F.tid;
    LAS float* V0 = (LAS float*)(F.lds); LAS int* I0 = (LAS int*)(F.lds + 16384);
    LAS float* V1 = (LAS float*)(F.lds + 32768); LAS int* I1 = (LAS int*)(F.lds + 49152);
    LAS float* VC = (LAS float*)(F.lds + 65536); LAS int* IC = (LAS int*)(F.lds + 81920);
    for (int item = (int)blockIdx.x * 256 + tid; item < M * PKH; item += F.G * 256) {
        const int tok = item >> 3, head = item & 7;
        const float* qrow = F_QP + (size_t)tok * DM + head * 256;
        for (int k = 0; k < 16; ++k) { V0[k * 256 + tid] = -INFINITY; I0[k * 256 + tid] = 0; V1[k * 256 + tid] = -INFINITY; I1[k * 256 + tid] = 0; VC[k * 256 + tid] = -INFINITY; IC[k * 256 + tid] = 0; }
        for (int half = 0; half < 2; ++half) {
            float q[128];
#pragma unroll
            for (int d = 0; d < 128; d += 4) { const f32x4 t = *(const GAS f32x4*)(qrow + half * 128 + d); q[d] = t.x; q[d + 1] = t.y; q[d + 2] = t.z; q[d + 3] = t.w; }
            for (int n = 0; n < 128; ++n) {
                const float* sk = F.sub_keys + (size_t)half * 16384 + n * 128;
                float s = 0.f;
#pragma unroll
                for (int d = 0; d < 128; ++d) s += q[d] * sk[d];
                if (half == 0) lds_insert(V0, I0, tid, s, n); else lds_insert(V1, I1, tid, s, n);
            }
        }
        for (int a = 0; a < 16; ++a) for (int b = 0; b < 16; ++b) lds_insert(VC, IC, tid, V0[a * 256 + tid] + V1[b * 256 + tid], I0[a * 256 + tid] * 128 + I1[b * 256 + tid]);
        const float mx = VC[tid]; float se = 0.f;
        for (int k = 0; k < 16; ++k) se += __expf(VC[k * 256 + tid] - mx);
        for (int k = 0; k < 16; ++k) { F_EIDX[(size_t)tok * 128 + head * 16 + k] = IC[k * 256 + tid]; F_GATE[(size_t)tok * 128 + head * 16 + k] = __expf(VC[k * 256 + tid] - mx) / se; }
    }
}

template <int N> __device__ __forceinline__ void treduce(float (&v)[N], int lane, int d) {
    const bool up = (lane & d) != 0;
#pragma unroll
    for (int i = 0; i < N / 2; ++i) { const float send = up ? v[i] : v[i + N / 2], keep = up ? v[i + N / 2] : v[i]; v[i] = keep + __shfl_xor(send, d); }
}
constexpr int SLICE_BYTES = NEXP * 128;
constexpr int NSLICE = 16;
#ifndef PEER_SLICE_BARRIER
#define PEER_SLICE_BARRIER 0
#endif
typedef float f32x2v __attribute__((ext_vector_type(2)));
__device__ __forceinline__ void peer_phase(Frame& F) {
    const int lane = F.lane, g = lane >> 3, p = lane & 7;
    const int tbase = (int)blockIdx.x * 32 + F.wave * 4;
    LAS float* alds = (LAS float*)(F.lds + RING_OFF + F.wave * 2048);
    const __amdgpu_buffer_rsrc_t rsu = __builtin_amdgcn_make_buffer_rsrc((void*)F_EU, 0, NEXP * DM, 0x00020000);
    const __amdgpu_buffer_rsrc_t rsv = __builtin_amdgcn_make_buffer_rsrc((void*)F_EV, 0, NEXP * DM, 0x00020000);
    const __amdgpu_buffer_rsrc_t rsx = __builtin_amdgcn_make_buffer_rsrc((void*)F_H1B, 0, M * DM * 2, 0x00020000);
    const __amdgpu_buffer_rsrc_t rsb = __builtin_amdgcn_make_buffer_rsrc((void*)F_H2B, 0, M * DM * 2, 0x00020000);
    const unsigned p16 = (unsigned)p * 16u;
    const unsigned cl = (unsigned)(16 * p + 8 * (g & 1) + 4 * ((g >> 1) & 1) + 2 * ((g >> 2) & 1));
    for (int tb = tbase; tb < M; tb += F.G * 32) {
        unsigned ev[4][8];
        float hacc[4][2];
#pragma unroll
        for (int tk = 0; tk < 4; ++tk) {
#pragma unroll
            for (int i = 0; i < 8; ++i) ev[tk][i] = (unsigned)F_EIDX[(size_t)(tb + tk) * 128 + 16 * i + g] | ((unsigned)F_EIDX[(size_t)(tb + tk) * 128 + 16 * i + 8 + g] << 16);
            hacc[tk][0] = 0.f; hacc[tk][1] = 0.f;
        }
#define PEER_VOFF(TK, i) ({ unsigned e_ = ev[TK][(i) >> 1]; asm volatile("" : "+v"(e_)); ((((i) & 1) ? (e_ >> 16) : (e_ & 0xffffu)) * 128u + p16); })
#define PEER_LOAD_X(X0, X1, S, TK) do { X0 = __builtin_amdgcn_raw_buffer_load_b128(rsx, 2u * p16, ((tb + (TK)) * DM + 128 * (S)) * 2, 0); X1 = __builtin_amdgcn_raw_buffer_load_b128(rsx, 2u * p16 + 16u, ((tb + (TK)) * DM + 128 * (S)) * 2, 0); } while (0)
#define PEER_LOAD_A(W, S, TK, H) do { _Pragma("unroll") for (int i = 0; i < 8; ++i) W[i] = __builtin_amdgcn_raw_buffer_load_b128(rsu, PEER_VOFF(TK, 8 * (H) + i), (S) * SLICE_BYTES, 0); } while (0)
#define PEER_COMP_A(W, H) do { \
        _Pragma("unroll") for (int i = 0; i < 8; ++i) { f32x2v a2 = {0.f, 0.f}; \
            _Pragma("unroll") for (int c = 0; c < 4; ++c) { const int wv = (int)W[i][c]; const f32x2v lo = __builtin_amdgcn_cvt_pk_f32_fp8(wv, false), hi = __builtin_amdgcn_cvt_pk_f32_fp8(wv, true); \
                a2 += lo * xf2[2 * c]; a2 += hi * xf2[2 * c + 1]; } \
            part[8 * (H) + i] = a2.x + a2.y; if (i & 1) __builtin_amdgcn_sched_barrier(0); } } while (0)
        for (int rep = 0; rep < NREP(6); ++rep) {
#pragma unroll
            for (int tk = 0; tk < 4; ++tk) { hacc[tk][0] = 0.f; hacc[tk][1] = 0.f; }
#pragma unroll 1
            for (int s = 0; s < NSLICE; ++s) {
#pragma unroll
                for (int tk = 0; tk < 4; ++tk) {
                    v4u w0[8], w1[8], x0, x1; f32x2v xf2[8]; float part[16];
                    PEER_LOAD_X(x0, x1, s, tk); PEER_LOAD_A(w0, s, tk, 0); PEER_LOAD_A(w1, s, tk, 1); __builtin_amdgcn_sched_barrier(0);
#pragma unroll
                    for (int c = 0; c < 4; ++c) { const unsigned a0 = x0[c], a1 = x1[c]; xf2[c] = (f32x2v){bf_lo(a0), bf_hi(a0)}; xf2[4 + c] = (f32x2v){bf_lo(a1), bf_hi(a1)}; }
                    PEER_COMP_A(w0, 0); __builtin_amdgcn_sched_barrier(0);
                    PEER_COMP_A(w1, 1); __builtin_amdgcn_sched_barrier(0);
                    treduce<16>(part, lane, 1); treduce<8>(reinterpret_cast<float (&)[8]>(part), lane, 2); treduce<4>(reinterpret_cast<float (&)[4]>(part), lane, 4);
                    hacc[tk][0] += part[0]; hacc[tk][1] += part[1]; __builtin_amdgcn_sched_barrier(0);
                }
                if (PEER_SLICE_BARRIER) __builtin_amdgcn_s_barrier();
            }
        }
#undef PEER_LOAD_X
#undef PEER_LOAD_A
#undef PEER_COMP_A
#pragma unroll
        for (int tk = 0; tk < 4; ++tk) {
            const int t = tb + tk;
            const float rs2 = (1.0f / EU_SCALE) / sqrtf(__hip_atomic_load(F_SSQ2 + t, RLX_AGENT) * (1.0f / DM) + EPS);
#pragma unroll
            for (int j = 0; j < 2; ++j) {
                const int i = 8 * (p & 1) + 4 * ((p >> 1) & 1) + 2 * ((p >> 2) & 1) + j;
                const float hv = hacc[tk][j] * rs2;
                const float ge = 0.5f * hv * (1.0f + erff(hv * 0.70710678118654752f));
                alds[tk * 128 + g * 16 + i] = F_GATE[(size_t)t * 128 + 8 * i + g] * ge * (1.0f / EV_SCALE);
            }
        }
        LDS_WAIT(); asm volatile("" ::: "memory");
        float ssq[4] = {0.f, 0.f, 0.f, 0.f};
        constexpr int NREPB = ((REP_MASK >> 9) & 1) ? 2 : 1;
        for (int repb = 0; repb < NREPB; ++repb) {
#pragma unroll
        for (int tk = 0; tk < 4; ++tk) ssq[tk] = 0.f;
#define PEER_LOAD_B(W, S, TK, H) do { _Pragma("unroll") for (int i = 0; i < 8; ++i) W[i] = __builtin_amdgcn_raw_buffer_load_b128(rsv, PEER_VOFF(TK, 8 * (H) + i), (S) * SLICE_BYTES, 0); } while (0)
#define PEER_COMP_B(W, TK, H) do { f32x4 av[2]; \
        _Pragma("unroll") for (int q4 = 0; q4 < 2; ++q4) av[q4] = *(const LAS f32x4*)(alds + (TK) * 128 + g * 16 + 8 * (H) + 4 * q4); \
        _Pragma("unroll") for (int i = 0; i < 8; ++i) { const float a = av[i >> 2][i & 3] * (1.0f / NREPB); const f32x2v a2 = {a, a}; \
            _Pragma("unroll") for (int c = 0; c < 4; ++c) { const int wv = (int)W[i][c]; const f32x2v lo = __builtin_amdgcn_cvt_pk_f32_fp8(wv, false), hi = __builtin_amdgcn_cvt_pk_f32_fp8(wv, true); \
                oc2[2 * c] += a2 * lo; oc2[2 * c + 1] += a2 * hi; } if (i & 1) __builtin_amdgcn_sched_barrier(0); } } while (0)
        {
#pragma unroll 1
            for (int s = 0; s < NSLICE; ++s) {
#pragma unroll
                for (int tk = 0; tk < 4; ++tk) {
                    v4u w0[8], w1[8]; f32x2v oc2[8]; float oc[16];
                    const int so = (tb + tk) * DM + 128 * s;
                    PEER_LOAD_B(w0, s, tk, 0); PEER_LOAD_B(w1, s, tk, 1);
                    const unsigned hv2 = __builtin_amdgcn_raw_buffer_load_b32(rsx, cl * 2u, so * 2, 0);
                    __builtin_amdgcn_sched_barrier(0);
#pragma unroll
                    for (int c = 0; c < 8; ++c) oc2[c] = (f32x2v){0.f, 0.f};
                    PEER_COMP_B(w0, tk, 0); __builtin_amdgcn_sched_barrier(0);
                    PEER_COMP_B(w1, tk, 1); __builtin_amdgcn_sched_barrier(0);
#pragma unroll
                    for (int c = 0; c < 8; ++c) { oc[2 * c] = oc2[c].x; oc[2 * c + 1] = oc2[c].y; }
                    treduce<16>(oc, lane, 8); treduce<8>(reinterpret_cast<float (&)[8]>(oc), lane, 16); treduce<4>(reinterpret_cast<float (&)[4]>(oc), lane, 32);
                    const float h2a = bf_lo(hv2) + oc[0], h2b = bf_hi(hv2) + oc[1];
                    __builtin_amdgcn_raw_buffer_store_b32(pk2(h2a, h2b), rsb, cl * 2u, so * 2, 0); ssq[tk] += h2a * h2a + h2b * h2b;
                    __builtin_amdgcn_sched_barrier(0);
                }
                if (PEER_SLICE_BARRIER) __builtin_amdgcn_s_barrier();
            }
        }
        }
#undef PEER_LOAD_B
#undef PEER_COMP_B
#pragma unroll
        for (int tk = 0; tk < 4; ++tk) { const float ss = wave_sum(ssq[tk]); if (lane == 0) F_RSTD3[tb + tk] = 1.0f / sqrtf(ss * (1.0f / DM) + EPS); }
        LDS_WAIT(); asm volatile("" ::: "memory");
    }
}

struct Args { const void* in[18]; float* out; unsigned char* ws; int ph_lo, ph_hi, li, pad; };
__global__ void __launch_bounds__(NWAVES * 64, 2) hymba_fwd(Args args) {
    extern __shared__ __attribute__((aligned(16))) unsigned char lds[];
    Frame F;
    F.lds = (LAS unsigned char*)lds;
    F.MISC = (volatile LAS unsigned*)(F.lds + MISC_OFF);
    F.tid = threadIdx.x; F.lane = F.tid & 63; F.wave = __builtin_amdgcn_readfirstlane(F.tid >> 6);
    F.G = gridDim.x; { const int bx = blockIdx.x; F.vcu = (F.G % 8 == 0) ? (bx % 8) * (F.G / 8) + bx / 8 : bx; }
    F.ws = args.ws;
    F.ctl = (gu32*)(F.ws + WS_CTL);
    F.x = (const float*)args.in[0]; F.p = (const float*)args.in[1]; F.positions = (const int*)args.in[2]; F.g_mix = (const float*)args.in[3]; F.w_in = (const float*)args.in[4];
    F.sinks = (const float*)args.in[5]; F.w_pool = (const float*)args.in[6]; F.pool_scale = (const float*)args.in[7]; F.w_out = (const float*)args.in[8]; F.g_ffn = (const float*)args.in[9];
    F.w_query = (const float*)args.in[10]; F.sub_keys = (const float*)args.in[11]; F.expert_u = (const float*)args.in[12]; F.expert_v = (const float*)args.in[13]; F.g_ple = (const float*)args.in[14];
    F.w_ple_gate = (const float*)args.in[15]; F.w_ple_proj = (const float*)args.in[16]; F.g_final = (const float*)args.in[17]; F.out = args.out;
    for (int u = F.tid; u < (LDS_BYTES - LDSCTL_OFF) / 4; u += NWAVES * 64) ((LAS unsigned*)(F.lds + LDSCTL_OFF))[u] = 0u;
    __syncthreads();
    const bool one_phase = (args.ph_hi - args.ph_lo) == 1;
    XcdBarrier bar; bar.bar = (unsigned*)(F.ctl + CW_BAR); bar.x = 0; bar.st = nullptr;
    if (!one_phase) bar = xcd_barrier_post((unsigned*)(F.ctl + CW_BAR), F.MISC + 8);
    const int lo = args.ph_lo, hi = args.ph_hi;
#define IN(k) (lo <= (k) && (k) < hi)
#define BOTH(k) (IN(k) && IN((k) + 1))
#define GRID_BAR() xcd_barrier(bar)

    if (IN(0)) { for (int rep = 0; rep < NREP(0); ++rep) p0_prologue(F); p1_queue(F, 0, Q_SPLIT, CW_QUEUE0); if (BOTH(0)) GRID_BAR(); }

    if (IN(1)) {
#if (REP_MASK >> 1) & 1
        { pg8::Gemm g{F_XB, F_Win_t, M, INW, DM, DM, DM}; pg8::StaticOrder S; S.init(M, INW, F.G, (int)blockIdx.x);
          EpiG1 E{F_QB, F_KB, F_VB, F_UB, F_RSTD1, F_ROPE};
          pg8::gemm_phase<EpiG1, pg8::StaticOrder, true, true>(F.lds + RING_OFF, g, S, E); }
        __syncthreads();
#endif
        const int nconv = (F.G == 256) ? NCONV : 0;
        if ((int)blockIdx.x >= nconv) {
        { pg8::Gemm g{F_XB, F_Win_t, M, INW, DM, DM, DM}; pg8::StaticOrder S; S.init(M, INW, F.G - nconv, (int)blockIdx.x - nconv);
          EpiG1 E{F_QB, F_KB, F_VB, F_UB, F_RSTD1, F_ROPE};
          pg8::gemm_phase<EpiG1, pg8::StaticOrder, true, true>(F.lds + RING_OFF, g, S, E); }
        { pg8::Gemm g{F_PB, F_Wp_t, M, DM, PLE, PLE, PLE}; PpOrder S; S.init(F.G, (int)blockIdx.x, nconv);
          EpiBf16Scale<false> E{F_PP, DM, 0, nullptr};
          pg8::gemm_phase<EpiBf16Scale<false>, PpOrder, false, true>(F.lds + RING_OFF, g, S, E); }
        }
        p1_queue(F, Q_SPLIT, Q_ITEMS, CW_QUEUE);
#if (REP_MASK >> 10) & 1
        p1_queue(F, 0, Q_ITEMS, CW_QUEUE0);
#endif
        if (BOTH(1)) GRID_BAR();
    }

    if (IN(2)) {
#if (REP_MASK >> 2) & 1
        if (F.G >= 256) { if ((int)blockIdx.x >= 128) for (int u = (int)blockIdx.x - 128; u < BATCH * 32 * NKVH; u += F.G - 128) attn_unit(F, u); }
#endif
        if (F.G >= 256) { if ((int)blockIdx.x >= 128) for (int u = (int)blockIdx.x - 128; u < BATCH * 32 * NKVH; u += F.G - 128) attn_unit(F, u); }
        else for (int u = (int)blockIdx.x; u < BATCH * 32 * NKVH; u += F.G) attn_unit(F, u);
        if ((int)blockIdx.x < 128) {
            const int pu = (int)blockIdx.x, pm = pu >> 2, g = pu & 3;
            pool_tile(F, pm, g);
            VM_WAIT(); __syncthreads();
            pg8::Gemm gm{F_POOLED + g * 256, F_Wpool_t + (size_t)g * 65536, M, 256, 256, POOLW, 256}; SingleUnit S{pm, 0};
            EpiBf16Scale<true> E{F_MIX, DM, ATTW + g * 256, F.pool_scale + g * 256};
            pg8::gemm_phase<EpiBf16Scale<true>, SingleUnit, false, true>(F.lds + RING_OFF, gm, S, E);
            __syncthreads();
        }
        if (BOTH(2)) GRID_BAR();
    }

    if (IN(3)) {
        pg8::Gemm g{F_MIX, F_Wout_t, M, DM, DM, DM, DM}; pg8::StaticOrder S; S.init(M, DM, F.G, (int)blockIdx.x);
#if (REP_MASK >> 3) & 1
        { EpiG3 E2{F_XB, F_H1B, (float*)(F.ws + WS_END)}; pg8::gemm_phase<EpiG3, pg8::StaticOrder, true, true>(F.lds + RING_OFF, g, S, E2); __syncthreads(); }
#endif
        EpiG3 E{F_XB, F_H1B, F_SSQ2};
        pg8::gemm_phase<EpiG3, pg8::StaticOrder, true, true>(F.lds + RING_OFF, g, S, E);
        if (BOTH(3)) GRID_BAR();
    }

    if (IN(4)) {
        pg8::Gemm g{F_H1B, F_Wq_t, M, DM, DM, DM, DM}; pg8::StaticOrder S; S.init(M, DM, F.G, (int)blockIdx.x);
        EpiG4 E{F_QP, F_SSQ2};
        for (int rep = 0; rep < NREP(4); ++rep)
        pg8::gemm_phase<EpiG4, pg8::StaticOrder, true, true>(F.lds + RING_OFF, g, S, E);
        if (BOTH(4)) GRID_BAR();
    }

    if (IN(5)) {
        for (int rep = 0; rep < NREP(5); ++rep)
        for (int base = (int)blockIdx.x * NWAVES; base < M * PKH / 32; base += F.G * NWAVES) { const int task = base + F.wave; route_task(F, task < M * PKH / 32 ? task : 0, task < M * PKH / 32); }
        __syncthreads();
        if (BOTH(5)) GRID_BAR();
    }

    if (IN(6)) {
        peer_phase(F);
        __syncthreads();
        if (BOTH(6)) GRID_BAR();
    }

    if (IN(7)) {
        pg8::Gemm g{F_H2B, F_Wg_t, M, DM, DM, DM, DM}; pg8::StaticOrder S; S.init(M, DM, F.G, (int)blockIdx.x);
#if (REP_MASK >> 7) & 1
        { EpiG5 E2{F_H2B, F_PP, F_RSTD3, F_H1B, (float*)(F.ws + WS_END)}; pg8::gemm_phase<EpiG5, pg8::StaticOrder, true, true>(F.lds + RING_OFF, g, S, E2); __syncthreads(); }
#endif
        EpiG5 E{F_H2B, F_PP, F_RSTD3, F_H1B, F_SSQ4};
        pg8::gemm_phase<EpiG5, pg8::StaticOrder, true, true>(F.lds + RING_OFF, g, S, E);
        if (BOTH(7)) GRID_BAR();
    }

    if (IN(8)) {
        const int gw = F.vcu * NWAVES + F.wave, NGW = F.G * NWAVES;
        for (int m = gw; m < M; m += NGW) {
            const float rs = 1.0f / sqrtf(__hip_atomic_load(F_SSQ4 + m, RLX_AGENT) * (1.0f / DM) + EPS);
            GAS f32x4* orow = (GAS f32x4*)(F.out + (size_t)m * DM) + F.lane; const GAS f32x4* gr = (const GAS f32x4*)F.g_final + F.lane; const GAS v2u* hr = (const GAS v2u*)(F_H1B + (size_t)m * DM) + F.lane;
#pragma unroll
            for (int j = 0; j < 8; ++j) { const v2u hw = hr[64 * j]; const f32x4 v = {bf_lo(hw.x), bf_hi(hw.x), bf_lo(hw.y), bf_hi(hw.y)}; orow[64 * j] = v * rs * gr[64 * j]; }
        }
    }
#undef IN
#undef BOTH
#undef GRID_BAR
}


#if DBG_ROUTE_BF
__global__ void __launch_bounds__(NWAVES * 64, 2) dbg_route_kernel(Args args) {
    extern __shared__ __attribute__((aligned(16))) unsigned char lds[];
    Frame F; F.lds = (LAS unsigned char*)lds; F.tid = threadIdx.x; F.lane = F.tid & 63; F.wave = F.tid >> 6; F.G = gridDim.x; F.vcu = blockIdx.x; F.ws = args.ws; F.sub_keys = (const float*)args.in[11];
    route_bruteforce(F);
}
#endif
extern "C" void kernel_launch(void* const* d_in, const int* in_sizes, int n_in, void* d_out, int out_size, void* d_ws, size_t ws_size, hipStream_t stream) {
    static int grid = 0;
    if (grid == 0) {
        if (n_in != 18 || out_size != M * DM || ws_size < WS_END + 65536) { fprintf(stderr, "kernel_launch: unexpected shapes (n_in %d, out %d, ws %zu)\n", n_in, out_size, ws_size); grid = -1; return; }
        int dev = 0, cus = 0, per_cu = 0;
        if (hipGetDevice(&dev) != hipSuccess || hipDeviceGetAttribute(&cus, hipDeviceAttributeMultiprocessorCount, dev) != hipSuccess) { grid = -1; return; }
#if DBG_ROUTE_BF
        (void)hipFuncSetAttribute((const void*)dbg_route_kernel, hipFuncAttributeMaxDynamicSharedMemorySize, 98304);
#endif
        if (hipFuncSetAttribute((const void*)hymba_fwd, hipFuncAttributeMaxDynamicSharedMemorySize, LDS_BYTES) != hipSuccess) { fprintf(stderr, "kernel_launch: hipFuncSetAttribute failed\n"); grid = -1; return; }
        if (hipOccupancyMaxActiveBlocksPerMultiprocessor(&per_cu, (const void*)hymba_fwd, NWAVES * 64, LDS_BYTES) != hipSuccess || per_cu < 1)
            fprintf(stderr, "kernel_launch: note: occupancy query reports %d workgroups per CU\n", per_cu);
        (void)hipGetLastError();
        if (cus < 128) { fprintf(stderr, "kernel_launch: needs >= 128 CUs\n"); grid = -1; return; }
        grid = cus;
    }
    if (grid < 0) return;
    if (hipMemsetAsync((char*)d_ws + WS_CTL, 0, CTL_ZERO_BYTES, stream) != hipSuccess) return;
    Args a{};
    for (int i = 0; i < 18; ++i) a.in[i] = d_in[i];
    a.out = (float*)d_out; a.ws = (unsigned char*)d_ws;
    constexpr int NL = MK_N_LAUNCHES;
    for (int li = 0; li < NL; ++li) {
        a.ph_lo = (NL == 1) ? 0 : li; a.ph_hi = (NL == 1) ? N_PHASES : li + 1; a.li = li;
#if DBG_ROUTE_BF
        if (NL == 9 && li == 5) { hipLaunchKernelGGL(dbg_route_kernel, dim3(grid), dim3(NWAVES * 64), 98304, stream, a); continue; }
#endif
        hipLaunchKernelGGL(hymba_fwd, dim3(grid), dim3(NWAVES * 64), LDS_BYTES, stream, a);
    }
}
```

```cpp
#include <hip/hip_runtime.h>
#include <cstdio>
#include <cstdint>
namespace pg8 {
#define PG8_LAS __attribute__((address_space(3)))
typedef unsigned short bf16_t;
typedef short bf16x8 __attribute__((ext_vector_type(8)));
typedef float f32x4 __attribute__((ext_vector_type(4)));
typedef unsigned u32x4 __attribute__((ext_vector_type(4)));
constexpr int BM = 256, BK = 64, HALF = 128, HTB = HALF * BK * 2  , STAGE_BYTES = 8 * HTB, NXCD = 8, WGM = 8;

__host__ __device__ __forceinline__ int lds_byte(int r, int c) { const int st = (r >> 4) * 2 + (c >> 5), rr = r & 15, cc = c & 31, ob = rr * 64 + cc * 2; return st * 1024 + (ob ^ (((ob >> 9) & 1) << 5)); }
__host__ __device__ __forceinline__ void stage_rc(int b, int& R, int& C) { const int st = b / 1024, sb = b % 1024, swz = sb ^ (((sb >> 9) & 1) << 5); R = (st >> 1) * 16 + swz / 64; C = (st & 1) * 32 + (swz % 64) / 2; }
__host__ __device__ __forceinline__ int perm32(int rho) { const int n = rho >> 4, i = rho & 15; return 8 * (i >> 2) + 4 * n + (i & 3); }

struct Unit { int pm, pn; };
struct Gemm { const bf16_t* A; const bf16_t* Bt; int M, N, K, lda, ldb; };

struct StaticOrder {
    int nM, nN, nwg, G, c;
    __host__ __device__ void init(int M, int N, int G_, int c_) { nM = M / BM; nN = N / BM; nwg = nM * nN; G = G_; c = c_; }
    __host__ __device__ bool next(int i, Unit& u) const {
        const long L = (long)i * G + c; if (L >= nwg) return false;
        int wgid = (int)L; { const int q = nwg / NXCD, r = nwg % NXCD, xcd = wgid % NXCD, off = wgid / NXCD; wgid = (xcd < r ? xcd * (q + 1) : r * (q + 1) + (xcd - r) * q) + off; }
        const int nig = WGM * nN, gid = wgid / nig, fm = gid * WGM, gsz = (nM - fm) < WGM ? (nM - fm) : WGM;
        u.pm = fm + ((wgid % nig) % gsz); u.pn = (wgid % nig) / gsz; return true;
    }
    __device__ __forceinline__ void a_ready(const Unit&) const {}
    __device__ __forceinline__ void done(const Unit&) const {}
};

__device__ __forceinline__ unsigned cvt_pk_bf16(float lo, float hi) { unsigned r; asm volatile("v_cvt_pk_bf16_f32 %0, %1, %2" : "=v"(r) : "v"(lo), "v"(hi)); return r; }
typedef float f32x2 __attribute__((ext_vector_type(2)));

template <class Epi, class Sched, bool ALIGN_EPI = false, bool SP2 = false>
__device__ __forceinline__ void gemm_phase(PG8_LAS unsigned char* lds, const Gemm g, const Sched& S, const Epi& E) {
    const int tid = threadIdx.x, wid = __builtin_amdgcn_readfirstlane(tid >> 6), lane = tid & 63, wr = wid >> 2, wc = wid & 3, fr = lane & 15, fq = lane >> 4;
    const int K = g.K, nt = K / BK;
    unsigned voffA[2], voffB[2];
#pragma unroll
    for (int i = 0; i < 2; ++i) { int R, C; stage_rc(tid * 16 + i * 8192, R, C); const int Rb = Epi::PERM ? ((R & ~31) + perm32(R & 31)) : R;
        voffA[i] = (unsigned)(R * g.lda + C) * 2u; voffB[i] = (unsigned)(Rb * g.ldb + C) * 2u; }
    const size_t kstep = (size_t)(BK * 2);
    const size_t hstepA = (size_t)HALF * g.lda * 2, hstepB = (size_t)HALF * g.ldb * 2;
    const size_t tstepA = 2 * hstepA, tstepB = 2 * hstepB;
    const unsigned ldsw = (unsigned)wid * 1024u;
    const int aoff = lds_byte(wr * 64 + fr, fq * 8), boff = lds_byte(wc * 32 + fr, fq * 8);
#define PG8_SA(b, h) (((b) * 2 + (h)) * HTB)
#define PG8_SB(b, h) ((4 + (b) * 2 + (h)) * HTB)
#define PG8_STAGE(bufoff, gbase, voff) do { _Pragma("unroll") for (int _i = 0; _i < 2; ++_i) \
        __builtin_amdgcn_global_load_lds((const unsigned*)((const char*)(gbase) + (voff)[_i]), (PG8_LAS unsigned*)(lds + (bufoff) + ldsw + _i * 8192), 16, 0, 0); } while (0)
#define PG8_LDA(dst, b, h) do { _Pragma("unroll") for (int m = 0; m < 4; ++m) _Pragma("unroll") for (int k = 0; k < 2; ++k) dst[m][k] = *(const PG8_LAS bf16x8*)(lds + PG8_SA(b, h) + aoff + m * 2048 + k * 1024); } while (0)
#define PG8_LDB(dst, b, h) do { _Pragma("unroll") for (int n = 0; n < 2; ++n) _Pragma("unroll") for (int k = 0; k < 2; ++k) dst[n][k] = *(const PG8_LAS bf16x8*)(lds + PG8_SB(b, h) + boff + n * 2048 + k * 1024); } while (0)
#define PG8_MMA(ai, bj, At, Bt) do { __builtin_amdgcn_s_setprio(1); _Pragma("unroll") for (int m = 0; m < 4; ++m) _Pragma("unroll") for (int n = 0; n < 2; ++n) _Pragma("unroll") for (int k = 0; k < 2; ++k) \
        acc[ai][bj][m][n] = __builtin_amdgcn_mfma_f32_16x16x32_bf16(Bt[n][k], At[m][k], acc[ai][bj][m][n], 0, 0, 0); __builtin_amdgcn_s_setprio(0); } while (0)
#define PG8_WAIT_V(n) asm volatile("s_waitcnt vmcnt(" #n ")" ::: "memory")
#define PG8_WAIT_L(n) asm volatile("s_waitcnt lgkmcnt(" #n ")" ::: "memory")
#define PG8_BAR __builtin_amdgcn_s_barrier()
#define PG8_SCHED __builtin_amdgcn_sched_barrier(0)
    Unit cur, nxt; int ui = 0;
    if (!S.next(0, cur)) return;
    f32x4 acc[2][2][4][2];
#pragma unroll
    for (int a = 0; a < 2; ++a)
#pragma unroll
        for (int b = 0; b < 2; ++b)
#pragma unroll
            for (int m = 0; m < 4; ++m)
#pragma unroll
                for (int n = 0; n < 2; ++n) acc[a][b][m][n] = (f32x4){0.f, 0.f, 0.f, 0.f};
    bf16x8 At[4][2], B0[2][2], B1[2][2];
    const char* cA = (const char*)g.A + (size_t)cur.pm * tstepA; const char* cB = (const char*)g.Bt + (size_t)cur.pn * tstepB;
    S.a_ready(cur);
    if constexpr (SP2) {
        PG8_STAGE(PG8_SB(0, 0), cB, voffB); PG8_STAGE(PG8_SB(0, 1), cB + hstepB, voffB); PG8_STAGE(PG8_SA(0, 0), cA, voffA); PG8_STAGE(PG8_SA(0, 1), cA + hstepA, voffA);
        if (wr == 1) PG8_BAR;
        PG8_WAIT_V(2); PG8_BAR;
        PG8_STAGE(PG8_SB(1, 0), cB + kstep, voffB); PG8_STAGE(PG8_SA(1, 0), cA + kstep, voffA); PG8_STAGE(PG8_SB(1, 1), cB + hstepB + kstep, voffB);
        PG8_WAIT_V(6); PG8_BAR;
    } else {
        PG8_STAGE(PG8_SB(0, 0), cB, voffB); PG8_STAGE(PG8_SA(0, 0), cA, voffA); PG8_STAGE(PG8_SB(0, 1), cB + hstepB, voffB); PG8_STAGE(PG8_SA(0, 1), cA + hstepA, voffA);
        if (wr == 1) PG8_BAR;
        PG8_WAIT_V(4); PG8_BAR;
        PG8_STAGE(PG8_SB(1, 0), cB + kstep, voffB); PG8_STAGE(PG8_SA(1, 0), cA + kstep, voffA); PG8_STAGE(PG8_SB(1, 1), cB + hstepB + kstep, voffB);
        PG8_WAIT_V(6); PG8_BAR;
    }
    for (;;) {
        const bool has_next = S.next(ui + 1, nxt);
        const char* nA = has_next ? (const char*)g.A + (size_t)nxt.pm * tstepA : cA; const char* nB = has_next ? (const char*)g.Bt + (size_t)nxt.pn * tstepB : cB;
        for (int t = 0; t < nt; t += 2) {
            const bool last = (t == nt - 2);
            const char* a1 = cA + (size_t)(t + 1) * kstep;
            const char* a2 = last ? nA : cA + (size_t)(t + 2) * kstep; const char* b2 = last ? nB : cB + (size_t)(t + 2) * kstep;
            const char* a3 = a2 + kstep; const char* b3 = b2 + kstep;
            if (last && has_next) S.a_ready(nxt);
            if constexpr (SP2) {
            PG8_LDB(B0, 0, 0); PG8_LDB(B1, 0, 1); PG8_SCHED; PG8_LDA(At, 0, 0); PG8_STAGE(PG8_SA(1, 1), a1 + hstepA, voffA);
            PG8_WAIT_V(8); PG8_WAIT_L(0); PG8_BAR; PG8_MMA(0, 0, At, B0); PG8_MMA(0, 1, At, B1); PG8_BAR; PG8_SCHED;
            PG8_LDA(At, 0, 1); PG8_STAGE(PG8_SB(0, 0), b2, voffB); PG8_STAGE(PG8_SB(0, 1), b2 + hstepB, voffB); PG8_STAGE(PG8_SA(0, 0), a2, voffA);
            PG8_WAIT_V(8); PG8_WAIT_L(0); PG8_BAR; PG8_MMA(1, 0, At, B0); PG8_MMA(1, 1, At, B1); PG8_BAR; PG8_SCHED;
            PG8_LDB(B0, 1, 0); PG8_LDB(B1, 1, 1); PG8_SCHED; PG8_LDA(At, 1, 0); PG8_STAGE(PG8_SA(0, 1), a2 + hstepA, voffA);
            PG8_WAIT_V(8); PG8_WAIT_L(0); PG8_BAR; PG8_MMA(0, 0, At, B0); PG8_MMA(0, 1, At, B1); PG8_BAR; PG8_SCHED;
            PG8_LDA(At, 1, 1); PG8_STAGE(PG8_SB(1, 0), b3, voffB); PG8_STAGE(PG8_SB(1, 1), b3 + hstepB, voffB); PG8_STAGE(PG8_SA(1, 0), a3, voffA);
            PG8_WAIT_V(8); PG8_WAIT_L(0); PG8_BAR; PG8_MMA(1, 0, At, B0); PG8_MMA(1, 1, At, B1); PG8_BAR; PG8_SCHED;
            } else {
            PG8_LDB(B0, 0, 0); PG8_SCHED; PG8_LDA(At, 0, 0); PG8_STAGE(PG8_SA(1, 1), a1 + hstepA, voffA);
            PG8_WAIT_L(8); PG8_BAR; PG8_WAIT_L(0); PG8_MMA(0, 0, At, B0); PG8_BAR; PG8_SCHED;
            PG8_LDB(B1, 0, 1); PG8_STAGE(PG8_SB(0, 0), b2, voffB);
            PG8_BAR; PG8_WAIT_L(0); PG8_MMA(0, 1, At, B1); PG8_BAR;
            PG8_LDA(At, 0, 1); PG8_STAGE(PG8_SA(0, 0), a2, voffA);
            PG8_BAR; PG8_WAIT_L(0); PG8_MMA(1, 0, At, B0); PG8_BAR; PG8_SCHED;
            PG8_STAGE(PG8_SB(0, 1), b2 + hstepB, voffB);
            PG8_WAIT_V(6); PG8_BAR; PG8_MMA(1, 1, At, B1); PG8_BAR;
            PG8_LDB(B0, 1, 0); PG8_SCHED; PG8_LDA(At, 1, 0); PG8_STAGE(PG8_SA(0, 1), a2 + hstepA, voffA);
            PG8_WAIT_L(8); PG8_BAR; PG8_WAIT_L(0); PG8_MMA(0, 0, At, B0); PG8_BAR; PG8_SCHED;
            PG8_LDB(B1, 1, 1); PG8_STAGE(PG8_SB(1, 0), b3, voffB);
            PG8_BAR; PG8_WAIT_L(0); PG8_MMA(0, 1, At, B1); PG8_BAR;
            PG8_LDA(At, 1, 1); PG8_STAGE(PG8_SA(1, 0), a3, voffA);
            PG8_BAR; PG8_WAIT_L(0); PG8_MMA(1, 0, At, B0); PG8_BAR; PG8_SCHED;
            PG8_STAGE(PG8_SB(1, 1), b3 + hstepB, voffB);
            PG8_WAIT_V(6); PG8_BAR; PG8_MMA(1, 1, At, B1); PG8_BAR;
            }
        }
        if constexpr (ALIGN_EPI) { if (wr == 0) PG8_BAR; }
        if constexpr (!Epi::AFTER_DRAIN) { E(acc, cur, wr, wc, fr, fq); S.done(cur); }
        if (!has_next) break;
#pragma unroll
        for (int a = 0; a < 2; ++a)
#pragma unroll
            for (int b = 0; b < 2; ++b)
#pragma unroll
                for (int m = 0; m < 4; ++m)
#pragma unroll
                    for (int n = 0; n < 2; ++n) acc[a][b][m][n] = (f32x4){0.f, 0.f, 0.f, 0.f};
        cur = nxt; cA = nA; cB = nB; ++ui;
        if constexpr (ALIGN_EPI) { if (wr == 1) PG8_BAR; }
    }
    PG8_WAIT_V(0);
    if constexpr (!ALIGN_EPI) { if (wr == 0) PG8_BAR; }
    PG8_BAR;
    if constexpr (Epi::AFTER_DRAIN) { E.fused(acc, cur, wr, wc, fr, fq, lds, wid, lane); S.done(cur); }
#undef PG8_SA
#undef PG8_SB
#undef PG8_STAGE
#undef PG8_LDA
#undef PG8_LDB
#undef PG8_MMA
#undef PG8_WAIT_V
#undef PG8_WAIT_L
#undef PG8_BAR
#undef PG8_SCHED
}
}


constexpr int NWAVES = 8;
constexpr int DM = 2048, BATCH = 2, SEQ = 4096, M = BATCH * SEQ;
constexpr int HD = 64, NQH = 16, NKVH = 4, ATTW = 1024, KVW = 256, POOLW = 1024, INW = 2560;
constexpr int PKH = 8, NEXP = 16384, PLE = 256;
constexpr float EPS = 1e-6f;
constexpr float EU_SCALE = 256.0f, EV_SCALE = 16.0f;
#ifndef MK_N_LAUNCHES
#define MK_N_LAUNCHES 1
#endif
constexpr int N_PHASES = 9;
#ifndef REP_MASK
#define REP_MASK 0
#endif
#define NREP(k) (((REP_MASK >> (k)) & 1) ? 2 : 1)
#ifndef DBG_NO_PEER
#define DBG_NO_PEER 0
#endif
#ifndef DBG_NO_PLE
#define DBG_NO_PLE 0
#endif
#ifndef DBG_NO_MIX
#define DBG_NO_MIX 0
#endif

constexpr size_t MiB = 1u << 20;
constexpr size_t WS_CTL = 0, CTL_ZERO_BYTES = 256 * 1024;
constexpr size_t WS_WIN = 1 * MiB, WS_WOUT = 11 * MiB, WS_WQ = 19 * MiB, WS_WG = 27 * MiB, WS_WP = 35 * MiB, WS_WPOOL = 36 * MiB;
constexpr size_t WS_SKH = 36 * MiB + 512 * 1024, WS_SKL = WS_SKH + 64 * 1024;
constexpr size_t WS_ROPE = 37 * MiB;
constexpr size_t WS_RSTD1 = 37 * MiB + 512 * 1024, WS_RSTD3 = WS_RSTD1 + 32 * 1024;
constexpr size_t WS_EU = 38 * MiB, WS_EV = 102 * MiB;
constexpr size_t WS_XB = 166 * MiB, WS_PB = 198 * MiB;
constexpr size_t WS_Q = 202 * MiB, WS_K = 218 * MiB, WS_V = 222 * MiB, WS_U = 226 * MiB, WS_POOLED = 242 * MiB, WS_MIX = 258 * MiB;
constexpr size_t WS_QP = 202 * MiB;
constexpr size_t WS_EIDX = 266 * MiB, WS_GATE = 270 * MiB;
constexpr size_t WS_H1 = 290 * MiB, WS_H1B = 354 * MiB, WS_PP = 386 * MiB, WS_H2B = 418 * MiB, WS_END = 450 * MiB;
constexpr int CW_QUEUE = 2048, CW_QUEUE0 = 2112;
#ifndef NCONV
#define NCONV 96
#endif
#ifndef Q_SPLIT
#define Q_SPLIT 0
#endif
constexpr int CW_BAR = 4096;
constexpr int CW_SSQ2 = 16384, CW_SSQ4 = 16384 + 8192;
static_assert((CW_SSQ4 + 8192) * 4 <= (int)CTL_ZERO_BYTES, "ctl");

constexpr int RING_OFF = 0, RING_BYTES = 131072;
constexpr int LDSCTL_OFF = RING_BYTES, MISC_OFF = LDSCTL_OFF + 320;
constexpr int LDS_BYTES = 147456;

#define GAS __attribute__((address_space(1)))
#define LAS __attribute__((address_space(3)))
typedef unsigned short bf16;
typedef unsigned v4u __attribute__((ext_vector_type(4)));
typedef unsigned v2u __attribute__((ext_vector_type(2)));
typedef float f32x4 __attribute__((ext_vector_type(4)));
typedef float f32x16 __attribute__((ext_vector_type(16)));
typedef short bf16x8 __attribute__((ext_vector_type(8)));
typedef GAS unsigned gu32;
#define RLX_AGENT __ATOMIC_RELAXED, __HIP_MEMORY_SCOPE_AGENT
#define LDS_WAIT() asm volatile("s_waitcnt lgkmcnt(0)" ::: "memory")
#define VM_WAIT() asm volatile("s_waitcnt vmcnt(0)" ::: "memory")
typedef float f32x2_t __attribute__((ext_vector_type(2))); typedef __bf16 bf16x2_t __attribute__((ext_vector_type(2)));
__device__ __forceinline__ unsigned pk2(float lo, float hi) { f32x2_t v = {lo, hi}; bf16x2_t b = __builtin_convertvector(v, bf16x2_t); return __builtin_bit_cast(unsigned, b); }
__device__ __forceinline__ float bf_lo(unsigned w) { return __uint_as_float(w << 16); }
__device__ __forceinline__ float bf_hi(unsigned w) { return __uint_as_float(w & 0xffff0000u); }
__device__ __forceinline__ float dot2bf(unsigned a, unsigned b, float c) { return __builtin_amdgcn_fdot2_f32_bf16(__builtin_bit_cast(bf16x2_t, a), __builtin_bit_cast(bf16x2_t, b), c, false); }
__device__ __forceinline__ float max2f(float a, float b) { float r; asm("v_max_f32_e32 %0, %1, %2" : "=v"(r) : "v"(a), "v"(b)); return r; }
__device__ __forceinline__ float min2f(float a, float b) { float r; asm("v_min_f32_e32 %0, %1, %2" : "=v"(r) : "v"(a), "v"(b)); return r; }
__device__ __forceinline__ float wave_sum(float v) {
#pragma unroll
    for (int o = 1; o < 64; o <<= 1) v += __shfl_xor(v, o);
    return v;
}

#define XB_TMO      128
#define XB_XCNT(j)  (256  + 64 * (j))
#define XB_XSUB(j)  (1280 + 64 * (j))
#define XB_XGEN(j)  (2304 + 64 * (j))
#define XB_TOP      3328
#define XB_TOPGEN   3392
#define XCD_BAR_WORDS 3456
#define XB_SPIN_CAP (1u << 18)
__device__ __forceinline__ unsigned xb_ld(unsigned* p)              { return __hip_atomic_load(p, __ATOMIC_RELAXED, __HIP_MEMORY_SCOPE_AGENT); }
__device__ __forceinline__ unsigned xb_add(unsigned* p, unsigned v) { return __hip_atomic_fetch_add(p, v, __ATOMIC_RELAXED, __HIP_MEMORY_SCOPE_AGENT); }
__device__ __forceinline__ unsigned xb_xcc_id() { return (unsigned)__builtin_amdgcn_s_getreg((3 << 11) | 20) & 0xFu; }
#define XB_SPIN(cond, bar) do { unsigned _sp = 0; while (cond) { __builtin_amdgcn_s_sleep(1); \
    if ((++_sp & 255u) == 0u) { if (xb_ld(&(bar)[XB_TMO])) break; if (_sp > XB_SPIN_CAP) { atomicAdd(&(bar)[XB_TMO], 1u); break; } } } } while (0)
struct XcdBarrier { unsigned* bar; unsigned x; volatile LAS unsigned* st; };
__device__ __forceinline__ XcdBarrier xcd_barrier_post(unsigned* bar, volatile LAS unsigned* st) {
    XcdBarrier b; b.bar = bar; b.x = xb_xcc_id(); b.st = st;
    if (threadIdx.x == 0) (void)xb_add(&bar[XB_XCNT(b.x)], 1u);
    return b;
}
__device__ __forceinline__ void xcd_barrier_complete(unsigned* bar, unsigned x, unsigned& nloc, unsigned& nx) {
    const unsigned G = gridDim.x * gridDim.y * gridDim.z;
    unsigned sum, cnt, mine, sp = 0u;
    for (;;) {
        sum = 0u; cnt = 0u; mine = 0u;
#pragma unroll
        for (unsigned j = 0; j < 16; ++j) { const unsigned c = xb_ld(&bar[XB_XCNT(j)]); sum += c; cnt += (c > 0u) ? 1u : 0u; mine = (j == x) ? c : mine; }
        if (sum == G) break;
        __builtin_amdgcn_s_sleep(1);
        if ((++sp & 255u) == 0u) { if (xb_ld(&bar[XB_TMO])) break; if (sp > XB_SPIN_CAP) { atomicAdd(&bar[XB_TMO], 1u); break; } }
    }
    nloc = mine > 0u ? mine : 1u; nx = cnt > 0u ? cnt : 1u;
}
__device__ __forceinline__ void xcd_barrier(const XcdBarrier& b) {
    asm volatile("s_waitcnt vmcnt(0)" ::: "memory");
    __syncthreads();
    if (threadIdx.x == 0) {
        unsigned* bar = b.bar;
        __builtin_amdgcn_s_waitcnt(0);
        unsigned nloc = b.st[0], nx = b.st[1];
        if (nloc == 0u) { xcd_barrier_complete(bar, b.x, nloc, nx); b.st[0] = nloc; b.st[1] = nx; }
        const unsigned old = xb_add(&bar[XB_XSUB(b.x)], 1u);
        const unsigned gen = old / nloc;
        if (old + 1u == (gen + 1u) * nloc) {
            __builtin_amdgcn_fence(__ATOMIC_RELEASE, "agent");
            asm volatile("s_waitcnt vmcnt(0)" ::: "memory");
            const unsigned og = xb_add(&bar[XB_TOP], 1u);
            const unsigned tg = og / nx;
            if (og + 1u == (tg + 1u) * nx) xb_add(&bar[XB_TOPGEN], 1u);
            else XB_SPIN(xb_ld(&bar[XB_TOPGEN]) == tg, bar);
            __builtin_amdgcn_fence(__ATOMIC_ACQUIRE, "agent");
            xb_add(&bar[XB_XGEN(b.x)], 1u);
            asm volatile("s_waitcnt vmcnt(0)" ::: "memory");
        } else {
            XB_SPIN(xb_ld(&bar[XB_XGEN(b.x)]) == gen, bar);
            __builtin_amdgcn_fence(__ATOMIC_ACQUIRE, "agent");
            asm volatile("s_waitcnt vmcnt(0)" ::: "memory");
        }
    }
    __syncthreads();
}

struct Frame {
    LAS unsigned char* lds;
    volatile LAS unsigned* MISC;
    gu32* ctl;
    int tid, lane, wave;
    int vcu, G;
    const float *x, *p, *g_mix, *w_in, *sinks, *w_pool, *pool_scale, *w_out, *g_ffn, *w_query, *sub_keys, *expert_u, *expert_v, *g_ple, *w_ple_gate, *w_ple_proj, *g_final;
    const int* positions;
    float* out;
    unsigned char* ws;
};
#define F_Win_t  ((bf16*)(F.ws + WS_WIN))
#define F_Wout_t ((bf16*)(F.ws + WS_WOUT))
#define F_Wq_t   ((bf16*)(F.ws + WS_WQ))
#define F_Wg_t   ((bf16*)(F.ws + WS_WG))
#define F_Wp_t   ((bf16*)(F.ws + WS_WP))
#define F_Wpool_t ((bf16*)(F.ws + WS_WPOOL))
#define F_SKH    ((bf16*)(F.ws + WS_SKH))
#define F_SKL    ((bf16*)(F.ws + WS_SKL))
#define F_EU     ((bf16*)(F.ws + WS_EU))
#define F_EV     ((bf16*)(F.ws + WS_EV))
#define F_XB     ((bf16*)(F.ws + WS_XB))
#define F_PB     ((bf16*)(F.ws + WS_PB))
#define F_QB     ((bf16*)(F.ws + WS_Q))
#define F_KB     ((bf16*)(F.ws + WS_K))
#define F_VB     ((bf16*)(F.ws + WS_V))
#define F_UB     ((bf16*)(F.ws + WS_U))
#define F_POOLED ((bf16*)(F.ws + WS_POOLED))
#define F_MIX    ((bf16*)(F.ws + WS_MIX))
#define F_H1B    ((bf16*)(F.ws + WS_H1B))
#define F_PP     ((bf16*)(F.ws + WS_PP))
#define F_H2B    ((bf16*)(F.ws + WS_H2B))
#define F_ROPE   ((float*)(F.ws + WS_ROPE))
#define F_RSTD1  ((float*)(F.ws + WS_RSTD1))
#define F_RSTD3  ((float*)(F.ws + WS_RSTD3))
#define F_QP     ((bf16*)(F.ws + WS_QP))
#define F_GATE   ((float*)(F.ws + WS_GATE))
#define F_H1     ((float*)(F.ws + WS_H1))
#define F_SSQ2   ((float*)(F.ws + WS_CTL) + CW_SSQ2)
#define F_SSQ4   ((float*)(F.ws + WS_CTL) + CW_SSQ4)
#define F_EIDX   ((int*)(F.ws + WS_EIDX))

__device__ __forceinline__ void p0_transpose_item(const float* W, int ldw, int N, const float* gain, bf16* WT, int ldt, LAS float* scr, int item, int lane) {
    const int nblk = N / 32, kb = item / nblk, nb = item % nblk, k0 = 64 * kb, n0 = 32 * nb;
    float wv[32];
#pragma unroll
    for (int i = 0; i < 32; ++i) { const int kk = 2 * i + (lane >> 5); wv[i] = W[(size_t)(k0 + kk) * ldw + n0 + (lane & 31)]; }
    if (gain) {
#pragma unroll
        for (int i = 0; i < 32; ++i) wv[i] *= gain[k0 + 2 * i + (lane >> 5)];
    }
#pragma unroll
    for (int i = 0; i < 32; ++i) { const int kk = 2 * i + (lane >> 5); scr[kk * 33 + (lane & 31)] = wv[i]; }
    LDS_WAIT(); asm volatile("" ::: "memory");
    const int c = lane & 7;
#pragma unroll
    for (int j = 0; j < 4; ++j) { const int n = (lane >> 3) + 8 * j; const LAS float* s = scr + (8 * c) * 33 + n;
        v4u o; o.x = pk2(s[0 * 33], s[1 * 33]); o.y = pk2(s[2 * 33], s[3 * 33]); o.z = pk2(s[4 * 33], s[5 * 33]); o.w = pk2(s[6 * 33], s[7 * 33]);
        *(GAS v4u*)(WT + (size_t)(n0 + n) * ldt + k0 + 8 * c) = o; }
    LDS_WAIT(); asm volatile("" ::: "memory");
}
__device__ __forceinline__ void p0_prologue(Frame& F) {
    LAS float* scr = (LAS float*)(F.lds + RING_OFF + F.wave * 16384);
    const int gw = F.vcu * NWAVES + F.wave, NGW = F.G * NWAVES;
    const int gt = gw * 64 + F.lane, NGT = NGW * 64;
    constexpr int I_IN = (DM / 64) * (INW / 32), I_P = (PLE / 64) * (DM / 32);
    constexpr int NITEMS = I_IN + I_P;
    for (int it = gw; it < NITEMS; it += NGW) {
        int r = it;
        if (r < I_IN) { p0_transpose_item(F.w_in, INW, INW, F.g_mix, F_Win_t, DM, scr, r, F.lane); continue; } r -= I_IN;
        p0_transpose_item(F.w_ple_proj, DM, DM, nullptr, F_Wp_t, PLE, scr, r, F.lane);
    }
    for (int m = gw; m < M; m += NGW) {
        const GAS f32x4* xr = (const GAS f32x4*)(F.x + (size_t)m * DM) + F.lane;
        f32x4 v[8]; float s = 0.f;
#pragma unroll
        for (int j = 0; j < 8; ++j) { v[j] = xr[64 * j]; s += (v[j].x * v[j].x + v[j].y * v[j].y) + (v[j].z * v[j].z + v[j].w * v[j].w); }
        s = wave_sum(s);
        if (F.lane == 0) F_RSTD1[m] = 1.0f / sqrtf(s * (1.0f / DM) + EPS);
        GAS v2u* o8 = (GAS v2u*)(F_XB + (size_t)m * DM) + F.lane;
#pragma unroll
        for (int j = 0; j < 8; ++j) { v2u o; o.x = pk2(v[j].x, v[j].y); o.y = pk2(v[j].z, v[j].w); o8[64 * j] = o; }
    }
    for (int c = gt; c < M * PLE / 8; c += NGT) {
        const GAS f32x4* s = (const GAS f32x4*)F.p + 2 * (size_t)c; const f32x4 a = s[0], b = s[1];
        v4u o; o.x = pk2(a.x, a.y); o.y = pk2(a.z, a.w); o.z = pk2(b.x, b.y); o.w = pk2(b.z, b.w);
        *((GAS v4u*)F_PB + c) = o;
    }
    for (int c = gt; c < M * 8; c += NGT) {
        const int t = c >> 3, i = c & 7;
        const float inv = 1.0f / (float)pow(500000.0, (double)(2 * i) / 16.0);
        const float ang = (float)F.positions[t] * inv;
        F_ROPE[t * 16 + i] = (float)cos((double)ang); F_ROPE[t * 16 + 8 + i] = (float)sin((double)ang);
    }
    for (int c = gt; c < 2 * 128 * 128; c += NGT) {
        const float v = F.sub_keys[c]; const unsigned h = pk2(v, 0.f) & 0xffffu; const float hf = __uint_as_float(h << 16);
        F_SKH[c] = (bf16)h; F_SKL[c] = (bf16)(pk2(v - hf, 0.f) & 0xffffu);
    }
}


constexpr int Q_EXP = 1024, Q_SQ = 256, Q_POOL = 16, Q_ITEMS = Q_EXP + 3 * Q_SQ + Q_POOL;
template <bool ISV> __device__ __forceinline__ void conv_expert_rows(Frame& F, int e0, int tid) {
    const float* src = ISV ? F.expert_v : F.expert_u; unsigned char* dstb = (unsigned char*)(ISV ? (void*)F_EV : (void*)F_EU);
    const float sc = ISV ? EV_SCALE : EU_SCALE;
    const int lane = tid & 63, wv = tid >> 6;
#pragma unroll 4
    for (int it = 0; it < 8; ++it) {
        const int ix = it * 8 + wv, eg = ix >> 4, s = ix & 15;
        const int e = e0 + eg * 8 + (lane >> 3), d0 = s * 128 + (lane & 7) * 16;
        const GAS f32x4* sp = (const GAS f32x4*)(src + (size_t)e * DM + d0); const GAS f32x4* gp = (const GAS f32x4*)(F.g_ffn + d0);
        v4u o;
#pragma unroll
        for (int q = 0; q < 4; ++q) { f32x4 a = sp[q] * sc; if constexpr (!ISV) a = a * gp[q]; int w = 0; w = __builtin_amdgcn_cvt_pk_fp8_f32(a.x, a.y, w, false); w = __builtin_amdgcn_cvt_pk_fp8_f32(a.z, a.w, w, true); o[q] = (unsigned)w; }
        *(GAS v4u*)(dstb + ((size_t)s * NEXP + e) * 128 + (lane & 7) * 16) = o;
    }
}
__device__ __forceinline__ void conv_expert_item(Frame& F, int idx, int tid) {
    if (idx >= 512) conv_expert_rows<true>(F, (idx & 511) * 32, tid); else conv_expert_rows<false>(F, (idx & 511) * 32, tid);
}
constexpr int Q_W = 3 * Q_SQ + Q_POOL;
__device__ __forceinline__ void p1_queue(Frame& F, int lo, int hi, int cw) {
    const int lane = (int)__builtin_amdgcn_mbcnt_hi(~0u, __builtin_amdgcn_mbcnt_lo(~0u, 0u)), tid = F.wave * 64 + lane;
    LAS float* scr = (LAS float*)(F.lds + RING_OFF + F.wave * 16384);
    volatile LAS unsigned* qslot = F.MISC + 12;
    unsigned mine = 0u;
    __syncthreads();
    if (tid == 0) { qslot[0] = __hip_atomic_fetch_add((unsigned*)(F.ctl + cw), 1u, RLX_AGENT); }
    __syncthreads();
    int idx = lo + (int)qslot[0];
    for (int n = 0;; ++n) {
        if (idx >= hi) break;
        if (tid == 0) mine = __hip_atomic_fetch_add((unsigned*)(F.ctl + cw), 1u, RLX_AGENT);
        if (idx >= Q_W) conv_expert_item(F, idx - Q_W, tid);
        else {
            int r = idx * 8 + F.wave;
            if (r < 8 * Q_SQ) p0_transpose_item(F.w_out, DM, DM, nullptr, F_Wout_t, DM, scr, r, lane);
            else if (r < 16 * Q_SQ) p0_transpose_item(F.w_query, DM, DM, F.g_ffn, F_Wq_t, DM, scr, r - 8 * Q_SQ, lane);
            else if (r < 24 * Q_SQ) p0_transpose_item(F.w_ple_gate, DM, DM, F.g_ple, F_Wg_t, DM, scr, r - 16 * Q_SQ, lane);
            else { const int rp = r - 24 * Q_SQ, g = rp / 32, rr = rp % 32; p0_transpose_item(F.w_pool + (size_t)g * 65536, 256, 256, nullptr, F_Wpool_t + (size_t)g * 65536, 256, scr, rr, lane); }
        }
        if (tid == 0) qslot[1 - (n & 1)] = mine;
        __syncthreads();
        idx = lo + (int)qslot[1 - (n & 1)];
    }
    __syncthreads();
}
struct PpOrder {
    int first, stride;
    __device__ __forceinline__ void init(int G, int c, int nconv) { const int heavy = nconv > 0 ? nconv : ((320 > G && 320 - G < G) ? 320 - G : 0); if (c < heavy) { first = 1 << 20; stride = 1; } else { first = c - heavy; stride = G - heavy; } }
    __device__ __forceinline__ bool next(int i, pg8::Unit& u) const { const long k = (long)first + (long)i * stride; if (k >= 256) return false; u.pm = (int)k >> 3; u.pn = (int)k & 7; return true; }
    __device__ __forceinline__ void a_ready(const pg8::Unit&) const {}
    __device__ __forceinline__ void done(const pg8::Unit&) const {}
};

struct EpiG1 {
    static constexpr bool PERM = true, AFTER_DRAIN = false;
    bf16 *Q, *Kb, *Vb, *U; const float* rstd; const float* rope;
    __device__ __forceinline__ void operator()(const f32x4 (&acc)[2][2][4][2], const pg8::Unit& u, int wr, int wc, int fr, int fq) const {
        const int pn = u.pn; bf16* base; int ldc, colt;
        if (pn < 4) { base = Q; ldc = ATTW; colt = pn * 256; } else if (pn == 4) { base = Kb; ldc = KVW; colt = 0; } else if (pn == 5) { base = Vb; ldc = KVW; colt = 0; } else { base = U; ldc = POOLW; colt = (pn - 6) * 256; }
        const bool rot = (pn <= 4) && ((wc & 1) == 0);
        const float qs = (pn < 4) ? 0.125f : 1.0f;
#pragma unroll
        for (int ai = 0; ai < 2; ++ai)
#pragma unroll
            for (int m = 0; m < 4; ++m) {
                const int row = u.pm * 256 + ai * 128 + wr * 64 + m * 16 + fr;
                const float rs = rstd[row] * qs;
                const GAS f32x4* rp = (const GAS f32x4*)(rope + (size_t)row * 16);
#pragma unroll
                for (int bj = 0; bj < 2; ++bj) {
                    f32x4 v0 = acc[ai][bj][m][0] * rs, v1 = acc[ai][bj][m][1] * rs;
                    if (rot) {
                        { const f32x4 c = rp[0], s = rp[2]; f32x4 p;
#pragma unroll
                          for (int i = 0; i < 4; ++i) p[i] = __shfl_xor(v0[i], 16);
                          if (fq == 0) v0 = v0 * c - p * s; else if (fq == 1) v0 = v0 * c + p * s; }
                        { const f32x4 c = rp[1], s = rp[3]; f32x4 p;
#pragma unroll
                          for (int i = 0; i < 4; ++i) p[i] = __shfl_xor(v1[i], 16);
                          if (fq == 0) v1 = v1 * c - p * s; else if (fq == 1) v1 = v1 * c + p * s; }
                    }
                    v4u w; w.x = pk2(v0[0], v0[1]); w.y = pk2(v0[2], v0[3]); w.z = pk2(v1[0], v1[1]); w.w = pk2(v1[2], v1[3]);
                    *(GAS v4u*)(base + (size_t)row * ldc + colt + bj * 128 + wc * 32 + 8 * fq) = w;
                }
            }
    }
};
template <bool HAS_SCALE> struct EpiBf16Scale {
    static constexpr bool PERM = true, AFTER_DRAIN = false;
    bf16* O; int ldc, col_off; const float* cscale;
    __device__ __forceinline__ void operator()(const f32x4 (&acc)[2][2][4][2], const pg8::Unit& u, int wr, int wc, int fr, int fq) const {
        const int c0 = u.pn * 256 + wc * 32 + 8 * fq;
#pragma unroll
        for (int ai = 0; ai < 2; ++ai)
#pragma unroll
            for (int m = 0; m < 4; ++m) {
                const int row = u.pm * 256 + ai * 128 + wr * 64 + m * 16 + fr;
#pragma unroll
                for (int bj = 0; bj < 2; ++bj) {
                    f32x4 v0 = acc[ai][bj][m][0], v1 = acc[ai][bj][m][1];
                    if constexpr (HAS_SCALE) { v0 = v0 * *(const GAS f32x4*)(cscale + c0 + bj * 128); v1 = v1 * *(const GAS f32x4*)(cscale + c0 + bj * 128 + 4); }
                    v4u w; w.x = pk2(v0[0], v0[1]); w.y = pk2(v0[2], v0[3]); w.z = pk2(v1[0], v1[1]); w.w = pk2(v1[2], v1[3]);
                    *(GAS v4u*)(O + (size_t)row * ldc + col_off + c0 + bj * 128) = w;
                }
            }
    }
};
struct EpiG3 {
    static constexpr bool PERM = false, AFTER_DRAIN = false;
    const bf16* xb; bf16* h1b; float* ssq;
    __device__ __forceinline__ void operator()(const f32x4 (&acc)[2][2][4][2], const pg8::Unit& u, int wr, int wc, int fr, int fq) const {
        const int col0 = u.pn * 256 + wc * 32 + 4 * fq;
#pragma unroll
        for (int ai = 0; ai < 2; ++ai)
#pragma unroll
            for (int m = 0; m < 4; ++m) {
                const int row = u.pm * 256 + ai * 128 + wr * 64 + m * 16 + fr; float ss = 0.f;
#pragma unroll
                for (int bj = 0; bj < 2; ++bj)
#pragma unroll
                    for (int n = 0; n < 2; ++n) {
                        const size_t off = (size_t)row * DM + col0 + bj * 128 + n * 16;
                        const v2u xw = *(const GAS v2u*)(xb + off); const f32x4 xv = {bf_lo(xw.x), bf_hi(xw.x), bf_lo(xw.y), bf_hi(xw.y)};
                        const f32x4 h = DBG_NO_MIX ? xv : xv + acc[ai][bj][m][n];
                        v2u w; w.x = pk2(h[0], h[1]); w.y = pk2(h[2], h[3]); *(GAS v2u*)(h1b + off) = w;
                        ss += (h[0] * h[0] + h[1] * h[1]) + (h[2] * h[2] + h[3] * h[3]);
                    }
                ss += __shfl_xor(ss, 16); ss += __shfl_xor(ss, 32);
                if (fq == 0) atomicAdd(ssq + row, ss);
            }
    }
};
struct EpiG4 {
    static constexpr bool PERM = false, AFTER_DRAIN = false;
    bf16* qp; const float* ssq;
    __device__ __forceinline__ void operator()(const f32x4 (&acc)[2][2][4][2], const pg8::Unit& u, int wr, int wc, int fr, int fq) const {
        const int col0 = u.pn * 256 + wc * 32 + 4 * fq;
#pragma unroll
        for (int ai = 0; ai < 2; ++ai)
#pragma unroll
            for (int m = 0; m < 4; ++m) {
                const int row = u.pm * 256 + ai * 128 + wr * 64 + m * 16 + fr;
                const float rs = 1.0f / sqrtf(__hip_atomic_load(ssq + row, RLX_AGENT) * (1.0f / DM) + EPS);
#pragma unroll
                for (int bj = 0; bj < 2; ++bj)
#pragma unroll
                    for (int n = 0; n < 2; ++n) { const f32x4 v = acc[ai][bj][m][n] * rs; v2u w; w.x = pk2(v[0], v[1]); w.y = pk2(v[2], v[3]); *(GAS v2u*)(qp + (size_t)row * DM + col0 + bj * 128 + n * 16) = w; }
            }
    }
};
struct EpiG5 {
    static constexpr bool PERM = false, AFTER_DRAIN = false;
    const bf16* h2b; const bf16* pp; const float* rstd3; bf16* h3b; float* ssq;
    __device__ __forceinline__ void operator()(const f32x4 (&acc)[2][2][4][2], const pg8::Unit& u, int wr, int wc, int fr, int fq) const {
        const int col0 = u.pn * 256 + wc * 32 + 4 * fq;
#pragma unroll
        for (int ai = 0; ai < 2; ++ai)
#pragma unroll
            for (int m = 0; m < 4; ++m) {
                const int row = u.pm * 256 + ai * 128 + wr * 64 + m * 16 + fr; float ss = 0.f;
                const float rs = rstd3[row];
#pragma unroll
                for (int bj = 0; bj < 2; ++bj)
#pragma unroll
                    for (int n = 0; n < 2; ++n) {
                        const size_t off = (size_t)row * DM + col0 + bj * 128 + n * 16;
                        const f32x4 z = DBG_NO_PLE ? (f32x4){-1e30f, -1e30f, -1e30f, -1e30f} : acc[ai][bj][m][n] * rs; const v2u pw = *(const GAS v2u*)(pp + off); const v2u hw = *(const GAS v2u*)(h2b + off);
                        f32x4 o;
                        o[0] = bf_lo(hw.x) + bf_lo(pw.x) / (1.0f + __expf(-z[0])); o[1] = bf_hi(hw.x) + bf_hi(pw.x) / (1.0f + __expf(-z[1]));
                        o[2] = bf_lo(hw.y) + bf_lo(pw.y) / (1.0f + __expf(-z[2])); o[3] = bf_hi(hw.y) + bf_hi(pw.y) / (1.0f + __expf(-z[3]));
                        v2u w; w.x = pk2(o[0], o[1]); w.y = pk2(o[2], o[3]); *(GAS v2u*)(h3b + off) = w;
                        ss += (o[0] * o[0] + o[1] * o[1]) + (o[2] * o[2] + o[3] * o[3]);
                    }
                ss += __shfl_xor(ss, 16); ss += __shfl_xor(ss, 32);
                if (fq == 0) atomicAdd(ssq + row, ss);
            }
    }
};
struct SingleUnit {
    int pm, pn;
    __device__ __forceinline__ bool next(int i, pg8::Unit& u) const { if (i != 0) return false; u.pm = pm; u.pn = pn; return true; }
    __device__ __forceinline__ void a_ready(const pg8::Unit&) const {}
    __device__ __forceinline__ void done(const pg8::Unit&) const {}
};

__device__ __forceinline__ int crow(int r, int hi) { return (r & 3) + 8 * (r >> 2) + 4 * hi; }
constexpr int KS_STRIDE = 144, VT_STRIDE = 520, VT_OFF = 256 * KS_STRIDE;
__device__ __forceinline__ void attn_unit(Frame& F, int unit) {
    const int g = unit & 3, nblk = (unit >> 2) & 31, b = unit >> 7;
    const int t0 = b * SEQ + nblk * 128;
    LAS unsigned char* Ks = F.lds + RING_OFF;
    LAS unsigned char* Vt = F.lds + RING_OFF + VT_OFF;
    for (int c = F.tid; c < 2048; c += NWAVES * 64) {
        const int j = c >> 3, ch = c & 7;
        v4u kv = {0u, 0u, 0u, 0u}, vv = {0u, 0u, 0u, 0u};
        if (nblk > 0 || j >= 128) { const size_t row = (size_t)(t0 - 128 + j); kv = *(const GAS v4u*)(F_KB + row * KVW + g * 64 + ch * 8); vv = *(const GAS v4u*)(F_VB + row * KVW + g * 64 + ch * 8); }
        *(LAS v4u*)(Ks + j * KS_STRIDE + ch * 16) = kv;
#pragma unroll
        for (int e = 0; e < 8; ++e) *(LAS unsigned short*)(Vt + (ch * 8 + e) * VT_STRIDE + j * 2) = (unsigned short)((vv[e >> 1] >> (16 * (e & 1))) & 0xffffu);
    }
    __syncthreads();
    const int hq = 4 * g + (F.wave >> 1);
    const float sink = F.sinks[hq];
    const int q = F.lane & 31, h = F.lane >> 5;
#pragma unroll 1
    for (int sub = 0; sub < 2; ++sub) {
        const int i0 = (F.wave & 1) * 64 + sub * 32;
        bf16x8 qf[4];
#pragma unroll
        for (int ks = 0; ks < 4; ++ks) qf[ks] = *(const GAS bf16x8*)(F_QB + (size_t)(t0 + i0 + q) * ATTW + hq * 64 + 16 * ks + 8 * h);
        f32x16 s[5];
#pragma unroll
        for (int kt = 0; kt < 5; ++kt) {
#pragma unroll
            for (int r = 0; r < 16; ++r) s[kt][r] = 0.f;
#pragma unroll
            for (int ks = 0; ks < 4; ++ks) {
                const bf16x8 a = *(const LAS bf16x8*)(Ks + (i0 + 32 * kt + q) * KS_STRIDE + (16 * ks + 8 * h) * 2);
                s[kt] = __builtin_amdgcn_mfma_f32_32x32x16_bf16(a, qf[ks], s[kt], 0, 0, 0);
            }
        }
        float mx = sink;
#pragma unroll
        for (int kt = 0; kt < 5; ++kt)
#pragma unroll
            for (int r = 0; r < 16; ++r) {
                const bool tv = (nblk > 0) || (i0 + 32 * kt >= 128);
                const bool ok = (kt == 0) ? (crow(r, h) > q) : (kt == 4) ? (crow(r, h) <= q) : true;
                const float v = (ok && tv) ? s[kt][r] : -INFINITY;
                s[kt][r] = v; mx = fmaxf(mx, v);
            }
        mx = fmaxf(mx, __shfl_xor(mx, 32));
        float sum = 0.f;
#pragma unroll
        for (int kt = 0; kt < 5; ++kt)
#pragma unroll
            for (int r = 0; r < 16; ++r) { const float pv = __expf(s[kt][r] - mx); s[kt][r] = pv; sum += pv; }
        sum += __shfl_xor(sum, 32);
        sum += __expf(sink - mx);
        const float inv = 1.0f / sum;
        f32x16 o[2];
#pragma unroll
        for (int dt = 0; dt < 2; ++dt)
#pragma unroll
            for (int r = 0; r < 16; ++r) o[dt][r] = 0.f;
#pragma unroll
        for (int kt = 0; kt < 5; ++kt)
#pragma unroll
            for (int st = 0; st < 2; ++st) {
                v4u pw; pw.x = pk2(s[kt][8 * st + 0], s[kt][8 * st + 1]); pw.y = pk2(s[kt][8 * st + 2], s[kt][8 * st + 3]); pw.z = pk2(s[kt][8 * st + 4], s[kt][8 * st + 5]); pw.w = pk2(s[kt][8 * st + 6], s[kt][8 * st + 7]);
                const bf16x8 pb = __builtin_bit_cast(bf16x8, pw);
#pragma unroll
                for (int dt = 0; dt < 2; ++dt) {
                    const LAS unsigned char* vb = Vt + (32 * dt + q) * VT_STRIDE + (i0 + 32 * kt + 16 * st + 4 * h) * 2;
                    const v2u lo = *(const LAS v2u*)vb, hi2 = *(const LAS v2u*)(vb + 16);
                    v4u aw; aw.x = lo.x; aw.y = lo.y; aw.z = hi2.x; aw.w = hi2.y;
                    o[dt] = __builtin_amdgcn_mfma_f32_32x32x16_bf16(__builtin_bit_cast(bf16x8, aw), pb, o[dt], 0, 0, 0);
                }
            }
        bf16* orow = F_MIX + (size_t)(t0 + i0 + q) * DM + hq * 64;
#pragma unroll
        for (int dt = 0; dt < 2; ++dt)
#pragma unroll
            for (int g4 = 0; g4 < 4; ++g4) {
                v2u w; w.x = pk2(o[dt][4 * g4] * inv, o[dt][4 * g4 + 1] * inv); w.y = pk2(o[dt][4 * g4 + 2] * inv, o[dt][4 * g4 + 3] * inv);
                *(GAS v2u*)(orow + 32 * dt + 8 * g4 + 4 * h) = w;
            }
    }
    __syncthreads();
}
template <int W> __device__ __forceinline__ void pool_tile_w(Frame& F, int pm, int g) {
    const int cg = F.tid & 31, rg = F.tid >> 5;
    const int r0 = pm * 256 + rg * 16;
    const int col = g * 256 + cg * 8;
    const int tseq0 = r0 & (SEQ - 1);
    const __amdgpu_buffer_rsrc_t rsu = __builtin_amdgcn_make_buffer_rsrc((void*)F_UB, 0, M * POOLW * 2, 0x00020000);
    const __amdgpu_buffer_rsrc_t rsp = __builtin_amdgcn_make_buffer_rsrc((void*)F_POOLED, 0, M * POOLW * 2, 0x00020000);
    v4u rows[W - 1 + 16];
#pragma unroll
    for (int j = 0; j < W - 1 + 16; ++j) { const int rr = r0 - (W - 1) + j; const bool ok = (tseq0 - (W - 1) + j) >= 0;
        rows[j] = __builtin_amdgcn_raw_buffer_load_b128(rsu, ok ? (unsigned)(rr * POOLW + col) * 2u : 0xFFFFFFF0u, 0, 0); }
    float sum[8];
#pragma unroll
    for (int e = 0; e < 8; ++e) sum[e] = 0.f;
#pragma unroll
    for (int j = 0; j < W - 1; ++j)
#pragma unroll
        for (int e = 0; e < 4; ++e) { const unsigned wv = rows[j][e]; sum[2 * e] += bf_lo(wv); sum[2 * e + 1] += bf_hi(wv); }
#pragma unroll
    for (int i = 0; i < 16; ++i) {
        const int ts = tseq0 + i;
        float cur[8];
#pragma unroll
        for (int e = 0; e < 4; ++e) { const unsigned wv = rows[W - 1 + i][e]; cur[2 * e] = bf_lo(wv); cur[2 * e + 1] = bf_hi(wv); }
#pragma unroll
        for (int e = 0; e < 8; ++e) sum[e] += cur[e];
        const int cnt = (ts + 1 < W) ? ts + 1 : W; const float ic = 1.0f / (float)cnt;
        v4u o;
        o.x = pk2(sum[0] * ic - cur[0], sum[1] * ic - cur[1]); o.y = pk2(sum[2] * ic - cur[2], sum[3] * ic - cur[3]);
        o.z = pk2(sum[4] * ic - cur[4], sum[5] * ic - cur[5]); o.w = pk2(sum[6] * ic - cur[6], sum[7] * ic - cur[7]);
        __builtin_amdgcn_raw_buffer_store_b128(o, rsp, (unsigned)((r0 + i) * POOLW + col) * 2u, 0, 0);
#pragma unroll
        for (int e = 0; e < 4; ++e) { const unsigned wv = rows[i][e]; sum[2 * e] -= bf_lo(wv); sum[2 * e + 1] -= bf_hi(wv); }
    }
}
__device__ __forceinline__ void pool_tile(Frame& F, int pm, int g) {
    if (g == 0) pool_tile_w<2>(F, pm, g); else if (g == 1) pool_tile_w<4>(F, pm, g); else if (g == 2) pool_tile_w<8>(F, pm, g); else pool_tile_w<16>(F, pm, g);
}

template <int N> __device__ __forceinline__ void insert_desc(float (&val)[N], float x) {
#pragma unroll
    for (int k = 0; k < N; ++k) { const float hi = max2f(x, val[k]); x = min2f(x, val[k]); val[k] = hi; }
}
__device__ __forceinline__ void bitonic_merge16(float (&m)[16]) {
#pragma unroll
    for (int st = 8; st >= 1; st >>= 1)
#pragma unroll
        for (int i = 0; i < 16; ++i) if ((i & st) == 0) { const float hi = max2f(m[i], m[i + st]), lo = min2f(m[i], m[i + st]); m[i] = hi; m[i + st] = lo; }
}
__device__ __forceinline__ void bitonic_sort16(float (&m)[16]) {
#pragma unroll
    for (int size = 2; size <= 16; size <<= 1)
#pragma unroll
        for (int st = size >> 1; st >= 1; st >>= 1)
#pragma unroll
            for (int i = 0; i < 16; ++i) { const int j = i ^ st; if (j > i) { const bool desc = (i & size) == 0 || size == 16; const float hi = max2f(m[i], m[j]), lo = min2f(m[i], m[j]); m[i] = desc ? hi : lo; m[j] = desc ? lo : hi; } }
}
__device__ __forceinline__ void merge_top16(float (&a)[16], const float (&b)[16]) {
#pragma unroll
    for (int k = 0; k < 16; ++k) a[k] = max2f(a[k], b[15 - k]);
    bitonic_merge16(a);
}
__device__ __forceinline__ void merge_partner16(float (&val)[16]) {
    float pr[16];
#pragma unroll
    for (int k = 0; k < 16; ++k) pr[k] = __shfl_xor(val[k], 32);
#pragma unroll
    for (int k = 0; k < 16; ++k) val[k] = max2f(val[k], pr[15 - k]);
    bitonic_merge16(val);
}
__device__ __forceinline__ void pin16(float (&v)[16]) {
#pragma unroll
    for (int k = 0; k < 16; ++k) asm volatile("" : "+v"(v[k]));
}
struct CandTab { int a[50], b[50]; };
__host__ __device__ constexpr CandTab make_cands() { CandTab t{}; int n = 0; for (int a = 0; a < 16; ++a) for (int b = 0; b < 16; ++b) if ((a + 1) * (b + 1) <= 16) { t.a[n] = a; t.b[n] = b; ++n; } return t; }
__device__ __forceinline__ float vsel(unsigned long long m, float a, float b) { float r; asm("v_cndmask_b32_e64 %0, %1, %2, %3" : "=v"(r) : "v"(b), "v"(a), "s"(m)); return r; }
__device__ __forceinline__ float sel16(const float (&L)[16], int a) { float r = L[0];
#pragma unroll
    for (int k = 1; k < 16; ++k) r = vsel(__ballot(a == k), L[k], r);
    return r; }
constexpr int SK_ROW = 272;
template <int HALF_>
__device__ __forceinline__ void route_stage(Frame& F) {
    for (int c = F.tid; c < 2 * 128 * 16; c += NWAVES * 64) {
        const int tab = c >> 11, row = (c >> 4) & 127, ch = c & 15;
        const v4u v = *(const GAS v4u*)((tab ? F_SKL : F_SKH) + HALF_ * 16384 + row * 128 + ch * 8);
        *(LAS v4u*)(F.lds + RING_OFF + tab * 128 * SK_ROW + row * SK_ROW + ch * 16) = v;
    }
}
template <int HALF_>
__device__ __forceinline__ void route_half(Frame& F, const bf16* qrow, int r, int h, float (&Lout)[16]) {
    f32x16 acc[4];
#pragma unroll
    for (int kt = 0; kt < 4; ++kt)
#pragma unroll
        for (int i = 0; i < 16; ++i) acc[kt][i] = 0.f;
    const LAS unsigned char* skh = F.lds + RING_OFF; const LAS unsigned char* skl = F.lds + RING_OFF + 128 * SK_ROW;
#pragma unroll
    for (int ks = 0; ks < 8; ++ks) {
        const bf16x8 bh = *(const GAS bf16x8*)(qrow + HALF_ * 128 + 16 * ks + 8 * h);
#pragma unroll
        for (int kt = 0; kt < 4; ++kt) {
            const bf16x8 ah = *(const LAS bf16x8*)(skh + (32 * kt + r) * SK_ROW + (16 * ks + 8 * h) * 2), al = *(const LAS bf16x8*)(skl + (32 * kt + r) * SK_ROW + (16 * ks + 8 * h) * 2);
            acc[kt] = __builtin_amdgcn_mfma_f32_32x32x16_bf16(ah, bh, acc[kt], 0, 0, 0);
            acc[kt] = __builtin_amdgcn_mfma_f32_32x32x16_bf16(al, bh, acc[kt], 0, 0, 0);
        }
    }
    float s4[4][16];
#pragma unroll
    for (int kt = 0; kt < 4; ++kt) {
#pragma unroll
        for (int i = 0; i < 16; ++i) { const unsigned n = (unsigned)(32 * kt + (i & 3) + 8 * (i >> 2) + 4 * h); s4[kt][i] = __uint_as_float((__float_as_uint(acc[kt][i]) & ~127u) | n); }
        bitonic_sort16(s4[kt]);
    }
    merge_top16(s4[0], s4[1]); merge_top16(s4[2], s4[3]); merge_top16(s4[0], s4[2]);
#pragma unroll
    for (int k = 0; k < 16; ++k) Lout[k] = s4[0][k];
    merge_partner16(Lout);
}
__device__ __forceinline__ void route_task(Frame& F, int task, bool valid) {
    const int r = F.lane & 31, h = F.lane >> 5;
    const int item = task * 32 + r, tok = item >> 3, head = item & 7;
    const bf16* qrow = F_QP + (size_t)tok * DM + head * 256;
    float L0[16], L1[16];
    __syncthreads(); route_stage<0>(F); __syncthreads();
    if (valid) route_half<0>(F, qrow, r, h, L0);
    __syncthreads(); route_stage<1>(F); __syncthreads();
    if (valid) route_half<1>(F, qrow, r, h, L1);
    if (!valid) return;
    pin16(L0); pin16(L1);
    constexpr CandTab CT = make_cands();
    const unsigned long long hm = __ballot(h != 0);
    float cand[16];
#pragma unroll
    for (int k = 0; k < 16; ++k) cand[k] = -INFINITY;
#pragma unroll
    for (int i = 0; i < 25; ++i) {
        const float v1 = vsel(hm, L0[CT.a[2 * i + 1]], L0[CT.a[2 * i]]);
        const float v2 = vsel(hm, L1[CT.b[2 * i + 1]], L1[CT.b[2 * i]]);
        const unsigned id = h ? (unsigned)(CT.a[2 * i + 1] * 16 + CT.b[2 * i + 1]) : (unsigned)(CT.a[2 * i] * 16 + CT.b[2 * i]);
        const float sm = __uint_as_float(__float_as_uint(v1) & ~127u) + __uint_as_float(__float_as_uint(v2) & ~127u);
        insert_desc<16>(cand, __uint_as_float((__float_as_uint(sm) & ~255u) | id));
    }
    merge_partner16(cand);
    pin16(cand);
    float se = 0.f;
#pragma unroll
    for (int k = 0; k < 16; ++k) se += __expf(cand[k] - cand[0]);
    const float ise = 1.0f / se;
    int eo[8]; float go[8];
#pragma unroll
    for (int kk = 0; kk < 8; ++kk) {
        const float cv = vsel(hm, cand[8 + kk], cand[kk]);
        const unsigned id = __float_as_uint(cv) & 255u; const int a = (int)(id >> 4), bb = (int)(id & 15u);
        const unsigned i1 = __float_as_uint(sel16(L0, a)) & 127u, i2 = __float_as_uint(sel16(L1, bb)) & 127u;
        eo[kk] = (int)(i1 * 128u + i2); go[kk] = __expf(cv - cand[0]) * ise;
    }
    int* ep = F_EIDX + (size_t)tok * 128 + head * 16 + 8 * h; float* gp = F_GATE + (size_t)tok * 128 + head * 16 + 8 * h;
    *(GAS v4u*)ep = (v4u){(unsigned)eo[0], (unsigned)eo[1], (unsigned)eo[2], (unsigned)eo[3]}; *(GAS v4u*)(ep + 4) = (v4u){(unsigned)eo[4], (unsigned)eo[5], (unsigned)eo[6], (unsigned)eo[7]};
    *(GAS f32x4*)gp = (f32x4){go[0], go[1], go[2], go[3]}; *(GAS f32x4*)(gp + 4) = (f32x4){go[4], go[5], go[6], go[7]};
}


template <int N> __device__ __forceinline__ void treduce(float (&v)[N], int lane, int d) {
    const bool up = (lane & d) != 0;
#pragma unroll
    for (int i = 0; i < N / 2; ++i) { const float send = up ? v[i] : v[i + N / 2], keep = up ? v[i + N / 2] : v[i]; v[i] = keep + __shfl_xor(send, d); }
}
constexpr int SLICE_BYTES = NEXP * 128;
constexpr int NSLICE = 16;
#ifndef PEER_SLICE_BARRIER
#define PEER_SLICE_BARRIER 0
#endif
typedef float f32x2v __attribute__((ext_vector_type(2)));
__device__ __forceinline__ void peer_phase(Frame& F) {
    const int lane = F.lane, g = lane >> 3, p = lane & 7;
    const int tbase = (int)blockIdx.x * 32 + F.wave * 4;
    LAS float* alds = (LAS float*)(F.lds + RING_OFF + F.wave * 2048);
    const __amdgpu_buffer_rsrc_t rsu = __builtin_amdgcn_make_buffer_rsrc((void*)F_EU, 0, NEXP * DM, 0x00020000);
    const __amdgpu_buffer_rsrc_t rsv = __builtin_amdgcn_make_buffer_rsrc((void*)F_EV, 0, NEXP * DM, 0x00020000);
    const __amdgpu_buffer_rsrc_t rsx = __builtin_amdgcn_make_buffer_rsrc((void*)F_H1B, 0, M * DM * 2, 0x00020000);
    const __amdgpu_buffer_rsrc_t rsb = __builtin_amdgcn_make_buffer_rsrc((void*)F_H2B, 0, M * DM * 2, 0x00020000);
    const unsigned p16 = (unsigned)p * 16u;
    const unsigned cl = (unsigned)(16 * p + 8 * (g & 1) + 4 * ((g >> 1) & 1) + 2 * ((g >> 2) & 1));
    for (int tb = tbase; tb < M; tb += F.G * 32) {
        unsigned ev[4][8];
        float hacc[4][2];
#pragma unroll
        for (int tk = 0; tk < 4; ++tk) {
#pragma unroll
            for (int i = 0; i < 8; ++i) ev[tk][i] = (unsigned)F_EIDX[(size_t)(tb + tk) * 128 + 16 * i + g] | ((unsigned)F_EIDX[(size_t)(tb + tk) * 128 + 16 * i + 8 + g] << 16);
            hacc[tk][0] = 0.f; hacc[tk][1] = 0.f;
        }
#define PEER_VOFF(TK, i) ({ unsigned e_ = ev[TK][(i) >> 1]; asm volatile("" : "+v"(e_)); ((((i) & 1) ? (e_ >> 16) : (e_ & 0xffffu)) * 128u + p16); })
#define PEER_LOAD_X(X0, X1, S, TK) do { X0 = __builtin_amdgcn_raw_buffer_load_b128(rsx, 2u * p16, ((tb + (TK)) * DM + 128 * (S)) * 2, 0); X1 = __builtin_amdgcn_raw_buffer_load_b128(rsx, 2u * p16 + 16u, ((tb + (TK)) * DM + 128 * (S)) * 2, 0); } while (0)
#define PEER_LOAD_A(W, S, TK, H) do { _Pragma("unroll") for (int i = 0; i < 8; ++i) W[i] = __builtin_amdgcn_raw_buffer_load_b128(rsu, PEER_VOFF(TK, 8 * (H) + i), (S) * SLICE_BYTES, 0); } while (0)
#define PEER_COMP_A(W, H) do { \
        _Pragma("unroll") for (int i = 0; i < 8; ++i) { f32x2v a2 = {0.f, 0.f}; \
            _Pragma("unroll") for (int c = 0; c < 4; ++c) { const int wv = (int)W[i][c]; const f32x2v lo = __builtin_amdgcn_cvt_pk_f32_fp8(wv, false), hi = __builtin_amdgcn_cvt_pk_f32_fp8(wv, true); \
                a2 += lo * xf2[2 * c]; a2 += hi * xf2[2 * c + 1]; } \
            part[8 * (H) + i] = a2.x + a2.y; if (i & 1) __builtin_amdgcn_sched_barrier(0); } } while (0)
        for (int rep = 0; rep < NREP(6); ++rep) {
#pragma unroll
            for (int tk = 0; tk < 4; ++tk) { hacc[tk][0] = 0.f; hacc[tk][1] = 0.f; }
#pragma unroll 1
            for (int s = 0; s < NSLICE; ++s) {
#pragma unroll
                for (int tk = 0; tk < 4; ++tk) {
                    v4u w0[8], w1[8], x0, x1; f32x2v xf2[8]; float part[16];
                    PEER_LOAD_X(x0, x1, s, tk); PEER_LOAD_A(w0, s, tk, 0); PEER_LOAD_A(w1, s, tk, 1); __builtin_amdgcn_sched_barrier(0);
#pragma unroll
                    for (int c = 0; c < 4; ++c) { const unsigned a0 = x0[c], a1 = x1[c]; xf2[c] = (f32x2v){bf_lo(a0), bf_hi(a0)}; xf2[4 + c] = (f32x2v){bf_lo(a1), bf_hi(a1)}; }
                    PEER_COMP_A(w0, 0); __builtin_amdgcn_sched_barrier(0);
                    PEER_COMP_A(w1, 1); __builtin_amdgcn_sched_barrier(0);
                    treduce<16>(part, lane, 1); treduce<8>(reinterpret_cast<float (&)[8]>(part), lane, 2); treduce<4>(reinterpret_cast<float (&)[4]>(part), lane, 4);
                    hacc[tk][0] += part[0]; hacc[tk][1] += part[1]; __builtin_amdgcn_sched_barrier(0);
                }
                if (PEER_SLICE_BARRIER) __builtin_amdgcn_s_barrier();
            }
        }
#undef PEER_LOAD_X
#undef PEER_LOAD_A
#undef PEER_COMP_A
#pragma unroll
        for (int tk = 0; tk < 4; ++tk) {
            const int t = tb + tk;
            const float rs2 = (1.0f / EU_SCALE) / sqrtf(__hip_atomic_load(F_SSQ2 + t, RLX_AGENT) * (1.0f / DM) + EPS);
#pragma unroll
            for (int j = 0; j < 2; ++j) {
                const int i = 8 * (p & 1) + 4 * ((p >> 1) & 1) + 2 * ((p >> 2) & 1) + j;
                const float hv = hacc[tk][j] * rs2;
                const float ge = 0.5f * hv * (1.0f + erff(hv * 0.70710678118654752f));
                alds[tk * 128 + g * 16 + i] = F_GATE[(size_t)t * 128 + 8 * i + g] * ge * (1.0f / EV_SCALE);
            }
        }
        LDS_WAIT(); asm volatile("" ::: "memory");
        float ssq[4] = {0.f, 0.f, 0.f, 0.f};
        constexpr int NREPB = ((REP_MASK >> 9) & 1) ? 2 : 1;
        for (int repb = 0; repb < NREPB; ++repb) {
#pragma unroll
        for (int tk = 0; tk < 4; ++tk) ssq[tk] = 0.f;
#define PEER_LOAD_B(W, S, TK, H) do { _Pragma("unroll") for (int i = 0; i < 8; ++i) W[i] = __builtin_amdgcn_raw_buffer_load_b128(rsv, PEER_VOFF(TK, 8 * (H) + i), (S) * SLICE_BYTES, 0); } while (0)
#define PEER_COMP_B(W, TK, H) do { f32x4 av[2]; \
        _Pragma("unroll") for (int q4 = 0; q4 < 2; ++q4) av[q4] = *(const LAS f32x4*)(alds + (TK) * 128 + g * 16 + 8 * (H) + 4 * q4); \
        _Pragma("unroll") for (int i = 0; i < 8; ++i) { const float a = av[i >> 2][i & 3] * (1.0f / NREPB); const f32x2v a2 = {a, a}; \
            _Pragma("unroll") for (int c = 0; c < 4; ++c) { const int wv = (int)W[i][c]; const f32x2v lo = __builtin_amdgcn_cvt_pk_f32_fp8(wv, false), hi = __builtin_amdgcn_cvt_pk_f32_fp8(wv, true); \
                oc2[2 * c] += a2 * lo; oc2[2 * c + 1] += a2 * hi; } if (i & 1) __builtin_amdgcn_sched_barrier(0); } } while (0)
        {
#pragma unroll 1
            for (int s = 0; s < NSLICE; ++s) {
#pragma unroll
                for (int tk = 0; tk < 4; ++tk) {
                    v4u w0[8], w1[8]; f32x2v oc2[8]; float oc[16];
                    const int so = (tb + tk) * DM + 128 * s;
                    PEER_LOAD_B(w0, s, tk, 0); PEER_LOAD_B(w1, s, tk, 1);
                    const unsigned hv2 = __builtin_amdgcn_raw_buffer_load_b32(rsx, cl * 2u, so * 2, 0);
                    __builtin_amdgcn_sched_barrier(0);
#pragma unroll
                    for (int c = 0; c < 8; ++c) oc2[c] = (f32x2v){0.f, 0.f};
                    PEER_COMP_B(w0, tk, 0); __builtin_amdgcn_sched_barrier(0);
                    PEER_COMP_B(w1, tk, 1); __builtin_amdgcn_sched_barrier(0);
#pragma unroll
                    for (int c = 0; c < 8; ++c) { oc[2 * c] = oc2[c].x; oc[2 * c + 1] = oc2[c].y; }
                    treduce<16>(oc, lane, 8); treduce<8>(reinterpret_cast<float (&)[8]>(oc), lane, 16); treduce<4>(reinterpret_cast<float (&)[4]>(oc), lane, 32);
                    const float h2a = bf_lo(hv2) + oc[0], h2b = bf_hi(hv2) + oc[1];
                    __builtin_amdgcn_raw_buffer_store_b32(pk2(h2a, h2b), rsb, cl * 2u, so * 2, 0); ssq[tk] += h2a * h2a + h2b * h2b;
                    __builtin_amdgcn_sched_barrier(0);
                }
                if (PEER_SLICE_BARRIER) __builtin_amdgcn_s_barrier();
            }
        }
        }
#undef PEER_LOAD_B
#undef PEER_COMP_B
#pragma unroll
        for (int tk = 0; tk < 4; ++tk) { const float ss = wave_sum(ssq[tk]); if (lane == 0) F_RSTD3[tb + tk] = 1.0f / sqrtf(ss * (1.0f / DM) + EPS); }
        LDS_WAIT(); asm volatile("" ::: "memory");
    }
}

struct Args { const void* in[18]; float* out; unsigned char* ws; int ph_lo, ph_hi, li, pad; };
__global__ void __launch_bounds__(NWAVES * 64, 2) hymba_fwd(Args args) {
    extern __shared__ __attribute__((aligned(16))) unsigned char lds[];
    Frame F;
    F.lds = (LAS unsigned char*)lds;
    F.MISC = (volatile LAS unsigned*)(F.lds + MISC_OFF);
    F.tid = threadIdx.x; F.lane = F.tid & 63; F.wave = __builtin_amdgcn_readfirstlane(F.tid >> 6);
    F.G = gridDim.x; { const int bx = blockIdx.x; F.vcu = (F.G % 8 == 0) ? (bx % 8) * (F.G / 8) + bx / 8 : bx; }
    F.ws = args.ws;
    F.ctl = (gu32*)(F.ws + WS_CTL);
    F.x = (const float*)args.in[0]; F.p = (const float*)args.in[1]; F.positions = (const int*)args.in[2]; F.g_mix = (const float*)args.in[3]; F.w_in = (const float*)args.in[4];
    F.sinks = (const float*)args.in[5]; F.w_pool = (const float*)args.in[6]; F.pool_scale = (const float*)args.in[7]; F.w_out = (const float*)args.in[8]; F.g_ffn = (const float*)args.in[9];
    F.w_query = (const float*)args.in[10]; F.sub_keys = (const float*)args.in[11]; F.expert_u = (const float*)args.in[12]; F.expert_v = (const float*)args.in[13]; F.g_ple = (const float*)args.in[14];
    F.w_ple_gate = (const float*)args.in[15]; F.w_ple_proj = (const float*)args.in[16]; F.g_final = (const float*)args.in[17]; F.out = args.out;
    for (int u = F.tid; u < (LDS_BYTES - LDSCTL_OFF) / 4; u += NWAVES * 64) ((LAS unsigned*)(F.lds + LDSCTL_OFF))[u] = 0u;
    __syncthreads();
    const bool one_phase = (args.ph_hi - args.ph_lo) == 1;
    XcdBarrier bar; bar.bar = (unsigned*)(F.ctl + CW_BAR); bar.x = 0; bar.st = nullptr;
    if (!one_phase) bar = xcd_barrier_post((unsigned*)(F.ctl + CW_BAR), F.MISC + 8);
    const int lo = args.ph_lo, hi = args.ph_hi;
#define IN(k) (lo <= (k) && (k) < hi)
#define BOTH(k) (IN(k) && IN((k) + 1))
#define GRID_BAR() xcd_barrier(bar)

    if (IN(0)) { for (int rep = 0; rep < NREP(0); ++rep) p0_prologue(F); p1_queue(F, 0, Q_SPLIT, CW_QUEUE0); if (BOTH(0)) GRID_BAR(); }

    if (IN(1)) {
#if (REP_MASK >> 1) & 1
        { pg8::Gemm g{F_XB, F_Win_t, M, INW, DM, DM, DM}; pg8::StaticOrder S; S.init(M, INW, F.G, (int)blockIdx.x);
          EpiG1 E{F_QB, F_KB, F_VB, F_UB, F_RSTD1, F_ROPE};
          pg8::gemm_phase<EpiG1, pg8::StaticOrder, true, true>(F.lds + RING_OFF, g, S, E); }
        __syncthreads();
#endif
        const int nconv = (F.G == 256) ? NCONV : 0;
        if ((int)blockIdx.x >= nconv) {
        { pg8::Gemm g{F_XB, F_Win_t, M, INW, DM, DM, DM}; pg8::StaticOrder S; S.init(M, INW, F.G - nconv, (int)blockIdx.x - nconv);
          EpiG1 E{F_QB, F_KB, F_VB, F_UB, F_RSTD1, F_ROPE};
          pg8::gemm_phase<EpiG1, pg8::StaticOrder, true, true>(F.lds + RING_OFF, g, S, E); }
        { pg8::Gemm g{F_PB, F_Wp_t, M, DM, PLE, PLE, PLE}; PpOrder S; S.init(F.G, (int)blockIdx.x, nconv);
          EpiBf16Scale<false> E{F_PP, DM, 0, nullptr};
          pg8::gemm_phase<EpiBf16Scale<false>, PpOrder, false, true>(F.lds + RING_OFF, g, S, E); }
        }
        p1_queue(F, Q_SPLIT, Q_ITEMS, CW_QUEUE);
#if (REP_MASK >> 10) & 1
        p1_queue(F, 0, Q_ITEMS, CW_QUEUE0);
#endif
        if (BOTH(1)) GRID_BAR();
    }

    if (IN(2)) {
#if (REP_MASK >> 2) & 1
        if (F.G >= 256) { if ((int)blockIdx.x >= 128) for (int u = (int)blockIdx.x - 128; u < BATCH * 32 * NKVH; u += F.G - 128) attn_unit(F, u); }
#endif
        if (F.G >= 256) { if ((int)blockIdx.x >= 128) for (int u = (int)blockIdx.x - 128; u < BATCH * 32 * NKVH; u += F.G - 128) attn_unit(F, u); }
        else for (int u = (int)blockIdx.x; u < BATCH * 32 * NKVH; u += F.G) attn_unit(F, u);
        if ((int)blockIdx.x < 128) {
            const int pu = (int)blockIdx.x, pm = pu >> 2, g = pu & 3;
            pool_tile(F, pm, g);
            VM_WAIT(); __syncthreads();
            pg8::Gemm gm{F_POOLED + g * 256, F_Wpool_t + (size_t)g * 65536, M, 256, 256, POOLW, 256}; SingleUnit S{pm, 0};
            EpiBf16Scale<true> E{F_MIX, DM, ATTW + g * 256, F.pool_scale + g * 256};
            pg8::gemm_phase<EpiBf16Scale<true>, SingleUnit, false, true>(F.lds + RING_OFF, gm, S, E);
            __syncthreads();
        }
        if (BOTH(2)) GRID_BAR();
    }

    if (IN(3)) {
        pg8::Gemm g{F_MIX, F_Wout_t, M, DM, DM, DM, DM}; pg8::StaticOrder S; S.init(M, DM, F.G, (int)blockIdx.x);
#if (REP_MASK >> 3) & 1
        { EpiG3 E2{F_XB, F_H1B, (float*)(F.ws + WS_END)}; pg8::gemm_phase<EpiG3, pg8::StaticOrder, true, true>(F.lds + RING_OFF, g, S, E2); __syncthreads(); }
#endif
        EpiG3 E{F_XB, F_H1B, F_SSQ2};
        pg8::gemm_phase<EpiG3, pg8::StaticOrder, true, true>(F.lds + RING_OFF, g, S, E);
        if (BOTH(3)) GRID_BAR();
    }

    if (IN(4)) {
        pg8::Gemm g{F_H1B, F_Wq_t, M, DM, DM, DM, DM}; pg8::StaticOrder S; S.init(M, DM, F.G, (int)blockIdx.x);
        EpiG4 E{F_QP, F_SSQ2};
        for (int rep = 0; rep < NREP(4); ++rep)
        pg8::gemm_phase<EpiG4, pg8::StaticOrder, true, true>(F.lds + RING_OFF, g, S, E);
        if (BOTH(4)) GRID_BAR();
    }

    if (IN(5)) {
        for (int rep = 0; rep < NREP(5); ++rep)
        for (int base = (int)blockIdx.x * NWAVES; base < M * PKH / 32; base += F.G * NWAVES) { const int task = base + F.wave; route_task(F, task < M * PKH / 32 ? task : 0, task < M * PKH / 32); }
        __syncthreads();
        if (BOTH(5)) GRID_BAR();
    }

    if (IN(6)) {
        peer_phase(F);
        __syncthreads();
        if (BOTH(6)) GRID_BAR();
    }

    if (IN(7)) {
        pg8::Gemm g{F_H2B, F_Wg_t, M, DM, DM, DM, DM}; pg8::StaticOrder S; S.init(M, DM, F.G, (int)blockIdx.x);
#if (REP_MASK >> 7) & 1
        { EpiG5 E2{F_H2B, F_PP, F_RSTD3, F_H1B, (float*)(F.ws + WS_END)}; pg8::gemm_phase<EpiG5, pg8::StaticOrder, true, true>(F.lds + RING_OFF, g, S, E2); __syncthreads(); }
#endif
        EpiG5 E{F_H2B, F_PP, F_RSTD3, F_H1B, F_SSQ4};
        pg8::gemm_phase<EpiG5, pg8::StaticOrder, true, true>(F.lds + RING_OFF, g, S, E);
        if (BOTH(7)) GRID_BAR();
    }

    if (IN(8)) {
        const int gw = F.vcu * NWAVES + F.wave, NGW = F.G * NWAVES;
        for (int m = gw; m < M; m += NGW) {
            const float rs = 1.0f / sqrtf(__hip_atomic_load(F_SSQ4 + m, RLX_AGENT) * (1.0f / DM) + EPS);
            GAS f32x4* orow = (GAS f32x4*)(F.out + (size_t)m * DM) + F.lane; const GAS f32x4* gr = (const GAS f32x4*)F.g_final + F.lane; const GAS v2u* hr = (const GAS v2u*)(F_H1B + (size_t)m * DM) + F.lane;
#pragma unroll
            for (int j = 0; j < 8; ++j) { const v2u hw = hr[64 * j]; const f32x4 v = {bf_lo(hw.x), bf_hi(hw.x), bf_lo(hw.y), bf_hi(hw.y)}; orow[64 * j] = v * rs * gr[64 * j]; }
        }
    }
#undef IN
#undef BOTH
#undef GRID_BAR
}


extern "C" void kernel_launch(void* const* d_in, const int* in_sizes, int n_in, void* d_out, int out_size, void* d_ws, size_t ws_size, hipStream_t stream) {
    static int grid = 0;
    if (grid == 0) {
        if (n_in != 18 || out_size != M * DM || ws_size < WS_END + 65536) { fprintf(stderr, "kernel_launch: unexpected shapes (n_in %d, out %d, ws %zu)\n", n_in, out_size, ws_size); grid = -1; return; }
        int dev = 0, cus = 0, per_cu = 0;
        if (hipGetDevice(&dev) != hipSuccess || hipDeviceGetAttribute(&cus, hipDeviceAttributeMultiprocessorCount, dev) != hipSuccess) { grid = -1; return; }
        if (hipFuncSetAttribute((const void*)hymba_fwd, hipFuncAttributeMaxDynamicSharedMemorySize, LDS_BYTES) != hipSuccess) { fprintf(stderr, "kernel_launch: hipFuncSetAttribute failed\n"); grid = -1; return; }
        if (hipOccupancyMaxActiveBlocksPerMultiprocessor(&per_cu, (const void*)hymba_fwd, NWAVES * 64, LDS_BYTES) != hipSuccess || per_cu < 1)
            fprintf(stderr, "kernel_launch: note: occupancy query reports %d workgroups per CU\n", per_cu);
        (void)hipGetLastError();
        if (cus < 128) { fprintf(stderr, "kernel_launch: needs >= 128 CUs\n"); grid = -1; return; }
        grid = cus;
    }
    if (grid < 0) return;
    if (hipMemsetAsync((char*)d_ws + WS_CTL, 0, CTL_ZERO_BYTES, stream) != hipSuccess) return;
    Args a{};
    for (int i = 0; i < 18; ++i) a.in[i] = d_in[i];
    a.out = (float*)d_out; a.ws = (unsigned char*)d_ws;
    constexpr int NL = MK_N_LAUNCHES;
    for (int li = 0; li < NL; ++li) {
        a.ph_lo = (NL == 1) ? 0 : li; a.ph_hi = (NL == 1) ? N_PHASES : li + 1; a.li = li;
        hipLaunchKernelGGL(hymba_fwd, dim3(grid), dim3(NWAVES * 64), LDS_BYTES, stream, a);
    }
}
```
